# Optimizing an MI355X kernel written in HIP

```python
import math
import jax, jax.numpy as jnp
from jax import lax
import numpy as np

D_MODEL = 2048
BATCH = 4
SEQ = 2048
DEPTH = 1
DEC_BATCH = 128
DEC_SEQ = 4
PAST_LEN = 16384
PAGE_SIZE = 128

E_CONV = D_MODEL // 2
CONV_W = 3
E_SSM = D_MODEL // 2
GROUP = 16
N_GROUPS = E_SSM // GROUP
P_STATE = 64
N_HEADS = 4
HEAD_DIM = D_MODEL // 8
E_ATTN = N_HEADS * HEAD_DIM
MEM_LEN = 256
N_BRANCH = 3
N_IN = 4 * E_CONV + 2 * E_SSM + 2 * E_ATTN + N_BRANCH * D_MODEL
EPS = 1e-6

kernel_name = "hybrid_conv_s5_memxattn_decode_step"


def _rmsnorm(x, g):
    x32 = x.astype(jnp.float32)
    y = x32 * lax.rsqrt(jnp.mean(x32 * x32, axis=-1, keepdims=True) + EPS)
    return (y * g.astype(jnp.float32)).astype(x.dtype)


def _split_points():
    sizes = [E_CONV, E_CONV, E_CONV, E_CONV, E_SSM, E_SSM, E_ATTN, E_ATTN]
    return list(np.cumsum(sizes))


def _combine(e1, e2):
    a1r, a1i, b1r, b1i = e1
    a2r, a2i, b2r, b2i = e2
    ar = a1r * a2r - a1i * a2i
    ai = a1r * a2i + a1i * a2r
    br = a2r * b1r - a2i * b1i + b2r
    bi = a2r * b1i + a2i * b1r + b2i
    return (ar, ai, br, bi)


def _s5(u, s0_re, s0_im, lam_re, lam_im, log_dt, b_re, b_im, c_re, c_im, d_skip):
    bsz, L, _ = u.shape
    u32 = u.astype(jnp.float32).reshape(bsz, L, N_GROUPS, GROUP)
    dt = jnp.exp(log_dt.astype(jnp.float32))[:, None]
    lr = lam_re.astype(jnp.float32)
    li = lam_im.astype(jnp.float32)
    mag = jnp.exp(lr * dt)
    ang = li * dt
    ar = mag * jnp.cos(ang)
    ai = mag * jnp.sin(ang)
    den = lr * lr + li * li
    fr = ((ar - 1.0) * lr + ai * li) / den
    fi = (ai * lr - (ar - 1.0) * li) / den
    br32 = b_re.astype(jnp.float32)
    bi32 = b_im.astype(jnp.float32)
    bbr = fr[..., None] * br32 - fi[..., None] * bi32
    bbi = fr[..., None] * bi32 + fi[..., None] * br32
    xr = jnp.einsum('blgc,gpc->blgp', u32, bbr)
    xi = jnp.einsum('blgc,gpc->blgp', u32, bbi)
    s0r = s0_re.astype(jnp.float32)
    s0i = s0_im.astype(jnp.float32)
    xr = xr.at[:, 0].add(ar * s0r - ai * s0i)
    xi = xi.at[:, 0].add(ar * s0i + ai * s0r)
    a_r = jnp.broadcast_to(ar, xr.shape)
    a_i = jnp.broadcast_to(ai, xr.shape)
    _, _, sr, si = lax.associative_scan(_combine, (a_r, a_i, xr, xi), axis=1)
    y = (jnp.einsum('blgp,gcp->blgc', sr, c_re.astype(jnp.float32))
         - jnp.einsum('blgp,gcp->blgc', si, c_im.astype(jnp.float32)))
    y = y.reshape(bsz, L, E_SSM) + d_skip.astype(jnp.float32) * u32.reshape(bsz, L, E_SSM)
    return y.astype(u.dtype), sr[:, -1], si[:, -1]


def _layer(x, mem_k, mem_v, conv_prev, s_re, s_im, p):
    bsz, L, _ = x.shape
    h = _rmsnorm(x, p['norm_g'])
    proj = h @ p['w_in']
    cb, cc, ch, cz, su, sz, aq, az, gpre = jnp.split(proj, _split_points(), axis=-1)

    v = cc * ch
    pad = jnp.concatenate([conv_prev.astype(v.dtype), v], axis=1)
    w = p['conv_w']
    conv = w[0] * pad[:, :L] + w[1] * pad[:, 1:L + 1] + w[2] * pad[:, 2:L + 2]
    conv_out = (cb * conv * jax.nn.silu(cz)) @ p['w_conv_out']
    new_conv = pad[:, L:]

    ys, new_re, new_im = _s5(su, s_re, s_im, p['lam_re'], p['lam_im'], p['log_dt'],
                             p['b_re'], p['b_im'], p['c_re'], p['c_im'], p['d_skip'])
    ys = jax.nn.gelu(ys * jax.nn.silu(sz))
    ssm_out = (ys @ p['w_glu_a']) * jax.nn.sigmoid(ys @ p['w_glu_b'])

    q = aq.reshape(bsz, L, N_HEADS, HEAD_DIM)
    scores = jnp.einsum('blhd,bmhd->bhlm', q, mem_k).astype(jnp.float32) * (HEAD_DIM ** -0.5)
    probs = jax.nn.softmax(scores, axis=-1).astype(mem_v.dtype)
    o = jnp.einsum('bhlm,bmhd->blhd', probs, mem_v).reshape(bsz, L, E_ATTN)
    attn_out = (o * jax.nn.silu(az)) @ p['w_attn_out']

    g = jax.nn.sigmoid(gpre).reshape(bsz, L, N_BRANCH, D_MODEL)
    merged = g[:, :, 0] * conv_out + g[:, :, 1] * ssm_out + g[:, :, 2] * attn_out
    return x + merged @ p['w_out'], new_conv, new_re, new_im


def setup_inputs(seed: int = 0) -> dict:
    key = jax.random.key(seed)
    ks = jax.random.split(key, 32)
    f = jnp.float32
    nrm = lambda k, shape, s: jax.random.normal(k, shape, f) * s
    lam_im0 = math.pi * jnp.arange(P_STATE, dtype=f)
    return {
        'x_prompt': nrm(ks[0], (BATCH, SEQ, D_MODEL), 1.0),
        'x_sample': nrm(ks[1], (DEC_BATCH, DEC_SEQ, D_MODEL), 1.0),
        'mem_prompt': nrm(ks[2], (BATCH, MEM_LEN, D_MODEL), 1.0),
        'cache_mem_k': nrm(ks[3], (DEPTH, DEC_BATCH, MEM_LEN, N_HEADS, HEAD_DIM), 1.0),
        'cache_mem_v': nrm(ks[4], (DEPTH, DEC_BATCH, MEM_LEN, N_HEADS, HEAD_DIM), 1.0),
        'state_conv': nrm(ks[5], (DEPTH, DEC_BATCH, CONV_W - 1, E_CONV), 0.5),
        'state_ssm_re': nrm(ks[6], (DEPTH, DEC_BATCH, N_GROUPS, P_STATE), 0.5),
        'state_ssm_im': nrm(ks[7], (DEPTH, DEC_BATCH, N_GROUPS, P_STATE), 0.5),
        'norm_g': 1.0 + nrm(ks[8], (DEPTH, D_MODEL), 0.02),
        'mem_norm_g': 1.0 + nrm(ks[9], (DEPTH, D_MODEL), 0.02),
        'w_in': nrm(ks[10], (DEPTH, D_MODEL, N_IN), D_MODEL ** -0.5),
        'conv_w': nrm(ks[11], (DEPTH, CONV_W, E_CONV), CONV_W ** -0.5),
        'w_conv_out': nrm(ks[12], (DEPTH, E_CONV, D_MODEL), E_CONV ** -0.5),
        'ssm_lambda_re': -0.5 + nrm(ks[13], (DEPTH, N_GROUPS, P_STATE), 0.01),
        'ssm_lambda_im': lam_im0 + nrm(ks[14], (DEPTH, N_GROUPS, P_STATE), 0.01),
        'ssm_log_dt': jax.random.uniform(ks[15], (DEPTH, N_GROUPS), f, math.log(1e-3), math.log(1e-1)),
        'ssm_b_re': nrm(ks[16], (DEPTH, N_GROUPS, P_STATE, GROUP), GROUP ** -0.5),
        'ssm_b_im': nrm(ks[17], (DEPTH, N_GROUPS, P_STATE, GROUP), GROUP ** -0.5),
        'ssm_c_re': nrm(ks[18], (DEPTH, N_GROUPS, GROUP, P_STATE), P_STATE ** -0.5),
        'ssm_c_im': nrm(ks[19], (DEPTH, N_GROUPS, GROUP, P_STATE), P_STATE ** -0.5),
        'ssm_d': 1.0 + nrm(ks[20], (DEPTH, E_SSM), 0.1),
        'w_glu_a': nrm(ks[21], (DEPTH, E_SSM, D_MODEL), E_SSM ** -0.5),
        'w_glu_b': nrm(ks[22], (DEPTH, E_SSM, D_MODEL), E_SSM ** -0.5),
        'w_mem_k': nrm(ks[23], (DEPTH, D_MODEL, E_ATTN), D_MODEL ** -0.5),
        'w_mem_v': nrm(ks[24], (DEPTH, D_MODEL, E_ATTN), D_MODEL ** -0.5),
        'w_attn_out': nrm(ks[25], (DEPTH, E_ATTN, D_MODEL), E_ATTN ** -0.5),
        'w_out': nrm(ks[26], (DEPTH, D_MODEL, D_MODEL), D_MODEL ** -0.5),
        'final_norm_g': 1.0 + nrm(ks[27], (D_MODEL,), 0.02),
    }


def reference(x_prompt, x_sample, mem_prompt, cache_mem_k, cache_mem_v, state_conv,
              state_ssm_re, state_ssm_im, norm_g, mem_norm_g, w_in, conv_w, w_conv_out,
              ssm_lambda_re, ssm_lambda_im, ssm_log_dt, ssm_b_re, ssm_b_im, ssm_c_re,
              ssm_c_im, ssm_d, w_glu_a, w_glu_b, w_mem_k, w_mem_v, w_attn_out, w_out,
              final_norm_g):
    xp = x_prompt
    xs = x_sample
    mk_p, mv_p, cv_p, sr_p, si_p = [], [], [], [], []
    cv_s, sr_s, si_s = [], [], []
    for l in range(DEPTH):
        p = {
            'norm_g': norm_g[l], 'w_in': w_in[l], 'conv_w': conv_w[l],
            'w_conv_out': w_conv_out[l], 'lam_re': ssm_lambda_re[l],
            'lam_im': ssm_lambda_im[l], 'log_dt': ssm_log_dt[l], 'b_re': ssm_b_re[l],
            'b_im': ssm_b_im[l], 'c_re': ssm_c_re[l], 'c_im': ssm_c_im[l],
            'd_skip': ssm_d[l], 'w_glu_a': w_glu_a[l], 'w_glu_b': w_glu_b[l],
            'w_attn_out': w_attn_out[l], 'w_out': w_out[l],
        }
        mem_n = _rmsnorm(mem_prompt, mem_norm_g[l])
        mk = (mem_n @ w_mem_k[l]).reshape(BATCH, MEM_LEN, N_HEADS, HEAD_DIM)
        mv = (mem_n @ w_mem_v[l]).reshape(BATCH, MEM_LEN, N_HEADS, HEAD_DIM)
        zc = jnp.zeros((BATCH, CONV_W - 1, E_CONV), xp.dtype)
        zs = jnp.zeros((BATCH, N_GROUPS, P_STATE), jnp.float32)
        xp, ncp, nrp, nip = _layer(xp, mk, mv, zc, zs, zs, p)
        mk_p.append(mk); mv_p.append(mv); cv_p.append(ncp); sr_p.append(nrp); si_p.append(nip)
        xs, ncs, nrs, nis = _layer(xs, cache_mem_k[l], cache_mem_v[l], state_conv[l],
                                   state_ssm_re[l], state_ssm_im[l], p)
        cv_s.append(ncs); sr_s.append(nrs); si_s.append(nis)
    y_prompt = _rmsnorm(xp, final_norm_g)
    y_sample = _rmsnorm(xs, final_norm_g)
    return (y_prompt, y_sample, jnp.stack(mk_p), jnp.stack(mv_p), jnp.stack(cv_p),
            jnp.stack(sr_p), jnp.stack(si_p), jnp.stack(cv_s), jnp.stack(sr_s),
            jnp.stack(si_s))
```

```cpp
#include <hip/hip_runtime.h>
#include <hip/hip_cooperative_groups.h>
#include <cstdio>
namespace cg = cooperative_groups;

#define LAS __attribute__((address_space(3)))
typedef unsigned short bf16_t;
typedef short bf16x8 __attribute__((ext_vector_type(8)));
typedef float f32x4 __attribute__((ext_vector_type(4)));
typedef unsigned u32x4 __attribute__((ext_vector_type(4)));
typedef unsigned u32x2 __attribute__((ext_vector_type(2)));

constexpr int DM = 2048, NPROMPT = 8192, NSAMPLE = 512, MTOK = 8704, NIN = 14336;
constexpr int OFF_CB = 0, OFF_CC = 1024, OFF_CH = 2048, OFF_CZ = 3072, OFF_SU = 4096, OFF_SZ = 5120, OFF_AQ = 6144, OFF_AZ = 7168, OFF_G = 8192;
constexpr int LDS_BYTES = 131072;
constexpr size_t O_Y = 0, O_MK = 17825792, O_MV = 18874368, O_CP = 19922944, O_RP = 19931136, O_IP = 19947520, O_CS = 19963904, O_RS = 20226048, O_IS = 20750336;
constexpr size_t WS_WIN = 0;
constexpr size_t WS_WGB = WS_WIN + (size_t)NIN * DM * 2;
constexpr size_t WS_WGA = WS_WGB + 4194304;
constexpr size_t WS_WC = WS_WGA + 4194304;
constexpr size_t WS_WA = WS_WC + 4194304;
constexpr size_t WS_WO = WS_WA + 4194304;
constexpr size_t WS_WK = WS_WO + 8388608;
constexpr size_t WS_WV = WS_WK + 4194304;
constexpr size_t WS_H = WS_WV + 4194304;
constexpr size_t WS_MEMN = WS_H + (size_t)MTOK * DM * 2;
constexpr size_t WS_PROJ = WS_MEMN + 4194304;
constexpr size_t WS_KB = WS_PROJ + (size_t)MTOK * NIN * 2;
constexpr size_t WS_VT = WS_KB + 2097152;
constexpr size_t WS_YS = WS_VT + 2097152;
constexpr size_t WS_ACONV = WS_YS + (size_t)MTOK * 1024 * 2;
constexpr size_t WS_OATT = WS_ACONV + (size_t)MTOK * 1024 * 2;
constexpr size_t WS_SS = WS_OATT + (size_t)MTOK * 1024 * 2;
constexpr size_t WS_END = WS_SS + (size_t)MTOK * 32 * 4;
constexpr size_t WS_MERGED = WS_WIN, WS_TMP = WS_H;

struct P {
    const float *x_prompt, *x_sample, *mem_prompt, *cache_k, *cache_v, *state_conv, *state_re, *state_im, *norm_g, *mem_norm_g, *w_in, *conv_w, *w_conv_out,
        *lam_re, *lam_im, *log_dt, *b_re, *b_im, *c_re, *c_im, *ssm_d, *w_glu_a, *w_glu_b, *w_mem_k, *w_mem_v, *w_attn_out, *w_out, *final_g;
    float* out; unsigned char* ws;
};

__device__ __forceinline__ unsigned cvt_pk_bf16(float lo, float hi) { unsigned r; asm("v_cvt_pk_bf16_f32 %0, %1, %2" : "=v"(r) : "v"(lo), "v"(hi)); return r; }
__device__ __forceinline__ float bf_lo(unsigned w) { return __uint_as_float(w << 16); }
__device__ __forceinline__ float bf_hi(unsigned w) { return __uint_as_float(w & 0xffff0000u); }
__device__ __forceinline__ float sigmoidf_(float x) { return 1.0f / (1.0f + __expf(-x)); }
__device__ __forceinline__ float siluf_(float x) { return x / (1.0f + __expf(-x)); }
__device__ __forceinline__ float gelu_tanh(float x) { const float u = 1.5957691216057308f * (x + 0.044715f * x * x * x); return x / (1.0f + __expf(-u)); }
__device__ __forceinline__ bf16x8 pack8(const f32x4 a, const f32x4 b) {
    u32x4 w; w.x = cvt_pk_bf16(a[0], a[1]); w.y = cvt_pk_bf16(a[2], a[3]); w.z = cvt_pk_bf16(b[0], b[1]); w.w = cvt_pk_bf16(b[2], b[3]);
    return __builtin_bit_cast(bf16x8, w);
}
__device__ __forceinline__ u32x4 pack8u(const f32x4 a, const f32x4 b) {
    u32x4 w; w.x = cvt_pk_bf16(a[0], a[1]); w.y = cvt_pk_bf16(a[2], a[3]); w.z = cvt_pk_bf16(b[0], b[1]); w.w = cvt_pk_bf16(b[2], b[3]); return w;
}
__device__ __forceinline__ void unpack8(const u32x4 w, float (&f)[8]) {
    f[0] = bf_lo(w.x); f[1] = bf_hi(w.x); f[2] = bf_lo(w.y); f[3] = bf_hi(w.y); f[4] = bf_lo(w.z); f[5] = bf_hi(w.z); f[6] = bf_lo(w.w); f[7] = bf_hi(w.w);
}
__device__ __forceinline__ int otid() { int t = threadIdx.x; asm volatile("" : "+v"(t)); return t; }
#define MFMA16(a, b, c) __builtin_amdgcn_mfma_f32_16x16x32_bf16((a), (b), (c), 0, 0, 0)

namespace pg8 {
constexpr int BM = 256, BK = 64, HALF = 128, HTB = HALF * BK * 2, STAGE_BYTES = 8 * HTB;
__device__ __forceinline__ int lds_byte(int r, int c) { const int st = (r >> 4) * 2 + (c >> 5), rr = r & 15, cc = c & 31, ob = rr * 64 + cc * 2; return st * 1024 + (ob ^ (((ob >> 9) & 1) << 5)); }
__device__ __forceinline__ void stage_rc(int b, int& R, int& C) { const int st = b / 1024, sb = b % 1024, swz = sb ^ (((sb >> 9) & 1) << 5); R = (st >> 1) * 16 + swz / 64; C = (st & 1) * 32 + (swz % 64) / 2; }
__device__ __forceinline__ int perm32(int rho) { const int n = rho >> 4, i = rho & 15; return 8 * (i >> 2) + 4 * n + (i & 3); }
struct Unit { const char* a; const char* b; int pm, pn, kind; };

template <class Sched, class Epi>
__device__ __forceinline__ void gemm_phase(LAS unsigned char* lds, const int K, const Sched& S, const Epi& E) {
    const int tid = otid(), wid = __builtin_amdgcn_readfirstlane(tid >> 6), lane = tid & 63, wr = wid >> 2, wc = wid & 3, fr = lane & 15, fq = lane >> 4;
    const int nt = K / BK;
    unsigned voffA[2], voffB[2];
#pragma unroll
    for (int i = 0; i < 2; ++i) { int R, C; stage_rc(tid * 16 + i * 8192, R, C); const int Rb = (R & ~31) + perm32(R & 31);
        voffA[i] = (unsigned)(R * K + C) * 2u; voffB[i] = (unsigned)(Rb * K + C) * 2u; }
    const size_t kstep = (size_t)(BK * 2);
    const size_t hstep = (size_t)HALF * K * 2;
    const unsigned ldsw = (unsigned)wid * 1024u;
    const int aoff = lds_byte(wr * 64 + fr, fq * 8), boff = lds_byte(wc * 32 + fr, fq * 8);
#define PG8_SA(b, h) (((b) * 2 + (h)) * HTB)
#define PG8_SB(b, h) ((4 + (b) * 2 + (h)) * HTB)
#define PG8_STAGE(bufoff, gbase, voff) do { _Pragma("unroll") for (int _i = 0; _i < 2; ++_i) \
        __builtin_amdgcn_global_load_lds((const unsigned*)((const char*)(gbase) + (voff)[_i]), (LAS unsigned*)(lds + (bufoff) + ldsw + _i * 8192), 16, 0, 0); } while (0)
#define PG8_LDA(dst, b, h) do { _Pragma("unroll") for (int m = 0; m < 4; ++m) _Pragma("unroll") for (int k = 0; k < 2; ++k) dst[m][k] = *(const LAS bf16x8*)(lds + PG8_SA(b, h) + aoff + m * 2048 + k * 1024); } while (0)
#define PG8_LDB(dst, b, h) do { _Pragma("unroll") for (int n = 0; n < 2; ++n) _Pragma("unroll") for (int k = 0; k < 2; ++k) dst[n][k] = *(const LAS bf16x8*)(lds + PG8_SB(b, h) + boff + n * 2048 + k * 1024); } while (0)
#define PG8_MMA(ai, bj, At, Bt) do { __builtin_amdgcn_s_setprio(1); _Pragma("unroll") for (int m = 0; m < 4; ++m) _Pragma("unroll") for (int n = 0; n < 2; ++n) _Pragma("unroll") for (int k = 0; k < 2; ++k) \
        acc[ai][bj][m][n] = __builtin_amdgcn_mfma_f32_16x16x32_bf16(Bt[n][k], At[m][k], acc[ai][bj][m][n], 0, 0, 0); __builtin_amdgcn_s_setprio(0); } while (0)
#define PG8_WAIT_V(n) asm volatile("s_waitcnt vmcnt(" #n ")" ::: "memory")
#define PG8_WAIT_L(n) asm volatile("s_waitcnt lgkmcnt(" #n ")" ::: "memory")
#define PG8_BAR __builtin_amdgcn_s_barrier()
#define PG8_SCHED __builtin_amdgcn_sched_barrier(0)
    Unit cur, nxt; int ui = 0;
    if (!S.next(0, cur)) return;
    f32x4 acc[2][2][4][2];
#pragma unroll
    for (int a = 0; a < 2; ++a)
#pragma unroll
        for (int b = 0; b < 2; ++b)
#pragma unroll
            for (int m = 0; m < 4; ++m)
#pragma unroll
                for (int n = 0; n < 2; ++n) acc[a][b][m][n] = (f32x4){0.f, 0.f, 0.f, 0.f};
    bf16x8 At[4][2], B0[2][2], B1[2][2];
    const char* cA = cur.a; const char* cB = cur.b;
    PG8_STAGE(PG8_SB(0, 0), cB, voffB); PG8_STAGE(PG8_SA(0, 0), cA, voffA); PG8_STAGE(PG8_SB(0, 1), cB + hstep, voffB); PG8_STAGE(PG8_SA(0, 1), cA + hstep, voffA);
    if (wr == 1) PG8_BAR;
    PG8_WAIT_V(4); PG8_BAR;
    PG8_STAGE(PG8_SB(1, 0), cB + kstep, voffB); PG8_STAGE(PG8_SA(1, 0), cA + kstep, voffA); PG8_STAGE(PG8_SB(1, 1), cB + hstep + kstep, voffB);
    PG8_WAIT_V(6); PG8_BAR;
    for (;;) {
        const bool has_next = S.next(ui + 1, nxt);
        const char* nA = has_next ? nxt.a : cA; const char* nB = has_next ? nxt.b : cB;
        for (int t = 0; t < nt; t += 2) {
            const bool last = (t == nt - 2);
            const char* a1 = cA + (size_t)(t + 1) * kstep;
            const char* a2 = last ? nA : cA + (size_t)(t + 2) * kstep; const char* b2 = last ? nB : cB + (size_t)(t + 2) * kstep;
            const char* a3 = a2 + kstep; const char* b3 = b2 + kstep;
            PG8_LDB(B0, 0, 0); PG8_SCHED; PG8_LDA(At, 0, 0); PG8_STAGE(PG8_SA(1, 1), a1 + hstep, voffA);
            PG8_WAIT_L(8); PG8_BAR; PG8_WAIT_L(0); PG8_MMA(0, 0, At, B0); PG8_BAR; PG8_SCHED;
            PG8_LDB(B1, 0, 1); PG8_STAGE(PG8_SB(0, 0), b2, voffB);
            PG8_BAR; PG8_WAIT_L(0); PG8_MMA(0, 1, At, B1); PG8_BAR;
            PG8_LDA(At, 0, 1); PG8_STAGE(PG8_SA(0, 0), a2, voffA);
            PG8_BAR; PG8_WAIT_L(0); PG8_MMA(1, 0, At, B0); PG8_BAR; PG8_SCHED;
            PG8_STAGE(PG8_SB(0, 1), b2 + hstep, voffB);
            PG8_WAIT_V(6); PG8_BAR; PG8_MMA(1, 1, At, B1); PG8_BAR;
            PG8_LDB(B0, 1, 0); PG8_SCHED; PG8_LDA(At, 1, 0); PG8_STAGE(PG8_SA(0, 1), a2 + hstep, voffA);
            PG8_WAIT_L(8); PG8_BAR; PG8_WAIT_L(0); PG8_MMA(0, 0, At, B0); PG8_BAR; PG8_SCHED;
            PG8_LDB(B1, 1, 1); PG8_STAGE(PG8_SB(1, 0), b3, voffB);
            PG8_BAR; PG8_WAIT_L(0); PG8_MMA(0, 1, At, B1); PG8_BAR;
            PG8_LDA(At, 1, 1); PG8_STAGE(PG8_SA(1, 0), a3, voffA);
            PG8_BAR; PG8_WAIT_L(0); PG8_MMA(1, 0, At, B0); PG8_BAR; PG8_SCHED;
            PG8_STAGE(PG8_SB(1, 1), b3 + hstep, voffB);
            PG8_WAIT_V(6); PG8_BAR; PG8_MMA(1, 1, At, B1); PG8_BAR;
        }
        const bool keep = E(acc, cur, wr, wc, fr, fq);
        if (!has_next) break;
        if (!keep) {
#pragma unroll
            for (int a = 0; a < 2; ++a)
#pragma unroll
                for (int b = 0; b < 2; ++b)
#pragma unroll
                    for (int m = 0; m < 4; ++m)
#pragma unroll
                        for (int n = 0; n < 2; ++n) acc[a][b][m][n] = (f32x4){0.f, 0.f, 0.f, 0.f};
        }
        cur = nxt; cA = nA; cB = nB; ++ui;
    }
    PG8_WAIT_V(0);
    if (wr == 0) PG8_BAR;
    PG8_BAR;
#undef PG8_SA
#undef PG8_SB
#undef PG8_STAGE
#undef PG8_LDA
#undef PG8_LDB
#undef PG8_MMA
#undef PG8_WAIT_V
#undef PG8_WAIT_L
#undef PG8_BAR
#undef PG8_SCHED
}
}
using pg8::Unit;

struct Sched1 {
    const char *H, *WIN, *MEMN, *WK, *WV; int G, c;
    __device__ __forceinline__ bool next(int i, Unit& u) const {
        const int L = i * G + c; if (L >= 1936) return false;
        if (L < 1904) {
            const int nM = 34, nN = 56, nwg = 1904, NX = 8, WGM = 8;
            int wgid = L; { const int q = nwg / NX, r = nwg % NX, xcd = wgid % NX, off = wgid / NX; wgid = (xcd < r ? xcd * (q + 1) : r * (q + 1) + (xcd - r) * q) + off; }
            const int nig = WGM * nN, gid = wgid / nig, fm = gid * WGM, gsz = (nM - fm) < WGM ? (nM - fm) : WGM;
            u.pm = fm + ((wgid % nig) % gsz); u.pn = (wgid % nig) / gsz; u.kind = 0;
            u.a = H + (size_t)u.pm * 1048576; u.b = WIN + (size_t)u.pn * 1048576;
        } else if (L < 1920) { const int j = L - 1904; u.pm = j >> 2; u.pn = j & 3; u.kind = 1; u.a = MEMN + (size_t)u.pm * 1048576; u.b = WK + (size_t)u.pn * 1048576; }
        else { const int j = L - 1920; u.pm = j >> 2; u.pn = j & 3; u.kind = 2; u.a = WV + (size_t)u.pm * 1048576; u.b = MEMN + (size_t)u.pn * 1048576; }
        return true;
    }
};
struct Epi1 {
    bf16_t* PROJ; float* outK; bf16_t* KB; float* outV; bf16_t* VT;
    __device__ __forceinline__ bool operator()(f32x4 (&acc)[2][2][4][2], const Unit& u, int wr, int wc, int fr, int fq) const {
        const int r0 = u.pm * 256 + wr * 64 + fr, c0 = u.pn * 256 + wc * 32 + 8 * fq;
        if (u.kind == 0) {
#pragma unroll
            for (int ai = 0; ai < 2; ++ai)
#pragma unroll
                for (int m = 0; m < 4; ++m) { bf16_t* rowp = PROJ + (size_t)(r0 + ai * 128 + m * 16) * NIN + c0;
#pragma unroll
                    for (int bj = 0; bj < 2; ++bj) *(u32x4*)(rowp + bj * 128) = pack8u(acc[ai][bj][m][0], acc[ai][bj][m][1]); }
        } else if (u.kind == 1) {
#pragma unroll
            for (int ai = 0; ai < 2; ++ai)
#pragma unroll
                for (int m = 0; m < 4; ++m) { const size_t off = (size_t)(r0 + ai * 128 + m * 16) * 1024 + c0;
#pragma unroll
                    for (int bj = 0; bj < 2; ++bj) { *(f32x4*)(outK + off + bj * 128) = acc[ai][bj][m][0]; *(f32x4*)(outK + off + bj * 128 + 4) = acc[ai][bj][m][1];
                        *(u32x4*)(KB + off + bj * 128) = pack8u(acc[ai][bj][m][0], acc[ai][bj][m][1]); } }
        } else {
            const int h = u.pm, b = u.pn;
#pragma unroll
            for (int ai = 0; ai < 2; ++ai)
#pragma unroll
                for (int m = 0; m < 4; ++m) { const int d = wr * 64 + fr + ai * 128 + m * 16;
#pragma unroll
                    for (int bj = 0; bj < 2; ++bj) { const int key0 = wc * 32 + 8 * fq + bj * 128;
                        *(u32x4*)(VT + ((size_t)((b * 4 + h) * 256 + d)) * 256 + key0) = pack8u(acc[ai][bj][m][0], acc[ai][bj][m][1]);
                        float* fp = outV + ((size_t)(b * 256 + key0)) * 1024 + h * 256 + d;
#pragma unroll
                        for (int e = 0; e < 4; ++e) { fp[(size_t)e * 1024] = acc[ai][bj][m][0][e]; fp[(size_t)(e + 4) * 1024] = acc[ai][bj][m][1][e]; } } }
        }
        return false;
    }
};

struct Sched2 {
    const char* ws; int G, c;
    __device__ __forceinline__ bool next(int i, Unit& u) const {
        const int ti = i >> 2, sub = i & 3, L = ti * G + c; if (L >= 272) return false;
        u.pm = L >> 3; u.pn = L & 7; u.kind = sub;
        const int ia = sub > 1 ? sub - 1 : 0;
        u.a = ws + WS_YS + (size_t)ia * ((size_t)MTOK * 1024 * 2) + (size_t)u.pm * 524288;
        u.b = ws + WS_WGB + (size_t)sub * 4194304 + (size_t)u.pn * 524288;
        return true;
    }
};
__device__ __forceinline__ float gate_e(float p) { return __expf(-fmaxf(p, -60.0f)); }
struct Epi2 {
    const bf16_t* PROJ; bf16_t* TMP; bf16_t* MERGED;
    __device__ __forceinline__ bool operator()(f32x4 (&acc)[2][2][4][2], const Unit& u, int wr, int wc, int fr, int fq) const {
        const int r0 = u.pm * 256 + wr * 64 + fr, c0 = u.pn * 256 + wc * 32 + 8 * fq;
        const int kind = u.kind;
#pragma unroll
        for (int ai = 0; ai < 2; ++ai)
#pragma unroll
            for (int m = 0; m < 4; ++m) {
                const size_t row = (size_t)(r0 + ai * 128 + m * 16);
                const bf16_t* pr = PROJ + row * NIN + OFF_G + c0;
#pragma unroll
                for (int bj = 0; bj < 2; ++bj) {
                    f32x4& v0 = acc[ai][bj][m][0]; f32x4& v1 = acc[ai][bj][m][1];
                    const size_t o = row * 2048 + c0 + bj * 128;
                    if (kind == 0) {
                        float g1[8]; unpack8(*(const u32x4*)(pr + 2048 + bj * 128), g1);
                        f32x4 t0, t1;
#pragma unroll
                        for (int e = 0; e < 4; ++e) { t0[e] = sigmoidf_(g1[e]) * sigmoidf_(v0[e]); t1[e] = sigmoidf_(g1[e + 4]) * sigmoidf_(v1[e]); }
                        *(u32x4*)(TMP + o) = pack8u(t0, t1);
                    } else if (kind == 1) {
                        float tt[8], p0[8]; unpack8(*(const u32x4*)(TMP + o), tt); unpack8(*(const u32x4*)(pr + bj * 128), p0);
#pragma unroll
                        for (int e = 0; e < 4; ++e) { v0[e] *= tt[e] * (1.0f + gate_e(p0[e])); v1[e] *= tt[e + 4] * (1.0f + gate_e(p0[e + 4])); }
                    } else if (kind == 2) {
                        float p0[8], p2[8]; unpack8(*(const u32x4*)(pr + bj * 128), p0); unpack8(*(const u32x4*)(pr + 4096 + bj * 128), p2);
#pragma unroll
                        for (int e = 0; e < 4; ++e) { v0[e] *= (1.0f + gate_e(p2[e])) / (1.0f + gate_e(p0[e])); v1[e] *= (1.0f + gate_e(p2[e + 4])) / (1.0f + gate_e(p0[e + 4])); }
                    } else {
                        float p2[8]; unpack8(*(const u32x4*)(pr + 4096 + bj * 128), p2);
                        f32x4 t0, t1;
#pragma unroll
                        for (int e = 0; e < 4; ++e) { t0[e] = v0[e] / (1.0f + gate_e(p2[e])); t1[e] = v1[e] / (1.0f + gate_e(p2[e + 4])); }
                        *(u32x4*)(MERGED + o) = pack8u(t0, t1);
                    }
                }
                asm volatile("" ::: "memory");
            }
        return kind == 1 || kind == 2;
    }
};

struct Sched3 {
    const char *MERGED, *WO; int G, c;
    __device__ __forceinline__ bool next(int i, Unit& u) const {
        const int L = i * G + c; if (L >= 272) return false;
        u.pm = L >> 3; u.pn = L & 7; u.kind = 0; u.a = MERGED + (size_t)u.pm * 1048576; u.b = WO + (size_t)u.pn * 1048576; return true;
    }
};
struct Epi3 {
    const float* xp; const float* xs; float* out; float* ss;
    __device__ __forceinline__ bool operator()(f32x4 (&acc)[2][2][4][2], const Unit& u, int wr, int wc, int fr, int fq) const {
        const int r0 = u.pm * 256 + wr * 64 + fr, c0 = u.pn * 256 + wc * 32 + 8 * fq;
#pragma unroll
        for (int ai = 0; ai < 2; ++ai)
#pragma unroll
            for (int m = 0; m < 4; ++m) {
                const int row = r0 + ai * 128 + m * 16;
                const float* xr = (row < NPROMPT ? xp + (size_t)row * DM : xs + (size_t)(row - NPROMPT) * DM) + c0;
                float* o = out + (size_t)row * DM + c0; float s = 0.f;
#pragma unroll
                for (int bj = 0; bj < 2; ++bj)
#pragma unroll
                    for (int n = 0; n < 2; ++n) { const f32x4 v = *(const f32x4*)(xr + bj * 128 + 4 * n) + acc[ai][bj][m][n]; *(f32x4*)(o + bj * 128 + 4 * n) = v;
                        s += (v[0] * v[0] + v[1] * v[1]) + (v[2] * v[2] + v[3] * v[3]); }
                s += __shfl_xor(s, 16); s += __shfl_xor(s, 32);
                if (fq == 0) ss[(size_t)row * 32 + u.pn * 4 + wc] = s;
            }
        return false;
    }
};

__device__ __forceinline__ void transpose_mat(const float* __restrict__ src, int K, int N, bf16_t* __restrict__ dst, LAS float* tile) {
    const int tid = otid(); const int tk = K / 64, tn = N / 64, ntile = tk * tn;
    const int r = tid >> 3, c8 = (tid & 7) * 8;
    for (int t = blockIdx.x; t < ntile; t += gridDim.x) {
        const int k0 = (t / tn) * 64, n0 = (t % tn) * 64;
        const float* s = src + (size_t)(k0 + r) * N + n0 + c8;
        const f32x4 v0 = *(const f32x4*)s, v1 = *(const f32x4*)(s + 4);
#pragma unroll
        for (int e = 0; e < 4; ++e) { tile[r * 65 + c8 + e] = v0[e]; tile[r * 65 + c8 + 4 + e] = v1[e]; }
        __syncthreads();
        f32x4 a, b;
#pragma unroll
        for (int e = 0; e < 4; ++e) { a[e] = tile[(c8 + e) * 65 + r]; b[e] = tile[(c8 + 4 + e) * 65 + r]; }
        *(u32x4*)(dst + (size_t)(n0 + r) * K + k0 + c8) = pack8u(a, b);
        __syncthreads();
    }
}
__device__ __forceinline__ void phase0(const P& p, LAS unsigned char* lds) {
    unsigned char* ws = p.ws; LAS float* tile = (LAS float*)lds;
    transpose_mat(p.w_in, 2048, NIN, (bf16_t*)(ws + WS_WIN), tile);
    transpose_mat(p.w_conv_out, 1024, 2048, (bf16_t*)(ws + WS_WC), tile);
    transpose_mat(p.w_attn_out, 1024, 2048, (bf16_t*)(ws + WS_WA), tile);
    transpose_mat(p.w_glu_a, 1024, 2048, (bf16_t*)(ws + WS_WGA), tile);
    transpose_mat(p.w_glu_b, 1024, 2048, (bf16_t*)(ws + WS_WGB), tile);
    transpose_mat(p.w_out, 2048, 2048, (bf16_t*)(ws + WS_WO), tile);
    transpose_mat(p.w_mem_k, 2048, 1024, (bf16_t*)(ws + WS_WK), tile);
    transpose_mat(p.w_mem_v, 2048, 1024, (bf16_t*)(ws + WS_WV), tile);
    const int t0 = otid(); const int lane = t0 & 63, gw = blockIdx.x * 8 + (t0 >> 6), nw = gridDim.x * 8;
    for (int row = gw; row < MTOK + 1024; row += nw) {
        const float* src; const float* g; bf16_t* dst;
        if (row < NPROMPT) { src = p.x_prompt + (size_t)row * DM; g = p.norm_g; dst = (bf16_t*)(ws + WS_H) + (size_t)row * DM; }
        else if (row < MTOK) { src = p.x_sample + (size_t)(row - NPROMPT) * DM; g = p.norm_g; dst = (bf16_t*)(ws + WS_H) + (size_t)row * DM; }
        else { src = p.mem_prompt + (size_t)(row - MTOK) * DM; g = p.mem_norm_g; dst = (bf16_t*)(ws + WS_MEMN) + (size_t)(row - MTOK) * DM; }
        f32x4 v[8]; float s = 0.f;
#pragma unroll
        for (int i = 0; i < 8; ++i) { v[i] = *(const f32x4*)(src + 4 * (lane + 64 * i)); s += (v[i][0] * v[i][0] + v[i][1] * v[i][1]) + (v[i][2] * v[i][2] + v[i][3] * v[i][3]); }
#pragma unroll
        for (int o = 32; o >= 1; o >>= 1) s += __shfl_xor(s, o);
        const float rstd = 1.0f / sqrtf(s * (1.0f / 2048.0f) + 1e-6f);
#pragma unroll
        for (int i = 0; i < 8; ++i) { const f32x4 gv = *(const f32x4*)(g + 4 * (lane + 64 * i));
            u32x2 w; w.x = cvt_pk_bf16(v[i][0] * rstd * gv[0], v[i][1] * rstd * gv[1]); w.y = cvt_pk_bf16(v[i][2] * rstd * gv[2], v[i][3] * rstd * gv[3]);
            *(u32x2*)(dst + 4 * (lane + 64 * i)) = w; }
    }
}

__device__ __forceinline__ void conv_phase(const P& p) {
    const bf16_t* PROJ = (const bf16_t*)(p.ws + WS_PROJ); bf16_t* ACONV = (bf16_t*)(p.ws + WS_ACONV);
    const int NTASK = 131072 + 16384;
    for (int task = blockIdx.x * 512 + otid(); task < NTASK; task += gridDim.x * 512) {
        int cgp, r0, len; bool prompt = task < 131072; int bs = 0;
        if (prompt) { cgp = task & 127; r0 = (task >> 7) * 8; len = 8; }
        else { const int ts = task - 131072; cgp = ts & 127; bs = ts >> 7; r0 = NPROMPT + 4 * bs; len = 4; }
        const int c0 = cgp * 8;
        float w0[8], w1[8], w2[8], vm2[8], vm1[8];
        { const f32x4 a0 = *(const f32x4*)(p.conv_w + c0), a1 = *(const f32x4*)(p.conv_w + c0 + 4), b0 = *(const f32x4*)(p.conv_w + 1024 + c0), b1 = *(const f32x4*)(p.conv_w + 1024 + c0 + 4),
              d0 = *(const f32x4*)(p.conv_w + 2048 + c0), d1 = *(const f32x4*)(p.conv_w + 2048 + c0 + 4);
#pragma unroll
          for (int e = 0; e < 4; ++e) { w0[e] = a0[e]; w0[e + 4] = a1[e]; w1[e] = b0[e]; w1[e + 4] = b1[e]; w2[e] = d0[e]; w2[e + 4] = d1[e]; } }
        if (prompt) {
            if ((r0 & 2047) == 0) {
#pragma unroll
                for (int e = 0; e < 8; ++e) { vm2[e] = 0.f; vm1[e] = 0.f; }
            } else {
                float a[8], b[8];
                unpack8(*(const u32x4*)(PROJ + (size_t)(r0 - 2) * NIN + OFF_CC + c0), a); unpack8(*(const u32x4*)(PROJ + (size_t)(r0 - 2) * NIN + OFF_CH + c0), b);
#pragma unroll
                for (int e = 0; e < 8; ++e) vm2[e] = a[e] * b[e];
                unpack8(*(const u32x4*)(PROJ + (size_t)(r0 - 1) * NIN + OFF_CC + c0), a); unpack8(*(const u32x4*)(PROJ + (size_t)(r0 - 1) * NIN + OFF_CH + c0), b);
#pragma unroll
                for (int e = 0; e < 8; ++e) vm1[e] = a[e] * b[e];
            }
        } else {
            const float* sc = p.state_conv + (size_t)bs * 2048 + c0;
            const f32x4 a0 = *(const f32x4*)sc, a1 = *(const f32x4*)(sc + 4), b0 = *(const f32x4*)(sc + 1024), b1 = *(const f32x4*)(sc + 1028);
#pragma unroll
            for (int e = 0; e < 4; ++e) { vm2[e] = a0[e]; vm2[e + 4] = a1[e]; vm1[e] = b0[e]; vm1[e + 4] = b1[e]; }
        }
        for (int i = 0; i < len; ++i) {
            const size_t row = (size_t)(r0 + i);
            const bf16_t* pr = PROJ + row * NIN + c0;
            float cb[8], cc[8], ch[8], cz[8], v[8];
            unpack8(*(const u32x4*)(pr + OFF_CB), cb); unpack8(*(const u32x4*)(pr + OFF_CC), cc); unpack8(*(const u32x4*)(pr + OFF_CH), ch); unpack8(*(const u32x4*)(pr + OFF_CZ), cz);
            f32x4 o0, o1;
#pragma unroll
            for (int e = 0; e < 8; ++e) { v[e] = cc[e] * ch[e]; const float cv = w0[e] * vm2[e] + w1[e] * vm1[e] + w2[e] * v[e]; const float r = cb[e] * cv * siluf_(cz[e]);
                if (e < 4) o0[e] = r; else o1[e - 4] = r; vm2[e] = vm1[e]; vm1[e] = v[e]; }
            *(u32x4*)(ACONV + row * 1024 + c0) = pack8u(o0, o1);
            float* dst = nullptr;
            if (prompt) { const int pos = (r0 + i) & 2047; if (pos >= 2046) dst = p.out + O_CP + ((size_t)((r0 + i) >> 11) * 2 + (pos - 2046)) * 1024 + c0; }
            else if (i >= 2) dst = p.out + O_CS + ((size_t)bs * 2 + (i - 2)) * 1024 + c0;
            if (dst) { *(f32x4*)dst = (f32x4){v[0], v[1], v[2], v[3]}; *(f32x4*)(dst + 4) = (f32x4){v[4], v[5], v[6], v[7]}; }
        }
    }
}

__device__ __forceinline__ void s5_steps4(const bf16_t* PROJ, bf16_t* YS, const size_t row0, const int g, const int g4, const bool Y,
                                          const bf16x8 (&bre)[4], const bf16x8 (&bim)[4], const bf16x8 (&cf)[4], const float (&ar)[16], const float (&ai)[16], const f32x4 dsk,
                                          float (&sr)[16], float (&si)[16]) {
    bf16x8 U[4]; u32x2 u4[4], z4[4];
    const bf16_t* base = PROJ + row0 * NIN + g * 16;
#pragma unroll
    for (int i = 0; i < 4; ++i) {
        U[i] = *(const bf16x8*)(base + (size_t)i * NIN + OFF_SU + 8 * (g4 & 1));
        u4[i] = *(const u32x2*)(base + (size_t)i * NIN + OFF_SU + 4 * g4); z4[i] = *(const u32x2*)(base + (size_t)i * NIN + OFF_SZ + 4 * g4);
    }
    const f32x4 zero4 = (f32x4){0.f, 0.f, 0.f, 0.f};
#pragma unroll
    for (int i = 0; i < 4; ++i) {
#pragma unroll
        for (int pb = 0; pb < 4; ++pb) {
            const f32x4 xr = MFMA16(bre[pb], U[i], zero4), xi = MFMA16(bim[pb], U[i], zero4);
#pragma unroll
            for (int j = 0; j < 4; ++j) { const int k = pb * 4 + j; const float nr = ar[k] * sr[k] - ai[k] * si[k] + xr[j]; const float ni = ar[k] * si[k] + ai[k] * sr[k] + xi[j]; sr[k] = nr; si[k] = ni; }
        }
        if (Y) {
            f32x4 y = zero4;
            y = MFMA16(cf[0], pack8((f32x4){sr[0], sr[1], sr[2], sr[3]}, (f32x4){sr[4], sr[5], sr[6], sr[7]}), y);
            y = MFMA16(cf[1], pack8((f32x4){sr[8], sr[9], sr[10], sr[11]}, (f32x4){sr[12], sr[13], sr[14], sr[15]}), y);
            y = MFMA16(cf[2], pack8((f32x4){si[0], si[1], si[2], si[3]}, (f32x4){si[4], si[5], si[6], si[7]}), y);
            y = MFMA16(cf[3], pack8((f32x4){si[8], si[9], si[10], si[11]}, (f32x4){si[12], si[13], si[14], si[15]}), y);
            const float uu[4] = {bf_lo(u4[i].x), bf_hi(u4[i].x), bf_lo(u4[i].y), bf_hi(u4[i].y)};
            const float zz[4] = {bf_lo(z4[i].x), bf_hi(z4[i].x), bf_lo(z4[i].y), bf_hi(z4[i].y)};
            float o[4];
#pragma unroll
            for (int j = 0; j < 4; ++j) { const float ysv = y[j] + dsk[j] * uu[j]; o[j] = gelu_tanh(ysv * siluf_(zz[j])); }
            u32x2 w; w.x = cvt_pk_bf16(o[0], o[1]); w.y = cvt_pk_bf16(o[2], o[3]);
            *(u32x2*)(YS + (row0 + i) * 1024 + g * 16 + 4 * g4) = w;
        }
    }
}
__device__ __forceinline__ void s5_coef(const P& p, int g, int pp, float dt, float& ar, float& ai, float& fr, float& fi) {
    const float lr = p.lam_re[g * 64 + pp], li = p.lam_im[g * 64 + pp];
    const float mag = expf(lr * dt), ang = li * dt; float sn, cs; sincosf(ang, &sn, &cs);
    ar = mag * cs; ai = mag * sn; const float den = lr * lr + li * li;
    fr = ((ar - 1.0f) * lr + ai * li) / den; fi = (ai * lr - (ar - 1.0f) * li) / den;
}
__device__ __forceinline__ void s5_unit(const P& p, const int unit, LAS unsigned char* lds) {
    const bf16_t* PROJ = (const bf16_t*)(p.ws + WS_PROJ); bf16_t* YS = (bf16_t*)(p.ws + WS_YS);
    const int tid = otid(), lane = tid & 63, w = tid >> 6, cl = lane & 15, g4 = lane >> 4;
    const bool prompt = unit < 256; const int g = prompt ? (unit & 63) : (unit - 256); const int b = unit >> 6;
    const float dt = expf(p.log_dt[g]);
    LAS float* E = (LAS float*)lds;
    LAS f32x4* CT = (LAS f32x4*)(lds + 65536);
    if (tid < 64) { float a_r, a_i, fr_, fi_; s5_coef(p, g, tid, dt, a_r, a_i, fr_, fi_); CT[tid] = (f32x4){a_r, a_i, fr_, fi_}; }
    __syncthreads();
    float ar[16], ai[16];
#pragma unroll
    for (int pb = 0; pb < 4; ++pb)
#pragma unroll
        for (int j = 0; j < 4; ++j) { const f32x4 t = CT[16 * pb + 4 * g4 + j]; ar[pb * 4 + j] = t[0]; ai[pb * 4 + j] = t[1]; }
    bf16x8 bre[4], bim[4], cf[4];
    const float bmask = g4 < 2 ? 1.0f : 0.0f;
#pragma unroll
    for (int pb = 0; pb < 4; ++pb) {
        const int pp = 16 * pb + cl; const f32x4 t = CT[pp]; const float fr_ = t[2] * bmask, fi_ = t[3] * bmask;
        const float* br = p.b_re + ((size_t)(g * 64 + pp)) * 16 + 8 * (g4 & 1); const float* bi = p.b_im + ((size_t)(g * 64 + pp)) * 16 + 8 * (g4 & 1);
        const f32x4 r0 = *(const f32x4*)br, r1 = *(const f32x4*)(br + 4), i0 = *(const f32x4*)bi, i1 = *(const f32x4*)(bi + 4);
        bre[pb] = pack8(fr_ * r0 - fi_ * i0, fr_ * r1 - fi_ * i1);
        bim[pb] = pack8(fr_ * i0 + fi_ * r0, fr_ * i1 + fi_ * r1);
    }
#pragma unroll
    for (int ks = 0; ks < 4; ++ks) {
        const float* cp = (ks < 2 ? p.c_re : p.c_im) + ((size_t)(g * 16 + cl)) * 64 + 32 * (ks & 1) + 4 * g4;
        f32x4 a = *(const f32x4*)cp, c = *(const f32x4*)(cp + 16);
        if (ks >= 2) { a = -a; c = -c; }
        cf[ks] = pack8(a, c);
    }
    const f32x4 dsk = *(const f32x4*)(p.ssm_d + g * 16 + 4 * g4);
    const int chain = 16 * w + cl;
    const size_t row0 = prompt ? (size_t)b * 2048 + (size_t)chain * 16 : (size_t)NPROMPT + 4 * chain;
    const size_t so = ((size_t)chain * 64 + g) * 64 + 4 * g4;
    const int nq = prompt ? 4 : 1;
    float sr[16], si[16];
#pragma unroll
    for (int k = 0; k < 16; ++k) { sr[k] = 0.f; si[k] = 0.f; }
    if (!prompt) {
#pragma unroll
        for (int pb = 0; pb < 4; ++pb) { const f32x4 a = *(const f32x4*)(p.state_re + so + 16 * pb), c = *(const f32x4*)(p.state_im + so + 16 * pb);
#pragma unroll
            for (int j = 0; j < 4; ++j) { sr[pb * 4 + j] = a[j]; si[pb * 4 + j] = c[j]; } }
    }
#pragma unroll 1
    for (int pass = prompt ? 0 : 1; pass < 2; ++pass) {
        if (pass == 1 && prompt) {
#pragma unroll
            for (int pb = 0; pb < 4; ++pb) {
                *(LAS f32x4*)(E + (chain * 2 + 0) * 64 + 16 * pb + 4 * g4) = (f32x4){sr[pb * 4], sr[pb * 4 + 1], sr[pb * 4 + 2], sr[pb * 4 + 3]};
                *(LAS f32x4*)(E + (chain * 2 + 1) * 64 + 16 * pb + 4 * g4) = (f32x4){si[pb * 4], si[pb * 4 + 1], si[pb * 4 + 2], si[pb * 4 + 3]};
            }
            __syncthreads();
            if (w == 0) {
                float a_r, a_i; { const f32x4 t = CT[lane]; a_r = t[0]; a_i = t[1]; }
#pragma unroll
                for (int q = 0; q < 4; ++q) { const float nr = a_r * a_r - a_i * a_i, ni = 2.0f * a_r * a_i; a_r = nr; a_i = ni; }
                float Fr = 0.f, Fi = 0.f;
#pragma unroll 8
                for (int k = 0; k < 128; ++k) {
                    const float er = E[(2 * k) * 64 + lane], ei = E[(2 * k + 1) * 64 + lane];
                    E[(2 * k) * 64 + lane] = Fr; E[(2 * k + 1) * 64 + lane] = Fi;
                    const float nr = a_r * Fr - a_i * Fi + er; Fi = a_r * Fi + a_i * Fr + ei; Fr = nr;
                }
                p.out[O_RP + (size_t)(b * 64 + g) * 64 + lane] = Fr; p.out[O_IP + (size_t)(b * 64 + g) * 64 + lane] = Fi;
            }
            __syncthreads();
#pragma unroll
            for (int pb = 0; pb < 4; ++pb) {
                const f32x4 a = *(LAS f32x4*)(E + (chain * 2 + 0) * 64 + 16 * pb + 4 * g4), c = *(LAS f32x4*)(E + (chain * 2 + 1) * 64 + 16 * pb + 4 * g4);
#pragma unroll
                for (int j = 0; j < 4; ++j) { sr[pb * 4 + j] = a[j]; si[pb * 4 + j] = c[j]; }
            }
        }
#pragma unroll 1
        for (int q = 0; q < nq; ++q) s5_steps4(PROJ, YS, row0 + 4 * q, g, g4, pass == 1, bre, bim, cf, ar, ai, dsk, sr, si);
    }
    if (!prompt) {
#pragma unroll
        for (int pb = 0; pb < 4; ++pb) {
            *(f32x4*)(p.out + O_RS + so + 16 * pb) = (f32x4){sr[pb * 4], sr[pb * 4 + 1], sr[pb * 4 + 2], sr[pb * 4 + 3]};
            *(f32x4*)(p.out + O_IS + so + 16 * pb) = (f32x4){si[pb * 4], si[pb * 4 + 1], si[pb * 4 + 2], si[pb * 4 + 3]};
        }
    }
    __syncthreads();
}

__device__ __forceinline__ void attn_prompt_unit(const P& p, const int unit, LAS unsigned char* lds) {
    const bf16_t* PROJ = (const bf16_t*)(p.ws + WS_PROJ); const bf16_t* KB = (const bf16_t*)(p.ws + WS_KB); const bf16_t* VT = (const bf16_t*)(p.ws + WS_VT);
    bf16_t* OATT = (bf16_t*)(p.ws + WS_OATT);
    const int tid = otid(), lane = tid & 63, w = tid >> 6, cl = lane & 15, g4 = lane >> 4;
    const int b = unit >> 6, h = (unit >> 4) & 3, qb = unit & 15;
    const bf16_t* kbase = KB + (size_t)(b * 256) * 1024 + h * 256;
#pragma unroll
    for (int i = 0; i < 16; ++i) { const int idx = tid + 512 * i, r = idx >> 5, m = idx & 31;
        const u32x4 v = *(const u32x4*)(kbase + (size_t)r * 1024 + m * 8); *(LAS u32x4*)(lds + r * 512 + ((m ^ (r & 15)) << 4)) = v; }
    const size_t qrow = (size_t)b * 2048 + qb * 128 + w * 16 + cl;
    const bf16_t* qp = PROJ + qrow * NIN + OFF_AQ + h * 256 + 8 * g4;
    bf16x8 qf[8];
#pragma unroll
    for (int ks = 0; ks < 8; ++ks) qf[ks] = *(const bf16x8*)(qp + 32 * ks);
    __syncthreads();
    f32x4 s[16];
#pragma unroll
    for (int kb = 0; kb < 16; ++kb) { s[kb] = (f32x4){0.f, 0.f, 0.f, 0.f};
#pragma unroll
        for (int ks = 0; ks < 8; ++ks) { const int key = 16 * kb + cl, m = 4 * ks + g4;
            const bf16x8 kf = *(const LAS bf16x8*)(lds + key * 512 + ((m ^ cl) << 4)); s[kb] = MFMA16(kf, qf[ks], s[kb]); }
        __builtin_amdgcn_sched_barrier(0); }
    float mx = -3.0e38f;
#pragma unroll
    for (int kb = 0; kb < 16; ++kb)
#pragma unroll
        for (int j = 0; j < 4; ++j) mx = fmaxf(mx, s[kb][j]);
    mx = fmaxf(mx, __shfl_xor(mx, 16)); mx = fmaxf(mx, __shfl_xor(mx, 32));
    float sum = 0.f;
#pragma unroll
    for (int kb = 0; kb < 16; ++kb)
#pragma unroll
        for (int j = 0; j < 4; ++j) { const float e = __expf((s[kb][j] - mx) * 0.0625f); s[kb][j] = e; sum += e; }
    sum += __shfl_xor(sum, 16); sum += __shfl_xor(sum, 32);
    const float inv = 1.0f / sum;
    bf16x8 pf[8];
#pragma unroll
    for (int kk = 0; kk < 8; ++kk) pf[kk] = pack8(s[2 * kk], s[2 * kk + 1]);
    __syncthreads();
    const bf16_t* vbase = VT + (size_t)((b * 4 + h) * 256) * 256;
#pragma unroll
    for (int i = 0; i < 16; ++i) { const int idx = tid + 512 * i, r = idx >> 5, m = idx & 31;
        const u32x4 v = *(const u32x4*)(vbase + (size_t)r * 256 + m * 8); *(LAS u32x4*)(lds + r * 512 + ((m ^ (r & 15)) << 4)) = v; }
    __syncthreads();
    const bf16_t* azp = PROJ + qrow * NIN + OFF_AZ + h * 256 + 4 * g4;
    bf16_t* op = OATT + qrow * 1024 + h * 256 + 4 * g4;
#pragma unroll
    for (int db = 0; db < 16; ++db) {
        f32x4 o = (f32x4){0.f, 0.f, 0.f, 0.f}; const int d = 16 * db + cl;
#pragma unroll
        for (int kk = 0; kk < 8; ++kk) {
            const int ch0 = 8 * kk + g4, ch1 = ch0 + 4;
            const u32x2 lo = *(const LAS u32x2*)(lds + d * 512 + (((ch0 >> 1) ^ cl) << 4) + (ch0 & 1) * 8);
            const u32x2 hi = *(const LAS u32x2*)(lds + d * 512 + (((ch1 >> 1) ^ cl) << 4) + (ch1 & 1) * 8);
            const u32x4 vv = (u32x4){lo.x, lo.y, hi.x, hi.y};
            o = MFMA16(__builtin_bit_cast(bf16x8, vv), pf[kk], o);
        }
        const u32x2 az = *(const u32x2*)(azp + 16 * db);
        const float z[4] = {bf_lo(az.x), bf_hi(az.x), bf_lo(az.y), bf_hi(az.y)};
        u32x2 wv; wv.x = cvt_pk_bf16(o[0] * inv * siluf_(z[0]), o[1] * inv * siluf_(z[1])); wv.y = cvt_pk_bf16(o[2] * inv * siluf_(z[2]), o[3] * inv * siluf_(z[3]));
        *(u32x2*)(op + 16 * db) = wv;
        __builtin_amdgcn_sched_barrier(0);
    }
    __syncthreads();
}

__device__ __forceinline__ void attn_sample_unit(const P& p, const int unit, LAS unsigned char* lds) {
    const bf16_t* PROJ = (const bf16_t*)(p.ws + WS_PROJ); bf16_t* OATT = (bf16_t*)(p.ws + WS_OATT);
    const int tid = otid(), lane = tid & 63, w = tid >> 6, cl = lane & 15, g4 = lane >> 4;
    const int b = unit >> 2, h = unit & 3;
    LAS float* sc = (LAS float*)lds;
    LAS float* po = (LAS float*)(lds + 4096);
    const float* kbase = p.cache_k + ((size_t)b * 1024 + h) * 256;
    const float* vbase = p.cache_v + ((size_t)b * 1024 + h) * 256;
    const size_t qrow = (size_t)NPROMPT + 4 * b + (cl & 3);
    const bf16_t* qp = PROJ + qrow * NIN + OFF_AQ + h * 256 + 8 * g4;
    bf16x8 qf[8];
#pragma unroll
    for (int ks = 0; ks < 8; ++ks) qf[ks] = *(const bf16x8*)(qp + 32 * ks);
#pragma unroll
    for (int kblk = 0; kblk < 2; ++kblk) {
        const int key = 32 * w + 16 * kblk + cl; const float* kr = kbase + (size_t)key * 1024 + 8 * g4;
        f32x4 ka[8], kc[8];
#pragma unroll
        for (int ks = 0; ks < 8; ++ks) { ka[ks] = *(const f32x4*)(kr + 32 * ks); kc[ks] = *(const f32x4*)(kr + 32 * ks + 4); }
        f32x4 s = (f32x4){0.f, 0.f, 0.f, 0.f};
#pragma unroll
        for (int ks = 0; ks < 8; ++ks) s = MFMA16(pack8(ka[ks], kc[ks]), qf[ks], s);
        if (cl < 4) *(LAS f32x4*)(sc + cl * 256 + 32 * w + 16 * kblk + 4 * g4) = s;
    }
    f32x4 vv[32];
#pragma unroll
    for (int i = 0; i < 32; ++i) vv[i] = *(const f32x4*)(vbase + (size_t)(32 * w + i) * 1024 + 4 * lane);
    __syncthreads();
    if (w == 0) {
#pragma unroll
        for (int q = 0; q < 4; ++q) {
            f32x4 v = *(LAS f32x4*)(sc + q * 256 + 4 * lane);
            float mx = fmaxf(fmaxf(v[0], v[1]), fmaxf(v[2], v[3]));
#pragma unroll
            for (int o = 32; o >= 1; o >>= 1) mx = fmaxf(mx, __shfl_xor(mx, o));
            float sum = 0.f;
#pragma unroll
            for (int e = 0; e < 4; ++e) { v[e] = __expf((v[e] - mx) * 0.0625f); sum += v[e]; }
#pragma unroll
            for (int o = 32; o >= 1; o >>= 1) sum += __shfl_xor(sum, o);
            const float inv = 1.0f / sum;
            *(LAS f32x4*)(sc + q * 256 + 4 * lane) = v * inv;
        }
    }
    __syncthreads();
    f32x4 o[4];
#pragma unroll
    for (int q = 0; q < 4; ++q) o[q] = (f32x4){0.f, 0.f, 0.f, 0.f};
#pragma unroll
    for (int ii = 0; ii < 8; ++ii)
#pragma unroll
        for (int q = 0; q < 4; ++q) { const f32x4 pv = *(LAS f32x4*)(sc + q * 256 + 32 * w + 4 * ii);
            o[q] += pv[0] * vv[4 * ii] + pv[1] * vv[4 * ii + 1] + pv[2] * vv[4 * ii + 2] + pv[3] * vv[4 * ii + 3]; }
#pragma unroll
    for (int q = 0; q < 4; ++q) *(LAS f32x4*)(po + (w * 4 + q) * 256 + 4 * lane) = o[q];
    __syncthreads();
    {
        const int q = tid >> 7, d = (tid & 127) * 2; float a0 = 0.f, a1 = 0.f;
#pragma unroll
        for (int ww = 0; ww < 8; ++ww) { a0 += po[(ww * 4 + q) * 256 + d]; a1 += po[(ww * 4 + q) * 256 + d + 1]; }
        const size_t row = (size_t)NPROMPT + 4 * b + q;
        const unsigned az = *(const unsigned*)(PROJ + row * NIN + OFF_AZ + h * 256 + d);
        *(unsigned*)(OATT + row * 1024 + h * 256 + d) = cvt_pk_bf16(a0 * siluf_(bf_lo(az)), a1 * siluf_(bf_hi(az)));
    }
    __syncthreads();
}

__device__ __forceinline__ void phase5(const P& p) {
    const float* ss = (const float*)(p.ws + WS_SS);
    const int t0 = otid(); const int lane = t0 & 63, gw = blockIdx.x * 8 + (t0 >> 6), nw = gridDim.x * 8;
    for (int row = gw; row < MTOK; row += nw) {
        float s = ss[(size_t)row * 32 + (lane & 31)];
#pragma unroll
        for (int o = 16; o >= 1; o >>= 1) s += __shfl_xor(s, o);
        const float rstd = 1.0f / sqrtf(s * (1.0f / 2048.0f) + 1e-6f);
        float* xr = p.out + (size_t)row * DM;
#pragma unroll
        for (int i = 0; i < 8; ++i) { const f32x4 v = *(const f32x4*)(xr + 4 * (lane + 64 * i)), gv = *(const f32x4*)(p.final_g + 4 * (lane + 64 * i));
            *(f32x4*)(xr + 4 * (lane + 64 * i)) = v * rstd * gv; }
    }
}

__global__ void __launch_bounds__(512, 2) mega_fwd(P p) {
    extern __shared__ __attribute__((aligned(16))) unsigned char shm[];
    LAS unsigned char* lds = (LAS unsigned char*)shm;
    cg::grid_group grid = cg::this_grid();
    unsigned char* ws = p.ws;
    const int G = gridDim.x, c = blockIdx.x;

#ifndef PHMASK
#define PHMASK 0xffff
#endif
    if (PHMASK & 1) phase0(p, lds);
    grid.sync();

    if (PHMASK & 2) {
        Sched1 S{(const char*)(ws + WS_H), (const char*)(ws + WS_WIN), (const char*)(ws + WS_MEMN), (const char*)(ws + WS_WK), (const char*)(ws + WS_WV), G, c};
        Epi1 E{(bf16_t*)(ws + WS_PROJ), p.out + O_MK, (bf16_t*)(ws + WS_KB), p.out + O_MV, (bf16_t*)(ws + WS_VT)};
        pg8::gemm_phase(lds, 2048, S, E);
    }
    grid.sync();

    {
        if (PHMASK & 4) for (int u = c; u < 512; u += G) attn_sample_unit(p, u, lds);
        if (PHMASK & 8) for (int u = c; u < 320; u += G) s5_unit(p, u, lds);
        if (PHMASK & 16) for (int u = c; u < 256; u += G) attn_prompt_unit(p, u, lds);
        if (PHMASK & 32) conv_phase(p);
    }
    grid.sync();

    if (PHMASK & 64) {
        Sched2 S{(const char*)ws, G, c};
        Epi2 E{(const bf16_t*)(ws + WS_PROJ), (bf16_t*)(ws + WS_TMP), (bf16_t*)(ws + WS_MERGED)};
        pg8::gemm_phase(lds, 1024, S, E);
    }
    grid.sync();

    if (PHMASK & 128) {
        Sched3 S{(const char*)(ws + WS_MERGED), (const char*)(ws + WS_WO), G, c};
        Epi3 E{p.x_prompt, p.x_sample, p.out + O_Y, (float*)(ws + WS_SS)};
        pg8::gemm_phase(lds, 2048, S, E);
    }
    grid.sync();

    if (PHMASK & 256) phase5(p);
}

extern "C" void kernel_launch(void* const* d_in, const int* in_sizes, int n_in, void* d_out, int out_size, void* d_ws, size_t ws_size, hipStream_t stream) {
    static int grid = 0;
    if (grid == 0) {
        int dev = 0, cus = 0, per_cu = 0;
        hipGetDevice(&dev);
        hipDeviceGetAttribute(&cus, hipDeviceAttributeMultiprocessorCount, dev);
        if (hipFuncSetAttribute((const void*)mega_fwd, hipFuncAttributeMaxDynamicSharedMemorySize, LDS_BYTES) != hipSuccess) fprintf(stderr, "kernel_launch: hipFuncSetAttribute failed\n");
        if (hipOccupancyMaxActiveBlocksPerMultiprocessor(&per_cu, (const void*)mega_fwd, 512, LDS_BYTES) != hipSuccess || per_cu < 1) per_cu = 1;
        (void)hipGetLastError();
        grid = cus * per_cu;
        if (ws_size < WS_END) fprintf(stderr, "kernel_launch: workspace too small (%zu < %zu)\n", ws_size, (size_t)WS_END);
    }
    P p{};
    const float** pp = (const float**)&p;
    for (int i = 0; i < 28; ++i) pp[i] = (const float*)d_in[i];
    p.out = (float*)d_out; p.ws = (unsigned char*)d_ws;
    void* args[] = {&p};
    hipError_t e = hipLaunchCooperativeKernel((const void*)mega_fwd, dim3(grid), dim3(512), args, LDS_BYTES, stream);
    if (e != hipSuccess) fprintf(stderr, "cooperative launch failed: %s (grid %d)\n", hipGetErrorString(e), grid);
}
```

```cpp
#include <hip/hip_runtime.h>
#include <hip/hip_cooperative_groups.h>
#include <cstdio>
namespace cg = cooperative_groups;

#define LAS __attribute__((address_space(3)))
typedef unsigned short bf16_t;
typedef short bf16x8 __attribute__((ext_vector_type(8)));
typedef float f32x4 __attribute__((ext_vector_type(4)));
typedef unsigned u32x4 __attribute__((ext_vector_type(4)));
typedef unsigned u32x2 __attribute__((ext_vector_type(2)));

constexpr int DM = 2048, NPROMPT = 8192, NSAMPLE = 512, MTOK = 8704, NIN = 14336;
constexpr int OFF_CB = 0, OFF_CC = 1024, OFF_CH = 2048, OFF_CZ = 3072, OFF_SU = 4096, OFF_SZ = 5120, OFF_AQ = 6144, OFF_AZ = 7168, OFF_G = 8192;
constexpr int LDS_BYTES = 131072;
constexpr size_t O_Y = 0, O_MK = 17825792, O_MV = 18874368, O_CP = 19922944, O_RP = 19931136, O_IP = 19947520, O_CS = 19963904, O_RS = 20226048, O_IS = 20750336;
constexpr size_t WS_WIN = 0;
constexpr size_t WS_WG = WS_WIN + (size_t)NIN * DM * 2;
constexpr size_t WS_WC = WS_WG + 8388608;
constexpr size_t WS_WA = WS_WC + 4194304;
constexpr size_t WS_WO = WS_WA + 4194304;
constexpr size_t WS_WK = WS_WO + 8388608;
constexpr size_t WS_WV = WS_WK + 4194304;
constexpr size_t WS_H = WS_WV + 4194304;
constexpr size_t WS_MEMN = WS_H + (size_t)MTOK * DM * 2;
constexpr size_t WS_PROJ = WS_MEMN + 4194304;
constexpr size_t WS_KB = WS_PROJ + (size_t)MTOK * NIN * 2;
constexpr size_t WS_VT = WS_KB + 2097152;
constexpr size_t WS_YS = WS_VT + 2097152;
constexpr size_t WS_ACONV = WS_YS + (size_t)MTOK * 1024 * 2;
constexpr size_t WS_OATT = WS_ACONV + (size_t)MTOK * 1024 * 2;
constexpr size_t WS_SS = WS_OATT + (size_t)MTOK * 1024 * 2;
constexpr size_t WS_GLU = WS_SS + (size_t)MTOK * 32 * 4;
constexpr size_t WS_MERGED = WS_GLU + (size_t)MTOK * DM * 2;
constexpr size_t WS_END = WS_MERGED + (size_t)MTOK * DM * 2;
constexpr size_t WS_CONVO = WS_H, WS_ATTO = WS_WIN;
static_assert(WS_END <= 536870912, "workspace");

struct P {
    const float *x_prompt, *x_sample, *mem_prompt, *cache_k, *cache_v, *state_conv, *state_re, *state_im, *norm_g, *mem_norm_g, *w_in, *conv_w, *w_conv_out,
        *lam_re, *lam_im, *log_dt, *b_re, *b_im, *c_re, *c_im, *ssm_d, *w_glu_a, *w_glu_b, *w_mem_k, *w_mem_v, *w_attn_out, *w_out, *final_g;
    float* out; unsigned char* ws;
};

__device__ __forceinline__ unsigned cvt_pk_bf16(float lo, float hi) { unsigned r; asm("v_cvt_pk_bf16_f32 %0, %1, %2" : "=v"(r) : "v"(lo), "v"(hi)); return r; }
__device__ __forceinline__ float bf_lo(unsigned w) { return __uint_as_float(w << 16); }
__device__ __forceinline__ float bf_hi(unsigned w) { return __uint_as_float(w & 0xffff0000u); }
__device__ __forceinline__ float sigmoidf_(float x) { return 1.0f / (1.0f + __expf(-x)); }
__device__ __forceinline__ float siluf_(float x) { return x / (1.0f + __expf(-x)); }
__device__ __forceinline__ float gelu_tanh(float x) { const float u = 1.5957691216057308f * (x + 0.044715f * x * x * x); return x / (1.0f + __expf(-u)); }
__device__ __forceinline__ bf16x8 pack8(const f32x4 a, const f32x4 b) {
    u32x4 w; w.x = cvt_pk_bf16(a[0], a[1]); w.y = cvt_pk_bf16(a[2], a[3]); w.z = cvt_pk_bf16(b[0], b[1]); w.w = cvt_pk_bf16(b[2], b[3]);
    return __builtin_bit_cast(bf16x8, w);
}
__device__ __forceinline__ u32x4 pack8u(const f32x4 a, const f32x4 b) {
    u32x4 w; w.x = cvt_pk_bf16(a[0], a[1]); w.y = cvt_pk_bf16(a[2], a[3]); w.z = cvt_pk_bf16(b[0], b[1]); w.w = cvt_pk_bf16(b[2], b[3]); return w;
}
__device__ __forceinline__ void unpack8(const u32x4 w, float (&f)[8]) {
    f[0] = bf_lo(w.x); f[1] = bf_hi(w.x); f[2] = bf_lo(w.y); f[3] = bf_hi(w.y); f[4] = bf_lo(w.z); f[5] = bf_hi(w.z); f[6] = bf_lo(w.w); f[7] = bf_hi(w.w);
}
__device__ __forceinline__ int otid() { int t = threadIdx.x; asm volatile("" : "+v"(t)); return t; }
#define MFMA16(a, b, c) __builtin_amdgcn_mfma_f32_16x16x32_bf16((a), (b), (c), 0, 0, 0)

namespace pg8 {
constexpr int BM = 256, BK = 64, HALF = 128, HTB = HALF * BK * 2, STAGE_BYTES = 8 * HTB;
__device__ __forceinline__ int lds_byte(int r, int c) { const int st = (r >> 4) * 2 + (c >> 5), rr = r & 15, cc = c & 31, ob = rr * 64 + cc * 2; return st * 1024 + (ob ^ (((ob >> 9) & 1) << 5)); }
__device__ __forceinline__ void stage_rc(int b, int& R, int& C) { const int st = b / 1024, sb = b % 1024, swz = sb ^ (((sb >> 9) & 1) << 5); R = (st >> 1) * 16 + swz / 64; C = (st & 1) * 32 + (swz % 64) / 2; }
__device__ __forceinline__ int perm32(int rho) { const int n = rho >> 4, i = rho & 15; return 8 * (i >> 2) + 4 * n + (i & 3); }
struct Unit { const char* a; const char* b; int pm, pn, kind; };

template <class Sched, class Epi>
__device__ __forceinline__ void gemm_phase(LAS unsigned char* lds, const int K, const Sched& S, const Epi& E) {
    const int tid = otid(), wid = __builtin_amdgcn_readfirstlane(tid >> 6), lane = tid & 63, wr = wid >> 2, wc = wid & 3, fr = lane & 15, fq = lane >> 4;
    const int nt = K / BK;
    unsigned voffA[2], voffB[2];
#pragma unroll
    for (int i = 0; i < 2; ++i) { int R, C; stage_rc(tid * 16 + i * 8192, R, C); const int Rb = (R & ~31) + perm32(R & 31);
        voffA[i] = (unsigned)(R * K + C) * 2u; voffB[i] = (unsigned)(Rb * K + C) * 2u; }
    const size_t kstep = (size_t)(BK * 2);
    const size_t hstep = (size_t)HALF * K * 2;
    const unsigned ldsw = (unsigned)wid * 1024u;
    const int aoff = lds_byte(wr * 64 + fr, fq * 8), boff = lds_byte(wc * 32 + fr, fq * 8);
#define PG8_SA(b, h) (((b) * 2 + (h)) * HTB)
#define PG8_SB(b, h) ((4 + (b) * 2 + (h)) * HTB)
#define PG8_STAGE(bufoff, gbase, voff) do { _Pragma("unroll") for (int _i = 0; _i < 2; ++_i) \
        __builtin_amdgcn_global_load_lds((const unsigned*)((const char*)(gbase) + (voff)[_i]), (LAS unsigned*)(lds + (bufoff) + ldsw + _i * 8192), 16, 0, 0); } while (0)
#define PG8_LDA(dst, b, h) do { _Pragma("unroll") for (int m = 0; m < 4; ++m) _Pragma("unroll") for (int k = 0; k < 2; ++k) dst[m][k] = *(const LAS bf16x8*)(lds + PG8_SA(b, h) + aoff + m * 2048 + k * 1024); } while (0)
#define PG8_LDB(dst, b, h) do { _Pragma("unroll") for (int n = 0; n < 2; ++n) _Pragma("unroll") for (int k = 0; k < 2; ++k) dst[n][k] = *(const LAS bf16x8*)(lds + PG8_SB(b, h) + boff + n * 2048 + k * 1024); } while (0)
#define PG8_MMA(ai, bj, At, Bt) do { __builtin_amdgcn_s_setprio(1); _Pragma("unroll") for (int m = 0; m < 4; ++m) _Pragma("unroll") for (int n = 0; n < 2; ++n) _Pragma("unroll") for (int k = 0; k < 2; ++k) \
        acc[ai][bj][m][n] = __builtin_amdgcn_mfma_f32_16x16x32_bf16(Bt[n][k], At[m][k], acc[ai][bj][m][n], 0, 0, 0); __builtin_amdgcn_s_setprio(0); } while (0)
#define PG8_WAIT_V(n) asm volatile("s_waitcnt vmcnt(" #n ")" ::: "memory")
#define PG8_WAIT_L(n) asm volatile("s_waitcnt lgkmcnt(" #n ")" ::: "memory")
#define PG8_BAR __builtin_amdgcn_s_barrier()
#define PG8_SCHED __builtin_amdgcn_sched_barrier(0)
    Unit cur, nxt; int ui = 0;
    if (!S.next(0, cur)) return;
    f32x4 acc[2][2][4][2];
#pragma unroll
    for (int a = 0; a < 2; ++a)
#pragma unroll
        for (int b = 0; b < 2; ++b)
#pragma unroll
            for (int m = 0; m < 4; ++m)
#pragma unroll
                for (int n = 0; n < 2; ++n) acc[a][b][m][n] = (f32x4){0.f, 0.f, 0.f, 0.f};
    bf16x8 At[4][2], B0[2][2], B1[2][2];
    const char* cA = cur.a; const char* cB = cur.b;
    PG8_STAGE(PG8_SB(0, 0), cB, voffB); PG8_STAGE(PG8_SA(0, 0), cA, voffA); PG8_STAGE(PG8_SB(0, 1), cB + hstep, voffB); PG8_STAGE(PG8_SA(0, 1), cA + hstep, voffA);
    if (wr == 1) PG8_BAR;
    PG8_WAIT_V(4); PG8_BAR;
    PG8_STAGE(PG8_SB(1, 0), cB + kstep, voffB); PG8_STAGE(PG8_SA(1, 0), cA + kstep, voffA); PG8_STAGE(PG8_SB(1, 1), cB + hstep + kstep, voffB);
    PG8_WAIT_V(6); PG8_BAR;
    for (;;) {
        const bool has_next = S.next(ui + 1, nxt);
        const char* nA = has_next ? nxt.a : cA; const char* nB = has_next ? nxt.b : cB;
        for (int t = 0; t < nt; t += 2) {
            const bool last = (t == nt - 2);
            const char* a1 = cA + (size_t)(t + 1) * kstep;
            const char* a2 = last ? nA : cA + (size_t)(t + 2) * kstep; const char* b2 = last ? nB : cB + (size_t)(t + 2) * kstep;
            const char* a3 = a2 + kstep; const char* b3 = b2 + kstep;
            PG8_LDB(B0, 0, 0); PG8_SCHED; PG8_LDA(At, 0, 0); PG8_STAGE(PG8_SA(1, 1), a1 + hstep, voffA);
            PG8_WAIT_L(8); PG8_BAR; PG8_WAIT_L(0); PG8_MMA(0, 0, At, B0); PG8_BAR; PG8_SCHED;
            PG8_LDB(B1, 0, 1); PG8_STAGE(PG8_SB(0, 0), b2, voffB);
            PG8_BAR; PG8_WAIT_L(0); PG8_MMA(0, 1, At, B1); PG8_BAR;
            PG8_LDA(At, 0, 1); PG8_STAGE(PG8_SA(0, 0), a2, voffA);
            PG8_BAR; PG8_WAIT_L(0); PG8_MMA(1, 0, At, B0); PG8_BAR; PG8_SCHED;
            PG8_STAGE(PG8_SB(0, 1), b2 + hstep, voffB);
            PG8_WAIT_V(6); PG8_BAR; PG8_MMA(1, 1, At, B1); PG8_BAR;
            PG8_LDB(B0, 1, 0); PG8_SCHED; PG8_LDA(At, 1, 0); PG8_STAGE(PG8_SA(0, 1), a2 + hstep, voffA);
            PG8_WAIT_L(8); PG8_BAR; PG8_WAIT_L(0); PG8_MMA(0, 0, At, B0); PG8_BAR; PG8_SCHED;
            PG8_LDB(B1, 1, 1); PG8_STAGE(PG8_SB(1, 0), b3, voffB);
            PG8_BAR; PG8_WAIT_L(0); PG8_MMA(0, 1, At, B1); PG8_BAR;
            PG8_LDA(At, 1, 1); PG8_STAGE(PG8_SA(1, 0), a3, voffA);
            PG8_BAR; PG8_WAIT_L(0); PG8_MMA(1, 0, At, B0); PG8_BAR; PG8_SCHED;
            PG8_STAGE(PG8_SB(1, 1), b3 + hstep, voffB);
            PG8_WAIT_V(6); PG8_BAR; PG8_MMA(1, 1, At, B1); PG8_BAR;
        }
        const bool keep = E(acc, cur, wr, wc, fr, fq);
        if (!has_next) break;
        if (!keep) {
#pragma unroll
            for (int a = 0; a < 2; ++a)
#pragma unroll
                for (int b = 0; b < 2; ++b)
#pragma unroll
                    for (int m = 0; m < 4; ++m)
#pragma unroll
                        for (int n = 0; n < 2; ++n) acc[a][b][m][n] = (f32x4){0.f, 0.f, 0.f, 0.f};
        }
        cur = nxt; cA = nA; cB = nB; ++ui;
    }
    PG8_WAIT_V(0);
    if (wr == 0) PG8_BAR;
    PG8_BAR;
#undef PG8_SA
#undef PG8_SB
#undef PG8_STAGE
#undef PG8_LDA
#undef PG8_LDB
#undef PG8_MMA
#undef PG8_WAIT_V
#undef PG8_WAIT_L
#undef PG8_BAR
#undef PG8_SCHED
}
}
using pg8::Unit;

struct Sched1 {
    const char *H, *WIN, *MEMN, *WK, *WV; int G, c;
    __device__ __forceinline__ bool next(int i, Unit& u) const {
        const int L = i * G + c; if (L >= 1936) return false;
        if (L < 1904) {
            const int nM = 34, nN = 56, nwg = 1904, NX = 8, WGM = 8;
            int wgid = L; { const int q = nwg / NX, r = nwg % NX, xcd = wgid % NX, off = wgid / NX; wgid = (xcd < r ? xcd * (q + 1) : r * (q + 1) + (xcd - r) * q) + off; }
            const int nig = WGM * nN, gid = wgid / nig, fm = gid * WGM, gsz = (nM - fm) < WGM ? (nM - fm) : WGM;
            u.pm = fm + ((wgid % nig) % gsz); u.pn = (wgid % nig) / gsz; u.kind = 0;
            u.a = H + (size_t)u.pm * 1048576; u.b = WIN + (size_t)u.pn * 1048576;
        } else if (L < 1920) { const int j = L - 1904; u.pm = j >> 2; u.pn = j & 3; u.kind = 1; u.a = MEMN + (size_t)u.pm * 1048576; u.b = WK + (size_t)u.pn * 1048576; }
        else { const int j = L - 1920; u.pm = j >> 2; u.pn = j & 3; u.kind = 2; u.a = WV + (size_t)u.pm * 1048576; u.b = MEMN + (size_t)u.pn * 1048576; }
        return true;
    }
};
struct Epi1 {
    bf16_t* PROJ; float* outK; bf16_t* KB; float* outV; bf16_t* VT;
    __device__ __forceinline__ bool operator()(f32x4 (&acc)[2][2][4][2], const Unit& u, int wr, int wc, int fr, int fq) const {
        const int r0 = u.pm * 256 + wr * 64 + fr, c0 = u.pn * 256 + wc * 32 + 8 * fq;
        if (u.kind == 0) {
#pragma unroll
            for (int ai = 0; ai < 2; ++ai)
#pragma unroll
                for (int m = 0; m < 4; ++m) { bf16_t* rowp = PROJ + (size_t)(r0 + ai * 128 + m * 16) * NIN + c0;
#pragma unroll
                    for (int bj = 0; bj < 2; ++bj) *(u32x4*)(rowp + bj * 128) = pack8u(acc[ai][bj][m][0], acc[ai][bj][m][1]); }
        } else if (u.kind == 1) {
#pragma unroll
            for (int ai = 0; ai < 2; ++ai)
#pragma unroll
                for (int m = 0; m < 4; ++m) { const size_t off = (size_t)(r0 + ai * 128 + m * 16) * 1024 + c0;
#pragma unroll
                    for (int bj = 0; bj < 2; ++bj) { *(f32x4*)(outK + off + bj * 128) = acc[ai][bj][m][0]; *(f32x4*)(outK + off + bj * 128 + 4) = acc[ai][bj][m][1];
                        *(u32x4*)(KB + off + bj * 128) = pack8u(acc[ai][bj][m][0], acc[ai][bj][m][1]); } }
        } else {
            const int h = u.pm, b = u.pn;
#pragma unroll
            for (int ai = 0; ai < 2; ++ai)
#pragma unroll
                for (int m = 0; m < 4; ++m) { const int d = wr * 64 + fr + ai * 128 + m * 16;
#pragma unroll
                    for (int bj = 0; bj < 2; ++bj) { const int key0 = wc * 32 + 8 * fq + bj * 128;
                        *(u32x4*)(VT + ((size_t)((b * 4 + h) * 256 + d)) * 256 + key0) = pack8u(acc[ai][bj][m][0], acc[ai][bj][m][1]);
                        float* fp = outV + ((size_t)(b * 256 + key0)) * 1024 + h * 256 + d;
#pragma unroll
                        for (int e = 0; e < 4; ++e) { fp[(size_t)e * 1024] = acc[ai][bj][m][0][e]; fp[(size_t)(e + 4) * 1024] = acc[ai][bj][m][1][e]; } } }
        }
        return false;
    }
};

struct Sched2 {
    const char* ws; int G, c;
    __device__ __forceinline__ bool next(int i, Unit& u) const {
        const int L = i * G + c; if (L >= 1088) return false;
        if (L < 544) { u.pm = L >> 4; u.pn = L & 15; u.kind = 0; u.a = ws + WS_YS + (size_t)u.pm * 524288; u.b = ws + WS_WG + (size_t)u.pn * 524288; }
        else { const int j = L - 544, k = j >= 272 ? 1 : 0, jj = j - 272 * k; u.pm = jj >> 3; u.pn = jj & 7; u.kind = 1 + k;
            u.a = ws + WS_ACONV + (size_t)k * ((size_t)MTOK * 1024 * 2) + (size_t)u.pm * 524288; u.b = ws + WS_WC + (size_t)k * 4194304 + (size_t)u.pn * 524288; }
        return true;
    }
};
struct Epi2 {
    bf16_t* GLU; bf16_t* CONVO; bf16_t* ATTO;
    __device__ __forceinline__ bool operator()(f32x4 (&acc)[2][2][4][2], const Unit& u, int wr, int wc, int fr, int fq) const {
        const int r0 = u.pm * 256 + wr * 64 + fr;
        if (u.kind == 0) {
            const int c0 = u.pn * 128 + wc * 32 + 8 * fq;
#pragma unroll
            for (int ai = 0; ai < 2; ++ai)
#pragma unroll
                for (int m = 0; m < 4; ++m) {
                    f32x4 t0, t1;
#pragma unroll
                    for (int e = 0; e < 4; ++e) { t0[e] = acc[ai][0][m][0][e] * sigmoidf_(acc[ai][1][m][0][e]); t1[e] = acc[ai][0][m][1][e] * sigmoidf_(acc[ai][1][m][1][e]); }
                    *(u32x4*)(GLU + (size_t)(r0 + ai * 128 + m * 16) * 2048 + c0) = pack8u(t0, t1);
                }
        } else {
            bf16_t* O = u.kind == 1 ? CONVO : ATTO; const int c0 = u.pn * 256 + wc * 32 + 8 * fq;
#pragma unroll
            for (int ai = 0; ai < 2; ++ai)
#pragma unroll
                for (int m = 0; m < 4; ++m) { bf16_t* rowp = O + (size_t)(r0 + ai * 128 + m * 16) * 2048 + c0;
#pragma unroll
                    for (int bj = 0; bj < 2; ++bj) *(u32x4*)(rowp + bj * 128) = pack8u(acc[ai][bj][m][0], acc[ai][bj][m][1]); }
        }
        return false;
    }
};
__device__ __forceinline__ void merge_phase(const P& p) {
    const bf16_t* PROJ = (const bf16_t*)(p.ws + WS_PROJ); const bf16_t* GLU = (const bf16_t*)(p.ws + WS_GLU); const bf16_t* CONVO = (const bf16_t*)(p.ws + WS_CONVO);
    const bf16_t* ATTO = (const bf16_t*)(p.ws + WS_ATTO); bf16_t* MERGED = (bf16_t*)(p.ws + WS_MERGED);
    const int NT = MTOK * 256;
    for (int t = blockIdx.x * 512 + otid(); t < NT; t += gridDim.x * 512) {
        const size_t row = (size_t)(t >> 8); const int c0 = (t & 255) * 8;
        const bf16_t* pr = PROJ + row * NIN + OFF_G + c0; const size_t o = row * 2048 + c0;
        float g0[8], g1[8], g2[8], cv[8], gl[8], at[8];
        unpack8(*(const u32x4*)pr, g0); unpack8(*(const u32x4*)(pr + 2048), g1); unpack8(*(const u32x4*)(pr + 4096), g2);
        unpack8(*(const u32x4*)(CONVO + o), cv); unpack8(*(const u32x4*)(GLU + o), gl); unpack8(*(const u32x4*)(ATTO + o), at);
        f32x4 m0, m1;
#pragma unroll
        for (int e = 0; e < 8; ++e) { const float v = sigmoidf_(g0[e]) * cv[e] + sigmoidf_(g1[e]) * gl[e] + sigmoidf_(g2[e]) * at[e]; if (e < 4) m0[e] = v; else m1[e - 4] = v; }
        *(u32x4*)(MERGED + o) = pack8u(m0, m1);
    }
}

struct Sched3 {
    const char *MERGED, *WO; int G, c;
    __device__ __forceinline__ bool next(int i, Unit& u) const {
        const int L = i * G + c; if (L >= 272) return false;
        u.pm = L >> 3; u.pn = L & 7; u.kind = 0; u.a = MERGED + (size_t)u.pm * 1048576; u.b = WO + (size_t)u.pn * 1048576; return true;
    }
};
struct Epi3 {
    const float* xp; const float* xs; float* out; float* ss;
    __device__ __forceinline__ bool operator()(f32x4 (&acc)[2][2][4][2], const Unit& u, int wr, int wc, int fr, int fq) const {
        const int r0 = u.pm * 256 + wr * 64 + fr, c0 = u.pn * 256 + wc * 32 + 8 * fq;
#pragma unroll
        for (int ai = 0; ai < 2; ++ai)
#pragma unroll
            for (int m = 0; m < 4; ++m) {
                const int row = r0 + ai * 128 + m * 16;
                const float* xr = (row < NPROMPT ? xp + (size_t)row * DM : xs + (size_t)(row - NPROMPT) * DM) + c0;
                float* o = out + (size_t)row * DM + c0; float s = 0.f;
#pragma unroll
                for (int bj = 0; bj < 2; ++bj)
#pragma unroll
                    for (int n = 0; n < 2; ++n) { const f32x4 v = *(const f32x4*)(xr + bj * 128 + 4 * n) + acc[ai][bj][m][n]; *(f32x4*)(o + bj * 128 + 4 * n) = v;
                        s += (v[0] * v[0] + v[1] * v[1]) + (v[2] * v[2] + v[3] * v[3]); }
                s += __shfl_xor(s, 16); s += __shfl_xor(s, 32);
                if (fq == 0) ss[(size_t)row * 32 + u.pn * 4 + wc] = s;
            }
        return false;
    }
};

__device__ __forceinline__ void transpose_tile(const float* __restrict__ src, const int K, const int N, bf16_t* __restrict__ dst, const int mode, const int t, LAS float* tile) {
    const int tid = otid(); const int tn = N / 256;
    const int r = tid >> 3, c8 = (tid & 7) * 8;
    const int k0 = (t / tn) * 64, n0 = (t % tn) * 256;
    const float* s = src + (size_t)(k0 + r) * N + n0 + c8;
    f32x4 v[8];
#pragma unroll
    for (int j = 0; j < 4; ++j) { v[2 * j] = *(const f32x4*)(s + j * 64); v[2 * j + 1] = *(const f32x4*)(s + j * 64 + 4); }
#pragma unroll
    for (int j = 0; j < 4; ++j)
#pragma unroll
        for (int e = 0; e < 4; ++e) { tile[j * 4160 + r * 65 + c8 + e] = v[2 * j][e]; tile[j * 4160 + r * 65 + c8 + 4 + e] = v[2 * j + 1][e]; }
    __syncthreads();
#pragma unroll
    for (int j = 0; j < 4; ++j) {
        f32x4 a, b;
#pragma unroll
        for (int e = 0; e < 4; ++e) { a[e] = tile[j * 4160 + (c8 + e) * 65 + r]; b[e] = tile[j * 4160 + (c8 + 4 + e) * 65 + r]; }
        const int n = n0 + j * 64 + r;
        const int row = mode == 0 ? n : ((n >> 7) * 256 + (mode - 1) * 128 + (n & 127));
        *(u32x4*)(dst + (size_t)row * K + k0 + c8) = pack8u(a, b);
    }
    __syncthreads();
}
__device__ __forceinline__ void phase0(const P& p, LAS unsigned char* lds) {
    unsigned char* ws = p.ws; LAS float* tile = (LAS float*)lds;
    for (int t = blockIdx.x; t < 1792; t += gridDim.x) transpose_tile(p.w_in, 2048, NIN, (bf16_t*)(ws + WS_WIN), 0, t, tile);
    for (int t = blockIdx.x; t < 1024; t += gridDim.x) {
        if (t < 128) transpose_tile(p.w_conv_out, 1024, 2048, (bf16_t*)(ws + WS_WC), 0, t, tile);
        else if (t < 256) transpose_tile(p.w_attn_out, 1024, 2048, (bf16_t*)(ws + WS_WA), 0, t - 128, tile);
        else if (t < 384) transpose_tile(p.w_glu_a, 1024, 2048, (bf16_t*)(ws + WS_WG), 1, t - 256, tile);
        else if (t < 512) transpose_tile(p.w_glu_b, 1024, 2048, (bf16_t*)(ws + WS_WG), 2, t - 384, tile);
        else if (t < 768) transpose_tile(p.w_out, 2048, 2048, (bf16_t*)(ws + WS_WO), 0, t - 512, tile);
        else if (t < 896) transpose_tile(p.w_mem_k, 2048, 1024, (bf16_t*)(ws + WS_WK), 0, t - 768, tile);
        else transpose_tile(p.w_mem_v, 2048, 1024, (bf16_t*)(ws + WS_WV), 0, t - 896, tile);
    }
    const int t0 = otid(); const int lane = t0 & 63, gw = blockIdx.x * 8 + (t0 >> 6), nw = gridDim.x * 8;
    for (int row = gw; row < MTOK + 1024; row += nw) {
        const float* src; const float* g; bf16_t* dst;
        if (row < NPROMPT) { src = p.x_prompt + (size_t)row * DM; g = p.norm_g; dst = (bf16_t*)(ws + WS_H) + (size_t)row * DM; }
        else if (row < MTOK) { src = p.x_sample + (size_t)(row - NPROMPT) * DM; g = p.norm_g; dst = (bf16_t*)(ws + WS_H) + (size_t)row * DM; }
        else { src = p.mem_prompt + (size_t)(row - MTOK) * DM; g = p.mem_norm_g; dst = (bf16_t*)(ws + WS_MEMN) + (size_t)(row - MTOK) * DM; }
        f32x4 v[8]; float s = 0.f;
#pragma unroll
        for (int i = 0; i < 8; ++i) { v[i] = *(const f32x4*)(src + 4 * (lane + 64 * i)); s += (v[i][0] * v[i][0] + v[i][1] * v[i][1]) + (v[i][2] * v[i][2] + v[i][3] * v[i][3]); }
#pragma unroll
        for (int o = 32; o >= 1; o >>= 1) s += __shfl_xor(s, o);
        const float rstd = 1.0f / sqrtf(s * (1.0f / 2048.0f) + 1e-6f);
#pragma unroll
        for (int i = 0; i < 8; ++i) { const f32x4 gv = *(const f32x4*)(g + 4 * (lane + 64 * i));
            u32x2 w; w.x = cvt_pk_bf16(v[i][0] * rstd * gv[0], v[i][1] * rstd * gv[1]); w.y = cvt_pk_bf16(v[i][2] * rstd * gv[2], v[i][3] * rstd * gv[3]);
            *(u32x2*)(dst + 4 * (lane + 64 * i)) = w; }
    }
}

__device__ __forceinline__ void conv_phase(const P& p) {
    const bf16_t* PROJ = (const bf16_t*)(p.ws + WS_PROJ); bf16_t* ACONV = (bf16_t*)(p.ws + WS_ACONV);
    const int NTASK = 131072 + 16384;
    for (int task = blockIdx.x * 512 + otid(); task < NTASK; task += gridDim.x * 512) {
        int cgp, r0, len; bool prompt = task < 131072; int bs = 0;
        if (prompt) { cgp = task & 127; r0 = (task >> 7) * 8; len = 8; }
        else { const int ts = task - 131072; cgp = ts & 127; bs = ts >> 7; r0 = NPROMPT + 4 * bs; len = 4; }
        const int c0 = cgp * 8;
        float w0[8], w1[8], w2[8], vm2[8], vm1[8];
        { const f32x4 a0 = *(const f32x4*)(p.conv_w + c0), a1 = *(const f32x4*)(p.conv_w + c0 + 4), b0 = *(const f32x4*)(p.conv_w + 1024 + c0), b1 = *(const f32x4*)(p.conv_w + 1024 + c0 + 4),
              d0 = *(const f32x4*)(p.conv_w + 2048 + c0), d1 = *(const f32x4*)(p.conv_w + 2048 + c0 + 4);
#pragma unroll
          for (int e = 0; e < 4; ++e) { w0[e] = a0[e]; w0[e + 4] = a1[e]; w1[e] = b0[e]; w1[e + 4] = b1[e]; w2[e] = d0[e]; w2[e + 4] = d1[e]; } }
        if (prompt) {
            if ((r0 & 2047) == 0) {
#pragma unroll
                for (int e = 0; e < 8; ++e) { vm2[e] = 0.f; vm1[e] = 0.f; }
            } else {
                float a[8], b[8];
                unpack8(*(const u32x4*)(PROJ + (size_t)(r0 - 2) * NIN + OFF_CC + c0), a); unpack8(*(const u32x4*)(PROJ + (size_t)(r0 - 2) * NIN + OFF_CH + c0), b);
#pragma unroll
                for (int e = 0; e < 8; ++e) vm2[e] = a[e] * b[e];
                unpack8(*(const u32x4*)(PROJ + (size_t)(r0 - 1) * NIN + OFF_CC + c0), a); unpack8(*(const u32x4*)(PROJ + (size_t)(r0 - 1) * NIN + OFF_CH + c0), b);
#pragma unroll
                for (int e = 0; e < 8; ++e) vm1[e] = a[e] * b[e];
            }
        } else {
            const float* sc = p.state_conv + (size_t)bs * 2048 + c0;
            const f32x4 a0 = *(const f32x4*)sc, a1 = *(const f32x4*)(sc + 4), b0 = *(const f32x4*)(sc + 1024), b1 = *(const f32x4*)(sc + 1028);
#pragma unroll
            for (int e = 0; e < 4; ++e) { vm2[e] = a0[e]; vm2[e + 4] = a1[e]; vm1[e] = b0[e]; vm1[e + 4] = b1[e]; }
        }
        for (int i = 0; i < len; ++i) {
            const size_t row = (size_t)(r0 + i);
            const bf16_t* pr = PROJ + row * NIN + c0;
            float cb[8], cc[8], ch[8], cz[8], v[8];
            unpack8(*(const u32x4*)(pr + OFF_CB), cb); unpack8(*(const u32x4*)(pr + OFF_CC), cc); unpack8(*(const u32x4*)(pr + OFF_CH), ch); unpack8(*(const u32x4*)(pr + OFF_CZ), cz);
            f32x4 o0, o1;
#pragma unroll
            for (int e = 0; e < 8; ++e) { v[e] = cc[e] * ch[e]; const float cv = w0[e] * vm2[e] + w1[e] * vm1[e] + w2[e] * v[e]; const float r = cb[e] * cv * siluf_(cz[e]);
                if (e < 4) o0[e] = r; else o1[e - 4] = r; vm2[e] = vm1[e]; vm1[e] = v[e]; }
            *(u32x4*)(ACONV + row * 1024 + c0) = pack8u(o0, o1);
            float* dst = nullptr;
            if (prompt) { const int pos = (r0 + i) & 2047; if (pos >= 2046) dst = p.out + O_CP + ((size_t)((r0 + i) >> 11) * 2 + (pos - 2046)) * 1024 + c0; }
            else if (i >= 2) dst = p.out + O_CS + ((size_t)bs * 2 + (i - 2)) * 1024 + c0;
            if (dst) { *(f32x4*)dst = (f32x4){v[0], v[1], v[2], v[3]}; *(f32x4*)(dst + 4) = (f32x4){v[4], v[5], v[6], v[7]}; }
        }
    }
}

__device__ __forceinline__ void s5_steps4(const bf16_t* PROJ, bf16_t* YS, const size_t row0, const int g, const int g4, const bool Y,
                                          const bf16x8 (&bre)[4], const bf16x8 (&bim)[4], const bf16x8 (&cf)[4], const float (&ar)[16], const float (&ai)[16], const f32x4 dsk,
                                          float (&sr)[16], float (&si)[16]) {
    bf16x8 U[4]; u32x2 u4[4], z4[4];
    const bf16_t* base = PROJ + row0 * NIN + g * 16;
#pragma unroll
    for (int i = 0; i < 4; ++i) {
        U[i] = *(const bf16x8*)(base + (size_t)i * NIN + OFF_SU + 8 * (g4 & 1));
        u4[i] = *(const u32x2*)(base + (size_t)i * NIN + OFF_SU + 4 * g4); z4[i] = *(const u32x2*)(base + (size_t)i * NIN + OFF_SZ + 4 * g4);
    }
    const f32x4 zero4 = (f32x4){0.f, 0.f, 0.f, 0.f};
#pragma unroll
    for (int i = 0; i < 4; ++i) {
#pragma unroll
        for (int pb = 0; pb < 4; ++pb) {
            const f32x4 xr = MFMA16(bre[pb], U[i], zero4), xi = MFMA16(bim[pb], U[i], zero4);
#pragma unroll
            for (int j = 0; j < 4; ++j) { const int k = pb * 4 + j; const float nr = ar[k] * sr[k] - ai[k] * si[k] + xr[j]; const float ni = ar[k] * si[k] + ai[k] * sr[k] + xi[j]; sr[k] = nr; si[k] = ni; }
        }
        if (Y) {
            f32x4 y = zero4;
            y = MFMA16(cf[0], pack8((f32x4){sr[0], sr[1], sr[2], sr[3]}, (f32x4){sr[4], sr[5], sr[6], sr[7]}), y);
            y = MFMA16(cf[1], pack8((f32x4){sr[8], sr[9], sr[10], sr[11]}, (f32x4){sr[12], sr[13], sr[14], sr[15]}), y);
            y = MFMA16(cf[2], pack8((f32x4){si[0], si[1], si[2], si[3]}, (f32x4){si[4], si[5], si[6], si[7]}), y);
            y = MFMA16(cf[3], pack8((f32x4){si[8], si[9], si[10], si[11]}, (f32x4){si[12], si[13], si[14], si[15]}), y);
            const float uu[4] = {bf_lo(u4[i].x), bf_hi(u4[i].x), bf_lo(u4[i].y), bf_hi(u4[i].y)};
            const float zz[4] = {bf_lo(z4[i].x), bf_hi(z4[i].x), bf_lo(z4[i].y), bf_hi(z4[i].y)};
            float o[4];
#pragma unroll
            for (int j = 0; j < 4; ++j) { const float ysv = y[j] + dsk[j] * uu[j]; o[j] = gelu_tanh(ysv * siluf_(zz[j])); }
            u32x2 w; w.x = cvt_pk_bf16(o[0], o[1]); w.y = cvt_pk_bf16(o[2], o[3]);
            *(u32x2*)(YS + (row0 + i) * 1024 + g * 16 + 4 * g4) = w;
        }
    }
}
__device__ __forceinline__ void s5_coef(const P& p, int g, int pp, float dt, float& ar, float& ai, float& fr, float& fi) {
    const float lr = p.lam_re[g * 64 + pp], li = p.lam_im[g * 64 + pp];
    const float mag = expf(lr * dt), ang = li * dt; float sn, cs; sincosf(ang, &sn, &cs);
    ar = mag * cs; ai = mag * sn; const float den = lr * lr + li * li;
    fr = ((ar - 1.0f) * lr + ai * li) / den; fi = (ai * lr - (ar - 1.0f) * li) / den;
}
__device__ __forceinline__ void s5_unit(const P& p, const int unit, LAS unsigned char* lds) {
    const bf16_t* PROJ = (const bf16_t*)(p.ws + WS_PROJ); bf16_t* YS = (bf16_t*)(p.ws + WS_YS);
    const int tid = otid(), lane = tid & 63, w = tid >> 6, cl = lane & 15, g4 = lane >> 4;
    const bool prompt = unit < 256; const int g = prompt ? (unit & 63) : (unit - 256); const int b = unit >> 6;
    const float dt = expf(p.log_dt[g]);
    LAS float* E = (LAS float*)lds;
    LAS f32x4* CT = (LAS f32x4*)(lds + 65536);
    if (tid < 64) { float a_r, a_i, fr_, fi_; s5_coef(p, g, tid, dt, a_r, a_i, fr_, fi_); CT[tid] = (f32x4){a_r, a_i, fr_, fi_}; }
    __syncthreads();
    float ar[16], ai[16];
#pragma unroll
    for (int pb = 0; pb < 4; ++pb)
#pragma unroll
        for (int j = 0; j < 4; ++j) { const f32x4 t = CT[16 * pb + 4 * g4 + j]; ar[pb * 4 + j] = t[0]; ai[pb * 4 + j] = t[1]; }
    bf16x8 bre[4], bim[4], cf[4];
    const float bmask = g4 < 2 ? 1.0f : 0.0f;
#pragma unroll
    for (int pb = 0; pb < 4; ++pb) {
        const int pp = 16 * pb + cl; const f32x4 t = CT[pp]; const float fr_ = t[2] * bmask, fi_ = t[3] * bmask;
        const float* br = p.b_re + ((size_t)(g * 64 + pp)) * 16 + 8 * (g4 & 1); const float* bi = p.b_im + ((size_t)(g * 64 + pp)) * 16 + 8 * (g4 & 1);
        const f32x4 r0 = *(const f32x4*)br, r1 = *(const f32x4*)(br + 4), i0 = *(const f32x4*)bi, i1 = *(const f32x4*)(bi + 4);
        bre[pb] = pack8(fr_ * r0 - fi_ * i0, fr_ * r1 - fi_ * i1);
        bim[pb] = pack8(fr_ * i0 + fi_ * r0, fr_ * i1 + fi_ * r1);
    }
#pragma unroll
    for (int ks = 0; ks < 4; ++ks) {
        const float* cp = (ks < 2 ? p.c_re : p.c_im) + ((size_t)(g * 16 + cl)) * 64 + 32 * (ks & 1) + 4 * g4;
        f32x4 a = *(const f32x4*)cp, c = *(const f32x4*)(cp + 16);
        if (ks >= 2) { a = -a; c = -c; }
        cf[ks] = pack8(a, c);
    }
    const f32x4 dsk = *(const f32x4*)(p.ssm_d + g * 16 + 4 * g4);
    const int chain = 16 * w + cl;
    const size_t row0 = prompt ? (size_t)b * 2048 + (size_t)chain * 16 : (size_t)NPROMPT + 4 * chain;
    const size_t so = ((size_t)chain * 64 + g) * 64 + 4 * g4;
    const int nq = prompt ? 4 : 1;
    float sr[16], si[16];
#pragma unroll
    for (int k = 0; k < 16; ++k) { sr[k] = 0.f; si[k] = 0.f; }
    if (!prompt) {
#pragma unroll
        for (int pb = 0; pb < 4; ++pb) { const f32x4 a = *(const f32x4*)(p.state_re + so + 16 * pb), c = *(const f32x4*)(p.state_im + so + 16 * pb);
#pragma unroll
            for (int j = 0; j < 4; ++j) { sr[pb * 4 + j] = a[j]; si[pb * 4 + j] = c[j]; } }
    }
#pragma unroll 1
    for (int pass = prompt ? 0 : 1; pass < 2; ++pass) {
        if (pass == 1 && prompt) {
#pragma unroll
            for (int pb = 0; pb < 4; ++pb) {
                *(LAS f32x4*)(E + (chain * 2 + 0) * 64 + 16 * pb + 4 * g4) = (f32x4){sr[pb * 4], sr[pb * 4 + 1], sr[pb * 4 + 2], sr[pb * 4 + 3]};
                *(LAS f32x4*)(E + (chain * 2 + 1) * 64 + 16 * pb + 4 * g4) = (f32x4){si[pb * 4], si[pb * 4 + 1], si[pb * 4 + 2], si[pb * 4 + 3]};
            }
            __syncthreads();
            if (w == 0) {
                float a_r, a_i; { const f32x4 t = CT[lane]; a_r = t[0]; a_i = t[1]; }
#pragma unroll
                for (int q = 0; q < 4; ++q) { const float nr = a_r * a_r - a_i * a_i, ni = 2.0f * a_r * a_i; a_r = nr; a_i = ni; }
                float Fr = 0.f, Fi = 0.f;
#pragma unroll 8
                for (int k = 0; k < 128; ++k) {
                    const float er = E[(2 * k) * 64 + lane], ei = E[(2 * k + 1) * 64 + lane];
                    E[(2 * k) * 64 + lane] = Fr; E[(2 * k + 1) * 64 + lane] = Fi;
                    const float nr = a_r * Fr - a_i * Fi + er; Fi = a_r * Fi + a_i * Fr + ei; Fr = nr;
                }
                p.out[O_RP + (size_t)(b * 64 + g) * 64 + lane] = Fr; p.out[O_IP + (size_t)(b * 64 + g) * 64 + lane] = Fi;
            }
            __syncthreads();
#pragma unroll
            for (int pb = 0; pb < 4; ++pb) {
                const f32x4 a = *(LAS f32x4*)(E + (chain * 2 + 0) * 64 + 16 * pb + 4 * g4), c = *(LAS f32x4*)(E + (chain * 2 + 1) * 64 + 16 * pb + 4 * g4);
#pragma unroll
                for (int j = 0; j < 4; ++j) { sr[pb * 4 + j] = a[j]; si[pb * 4 + j] = c[j]; }
            }
        }
#pragma unroll 1
        for (int q = 0; q < nq; ++q) s5_steps4(PROJ, YS, row0 + 4 * q, g, g4, pass == 1, bre, bim, cf, ar, ai, dsk, sr, si);
    }
    if (!prompt) {
#pragma unroll
        for (int pb = 0; pb < 4; ++pb) {
            *(f32x4*)(p.out + O_RS + so + 16 * pb) = (f32x4){sr[pb * 4], sr[pb * 4 + 1], sr[pb * 4 + 2], sr[pb * 4 + 3]};
            *(f32x4*)(p.out + O_IS + so + 16 * pb) = (f32x4){si[pb * 4], si[pb * 4 + 1], si[pb * 4 + 2], si[pb * 4 + 3]};
        }
    }
    __syncthreads();
}

__device__ __forceinline__ void attn_prompt_unit(const P& p, const int unit, LAS unsigned char* lds) {
    const bf16_t* PROJ = (const bf16_t*)(p.ws + WS_PROJ); const bf16_t* KB = (const bf16_t*)(p.ws + WS_KB); const bf16_t* VT = (const bf16_t*)(p.ws + WS_VT);
    bf16_t* OATT = (bf16_t*)(p.ws + WS_OATT);
    const int tid = otid(), lane = tid & 63, w = tid >> 6, cl = lane & 15, g4 = lane >> 4;
    const int b = unit >> 6, h = (unit >> 4) & 3, qb = unit & 15;
    const bf16_t* kbase = KB + (size_t)(b * 256) * 1024 + h * 256;
#pragma unroll
    for (int i = 0; i < 16; ++i) { const int idx = tid + 512 * i, r = idx >> 5, m = idx & 31;
        const u32x4 v = *(const u32x4*)(kbase + (size_t)r * 1024 + m * 8); *(LAS u32x4*)(lds + r * 512 + ((m ^ (r & 15)) << 4)) = v; }
    const size_t qrow = (size_t)b * 2048 + qb * 128 + w * 16 + cl;
    const bf16_t* qp = PROJ + qrow * NIN + OFF_AQ + h * 256 + 8 * g4;
    bf16x8 qf[8];
#pragma unroll
    for (int ks = 0; ks < 8; ++ks) qf[ks] = *(const bf16x8*)(qp + 32 * ks);
    __syncthreads();
    f32x4 s[16];
#pragma unroll
    for (int kb = 0; kb < 16; ++kb) { s[kb] = (f32x4){0.f, 0.f, 0.f, 0.f};
#pragma unroll
        for (int ks = 0; ks < 8; ++ks) { const int key = 16 * kb + cl, m = 4 * ks + g4;
            const bf16x8 kf = *(const LAS bf16x8*)(lds + key * 512 + ((m ^ cl) << 4)); s[kb] = MFMA16(kf, qf[ks], s[kb]); }
        __builtin_amdgcn_sched_barrier(0); }
    float mx = -3.0e38f;
#pragma unroll
    for (int kb = 0; kb < 16; ++kb)
#pragma unroll
        for (int j = 0; j < 4; ++j) mx = fmaxf(mx, s[kb][j]);
    mx = fmaxf(mx, __shfl_xor(mx, 16)); mx = fmaxf(mx, __shfl_xor(mx, 32));
    float sum = 0.f;
#pragma unroll
    for (int kb = 0; kb < 16; ++kb)
#pragma unroll
        for (int j = 0; j < 4; ++j) { const float e = __expf((s[kb][j] - mx) * 0.0625f); s[kb][j] = e; sum += e; }
    sum += __shfl_xor(sum, 16); sum += __shfl_xor(sum, 32);
    const float inv = 1.0f / sum;
    bf16x8 pf[8];
#pragma unroll
    for (int kk = 0; kk < 8; ++kk) pf[kk] = pack8(s[2 * kk], s[2 * kk + 1]);
    __syncthreads();
    const bf16_t* vbase = VT + (size_t)((b * 4 + h) * 256) * 256;
#pragma unroll
    for (int i = 0; i < 16; ++i) { const int idx = tid + 512 * i, r = idx >> 5, m = idx & 31;
        const u32x4 v = *(const u32x4*)(vbase + (size_t)r * 256 + m * 8); *(LAS u32x4*)(lds + r * 512 + ((m ^ (r & 15)) << 4)) = v; }
    __syncthreads();
    const bf16_t* azp = PROJ + qrow * NIN + OFF_AZ + h * 256 + 4 * g4;
    bf16_t* op = OATT + qrow * 1024 + h * 256 + 4 * g4;
#pragma unroll
    for (int db = 0; db < 16; ++db) {
        f32x4 o = (f32x4){0.f, 0.f, 0.f, 0.f}; const int d = 16 * db + cl;
#pragma unroll
        for (int kk = 0; kk < 8; ++kk) {
            const int ch0 = 8 * kk + g4, ch1 = ch0 + 4;
            const u32x2 lo = *(const LAS u32x2*)(lds + d * 512 + (((ch0 >> 1) ^ cl) << 4) + (ch0 & 1) * 8);
            const u32x2 hi = *(const LAS u32x2*)(lds + d * 512 + (((ch1 >> 1) ^ cl) << 4) + (ch1 & 1) * 8);
            const u32x4 vv = (u32x4){lo.x, lo.y, hi.x, hi.y};
            o = MFMA16(__builtin_bit_cast(bf16x8, vv), pf[kk], o);
        }
        const u32x2 az = *(const u32x2*)(azp + 16 * db);
        const float z[4] = {bf_lo(az.x), bf_hi(az.x), bf_lo(az.y), bf_hi(az.y)};
        u32x2 wv; wv.x = cvt_pk_bf16(o[0] * inv * siluf_(z[0]), o[1] * inv * siluf_(z[1])); wv.y = cvt_pk_bf16(o[2] * inv * siluf_(z[2]), o[3] * inv * siluf_(z[3]));
        *(u32x2*)(op + 16 * db) = wv;
        __builtin_amdgcn_sched_barrier(0);
    }
    __syncthreads();
}

__device__ __forceinline__ void attn_sample_unit(const P& p, const int unit, LAS unsigned char* lds) {
    const bf16_t* PROJ = (const bf16_t*)(p.ws + WS_PROJ); bf16_t* OATT = (bf16_t*)(p.ws + WS_OATT);
    const int tid = otid(), lane = tid & 63, w = tid >> 6, cl = lane & 15, g4 = lane >> 4;
    const int b = unit >> 2, h = unit & 3;
    LAS float* sc = (LAS float*)lds;
    LAS float* po = (LAS float*)(lds + 4096);
    const float* kbase = p.cache_k + ((size_t)b * 1024 + h) * 256;
    const float* vbase = p.cache_v + ((size_t)b * 1024 + h) * 256;
    const size_t qrow = (size_t)NPROMPT + 4 * b + (cl & 3);
    const bf16_t* qp = PROJ + qrow * NIN + OFF_AQ + h * 256 + 8 * g4;
    bf16x8 qf[8];
#pragma unroll
    for (int ks = 0; ks < 8; ++ks) qf[ks] = *(const bf16x8*)(qp + 32 * ks);
#pragma unroll
    for (int kblk = 0; kblk < 2; ++kblk) {
        const int key = 32 * w + 16 * kblk + cl; const float* kr = kbase + (size_t)key * 1024 + 8 * g4;
        f32x4 ka[8], kc[8];
#pragma unroll
        for (int ks = 0; ks < 8; ++ks) { ka[ks] = *(const f32x4*)(kr + 32 * ks); kc[ks] = *(const f32x4*)(kr + 32 * ks + 4); }
        f32x4 s = (f32x4){0.f, 0.f, 0.f, 0.f};
#pragma unroll
        for (int ks = 0; ks < 8; ++ks) s = MFMA16(pack8(ka[ks], kc[ks]), qf[ks], s);
        if (cl < 4) *(LAS f32x4*)(sc + cl * 256 + 32 * w + 16 * kblk + 4 * g4) = s;
    }
    f32x4 vv[32];
#pragma unroll
    for (int i = 0; i < 32; ++i) vv[i] = *(const f32x4*)(vbase + (size_t)(32 * w + i) * 1024 + 4 * lane);
    __syncthreads();
    if (w == 0) {
#pragma unroll
        for (int q = 0; q < 4; ++q) {
            f32x4 v = *(LAS f32x4*)(sc + q * 256 + 4 * lane);
            float mx = fmaxf(fmaxf(v[0], v[1]), fmaxf(v[2], v[3]));
#pragma unroll
            for (int o = 32; o >= 1; o >>= 1) mx = fmaxf(mx, __shfl_xor(mx, o));
            float sum = 0.f;
#pragma unroll
            for (int e = 0; e < 4; ++e) { v[e] = __expf((v[e] - mx) * 0.0625f); sum += v[e]; }
#pragma unroll
            for (int o = 32; o >= 1; o >>= 1) sum += __shfl_xor(sum, o);
            const float inv = 1.0f / sum;
            *(LAS f32x4*)(sc + q * 256 + 4 * lane) = v * inv;
        }
    }
    __syncthreads();
    f32x4 o[4];
#pragma unroll
    for (int q = 0; q < 4; ++q) o[q] = (f32x4){0.f, 0.f, 0.f, 0.f};
#pragma unroll
    for (int ii = 0; ii < 8; ++ii)
#pragma unroll
        for (int q = 0; q < 4; ++q) { const f32x4 pv = *(LAS f32x4*)(sc + q * 256 + 32 * w + 4 * ii);
            o[q] += pv[0] * vv[4 * ii] + pv[1] * vv[4 * ii + 1] + pv[2] * vv[4 * ii + 2] + pv[3] * vv[4 * ii + 3]; }
#pragma unroll
    for (int q = 0; q < 4; ++q) *(LAS f32x4*)(po + (w * 4 + q) * 256 + 4 * lane) = o[q];
    __syncthreads();
    {
        const int q = tid >> 7, d = (tid & 127) * 2; float a0 = 0.f, a1 = 0.f;
#pragma unroll
        for (int ww = 0; ww < 8; ++ww) { a0 += po[(ww * 4 + q) * 256 + d]; a1 += po[(ww * 4 + q) * 256 + d + 1]; }
        const size_t row = (size_t)NPROMPT + 4 * b + q;
        const unsigned az = *(const unsigned*)(PROJ + row * NIN + OFF_AZ + h * 256 + d);
        *(unsigned*)(OATT + row * 1024 + h * 256 + d) = cvt_pk_bf16(a0 * siluf_(bf_lo(az)), a1 * siluf_(bf_hi(az)));
    }
    __syncthreads();
}

__device__ __forceinline__ void phase5(const P& p) {
    const float* ss = (const float*)(p.ws + WS_SS);
    const int t0 = otid(); const int lane = t0 & 63, gw = blockIdx.x * 8 + (t0 >> 6), nw = gridDim.x * 8;
    for (int row = gw; row < MTOK; row += nw) {
        float s = ss[(size_t)row * 32 + (lane & 31)];
#pragma unroll
        for (int o = 16; o >= 1; o >>= 1) s += __shfl_xor(s, o);
        const float rstd = 1.0f / sqrtf(s * (1.0f / 2048.0f) + 1e-6f);
        float* xr = p.out + (size_t)row * DM;
#pragma unroll
        for (int i = 0; i < 8; ++i) { const f32x4 v = *(const f32x4*)(xr + 4 * (lane + 64 * i)), gv = *(const f32x4*)(p.final_g + 4 * (lane + 64 * i));
            *(f32x4*)(xr + 4 * (lane + 64 * i)) = v * rstd * gv; }
    }
}

__global__ void __launch_bounds__(512, 2) mega_fwd(P p) {
    extern __shared__ __attribute__((aligned(16))) unsigned char shm[];
    LAS unsigned char* lds = (LAS unsigned char*)shm;
    cg::grid_group grid = cg::this_grid();
    unsigned char* ws = p.ws;
    const int G = gridDim.x, c = blockIdx.x;

#ifndef PHMASK
#define PHMASK 0xffff
#endif
#ifndef REPMASK
#define REPMASK 0
#endif
#define NREP(bit) ((REPMASK & (bit)) ? 2 : 1)
    for (int rep = 0; rep < NREP(1); ++rep) if (PHMASK & 1) phase0(p, lds);
    grid.sync();

    for (int rep = 0; rep < NREP(2); ++rep) if (PHMASK & 2) {
        Sched1 S{(const char*)(ws + WS_H), (const char*)(ws + WS_WIN), (const char*)(ws + WS_MEMN), (const char*)(ws + WS_WK), (const char*)(ws + WS_WV), G, c};
        Epi1 E{(bf16_t*)(ws + WS_PROJ), p.out + O_MK, (bf16_t*)(ws + WS_KB), p.out + O_MV, (bf16_t*)(ws + WS_VT)};
        pg8::gemm_phase(lds, 2048, S, E);
    }
    grid.sync();

    for (int rep = 0; rep < NREP(4); ++rep) {
        if ((c & 1) == 0) for (int u = c; u < 512; u += G) attn_sample_unit(p, u, lds);
        for (int u = c; u < 320; u += G) s5_unit(p, u, lds);
        for (int u = c; u < 256; u += G) attn_prompt_unit(p, u, lds);
        conv_phase(p);
        if ((c & 1) != 0) for (int u = c; u < 512; u += G) attn_sample_unit(p, u, lds);
    }
    grid.sync();

    for (int rep = 0; rep < NREP(8); ++rep) if (PHMASK & 64) {
        Sched2 S{(const char*)ws, G, c};
        Epi2 E{(bf16_t*)(ws + WS_GLU), (bf16_t*)(ws + WS_CONVO), (bf16_t*)(ws + WS_ATTO)};
        pg8::gemm_phase(lds, 1024, S, E);
    }
    grid.sync();

    for (int rep = 0; rep < NREP(32); ++rep) merge_phase(p);
    grid.sync();

    for (int rep = 0; rep < NREP(16); ++rep) if (PHMASK & 128) {
        Sched3 S{(const char*)(ws + WS_MERGED), (const char*)(ws + WS_WO), G, c};
        Epi3 E{p.x_prompt, p.x_sample, p.out + O_Y, (float*)(ws + WS_SS)};
        pg8::gemm_phase(lds, 2048, S, E);
    }
    grid.sync();

    if (PHMASK & 256) phase5(p);
}

extern "C" void kernel_launch(void* const* d_in, const int* in_sizes, int n_in, void* d_out, int out_size, void* d_ws, size_t ws_size, hipStream_t stream) {
    static int grid = 0;
    if (grid == 0) {
        int dev = 0, cus = 0, per_cu = 0;
        hipGetDevice(&dev);
        hipDeviceGetAttribute(&cus, hipDeviceAttributeMultiprocessorCount, dev);
        if (hipFuncSetAttribute((const void*)mega_fwd, hipFuncAttributeMaxDynamicSharedMemorySize, LDS_BYTES) != hipSuccess) fprintf(stderr, "kernel_launch: hipFuncSetAttribute failed\n");
        if (hipOccupancyMaxActiveBlocksPerMultiprocessor(&per_cu, (const void*)mega_fwd, 512, LDS_BYTES) != hipSuccess || per_cu < 1) per_cu = 1;
        (void)hipGetLastError();
        grid = cus * per_cu;
        if (ws_size < WS_END) fprintf(stderr, "kernel_launch: workspace too small (%zu < %zu)\n", ws_size, (size_t)WS_END);
    }
    P p{};
    const float** pp = (const float**)&p;
    for (int i = 0; i < 28; ++i) pp[i] = (const float*)d_in[i];
    p.out = (float*)d_out; p.ws = (unsigned char*)d_ws;
    void* args[] = {&p};
    hipError_t e = hipLaunchCooperativeKernel((const void*)mega_fwd, dim3(grid), dim3(512), args, LDS_BYTES, stream);
    if (e != hipSuccess) fprintf(stderr, "cooperative launch failed: %s (grid %d)\n", hipGetErrorString(e), grid);
}
```

```cpp
#include <hip/hip_runtime.h>
#include <hip/hip_cooperative_groups.h>
#include <cstdio>
namespace cg = cooperative_groups;

#define LAS __attribute__((address_space(3)))
typedef unsigned short bf16_t;
typedef short bf16x8 __attribute__((ext_vector_type(8)));
typedef float f32x4 __attribute__((ext_vector_type(4)));
typedef unsigned u32x4 __attribute__((ext_vector_type(4)));
typedef unsigned u32x2 __attribute__((ext_vector_type(2)));

constexpr int DM = 2048, NPROMPT = 8192, NSAMPLE = 512, MTOK = 8704, NIN = 14336;
constexpr int OFF_CB = 0, OFF_CC = 1024, OFF_CH = 2048, OFF_CZ = 3072, OFF_SU = 4096, OFF_SZ = 5120, OFF_AQ = 6144, OFF_AZ = 7168, OFF_G = 8192;
constexpr int LDS_BYTES = 131072;
constexpr size_t O_Y = 0, O_MK = 17825792, O_MV = 18874368, O_CP = 19922944, O_RP = 19931136, O_IP = 19947520, O_CS = 19963904, O_RS = 20226048, O_IS = 20750336;
constexpr size_t WS_WIN = 0;
constexpr size_t WS_WG = WS_WIN + (size_t)NIN * DM * 2;
constexpr size_t WS_WC = WS_WG + 8388608;
constexpr size_t WS_WA = WS_WC + 4194304;
constexpr size_t WS_WO = WS_WA + 4194304;
constexpr size_t WS_WK = WS_WO + 8388608;
constexpr size_t WS_WV = WS_WK + 4194304;
constexpr size_t WS_H = WS_WV + 4194304;
constexpr size_t WS_MEMN = WS_H + (size_t)MTOK * DM * 2;
constexpr size_t WS_PROJ = WS_MEMN + 4194304;
constexpr size_t WS_KB = WS_PROJ + (size_t)MTOK * NIN * 2;
constexpr size_t WS_VT = WS_KB + 2097152;
constexpr size_t WS_YS = WS_VT + 2097152;
constexpr size_t WS_ACONV = WS_YS + (size_t)MTOK * 1024 * 2;
constexpr size_t WS_OATT = WS_ACONV + (size_t)MTOK * 1024 * 2;
constexpr size_t WS_SS = WS_OATT + (size_t)MTOK * 1024 * 2;
constexpr size_t WS_GLU = WS_SS + (size_t)MTOK * 32 * 4;
constexpr size_t WS_MERGED = WS_GLU + (size_t)MTOK * DM * 2;
constexpr size_t WS_END = WS_MERGED + (size_t)MTOK * DM * 2;
constexpr size_t WS_CONVO = WS_H, WS_ATTO = WS_WIN, WS_PART = WS_PROJ;
static_assert(WS_END <= 536870912, "workspace");

struct P {
    const float *x_prompt, *x_sample, *mem_prompt, *cache_k, *cache_v, *state_conv, *state_re, *state_im, *norm_g, *mem_norm_g, *w_in, *conv_w, *w_conv_out,
        *lam_re, *lam_im, *log_dt, *b_re, *b_im, *c_re, *c_im, *ssm_d, *w_glu_a, *w_glu_b, *w_mem_k, *w_mem_v, *w_attn_out, *w_out, *final_g;
    float* out; unsigned char* ws;
};

__device__ __forceinline__ unsigned cvt_pk_bf16(float lo, float hi) { unsigned r; asm("v_cvt_pk_bf16_f32 %0, %1, %2" : "=v"(r) : "v"(lo), "v"(hi)); return r; }
__device__ __forceinline__ float bf_lo(unsigned w) { return __uint_as_float(w << 16); }
__device__ __forceinline__ float bf_hi(unsigned w) { return __uint_as_float(w & 0xffff0000u); }
__device__ __forceinline__ float sigmoidf_(float x) { return 1.0f / (1.0f + __expf(-x)); }
__device__ __forceinline__ float siluf_(float x) { return x / (1.0f + __expf(-x)); }
__device__ __forceinline__ float gelu_tanh(float x) { const float u = 1.5957691216057308f * (x + 0.044715f * x * x * x); return x / (1.0f + __expf(-u)); }
__device__ __forceinline__ bf16x8 pack8(const f32x4 a, const f32x4 b) {
    u32x4 w; w.x = cvt_pk_bf16(a[0], a[1]); w.y = cvt_pk_bf16(a[2], a[3]); w.z = cvt_pk_bf16(b[0], b[1]); w.w = cvt_pk_bf16(b[2], b[3]);
    return __builtin_bit_cast(bf16x8, w);
}
__device__ __forceinline__ u32x4 pack8u(const f32x4 a, const f32x4 b) {
    u32x4 w; w.x = cvt_pk_bf16(a[0], a[1]); w.y = cvt_pk_bf16(a[2], a[3]); w.z = cvt_pk_bf16(b[0], b[1]); w.w = cvt_pk_bf16(b[2], b[3]); return w;
}
__device__ __forceinline__ void unpack8(const u32x4 w, float (&f)[8]) {
    f[0] = bf_lo(w.x); f[1] = bf_hi(w.x); f[2] = bf_lo(w.y); f[3] = bf_hi(w.y); f[4] = bf_lo(w.z); f[5] = bf_hi(w.z); f[6] = bf_lo(w.w); f[7] = bf_hi(w.w);
}
__device__ __forceinline__ int otid() { int t = threadIdx.x; asm volatile("" : "+v"(t)); return t; }
#define MFMA16(a, b, c) __builtin_amdgcn_mfma_f32_16x16x32_bf16((a), (b), (c), 0, 0, 0)

namespace pg8 {
constexpr int BM = 256, BK = 64, HALF = 128, HTB = HALF * BK * 2, STAGE_BYTES = 8 * HTB;
__device__ __forceinline__ int lds_byte(int r, int c) { const int st = (r >> 4) * 2 + (c >> 5), rr = r & 15, cc = c & 31, ob = rr * 64 + cc * 2; return st * 1024 + (ob ^ (((ob >> 9) & 1) << 5)); }
__device__ __forceinline__ void stage_rc(int b, int& R, int& C) { const int st = b / 1024, sb = b % 1024, swz = sb ^ (((sb >> 9) & 1) << 5); R = (st >> 1) * 16 + swz / 64; C = (st & 1) * 32 + (swz % 64) / 2; }
__device__ __forceinline__ int perm32(int rho) { const int n = rho >> 4, i = rho & 15; return 8 * (i >> 2) + 4 * n + (i & 3); }
struct Unit { const char* a; const char* b; int pm, pn, kind; };

template <class Sched, class Epi>
__device__ __forceinline__ void gemm_phase(LAS unsigned char* lds, const int K, const int ld, const Sched& S, const Epi& E) {
    const int tid = otid(), wid = __builtin_amdgcn_readfirstlane(tid >> 6), lane = tid & 63, wr = wid >> 2, wc = wid & 3, fr = lane & 15, fq = lane >> 4;
    const int nt = K / BK;
    unsigned voffA[2], voffB[2];
#pragma unroll
    for (int i = 0; i < 2; ++i) { int R, C; stage_rc(tid * 16 + i * 8192, R, C); const int Rb = (R & ~31) + perm32(R & 31);
        voffA[i] = (unsigned)(R * ld + C) * 2u; voffB[i] = (unsigned)(Rb * ld + C) * 2u; }
    const size_t kstep = (size_t)(BK * 2);
    const size_t hstep = (size_t)HALF * ld * 2;
    const unsigned ldsw = (unsigned)wid * 1024u;
    const int aoff = lds_byte(wr * 64 + fr, fq * 8), boff = lds_byte(wc * 32 + fr, fq * 8);
#define PG8_SA(b, h) (((b) * 2 + (h)) * HTB)
#define PG8_SB(b, h) ((4 + (b) * 2 + (h)) * HTB)
#define PG8_STAGE(bufoff, gbase, voff) do { _Pragma("unroll") for (int _i = 0; _i < 2; ++_i) \
        __builtin_amdgcn_global_load_lds((const unsigned*)((const char*)(gbase) + (voff)[_i]), (LAS unsigned*)(lds + (bufoff) + ldsw + _i * 8192), 16, 0, 0); } while (0)
#define PG8_LDA(dst, b, h) do { _Pragma("unroll") for (int m = 0; m < 4; ++m) _Pragma("unroll") for (int k = 0; k < 2; ++k) dst[m][k] = *(const LAS bf16x8*)(lds + PG8_SA(b, h) + aoff + m * 2048 + k * 1024); } while (0)
#define PG8_LDB(dst, b, h) do { _Pragma("unroll") for (int n = 0; n < 2; ++n) _Pragma("unroll") for (int k = 0; k < 2; ++k) dst[n][k] = *(const LAS bf16x8*)(lds + PG8_SB(b, h) + boff + n * 2048 + k * 1024); } while (0)
#define PG8_MMA(ai, bj, At, Bt) do { __builtin_amdgcn_s_setprio(1); _Pragma("unroll") for (int m = 0; m < 4; ++m) _Pragma("unroll") for (int n = 0; n < 2; ++n) _Pragma("unroll") for (int k = 0; k < 2; ++k) \
        acc[ai][bj][m][n] = __builtin_amdgcn_mfma_f32_16x16x32_bf16(Bt[n][k], At[m][k], acc[ai][bj][m][n], 0, 0, 0); __builtin_amdgcn_s_setprio(0); } while (0)
#define PG8_WAIT_V(n) asm volatile("s_waitcnt vmcnt(" #n ")" ::: "memory")
#define PG8_WAIT_L(n) asm volatile("s_waitcnt lgkmcnt(" #n ")" ::: "memory")
#define PG8_BAR __builtin_amdgcn_s_barrier()
#define PG8_SCHED __builtin_amdgcn_sched_barrier(0)
    Unit cur, nxt; int ui = 0;
    if (!S.next(0, cur)) return;
    f32x4 acc[2][2][4][2];
#pragma unroll
    for (int a = 0; a < 2; ++a)
#pragma unroll
        for (int b = 0; b < 2; ++b)
#pragma unroll
            for (int m = 0; m < 4; ++m)
#pragma unroll
                for (int n = 0; n < 2; ++n) acc[a][b][m][n] = (f32x4){0.f, 0.f, 0.f, 0.f};
    bf16x8 At[4][2], B0[2][2], B1[2][2];
    const char* cA = cur.a; const char* cB = cur.b;
    PG8_STAGE(PG8_SB(0, 0), cB, voffB); PG8_STAGE(PG8_SA(0, 0), cA, voffA); PG8_STAGE(PG8_SB(0, 1), cB + hstep, voffB); PG8_STAGE(PG8_SA(0, 1), cA + hstep, voffA);
    if (wr == 1) PG8_BAR;
    PG8_WAIT_V(4); PG8_BAR;
    PG8_STAGE(PG8_SB(1, 0), cB + kstep, voffB); PG8_STAGE(PG8_SA(1, 0), cA + kstep, voffA); PG8_STAGE(PG8_SB(1, 1), cB + hstep + kstep, voffB);
    PG8_WAIT_V(6); PG8_BAR;
    for (;;) {
        const bool has_next = S.next(ui + 1, nxt);
        const char* nA = has_next ? nxt.a : cA; const char* nB = has_next ? nxt.b : cB;
        for (int t = 0; t < nt; t += 2) {
            const bool last = (t == nt - 2);
            const char* a1 = cA + (size_t)(t + 1) * kstep;
            const char* a2 = last ? nA : cA + (size_t)(t + 2) * kstep; const char* b2 = last ? nB : cB + (size_t)(t + 2) * kstep;
            const char* a3 = a2 + kstep; const char* b3 = b2 + kstep;
            PG8_LDB(B0, 0, 0); PG8_SCHED; PG8_LDA(At, 0, 0); PG8_STAGE(PG8_SA(1, 1), a1 + hstep, voffA);
            PG8_WAIT_L(8); PG8_BAR; PG8_WAIT_L(0); PG8_MMA(0, 0, At, B0); PG8_BAR; PG8_SCHED;
            PG8_LDB(B1, 0, 1); PG8_STAGE(PG8_SB(0, 0), b2, voffB);
            PG8_BAR; PG8_WAIT_L(0); PG8_MMA(0, 1, At, B1); PG8_BAR;
            PG8_LDA(At, 0, 1); PG8_STAGE(PG8_SA(0, 0), a2, voffA);
            PG8_BAR; PG8_WAIT_L(0); PG8_MMA(1, 0, At, B0); PG8_BAR; PG8_SCHED;
            PG8_STAGE(PG8_SB(0, 1), b2 + hstep, voffB);
            PG8_WAIT_V(6); PG8_BAR; PG8_MMA(1, 1, At, B1); PG8_BAR;
            PG8_LDB(B0, 1, 0); PG8_SCHED; PG8_LDA(At, 1, 0); PG8_STAGE(PG8_SA(0, 1), a2 + hstep, voffA);
            PG8_WAIT_L(8); PG8_BAR; PG8_WAIT_L(0); PG8_MMA(0, 0, At, B0); PG8_BAR; PG8_SCHED;
            PG8_LDB(B1, 1, 1); PG8_STAGE(PG8_SB(1, 0), b3, voffB);
            PG8_BAR; PG8_WAIT_L(0); PG8_MMA(0, 1, At, B1); PG8_BAR;
            PG8_LDA(At, 1, 1); PG8_STAGE(PG8_SA(1, 0), a3, voffA);
            PG8_BAR; PG8_WAIT_L(0); PG8_MMA(1, 0, At, B0); PG8_BAR; PG8_SCHED;
            PG8_STAGE(PG8_SB(1, 1), b3 + hstep, voffB);
            PG8_WAIT_V(6); PG8_BAR; PG8_MMA(1, 1, At, B1); PG8_BAR;
        }
        const bool keep = E(acc, cur, wr, wc, fr, fq);
        if (!has_next) break;
        if (!keep) {
#pragma unroll
            for (int a = 0; a < 2; ++a)
#pragma unroll
                for (int b = 0; b < 2; ++b)
#pragma unroll
                    for (int m = 0; m < 4; ++m)
#pragma unroll
                        for (int n = 0; n < 2; ++n) acc[a][b][m][n] = (f32x4){0.f, 0.f, 0.f, 0.f};
        }
        cur = nxt; cA = nA; cB = nB; ++ui;
    }
    PG8_WAIT_V(0);
    if (wr == 0) PG8_BAR;
    PG8_BAR;
#undef PG8_SA
#undef PG8_SB
#undef PG8_STAGE
#undef PG8_LDA
#undef PG8_LDB
#undef PG8_MMA
#undef PG8_WAIT_V
#undef PG8_WAIT_L
#undef PG8_BAR
#undef PG8_SCHED
}
}
using pg8::Unit;

struct Sched1 {
    const char *H, *WIN, *MEMN, *WK, *WV; int G, c;
    __device__ __forceinline__ bool next(int i, Unit& u) const {
        const int L = i * G + c; if (L >= 1936) return false;
        if (L < 1904) {
            const int nM = 34, nN = 56, nwg = 1904, NX = 8, WGM = 8;
            int wgid = L; { const int q = nwg / NX, r = nwg % NX, xcd = wgid % NX, off = wgid / NX; wgid = (xcd < r ? xcd * (q + 1) : r * (q + 1) + (xcd - r) * q) + off; }
            const int nig = WGM * nN, gid = wgid / nig, fm = gid * WGM, gsz = (nM - fm) < WGM ? (nM - fm) : WGM;
            u.pm = fm + ((wgid % nig) % gsz); u.pn = (wgid % nig) / gsz; u.kind = 0;
            u.a = H + (size_t)u.pm * 1048576; u.b = WIN + (size_t)u.pn * 1048576;
        } else if (L < 1920) { const int j = L - 1904; u.pm = j >> 2; u.pn = j & 3; u.kind = 1; u.a = MEMN + (size_t)u.pm * 1048576; u.b = WK + (size_t)u.pn * 1048576; }
        else { const int j = L - 1920; u.pm = j >> 2; u.pn = j & 3; u.kind = 2; u.a = WV + (size_t)u.pm * 1048576; u.b = MEMN + (size_t)u.pn * 1048576; }
        return true;
    }
};
struct Epi1 {
    bf16_t* PROJ; float* outK; bf16_t* KB; float* outV; bf16_t* VT;
    __device__ __forceinline__ bool operator()(f32x4 (&acc)[2][2][4][2], const Unit& u, int wr, int wc, int fr, int fq) const {
        const int r0 = u.pm * 256 + wr * 64 + fr, c0 = u.pn * 256 + wc * 32 + 8 * fq;
        if (u.kind == 0) {
#pragma unroll
            for (int ai = 0; ai < 2; ++ai)
#pragma unroll
                for (int m = 0; m < 4; ++m) { bf16_t* rowp = PROJ + (size_t)(r0 + ai * 128 + m * 16) * NIN + c0;
#pragma unroll
                    for (int bj = 0; bj < 2; ++bj) *(u32x4*)(rowp + bj * 128) = pack8u(acc[ai][bj][m][0], acc[ai][bj][m][1]); }
        } else if (u.kind == 1) {
#pragma unroll
            for (int ai = 0; ai < 2; ++ai)
#pragma unroll
                for (int m = 0; m < 4; ++m) { const size_t off = (size_t)(r0 + ai * 128 + m * 16) * 1024 + c0;
#pragma unroll
                    for (int bj = 0; bj < 2; ++bj) { *(f32x4*)(outK + off + bj * 128) = acc[ai][bj][m][0]; *(f32x4*)(outK + off + bj * 128 + 4) = acc[ai][bj][m][1];
                        *(u32x4*)(KB + off + bj * 128) = pack8u(acc[ai][bj][m][0], acc[ai][bj][m][1]); } }
        } else {
            const int h = u.pm, b = u.pn;
#pragma unroll
            for (int ai = 0; ai < 2; ++ai)
#pragma unroll
                for (int m = 0; m < 4; ++m) { const int d = wr * 64 + fr + ai * 128 + m * 16;
#pragma unroll
                    for (int bj = 0; bj < 2; ++bj) { const int key0 = wc * 32 + 8 * fq + bj * 128;
                        *(u32x4*)(VT + ((size_t)((b * 4 + h) * 256 + d)) * 256 + key0) = pack8u(acc[ai][bj][m][0], acc[ai][bj][m][1]);
                        float* fp = outV + ((size_t)(b * 256 + key0)) * 1024 + h * 256 + d;
#pragma unroll
                        for (int e = 0; e < 4; ++e) { fp[(size_t)e * 1024] = acc[ai][bj][m][0][e]; fp[(size_t)(e + 4) * 1024] = acc[ai][bj][m][1][e]; } } }
        }
        return false;
    }
};

struct Sched2 {
    const char* ws; int G, c;
    __device__ __forceinline__ bool next(int i, Unit& u) const {
        const int L = i * G + c; if (L >= 1088) return false;
        if (L < 544) { u.pm = L >> 4; u.pn = L & 15; u.kind = 0; u.a = ws + WS_YS + (size_t)u.pm * 524288; u.b = ws + WS_WG + (size_t)u.pn * 524288; }
        else { const int j = L - 544, k = j >= 272 ? 1 : 0, jj = j - 272 * k; u.pm = jj >> 3; u.pn = jj & 7; u.kind = 1 + k;
            u.a = ws + WS_ACONV + (size_t)k * ((size_t)MTOK * 1024 * 2) + (size_t)u.pm * 524288; u.b = ws + WS_WC + (size_t)k * 4194304 + (size_t)u.pn * 524288; }
        return true;
    }
};
struct Epi2 {
    bf16_t* GLU; bf16_t* CONVO; bf16_t* ATTO;
    __device__ __forceinline__ bool operator()(f32x4 (&acc)[2][2][4][2], const Unit& u, int wr, int wc, int fr, int fq) const {
        const int r0 = u.pm * 256 + wr * 64 + fr;
        if (u.kind == 0) {
            const int c0 = u.pn * 128 + wc * 32 + 8 * fq;
#pragma unroll
            for (int ai = 0; ai < 2; ++ai)
#pragma unroll
                for (int m = 0; m < 4; ++m) {
                    f32x4 t0, t1;
#pragma unroll
                    for (int e = 0; e < 4; ++e) { t0[e] = acc[ai][0][m][0][e] * sigmoidf_(acc[ai][1][m][0][e]); t1[e] = acc[ai][0][m][1][e] * sigmoidf_(acc[ai][1][m][1][e]); }
                    *(u32x4*)(GLU + (size_t)(r0 + ai * 128 + m * 16) * 2048 + c0) = pack8u(t0, t1);
                }
        } else {
            bf16_t* O = u.kind == 1 ? CONVO : ATTO; const int c0 = u.pn * 256 + wc * 32 + 8 * fq;
#pragma unroll
            for (int ai = 0; ai < 2; ++ai)
#pragma unroll
                for (int m = 0; m < 4; ++m) { bf16_t* rowp = O + (size_t)(r0 + ai * 128 + m * 16) * 2048 + c0;
#pragma unroll
                    for (int bj = 0; bj < 2; ++bj) *(u32x4*)(rowp + bj * 128) = pack8u(acc[ai][bj][m][0], acc[ai][bj][m][1]); }
        }
        return false;
    }
};
__device__ __forceinline__ void merge_phase(const P& p) {
    const bf16_t* PROJ = (const bf16_t*)(p.ws + WS_PROJ); const bf16_t* GLU = (const bf16_t*)(p.ws + WS_GLU); const bf16_t* CONVO = (const bf16_t*)(p.ws + WS_CONVO);
    const bf16_t* ATTO = (const bf16_t*)(p.ws + WS_ATTO); bf16_t* MERGED = (bf16_t*)(p.ws + WS_MERGED);
    const int NT = MTOK * 256;
    for (int t = blockIdx.x * 512 + otid(); t < NT; t += gridDim.x * 512) {
        const size_t row = (size_t)(t >> 8); const int c0 = (t & 255) * 8;
        const bf16_t* pr = PROJ + row * NIN + OFF_G + c0; const size_t o = row * 2048 + c0;
        float g0[8], g1[8], g2[8], cv[8], gl[8], at[8];
        unpack8(*(const u32x4*)pr, g0); unpack8(*(const u32x4*)(pr + 2048), g1); unpack8(*(const u32x4*)(pr + 4096), g2);
        unpack8(*(const u32x4*)(CONVO + o), cv); unpack8(*(const u32x4*)(GLU + o), gl); unpack8(*(const u32x4*)(ATTO + o), at);
        f32x4 m0, m1;
#pragma unroll
        for (int e = 0; e < 8; ++e) { const float v = sigmoidf_(g0[e]) * cv[e] + sigmoidf_(g1[e]) * gl[e] + sigmoidf_(g2[e]) * at[e]; if (e < 4) m0[e] = v; else m1[e - 4] = v; }
        *(u32x4*)(MERGED + o) = pack8u(m0, m1);
    }
}

struct Sched3 {
    const char *MERGED, *WO; int G, c;
    __device__ __forceinline__ bool next(int i, Unit& u) const {
        const int L = i * G + c; if (L >= 256) return false;
        u.pm = L >> 3; u.pn = L & 7; u.kind = 0; u.a = MERGED + (size_t)u.pm * 1048576; u.b = WO + (size_t)u.pn * 1048576; return true;
    }
};
struct Sched3b {
    const char *MERGED, *WO; int G, c;
    __device__ __forceinline__ bool next(int i, Unit& u) const {
        const int L = i * G + c; if (L >= 128) return false;
        const int tile = L >> 3, ks = L & 7; u.pm = 32 + (tile >> 3); u.pn = tile & 7; u.kind = ks;
        u.a = MERGED + (size_t)u.pm * 1048576 + (size_t)ks * 512; u.b = WO + (size_t)u.pn * 1048576 + (size_t)ks * 512; return true;
    }
};
struct Epi3 {
    float* out; float* part;
    bool sample;
    __device__ __forceinline__ bool operator()(f32x4 (&acc)[2][2][4][2], const Unit& u, int wr, int wc, int fr, int fq) const {
        const int r0 = u.pm * 256 + wr * 64 + fr, c0 = u.pn * 256 + wc * 32 + 8 * fq;
        float* base = sample ? part + ((size_t)u.kind * 512 - NPROMPT) * DM : out;
#pragma unroll
        for (int ai = 0; ai < 2; ++ai)
#pragma unroll
            for (int m = 0; m < 4; ++m) {
                float* o = base + (size_t)(r0 + ai * 128 + m * 16) * DM + c0;
#pragma unroll
                for (int bj = 0; bj < 2; ++bj)
#pragma unroll
                    for (int n = 0; n < 2; ++n) *(f32x4*)(o + bj * 128 + 4 * n) = acc[ai][bj][m][n];
            }
        return false;
    }
};

__device__ __forceinline__ void transpose_tile(const float* __restrict__ src, const int K, const int N, bf16_t* __restrict__ dst, const int mode, const int t, LAS float* tile) {
    const int tid = otid(); const int tn = N / 256;
    const int r = tid >> 3, c8 = (tid & 7) * 8;
    const int k0 = (t / tn) * 64, n0 = (t % tn) * 256;
    const float* s = src + (size_t)(k0 + r) * N + n0 + c8;
    f32x4 v[8];
#pragma unroll
    for (int j = 0; j < 4; ++j) { v[2 * j] = *(const f32x4*)(s + j * 64); v[2 * j + 1] = *(const f32x4*)(s + j * 64 + 4); }
#pragma unroll
    for (int j = 0; j < 4; ++j)
#pragma unroll
        for (int e = 0; e < 4; ++e) { tile[j * 4160 + r * 65 + c8 + e] = v[2 * j][e]; tile[j * 4160 + r * 65 + c8 + 4 + e] = v[2 * j + 1][e]; }
    __syncthreads();
#pragma unroll
    for (int j = 0; j < 4; ++j) {
        f32x4 a, b;
#pragma unroll
        for (int e = 0; e < 4; ++e) { a[e] = tile[j * 4160 + (c8 + e) * 65 + r]; b[e] = tile[j * 4160 + (c8 + 4 + e) * 65 + r]; }
        const int n = n0 + j * 64 + r;
        const int row = mode == 0 ? n : ((n >> 7) * 256 + (mode - 1) * 128 + (n & 127));
        *(u32x4*)(dst + (size_t)row * K + k0 + c8) = pack8u(a, b);
    }
    __syncthreads();
}
__device__ __forceinline__ void tload_win(const float* w_in, int t, int r, int c8, f32x4 (&v)[8]) {
    const int k0 = (t / 56) * 64, n0 = (t % 56) * 256;
    const float* s = w_in + (size_t)(k0 + r) * NIN + n0 + c8;
#pragma unroll
    for (int j = 0; j < 4; ++j) { v[2 * j] = *(const f32x4*)(s + j * 64); v[2 * j + 1] = *(const f32x4*)(s + j * 64 + 4); }
}
__device__ __forceinline__ void phase0(const P& p, LAS unsigned char* lds) {
    unsigned char* ws = p.ws; LAS float* tile = (LAS float*)lds;
    {
        const int tid = otid(); const int r = tid >> 3, c8 = (tid & 7) * 8;
        bf16_t* dst = (bf16_t*)(ws + WS_WIN);
        int j = blockIdx.x; f32x4 v[8];
        if (j < 1792) tload_win(p.w_in, j, r, c8, v);
        while (j < 1792) {
#pragma unroll
            for (int q = 0; q < 4; ++q)
#pragma unroll
                for (int e = 0; e < 4; ++e) { tile[q * 4160 + r * 65 + c8 + e] = v[2 * q][e]; tile[q * 4160 + r * 65 + c8 + 4 + e] = v[2 * q + 1][e]; }
            const int jn = j + gridDim.x;
            if (jn < 1792) tload_win(p.w_in, jn, r, c8, v);
            __syncthreads();
            const int k0 = (j / 56) * 64, n0 = (j % 56) * 256;
#pragma unroll
            for (int q = 0; q < 4; ++q) {
                f32x4 a, b;
#pragma unroll
                for (int e = 0; e < 4; ++e) { a[e] = tile[q * 4160 + (c8 + e) * 65 + r]; b[e] = tile[q * 4160 + (c8 + 4 + e) * 65 + r]; }
                *(u32x4*)(dst + (size_t)(n0 + q * 64 + r) * 2048 + k0 + c8) = pack8u(a, b);
            }
            __syncthreads();
            j = jn;
        }
    }
    for (int t = blockIdx.x; t < 1024; t += gridDim.x) {
        if (t < 128) transpose_tile(p.w_conv_out, 1024, 2048, (bf16_t*)(ws + WS_WC), 0, t, tile);
        else if (t < 256) transpose_tile(p.w_attn_out, 1024, 2048, (bf16_t*)(ws + WS_WA), 0, t - 128, tile);
        else if (t < 384) transpose_tile(p.w_glu_a, 1024, 2048, (bf16_t*)(ws + WS_WG), 1, t - 256, tile);
        else if (t < 512) transpose_tile(p.w_glu_b, 1024, 2048, (bf16_t*)(ws + WS_WG), 2, t - 384, tile);
        else if (t < 768) transpose_tile(p.w_out, 2048, 2048, (bf16_t*)(ws + WS_WO), 0, t - 512, tile);
        else if (t < 896) transpose_tile(p.w_mem_k, 2048, 1024, (bf16_t*)(ws + WS_WK), 0, t - 768, tile);
        else transpose_tile(p.w_mem_v, 2048, 1024, (bf16_t*)(ws + WS_WV), 0, t - 896, tile);
    }
    const int t0 = otid(); const int lane = t0 & 63, gw = blockIdx.x * 8 + (t0 >> 6), nw = gridDim.x * 8;
    for (int row = gw; row < MTOK + 1024; row += nw) {
        const float* src; const float* g; bf16_t* dst;
        if (row < NPROMPT) { src = p.x_prompt + (size_t)row * DM; g = p.norm_g; dst = (bf16_t*)(ws + WS_H) + (size_t)row * DM; }
        else if (row < MTOK) { src = p.x_sample + (size_t)(row - NPROMPT) * DM; g = p.norm_g; dst = (bf16_t*)(ws + WS_H) + (size_t)row * DM; }
        else { src = p.mem_prompt + (size_t)(row - MTOK) * DM; g = p.mem_norm_g; dst = (bf16_t*)(ws + WS_MEMN) + (size_t)(row - MTOK) * DM; }
        f32x4 v[8]; float s = 0.f;
#pragma unroll
        for (int i = 0; i < 8; ++i) { v[i] = *(const f32x4*)(src + 4 * (lane + 64 * i)); s += (v[i][0] * v[i][0] + v[i][1] * v[i][1]) + (v[i][2] * v[i][2] + v[i][3] * v[i][3]); }
#pragma unroll
        for (int o = 32; o >= 1; o >>= 1) s += __shfl_xor(s, o);
        const float rstd = 1.0f / sqrtf(s * (1.0f / 2048.0f) + 1e-6f);
#pragma unroll
        for (int i = 0; i < 8; ++i) { const f32x4 gv = *(const f32x4*)(g + 4 * (lane + 64 * i));
            u32x2 w; w.x = cvt_pk_bf16(v[i][0] * rstd * gv[0], v[i][1] * rstd * gv[1]); w.y = cvt_pk_bf16(v[i][2] * rstd * gv[2], v[i][3] * rstd * gv[3]);
            *(u32x2*)(dst + 4 * (lane + 64 * i)) = w; }
    }
}

template <int LEN, bool PROMPT>
__device__ __forceinline__ void conv_task(const P& p, const int r0, const int cgp, const int bs) {
    const bf16_t* PROJ = (const bf16_t*)(p.ws + WS_PROJ); bf16_t* ACONV = (bf16_t*)(p.ws + WS_ACONV);
    const int c0 = cgp * 8;
    const bf16_t* pr = PROJ + (size_t)r0 * NIN + c0;
    u32x4 lcb[LEN], lcz[LEN], lcc[LEN + 2], lch[LEN + 2];
    const bool has_halo = PROMPT && (r0 & 2047) != 0;
#pragma unroll
    for (int i = 0; i < LEN; ++i) { lcb[i] = *(const u32x4*)(pr + (size_t)i * NIN + OFF_CB); lcz[i] = *(const u32x4*)(pr + (size_t)i * NIN + OFF_CZ);
        lcc[i + 2] = *(const u32x4*)(pr + (size_t)i * NIN + OFF_CC); lch[i + 2] = *(const u32x4*)(pr + (size_t)i * NIN + OFF_CH); }
#pragma unroll
    for (int i = 0; i < 2; ++i) { lcc[i] = (u32x4){0u, 0u, 0u, 0u}; lch[i] = lcc[i];
        if (has_halo) { lcc[i] = *(const u32x4*)(pr - (size_t)(2 - i) * NIN + OFF_CC); lch[i] = *(const u32x4*)(pr - (size_t)(2 - i) * NIN + OFF_CH); } }
    float w0[8], w1[8], w2[8], vm2[8], vm1[8];
    { const f32x4 a0 = *(const f32x4*)(p.conv_w + c0), a1 = *(const f32x4*)(p.conv_w + c0 + 4), b0 = *(const f32x4*)(p.conv_w + 1024 + c0), b1 = *(const f32x4*)(p.conv_w + 1024 + c0 + 4),
          d0 = *(const f32x4*)(p.conv_w + 2048 + c0), d1 = *(const f32x4*)(p.conv_w + 2048 + c0 + 4);
#pragma unroll
      for (int e = 0; e < 4; ++e) { w0[e] = a0[e]; w0[e + 4] = a1[e]; w1[e] = b0[e]; w1[e + 4] = b1[e]; w2[e] = d0[e]; w2[e + 4] = d1[e]; } }
    if (PROMPT) {
        float a[8], b[8];
        unpack8(lcc[0], a); unpack8(lch[0], b);
#pragma unroll
        for (int e = 0; e < 8; ++e) vm2[e] = a[e] * b[e];
        unpack8(lcc[1], a); unpack8(lch[1], b);
#pragma unroll
        for (int e = 0; e < 8; ++e) vm1[e] = a[e] * b[e];
    } else {
        const float* sc = p.state_conv + (size_t)bs * 2048 + c0;
        const f32x4 a0 = *(const f32x4*)sc, a1 = *(const f32x4*)(sc + 4), b0 = *(const f32x4*)(sc + 1024), b1 = *(const f32x4*)(sc + 1028);
#pragma unroll
        for (int e = 0; e < 4; ++e) { vm2[e] = a0[e]; vm2[e + 4] = a1[e]; vm1[e] = b0[e]; vm1[e + 4] = b1[e]; }
    }
#pragma unroll
    for (int i = 0; i < LEN; ++i) {
        const size_t row = (size_t)(r0 + i);
        float cb[8], cc[8], ch[8], cz[8], v[8];
        unpack8(lcb[i], cb); unpack8(lcc[i + 2], cc); unpack8(lch[i + 2], ch); unpack8(lcz[i], cz);
        f32x4 o0, o1;
#pragma unroll
        for (int e = 0; e < 8; ++e) { v[e] = cc[e] * ch[e]; const float cv = w0[e] * vm2[e] + w1[e] * vm1[e] + w2[e] * v[e]; const float r = cb[e] * cv * siluf_(cz[e]);
            if (e < 4) o0[e] = r; else o1[e - 4] = r; vm2[e] = vm1[e]; vm1[e] = v[e]; }
        *(u32x4*)(ACONV + row * 1024 + c0) = pack8u(o0, o1);
        float* dst = nullptr;
        if (PROMPT) { const int pos = (r0 + i) & 2047; if (pos >= 2046) dst = p.out + O_CP + ((size_t)((r0 + i) >> 11) * 2 + (pos - 2046)) * 1024 + c0; }
        else if (i >= 2) dst = p.out + O_CS + ((size_t)bs * 2 + (i - 2)) * 1024 + c0;
        if (dst) { *(f32x4*)dst = (f32x4){v[0], v[1], v[2], v[3]}; *(f32x4*)(dst + 4) = (f32x4){v[4], v[5], v[6], v[7]}; }
    }
}
__device__ __forceinline__ void conv_phase(const P& p) {
    const int t0 = blockIdx.x * 512 + otid(), nt = gridDim.x * 512;
    for (int task = t0; task < 262144; task += nt) conv_task<4, true>(p, (task >> 7) * 4, task & 127, 0);
    for (int task = t0; task < 16384; task += nt) conv_task<4, false>(p, NPROMPT + 4 * (task >> 7), task & 127, task >> 7);
}

struct S5In { bf16x8 U[4]; u32x2 u4[4], z4[4]; };
__device__ __forceinline__ void s5_load4(S5In& in, const bf16_t* PROJ, const size_t row0, const int g, const int g4) {
    const bf16_t* base = PROJ + row0 * NIN + g * 16;
#pragma unroll
    for (int i = 0; i < 4; ++i) {
        in.U[i] = *(const bf16x8*)(base + (size_t)i * NIN + OFF_SU + 8 * (g4 & 1));
        in.u4[i] = *(const u32x2*)(base + (size_t)i * NIN + OFF_SU + 4 * g4); in.z4[i] = *(const u32x2*)(base + (size_t)i * NIN + OFF_SZ + 4 * g4);
    }
}
__device__ __forceinline__ void s5_steps4(const S5In& in, bf16_t* YS, const size_t row0, const int g, const int g4, const bool Y,
                                          const bf16x8 (&bre)[4], const bf16x8 (&bim)[4], const bf16x8 (&cf)[4], const float (&ar)[16], const float (&ai)[16], const f32x4 dsk,
                                          float (&sr)[16], float (&si)[16]) {
    const f32x4 zero4 = (f32x4){0.f, 0.f, 0.f, 0.f};
#pragma unroll
    for (int i = 0; i < 4; ++i) {
#pragma unroll
        for (int pb = 0; pb < 4; ++pb) {
            const f32x4 xr = MFMA16(bre[pb], in.U[i], zero4), xi = MFMA16(bim[pb], in.U[i], zero4);
#pragma unroll
            for (int j = 0; j < 4; ++j) { const int k = pb * 4 + j; const float nr = ar[k] * sr[k] - ai[k] * si[k] + xr[j]; const float ni = ar[k] * si[k] + ai[k] * sr[k] + xi[j]; sr[k] = nr; si[k] = ni; }
        }
        if (Y) {
            f32x4 y = zero4;
            y = MFMA16(cf[0], pack8((f32x4){sr[0], sr[1], sr[2], sr[3]}, (f32x4){sr[4], sr[5], sr[6], sr[7]}), y);
            y = MFMA16(cf[1], pack8((f32x4){sr[8], sr[9], sr[10], sr[11]}, (f32x4){sr[12], sr[13], sr[14], sr[15]}), y);
            y = MFMA16(cf[2], pack8((f32x4){si[0], si[1], si[2], si[3]}, (f32x4){si[4], si[5], si[6], si[7]}), y);
            y = MFMA16(cf[3], pack8((f32x4){si[8], si[9], si[10], si[11]}, (f32x4){si[12], si[13], si[14], si[15]}), y);
            const float uu[4] = {bf_lo(in.u4[i].x), bf_hi(in.u4[i].x), bf_lo(in.u4[i].y), bf_hi(in.u4[i].y)};
            const float zz[4] = {bf_lo(in.z4[i].x), bf_hi(in.z4[i].x), bf_lo(in.z4[i].y), bf_hi(in.z4[i].y)};
            float o[4];
#pragma unroll
            for (int j = 0; j < 4; ++j) { const float ysv = y[j] + dsk[j] * uu[j]; o[j] = gelu_tanh(ysv * siluf_(zz[j])); }
            u32x2 w; w.x = cvt_pk_bf16(o[0], o[1]); w.y = cvt_pk_bf16(o[2], o[3]);
            *(u32x2*)(YS + (row0 + i) * 1024 + g * 16 + 4 * g4) = w;
        }
    }
}
__device__ __forceinline__ void s5_coef(const P& p, int g, int pp, float dt, float& ar, float& ai, float& fr, float& fi) {
    const float lr = p.lam_re[g * 64 + pp], li = p.lam_im[g * 64 + pp];
    const float mag = expf(lr * dt), ang = li * dt; float sn, cs; sincosf(ang, &sn, &cs);
    ar = mag * cs; ai = mag * sn; const float den = lr * lr + li * li;
    fr = ((ar - 1.0f) * lr + ai * li) / den; fi = (ai * lr - (ar - 1.0f) * li) / den;
}
__device__ __forceinline__ void s5_unit(const P& p, const int unit, LAS unsigned char* lds) {
    const bf16_t* PROJ = (const bf16_t*)(p.ws + WS_PROJ); bf16_t* YS = (bf16_t*)(p.ws + WS_YS);
    const int tid = otid(), lane = tid & 63, w = tid >> 6, cl = lane & 15, g4 = lane >> 4;
    const bool prompt = unit < 256; const int g = prompt ? (unit & 63) : (unit - 256); const int b = unit >> 6;
    const float dt = expf(p.log_dt[g]);
    LAS float* E = (LAS float*)lds;
    LAS f32x4* CT = (LAS f32x4*)(lds + 65536);
    if (tid < 64) { float a_r, a_i, fr_, fi_; s5_coef(p, g, tid, dt, a_r, a_i, fr_, fi_); CT[tid] = (f32x4){a_r, a_i, fr_, fi_}; }
    __syncthreads();
    float ar[16], ai[16];
#pragma unroll
    for (int pb = 0; pb < 4; ++pb)
#pragma unroll
        for (int j = 0; j < 4; ++j) { const f32x4 t = CT[16 * pb + 4 * g4 + j]; ar[pb * 4 + j] = t[0]; ai[pb * 4 + j] = t[1]; }
    bf16x8 bre[4], bim[4], cf[4];
    const float bmask = g4 < 2 ? 1.0f : 0.0f;
#pragma unroll
    for (int pb = 0; pb < 4; ++pb) {
        const int pp = 16 * pb + cl; const f32x4 t = CT[pp]; const float fr_ = t[2] * bmask, fi_ = t[3] * bmask;
        const float* br = p.b_re + ((size_t)(g * 64 + pp)) * 16 + 8 * (g4 & 1); const float* bi = p.b_im + ((size_t)(g * 64 + pp)) * 16 + 8 * (g4 & 1);
        const f32x4 r0 = *(const f32x4*)br, r1 = *(const f32x4*)(br + 4), i0 = *(const f32x4*)bi, i1 = *(const f32x4*)(bi + 4);
        bre[pb] = pack8(fr_ * r0 - fi_ * i0, fr_ * r1 - fi_ * i1);
        bim[pb] = pack8(fr_ * i0 + fi_ * r0, fr_ * i1 + fi_ * r1);
    }
#pragma unroll
    for (int ks = 0; ks < 4; ++ks) {
        const float* cp = (ks < 2 ? p.c_re : p.c_im) + ((size_t)(g * 16 + cl)) * 64 + 32 * (ks & 1) + 4 * g4;
        f32x4 a = *(const f32x4*)cp, c = *(const f32x4*)(cp + 16);
        if (ks >= 2) { a = -a; c = -c; }
        cf[ks] = pack8(a, c);
    }
    const f32x4 dsk = *(const f32x4*)(p.ssm_d + g * 16 + 4 * g4);
    const int chain = 16 * w + cl;
    const size_t row0 = prompt ? (size_t)b * 2048 + (size_t)chain * 16 : (size_t)NPROMPT + 4 * chain;
    const size_t so = ((size_t)chain * 64 + g) * 64 + 4 * g4;
    const int nq = prompt ? 4 : 1;
    float sr[16], si[16];
#pragma unroll
    for (int k = 0; k < 16; ++k) { sr[k] = 0.f; si[k] = 0.f; }
    if (!prompt) {
#pragma unroll
        for (int pb = 0; pb < 4; ++pb) { const f32x4 a = *(const f32x4*)(p.state_re + so + 16 * pb), c = *(const f32x4*)(p.state_im + so + 16 * pb);
#pragma unroll
            for (int j = 0; j < 4; ++j) { sr[pb * 4 + j] = a[j]; si[pb * 4 + j] = c[j]; } }
    }
#pragma unroll 1
    for (int pass = prompt ? 0 : 1; pass < 2; ++pass) {
        if (pass == 1 && prompt) {
#pragma unroll
            for (int pb = 0; pb < 4; ++pb) {
                *(LAS f32x4*)(E + (chain * 2 + 0) * 64 + 16 * pb + 4 * g4) = (f32x4){sr[pb * 4], sr[pb * 4 + 1], sr[pb * 4 + 2], sr[pb * 4 + 3]};
                *(LAS f32x4*)(E + (chain * 2 + 1) * 64 + 16 * pb + 4 * g4) = (f32x4){si[pb * 4], si[pb * 4 + 1], si[pb * 4 + 2], si[pb * 4 + 3]};
            }
            __syncthreads();
            if (w == 0) {
                float a_r, a_i; { const f32x4 t = CT[lane]; a_r = t[0]; a_i = t[1]; }
#pragma unroll
                for (int q = 0; q < 4; ++q) { const float nr = a_r * a_r - a_i * a_i, ni = 2.0f * a_r * a_i; a_r = nr; a_i = ni; }
                float Fr = 0.f, Fi = 0.f;
#pragma unroll 8
                for (int k = 0; k < 128; ++k) {
                    const float er = E[(2 * k) * 64 + lane], ei = E[(2 * k + 1) * 64 + lane];
                    E[(2 * k) * 64 + lane] = Fr; E[(2 * k + 1) * 64 + lane] = Fi;
                    const float nr = a_r * Fr - a_i * Fi + er; Fi = a_r * Fi + a_i * Fr + ei; Fr = nr;
                }
                p.out[O_RP + (size_t)(b * 64 + g) * 64 + lane] = Fr; p.out[O_IP + (size_t)(b * 64 + g) * 64 + lane] = Fi;
            }
            __syncthreads();
#pragma unroll
            for (int pb = 0; pb < 4; ++pb) {
                const f32x4 a = *(LAS f32x4*)(E + (chain * 2 + 0) * 64 + 16 * pb + 4 * g4), c = *(LAS f32x4*)(E + (chain * 2 + 1) * 64 + 16 * pb + 4 * g4);
#pragma unroll
                for (int j = 0; j < 4; ++j) { sr[pb * 4 + j] = a[j]; si[pb * 4 + j] = c[j]; }
            }
        }
        S5In cur; s5_load4(cur, PROJ, row0, g, g4);
#pragma unroll 1
        for (int q = 0; q < nq; ++q) {
            S5In nxt = cur;
            if (q + 1 < nq) s5_load4(nxt, PROJ, row0 + 4 * (q + 1), g, g4);
            s5_steps4(cur, YS, row0 + 4 * q, g, g4, pass == 1, bre, bim, cf, ar, ai, dsk, sr, si);
            cur = nxt;
        }
    }
    if (!prompt) {
#pragma unroll
        for (int pb = 0; pb < 4; ++pb) {
            *(f32x4*)(p.out + O_RS + so + 16 * pb) = (f32x4){sr[pb * 4], sr[pb * 4 + 1], sr[pb * 4 + 2], sr[pb * 4 + 3]};
            *(f32x4*)(p.out + O_IS + so + 16 * pb) = (f32x4){si[pb * 4], si[pb * 4 + 1], si[pb * 4 + 2], si[pb * 4 + 3]};
        }
    }
    __syncthreads();
}

__device__ __forceinline__ void attn_prompt_unit(const P& p, const int unit, LAS unsigned char* lds) {
    const bf16_t* PROJ = (const bf16_t*)(p.ws + WS_PROJ); const bf16_t* KB = (const bf16_t*)(p.ws + WS_KB); const bf16_t* VT = (const bf16_t*)(p.ws + WS_VT);
    bf16_t* OATT = (bf16_t*)(p.ws + WS_OATT);
    const int tid = otid(), lane = tid & 63, w = tid >> 6, cl = lane & 15, g4 = lane >> 4;
    const int b = unit >> 6, h = (unit >> 4) & 3, qb = unit & 15;
    const bf16_t* kbase = KB + (size_t)(b * 256) * 1024 + h * 256;
#pragma unroll
    for (int i = 0; i < 16; ++i) { const int idx = tid + 512 * i, r = idx >> 5, m = idx & 31;
        const u32x4 v = *(const u32x4*)(kbase + (size_t)r * 1024 + m * 8); *(LAS u32x4*)(lds + r * 512 + ((m ^ (r & 15)) << 4)) = v; }
    const size_t qrow = (size_t)b * 2048 + qb * 128 + w * 16 + cl;
    const bf16_t* qp = PROJ + qrow * NIN + OFF_AQ + h * 256 + 8 * g4;
    bf16x8 qf[8];
#pragma unroll
    for (int ks = 0; ks < 8; ++ks) qf[ks] = *(const bf16x8*)(qp + 32 * ks);
    __syncthreads();
    f32x4 s[16];
#pragma unroll
    for (int kb = 0; kb < 16; ++kb) { s[kb] = (f32x4){0.f, 0.f, 0.f, 0.f};
#pragma unroll
        for (int ks = 0; ks < 8; ++ks) { const int key = 16 * kb + cl, m = 4 * ks + g4;
            const bf16x8 kf = *(const LAS bf16x8*)(lds + key * 512 + ((m ^ cl) << 4)); s[kb] = MFMA16(kf, qf[ks], s[kb]); }
        __builtin_amdgcn_sched_barrier(0); }
    float mx = -3.0e38f;
#pragma unroll
    for (int kb = 0; kb < 16; ++kb)
#pragma unroll
        for (int j = 0; j < 4; ++j) mx = fmaxf(mx, s[kb][j]);
    mx = fmaxf(mx, __shfl_xor(mx, 16)); mx = fmaxf(mx, __shfl_xor(mx, 32));
    float sum = 0.f;
#pragma unroll
    for (int kb = 0; kb < 16; ++kb)
#pragma unroll
        for (int j = 0; j < 4; ++j) { const float e = __expf((s[kb][j] - mx) * 0.0625f); s[kb][j] = e; sum += e; }
    sum += __shfl_xor(sum, 16); sum += __shfl_xor(sum, 32);
    const float inv = 1.0f / sum;
    bf16x8 pf[8];
#pragma unroll
    for (int kk = 0; kk < 8; ++kk) pf[kk] = pack8(s[2 * kk], s[2 * kk + 1]);
    __syncthreads();
    const bf16_t* vbase = VT + (size_t)((b * 4 + h) * 256) * 256;
#pragma unroll
    for (int i = 0; i < 16; ++i) { const int idx = tid + 512 * i, r = idx >> 5, m = idx & 31;
        const u32x4 v = *(const u32x4*)(vbase + (size_t)r * 256 + m * 8); *(LAS u32x4*)(lds + r * 512 + ((m ^ (r & 15)) << 4)) = v; }
    __syncthreads();
    const bf16_t* azp = PROJ + qrow * NIN + OFF_AZ + h * 256 + 4 * g4;
    bf16_t* op = OATT + qrow * 1024 + h * 256 + 4 * g4;
#pragma unroll
    for (int db = 0; db < 16; ++db) {
        f32x4 o = (f32x4){0.f, 0.f, 0.f, 0.f}; const int d = 16 * db + cl;
#pragma unroll
        for (int kk = 0; kk < 8; ++kk) {
            const int ch0 = 8 * kk + g4, ch1 = ch0 + 4;
            const u32x2 lo = *(const LAS u32x2*)(lds + d * 512 + (((ch0 >> 1) ^ cl) << 4) + (ch0 & 1) * 8);
            const u32x2 hi = *(const LAS u32x2*)(lds + d * 512 + (((ch1 >> 1) ^ cl) << 4) + (ch1 & 1) * 8);
            const u32x4 vv = (u32x4){lo.x, lo.y, hi.x, hi.y};
            o = MFMA16(__builtin_bit_cast(bf16x8, vv), pf[kk], o);
        }
        const u32x2 az = *(const u32x2*)(azp + 16 * db);
        const float z[4] = {bf_lo(az.x), bf_hi(az.x), bf_lo(az.y), bf_hi(az.y)};
        u32x2 wv; wv.x = cvt_pk_bf16(o[0] * inv * siluf_(z[0]), o[1] * inv * siluf_(z[1])); wv.y = cvt_pk_bf16(o[2] * inv * siluf_(z[2]), o[3] * inv * siluf_(z[3]));
        *(u32x2*)(op + 16 * db) = wv;
        __builtin_amdgcn_sched_barrier(0);
    }
    __syncthreads();
}

__device__ __forceinline__ void attn_sample_unit(const P& p, const int unit, LAS unsigned char* lds) {
    const bf16_t* PROJ = (const bf16_t*)(p.ws + WS_PROJ); bf16_t* OATT = (bf16_t*)(p.ws + WS_OATT);
    const int tid = otid(), lane = tid & 63, w = tid >> 6, cl = lane & 15, g4 = lane >> 4;
    const int b = unit >> 2, h = unit & 3;
    LAS float* sc = (LAS float*)lds;
    LAS float* po = (LAS float*)(lds + 4096);
    const float* kbase = p.cache_k + ((size_t)b * 1024 + h) * 256;
    const float* vbase = p.cache_v + ((size_t)b * 1024 + h) * 256;
    const size_t qrow = (size_t)NPROMPT + 4 * b + (cl & 3);
    const bf16_t* qp = PROJ + qrow * NIN + OFF_AQ + h * 256 + 8 * g4;
    bf16x8 qf[8];
#pragma unroll
    for (int ks = 0; ks < 8; ++ks) qf[ks] = *(const bf16x8*)(qp + 32 * ks);
#pragma unroll
    for (int kblk = 0; kblk < 2; ++kblk) {
        const int key = 32 * w + 16 * kblk + cl; const float* kr = kbase + (size_t)key * 1024 + 8 * g4;
        f32x4 ka[8], kc[8];
#pragma unroll
        for (int ks = 0; ks < 8; ++ks) { ka[ks] = *(const f32x4*)(kr + 32 * ks); kc[ks] = *(const f32x4*)(kr + 32 * ks + 4); }
        f32x4 s = (f32x4){0.f, 0.f, 0.f, 0.f};
#pragma unroll
        for (int ks = 0; ks < 8; ++ks) s = MFMA16(pack8(ka[ks], kc[ks]), qf[ks], s);
        if (cl < 4) *(LAS f32x4*)(sc + cl * 256 + 32 * w + 16 * kblk + 4 * g4) = s;
    }
    f32x4 vv[32];
#pragma unroll
    for (int i = 0; i < 32; ++i) vv[i] = *(const f32x4*)(vbase + (size_t)(32 * w + i) * 1024 + 4 * lane);
    __syncthreads();
    if (w == 0) {
#pragma unroll
        for (int q = 0; q < 4; ++q) {
            f32x4 v = *(LAS f32x4*)(sc + q * 256 + 4 * lane);
            float mx = fmaxf(fmaxf(v[0], v[1]), fmaxf(v[2], v[3]));
#pragma unroll
            for (int o = 32; o >= 1; o >>= 1) mx = fmaxf(mx, __shfl_xor(mx, o));
            float sum = 0.f;
#pragma unroll
            for (int e = 0; e < 4; ++e) { v[e] = __expf((v[e] - mx) * 0.0625f); sum += v[e]; }
#pragma unroll
            for (int o = 32; o >= 1; o >>= 1) sum += __shfl_xor(sum, o);
            const float inv = 1.0f / sum;
            *(LAS f32x4*)(sc + q * 256 + 4 * lane) = v * inv;
        }
    }
    __syncthreads();
    f32x4 o[4];
#pragma unroll
    for (int q = 0; q < 4; ++q) o[q] = (f32x4){0.f, 0.f, 0.f, 0.f};
#pragma unroll
    for (int ii = 0; ii < 8; ++ii)
#pragma unroll
        for (int q = 0; q < 4; ++q) { const f32x4 pv = *(LAS f32x4*)(sc + q * 256 + 32 * w + 4 * ii);
            o[q] += pv[0] * vv[4 * ii] + pv[1] * vv[4 * ii + 1] + pv[2] * vv[4 * ii + 2] + pv[3] * vv[4 * ii + 3]; }
#pragma unroll
    for (int q = 0; q < 4; ++q) *(LAS f32x4*)(po + (w * 4 + q) * 256 + 4 * lane) = o[q];
    __syncthreads();
    {
        const int q = tid >> 7, d = (tid & 127) * 2; float a0 = 0.f, a1 = 0.f;
#pragma unroll
        for (int ww = 0; ww < 8; ++ww) { a0 += po[(ww * 4 + q) * 256 + d]; a1 += po[(ww * 4 + q) * 256 + d + 1]; }
        const size_t row = (size_t)NPROMPT + 4 * b + q;
        const unsigned az = *(const unsigned*)(PROJ + row * NIN + OFF_AZ + h * 256 + d);
        *(unsigned*)(OATT + row * 1024 + h * 256 + d) = cvt_pk_bf16(a0 * siluf_(bf_lo(az)), a1 * siluf_(bf_hi(az)));
    }
    __syncthreads();
}

__device__ __forceinline__ void phase5(const P& p) {
    const float* part = (const float*)(p.ws + WS_PART);
    const int t0 = otid(); const int lane = t0 & 63, gw = blockIdx.x * 8 + (t0 >> 6), nw = gridDim.x * 8;
    for (int row = gw; row < MTOK; row += nw) {
        float* orow = p.out + (size_t)row * DM;
        f32x4 v[8]; float s = 0.f;
        if (row < NPROMPT) {
            const float* xr = p.x_prompt + (size_t)row * DM;
#pragma unroll
            for (int i = 0; i < 8; ++i) v[i] = *(const f32x4*)(xr + 4 * (lane + 64 * i)) + *(const f32x4*)(orow + 4 * (lane + 64 * i));
        } else {
            const float* xr = p.x_sample + (size_t)(row - NPROMPT) * DM;
#pragma unroll
            for (int i = 0; i < 8; ++i) v[i] = *(const f32x4*)(xr + 4 * (lane + 64 * i));
#pragma unroll 2
            for (int ks = 0; ks < 8; ++ks) { const float* pr = part + ((size_t)ks * 512 + (row - NPROMPT)) * DM;
#pragma unroll
                for (int i = 0; i < 8; ++i) v[i] += *(const f32x4*)(pr + 4 * (lane + 64 * i)); }
        }
#pragma unroll
        for (int i = 0; i < 8; ++i) s += (v[i][0] * v[i][0] + v[i][1] * v[i][1]) + (v[i][2] * v[i][2] + v[i][3] * v[i][3]);
#pragma unroll
        for (int o = 32; o >= 1; o >>= 1) s += __shfl_xor(s, o);
        const float rstd = 1.0f / sqrtf(s * (1.0f / 2048.0f) + 1e-6f);
#pragma unroll
        for (int i = 0; i < 8; ++i) { const f32x4 gv = *(const f32x4*)(p.final_g + 4 * (lane + 64 * i)); *(f32x4*)(orow + 4 * (lane + 64 * i)) = v[i] * rstd * gv; }
    }
}

__global__ void __launch_bounds__(512, 2) mega_fwd(P p) {
    extern __shared__ __attribute__((aligned(16))) unsigned char shm[];
    LAS unsigned char* lds = (LAS unsigned char*)shm;
    cg::grid_group grid = cg::this_grid();
    unsigned char* ws = p.ws;
    const int G = gridDim.x, c = blockIdx.x;

#ifndef PHMASK
#define PHMASK 0xffff
#endif
#ifndef REPMASK
#define REPMASK 0
#endif
#define NREP(bit) ((REPMASK & (bit)) ? 2 : 1)
#ifndef TPHASE
#define TPHASE -1
#endif
#ifndef TMULT
#define TMULT 4
#endif
    unsigned long long ts[8]; int nts = 0;
#define STAMP() do { if (TPHASE >= 0) { ts[nts] = wall_clock64(); } ++nts; } while (0)
    STAMP();
    for (int rep = 0; rep < NREP(1); ++rep) if (PHMASK & 1) phase0(p, lds);
    grid.sync(); STAMP();

    for (int rep = 0; rep < NREP(2); ++rep) if (PHMASK & 2) {
        Sched1 S{(const char*)(ws + WS_H), (const char*)(ws + WS_WIN), (const char*)(ws + WS_MEMN), (const char*)(ws + WS_WK), (const char*)(ws + WS_WV), G, c};
        Epi1 E{(bf16_t*)(ws + WS_PROJ), p.out + O_MK, (bf16_t*)(ws + WS_KB), p.out + O_MV, (bf16_t*)(ws + WS_VT)};
        pg8::gemm_phase(lds, 2048, 2048, S, E);
    }
    grid.sync(); STAMP();

    for (int rep = 0; rep < NREP(4); ++rep) {
        if ((c & 1) == 0) for (int u = c; u < 512; u += G) attn_sample_unit(p, u, lds);
        for (int u = c; u < 320; u += G) s5_unit(p, u, lds);
        for (int u = c; u < 256; u += G) attn_prompt_unit(p, u, lds);
        conv_phase(p);
        if ((c & 1) != 0) for (int u = c; u < 512; u += G) attn_sample_unit(p, u, lds);
    }
    grid.sync(); STAMP();

    for (int rep = 0; rep < NREP(8); ++rep) if (PHMASK & 64) {
        Sched2 S{(const char*)ws, G, c};
        Epi2 E{(bf16_t*)(ws + WS_GLU), (bf16_t*)(ws + WS_CONVO), (bf16_t*)(ws + WS_ATTO)};
        pg8::gemm_phase(lds, 1024, 1024, S, E);
    }
    grid.sync(); STAMP();

    for (int rep = 0; rep < NREP(32); ++rep) merge_phase(p);
    grid.sync(); STAMP();

    for (int rep = 0; rep < NREP(16); ++rep) if (PHMASK & 128) {
        { Sched3 S{(const char*)(ws + WS_MERGED), (const char*)(ws + WS_WO), G, c}; Epi3 E{p.out + O_Y, (float*)(ws + WS_PART), false}; pg8::gemm_phase(lds, 2048, 2048, S, E); }
        { Sched3b S{(const char*)(ws + WS_MERGED), (const char*)(ws + WS_WO), G, c}; Epi3 E{p.out + O_Y, (float*)(ws + WS_PART), true}; pg8::gemm_phase(lds, 256, 2048, S, E); }
    }
    grid.sync(); STAMP();

    if (PHMASK & 256) phase5(p);
    STAMP();
    if (TPHASE >= 0 && blockIdx.x == 0 && threadIdx.x == 0) {
        const unsigned long long d = (ts[TPHASE + 1] - ts[TPHASE]) * TMULT, t0 = wall_clock64();
        while (wall_clock64() - t0 < d) __builtin_amdgcn_s_sleep(16);
    }
}

extern "C" void kernel_launch(void* const* d_in, const int* in_sizes, int n_in, void* d_out, int out_size, void* d_ws, size_t ws_size, hipStream_t stream) {
    static int grid = 0;
    if (grid == 0) {
        int dev = 0, cus = 0, per_cu = 0;
        hipGetDevice(&dev);
        hipDeviceGetAttribute(&cus, hipDeviceAttributeMultiprocessorCount, dev);
        if (hipFuncSetAttribute((const void*)mega_fwd, hipFuncAttributeMaxDynamicSharedMemorySize, LDS_BYTES) != hipSuccess) fprintf(stderr, "kernel_launch: hipFuncSetAttribute failed\n");
        if (hipOccupancyMaxActiveBlocksPerMultiprocessor(&per_cu, (const void*)mega_fwd, 512, LDS_BYTES) != hipSuccess || per_cu < 1) per_cu = 1;
        (void)hipGetLastError();
        grid = cus * per_cu;
        if (ws_size < WS_END) fprintf(stderr, "kernel_launch: workspace too small (%zu < %zu)\n", ws_size, (size_t)WS_END);
    }
    P p{};
    const float** pp = (const float**)&p;
    for (int i = 0; i < 28; ++i) pp[i] = (const float*)d_in[i];
    p.out = (float*)d_out; p.ws = (unsigned char*)d_ws;
    void* args[] = {&p};
    hipError_t e = hipLaunchCooperativeKernel((const void*)mega_fwd, dim3(grid), dim3(512), args, LDS_BYTES, stream);
    if (e != hipSuccess) fprintf(stderr, "cooperative launch failed: %s (grid %d)\n", hipGetErrorString(e), grid);
}
```

```cpp
#include <hip/hip_runtime.h>
#include <hip/hip_cooperative_groups.h>
#include <cstdio>
namespace cg = cooperative_groups;

#define LAS __attribute__((address_space(3)))
typedef unsigned short bf16_t;
typedef short bf16x8 __attribute__((ext_vector_type(8)));
typedef float f32x4 __attribute__((ext_vector_type(4)));
typedef unsigned u32x4 __attribute__((ext_vector_type(4)));
typedef unsigned u32x2 __attribute__((ext_vector_type(2)));

constexpr int DM = 2048, NPROMPT = 8192, NSAMPLE = 512, MTOK = 8704, NIN = 14336;
constexpr int OFF_CB = 0, OFF_CC = 1024, OFF_CH = 2048, OFF_CZ = 3072, OFF_SU = 4096, OFF_SZ = 5120, OFF_AQ = 6144, OFF_AZ = 7168, OFF_G = 8192;
constexpr int LDS_BYTES = 131072 + 16;
constexpr size_t O_Y = 0, O_MK = 17825792, O_MV = 18874368, O_CP = 19922944, O_RP = 19931136, O_IP = 19947520, O_CS = 19963904, O_RS = 20226048, O_IS = 20750336;
constexpr size_t WS_WIN = 0;
constexpr size_t WS_WG = WS_WIN + (size_t)NIN * DM * 2;
constexpr size_t WS_WC = WS_WG + 8388608;
constexpr size_t WS_WA = WS_WC + 4194304;
constexpr size_t WS_WO = WS_WA + 4194304;
constexpr size_t WS_WK = WS_WO + 8388608;
constexpr size_t WS_WV = WS_WK + 4194304;
constexpr size_t WS_H = WS_WV + 4194304;
constexpr size_t WS_MEMN = WS_H + (size_t)MTOK * DM * 2;
constexpr size_t WS_PROJ = WS_MEMN + 4194304;
constexpr size_t WS_KB = WS_PROJ + (size_t)MTOK * NIN * 2;
constexpr size_t WS_VT = WS_KB + 2097152;
constexpr size_t WS_YS = WS_VT + 2097152;
constexpr size_t WS_ACONV = WS_YS + (size_t)MTOK * 1024 * 2;
constexpr size_t WS_OATT = WS_ACONV + (size_t)MTOK * 1024 * 2;
constexpr size_t WS_SS = WS_OATT + (size_t)MTOK * 1024 * 2;
constexpr size_t WS_GLU = WS_SS + (size_t)MTOK * 32 * 4;
constexpr size_t WS_MERGED = WS_GLU + (size_t)MTOK * DM * 2;
constexpr size_t WS_BAR = WS_MERGED + (size_t)MTOK * DM * 2;
constexpr size_t WS_END = WS_BAR + 16384;
constexpr size_t WS_CONVO = WS_H, WS_ATTO = WS_WIN, WS_PART = WS_PROJ;
static_assert(WS_END <= 536870912, "workspace");

struct P {
    const float *x_prompt, *x_sample, *mem_prompt, *cache_k, *cache_v, *state_conv, *state_re, *state_im, *norm_g, *mem_norm_g, *w_in, *conv_w, *w_conv_out,
        *lam_re, *lam_im, *log_dt, *b_re, *b_im, *c_re, *c_im, *ssm_d, *w_glu_a, *w_glu_b, *w_mem_k, *w_mem_v, *w_attn_out, *w_out, *final_g;
    float* out; unsigned char* ws;
};

__device__ __forceinline__ unsigned cvt_pk_bf16(float lo, float hi) { unsigned r; asm("v_cvt_pk_bf16_f32 %0, %1, %2" : "=v"(r) : "v"(lo), "v"(hi)); return r; }
__device__ __forceinline__ float bf_lo(unsigned w) { return __uint_as_float(w << 16); }
__device__ __forceinline__ float bf_hi(unsigned w) { return __uint_as_float(w & 0xffff0000u); }
__device__ __forceinline__ float rcp_(float x) { return __builtin_amdgcn_rcpf(x); }
__device__ __forceinline__ float sigmoidf_(float x) { return rcp_(1.0f + __expf(-x)); }
__device__ __forceinline__ float siluf_(float x) { return x * rcp_(1.0f + __expf(-x)); }
__device__ __forceinline__ float gelu_tanh(float x) { const float u = 1.5957691216057308f * (x + 0.044715f * x * x * x); return x * rcp_(1.0f + __expf(-u)); }
__device__ __forceinline__ bf16x8 pack8(const f32x4 a, const f32x4 b) {
    u32x4 w; w.x = cvt_pk_bf16(a[0], a[1]); w.y = cvt_pk_bf16(a[2], a[3]); w.z = cvt_pk_bf16(b[0], b[1]); w.w = cvt_pk_bf16(b[2], b[3]);
    return __builtin_bit_cast(bf16x8, w);
}
__device__ __forceinline__ u32x4 pack8u(const f32x4 a, const f32x4 b) {
    u32x4 w; w.x = cvt_pk_bf16(a[0], a[1]); w.y = cvt_pk_bf16(a[2], a[3]); w.z = cvt_pk_bf16(b[0], b[1]); w.w = cvt_pk_bf16(b[2], b[3]); return w;
}
__device__ __forceinline__ void unpack8(const u32x4 w, float (&f)[8]) {
    f[0] = bf_lo(w.x); f[1] = bf_hi(w.x); f[2] = bf_lo(w.y); f[3] = bf_hi(w.y); f[4] = bf_lo(w.z); f[5] = bf_hi(w.z); f[6] = bf_lo(w.w); f[7] = bf_hi(w.w);
}
__device__ __forceinline__ int otid() { int t = threadIdx.x; asm volatile("" : "+v"(t)); return t; }
#define MFMA16(a, b, c) __builtin_amdgcn_mfma_f32_16x16x32_bf16((a), (b), (c), 0, 0, 0)

namespace pg8 {
constexpr int BM = 256, BK = 64, HALF = 128, HTB = HALF * BK * 2, STAGE_BYTES = 8 * HTB;
__device__ __forceinline__ int lds_byte(int r, int c) { const int st = (r >> 4) * 2 + (c >> 5), rr = r & 15, cc = c & 31, ob = rr * 64 + cc * 2; return st * 1024 + (ob ^ (((ob >> 9) & 1) << 5)); }
__device__ __forceinline__ void stage_rc(int b, int& R, int& C) { const int st = b / 1024, sb = b % 1024, swz = sb ^ (((sb >> 9) & 1) << 5); R = (st >> 1) * 16 + swz / 64; C = (st & 1) * 32 + (swz % 64) / 2; }
__device__ __forceinline__ int perm32(int rho) { const int n = rho >> 4, i = rho & 15; return 8 * (i >> 2) + 4 * n + (i & 3); }
struct Unit { const char* a; const char* b; int pm, pn, kind; };

template <class Sched, class Epi>
__device__ __forceinline__ void gemm_phase(LAS unsigned char* lds, const int K, const int ld, const Sched& S, const Epi& E) {
    const int tid = otid(), wid = __builtin_amdgcn_readfirstlane(tid >> 6), lane = tid & 63, wr = wid >> 2, wc = wid & 3, fr = lane & 15, fq = lane >> 4;
    const int nt = K / BK;
    unsigned voffA[2], voffB[2];
#pragma unroll
    for (int i = 0; i < 2; ++i) { int R, C; stage_rc(tid * 16 + i * 8192, R, C); const int Rb = (R & ~31) + perm32(R & 31);
        voffA[i] = (unsigned)(R * ld + C) * 2u; voffB[i] = (unsigned)(Rb * ld + C) * 2u; }
    const size_t kstep = (size_t)(BK * 2);
    const size_t hstep = (size_t)HALF * ld * 2;
    const unsigned ldsw = (unsigned)wid * 1024u;
    const int aoff = lds_byte(wr * 64 + fr, fq * 8), boff = lds_byte(wc * 32 + fr, fq * 8);
#define PG8_SA(b, h) (((b) * 2 + (h)) * HTB)
#define PG8_SB(b, h) ((4 + (b) * 2 + (h)) * HTB)
#define PG8_STAGE(bufoff, gbase, voff) do { _Pragma("unroll") for (int _i = 0; _i < 2; ++_i) \
        __builtin_amdgcn_global_load_lds((const unsigned*)((const char*)(gbase) + (voff)[_i]), (LAS unsigned*)(lds + (bufoff) + ldsw + _i * 8192), 16, 0, 0); } while (0)
#define PG8_LDA(dst, b, h) do { _Pragma("unroll") for (int m = 0; m < 4; ++m) _Pragma("unroll") for (int k = 0; k < 2; ++k) dst[m][k] = *(const LAS bf16x8*)(lds + PG8_SA(b, h) + aoff + m * 2048 + k * 1024); } while (0)
#define PG8_LDB(dst, b, h) do { _Pragma("unroll") for (int n = 0; n < 2; ++n) _Pragma("unroll") for (int k = 0; k < 2; ++k) dst[n][k] = *(const LAS bf16x8*)(lds + PG8_SB(b, h) + boff + n * 2048 + k * 1024); } while (0)
#define PG8_MMA(ai, bj, At, Bt) do { __builtin_amdgcn_s_setprio(1); _Pragma("unroll") for (int m = 0; m < 4; ++m) _Pragma("unroll") for (int n = 0; n < 2; ++n) _Pragma("unroll") for (int k = 0; k < 2; ++k) \
        acc[ai][bj][m][n] = __builtin_amdgcn_mfma_f32_16x16x32_bf16(Bt[n][k], At[m][k], acc[ai][bj][m][n], 0, 0, 0); __builtin_amdgcn_s_setprio(0); } while (0)
#define PG8_WAIT_V(n) asm volatile("s_waitcnt vmcnt(" #n ")" ::: "memory")
#define PG8_WAIT_L(n) asm volatile("s_waitcnt lgkmcnt(" #n ")" ::: "memory")
#define PG8_BAR __builtin_amdgcn_s_barrier()
#define PG8_SCHED __builtin_amdgcn_sched_barrier(0)
    Unit cur, nxt; int ui = 0;
    if (!S.next(0, cur)) return;
    f32x4 acc[2][2][4][2];
#pragma unroll
    for (int a = 0; a < 2; ++a)
#pragma unroll
        for (int b = 0; b < 2; ++b)
#pragma unroll
            for (int m = 0; m < 4; ++m)
#pragma unroll
                for (int n = 0; n < 2; ++n) acc[a][b][m][n] = (f32x4){0.f, 0.f, 0.f, 0.f};
    bf16x8 At[4][2], B0[2][2], B1[2][2];
    const char* cA = cur.a; const char* cB = cur.b;
    PG8_STAGE(PG8_SB(0, 0), cB, voffB); PG8_STAGE(PG8_SA(0, 0), cA, voffA); PG8_STAGE(PG8_SB(0, 1), cB + hstep, voffB); PG8_STAGE(PG8_SA(0, 1), cA + hstep, voffA);
    if (wr == 1) PG8_BAR;
    PG8_WAIT_V(4); PG8_BAR;
    PG8_STAGE(PG8_SB(1, 0), cB + kstep, voffB); PG8_STAGE(PG8_SA(1, 0), cA + kstep, voffA); PG8_STAGE(PG8_SB(1, 1), cB + hstep + kstep, voffB);
    PG8_WAIT_V(6); PG8_BAR;
    for (;;) {
        const bool has_next = S.next(ui + 1, nxt);
        const char* nA = has_next ? nxt.a : cA; const char* nB = has_next ? nxt.b : cB;
        for (int t = 0; t < nt; t += 2) {
            const bool last = (t == nt - 2);
            const char* a1 = cA + (size_t)(t + 1) * kstep;
            const char* a2 = last ? nA : cA + (size_t)(t + 2) * kstep; const char* b2 = last ? nB : cB + (size_t)(t + 2) * kstep;
            const char* a3 = a2 + kstep; const char* b3 = b2 + kstep;
            PG8_LDB(B0, 0, 0); PG8_SCHED; PG8_LDA(At, 0, 0); PG8_STAGE(PG8_SA(1, 1), a1 + hstep, voffA);
            PG8_WAIT_L(8); PG8_BAR; PG8_WAIT_L(0); PG8_MMA(0, 0, At, B0); PG8_BAR; PG8_SCHED;
            PG8_LDB(B1, 0, 1); PG8_STAGE(PG8_SB(0, 0), b2, voffB);
            PG8_BAR; PG8_WAIT_L(0); PG8_MMA(0, 1, At, B1); PG8_BAR;
            PG8_LDA(At, 0, 1); PG8_STAGE(PG8_SA(0, 0), a2, voffA);
            PG8_BAR; PG8_WAIT_L(0); PG8_MMA(1, 0, At, B0); PG8_BAR; PG8_SCHED;
            PG8_STAGE(PG8_SB(0, 1), b2 + hstep, voffB);
            PG8_WAIT_V(6); PG8_BAR; PG8_MMA(1, 1, At, B1); PG8_BAR;
            PG8_LDB(B0, 1, 0); PG8_SCHED; PG8_LDA(At, 1, 0); PG8_STAGE(PG8_SA(0, 1), a2 + hstep, voffA);
            PG8_WAIT_L(8); PG8_BAR; PG8_WAIT_L(0); PG8_MMA(0, 0, At, B0); PG8_BAR; PG8_SCHED;
            PG8_LDB(B1, 1, 1); PG8_STAGE(PG8_SB(1, 0), b3, voffB);
            PG8_BAR; PG8_WAIT_L(0); PG8_MMA(0, 1, At, B1); PG8_BAR;
            PG8_LDA(At, 1, 1); PG8_STAGE(PG8_SA(1, 0), a3, voffA);
            PG8_BAR; PG8_WAIT_L(0); PG8_MMA(1, 0, At, B0); PG8_BAR; PG8_SCHED;
            PG8_STAGE(PG8_SB(1, 1), b3 + hstep, voffB);
            PG8_WAIT_V(6); PG8_BAR; PG8_MMA(1, 1, At, B1); PG8_BAR;
        }
        const bool keep = E(acc, cur, wr, wc, fr, fq);
        if (!has_next) break;
        if (!keep) {
#pragma unroll
            for (int a = 0; a < 2; ++a)
#pragma unroll
                for (int b = 0; b < 2; ++b)
#pragma unroll
                    for (int m = 0; m < 4; ++m)
#pragma unroll
                        for (int n = 0; n < 2; ++n) acc[a][b][m][n] = (f32x4){0.f, 0.f, 0.f, 0.f};
        }
        cur = nxt; cA = nA; cB = nB; ++ui;
    }
    PG8_WAIT_V(0);
    if (wr == 0) PG8_BAR;
    PG8_BAR;
#undef PG8_SA
#undef PG8_SB
#undef PG8_STAGE
#undef PG8_LDA
#undef PG8_LDB
#undef PG8_MMA
#undef PG8_WAIT_V
#undef PG8_WAIT_L
#undef PG8_BAR
#undef PG8_SCHED
}
}
using pg8::Unit;

struct Sched1 {
    const char *H, *WIN, *MEMN, *WK, *WV; int G, c;
    __device__ __forceinline__ bool next(int i, Unit& u) const {
        const int L = i * G + c; if (L >= 1936) return false;
        if (L < 1904) {
            const int nM = 34, nN = 56, nwg = 1904, NX = 8, WGM = 8;
            int wgid = L; { const int q = nwg / NX, r = nwg % NX, xcd = wgid % NX, off = wgid / NX; wgid = (xcd < r ? xcd * (q + 1) : r * (q + 1) + (xcd - r) * q) + off; }
            const int nig = WGM * nN, gid = wgid / nig, fm = gid * WGM, gsz = (nM - fm) < WGM ? (nM - fm) : WGM;
            u.pm = fm + ((wgid % nig) % gsz); u.pn = (wgid % nig) / gsz; u.kind = 0;
            u.a = H + (size_t)u.pm * 1048576; u.b = WIN + (size_t)u.pn * 1048576;
        } else if (L < 1920) { const int j = L - 1904; u.pm = j >> 2; u.pn = j & 3; u.kind = 1; u.a = MEMN + (size_t)u.pm * 1048576; u.b = WK + (size_t)u.pn * 1048576; }
        else { const int j = L - 1920; u.pm = j >> 2; u.pn = j & 3; u.kind = 2; u.a = WV + (size_t)u.pm * 1048576; u.b = MEMN + (size_t)u.pn * 1048576; }
        return true;
    }
};
struct Epi1 {
    bf16_t* PROJ; float* outK; bf16_t* KB; float* outV; bf16_t* VT;
    __device__ __forceinline__ bool operator()(f32x4 (&acc)[2][2][4][2], const Unit& u, int wr, int wc, int fr, int fq) const {
        const int r0 = u.pm * 256 + wr * 64 + fr, c0 = u.pn * 256 + wc * 32 + 8 * fq;
        if (u.kind == 0) {
#pragma unroll
            for (int ai = 0; ai < 2; ++ai)
#pragma unroll
                for (int m = 0; m < 4; ++m) { bf16_t* rowp = PROJ + (size_t)(r0 + ai * 128 + m * 16) * NIN + c0;
#pragma unroll
                    for (int bj = 0; bj < 2; ++bj) *(u32x4*)(rowp + bj * 128) = pack8u(acc[ai][bj][m][0], acc[ai][bj][m][1]); }
        } else if (u.kind == 1) {
#pragma unroll
            for (int ai = 0; ai < 2; ++ai)
#pragma unroll
                for (int m = 0; m < 4; ++m) { const size_t off = (size_t)(r0 + ai * 128 + m * 16) * 1024 + c0;
#pragma unroll
                    for (int bj = 0; bj < 2; ++bj) { *(f32x4*)(outK + off + bj * 128) = acc[ai][bj][m][0]; *(f32x4*)(outK + off + bj * 128 + 4) = acc[ai][bj][m][1];
                        *(u32x4*)(KB + off + bj * 128) = pack8u(acc[ai][bj][m][0], acc[ai][bj][m][1]); } }
        } else {
            const int h = u.pm, b = u.pn;
#pragma unroll
            for (int ai = 0; ai < 2; ++ai)
#pragma unroll
                for (int m = 0; m < 4; ++m) { const int d = wr * 64 + fr + ai * 128 + m * 16;
#pragma unroll
                    for (int bj = 0; bj < 2; ++bj) { const int key0 = wc * 32 + 8 * fq + bj * 128;
                        *(u32x4*)(VT + ((size_t)((b * 4 + h) * 256 + d)) * 256 + key0) = pack8u(acc[ai][bj][m][0], acc[ai][bj][m][1]);
                        float* fp = outV + ((size_t)(b * 256 + key0)) * 1024 + h * 256 + d;
#pragma unroll
                        for (int e = 0; e < 4; ++e) { fp[(size_t)e * 1024] = acc[ai][bj][m][0][e]; fp[(size_t)(e + 4) * 1024] = acc[ai][bj][m][1][e]; } } }
        }
        return false;
    }
};

struct Sched2 {
    const char* ws; int G, c;
    __device__ __forceinline__ bool next(int i, Unit& u) const {
        const int L = i * G + c; if (L >= 1088) return false;
        if (L < 544) { u.pm = L >> 4; u.pn = L & 15; u.kind = 0; u.a = ws + WS_YS + (size_t)u.pm * 524288; u.b = ws + WS_WG + (size_t)u.pn * 524288; }
        else { const int j = L - 544, k = j >= 272 ? 1 : 0, jj = j - 272 * k; u.pm = jj >> 3; u.pn = jj & 7; u.kind = 1 + k;
            u.a = ws + WS_ACONV + (size_t)k * ((size_t)MTOK * 1024 * 2) + (size_t)u.pm * 524288; u.b = ws + WS_WC + (size_t)k * 4194304 + (size_t)u.pn * 524288; }
        return true;
    }
};
struct Epi2 {
    bf16_t* GLU; bf16_t* CONVO; bf16_t* ATTO;
    __device__ __forceinline__ bool operator()(f32x4 (&acc)[2][2][4][2], const Unit& u, int wr, int wc, int fr, int fq) const {
        const int r0 = u.pm * 256 + wr * 64 + fr;
        if (u.kind == 0) {
            const int c0 = u.pn * 128 + wc * 32 + 8 * fq;
#pragma unroll
            for (int ai = 0; ai < 2; ++ai)
#pragma unroll
                for (int m = 0; m < 4; ++m) {
                    f32x4 t0, t1;
#pragma unroll
                    for (int e = 0; e < 4; ++e) { t0[e] = acc[ai][0][m][0][e] * sigmoidf_(acc[ai][1][m][0][e]); t1[e] = acc[ai][0][m][1][e] * sigmoidf_(acc[ai][1][m][1][e]); }
                    *(u32x4*)(GLU + (size_t)(r0 + ai * 128 + m * 16) * 2048 + c0) = pack8u(t0, t1);
                }
        } else {
            bf16_t* O = u.kind == 1 ? CONVO : ATTO; const int c0 = u.pn * 256 + wc * 32 + 8 * fq;
#pragma unroll
            for (int ai = 0; ai < 2; ++ai)
#pragma unroll
                for (int m = 0; m < 4; ++m) { bf16_t* rowp = O + (size_t)(r0 + ai * 128 + m * 16) * 2048 + c0;
#pragma unroll
                    for (int bj = 0; bj < 2; ++bj) *(u32x4*)(rowp + bj * 128) = pack8u(acc[ai][bj][m][0], acc[ai][bj][m][1]); }
        }
        return false;
    }
};
__device__ __forceinline__ void merge_phase(const P& p) {
    const bf16_t* PROJ = (const bf16_t*)(p.ws + WS_PROJ); const bf16_t* GLU = (const bf16_t*)(p.ws + WS_GLU); const bf16_t* CONVO = (const bf16_t*)(p.ws + WS_CONVO);
    const bf16_t* ATTO = (const bf16_t*)(p.ws + WS_ATTO); bf16_t* MERGED = (bf16_t*)(p.ws + WS_MERGED);
    const int NT = MTOK * 256;
    for (int t = blockIdx.x * 512 + otid(); t < NT; t += gridDim.x * 512) {
        const size_t row = (size_t)(t >> 8); const int c0 = (t & 255) * 8;
        const bf16_t* pr = PROJ + row * NIN + OFF_G + c0; const size_t o = row * 2048 + c0;
        float g0[8], g1[8], g2[8], cv[8], gl[8], at[8];
        unpack8(*(const u32x4*)pr, g0); unpack8(*(const u32x4*)(pr + 2048), g1); unpack8(*(const u32x4*)(pr + 4096), g2);
        unpack8(*(const u32x4*)(CONVO + o), cv); unpack8(*(const u32x4*)(GLU + o), gl); unpack8(*(const u32x4*)(ATTO + o), at);
        f32x4 m0, m1;
#pragma unroll
        for (int e = 0; e < 8; ++e) { const float v = sigmoidf_(g0[e]) * cv[e] + sigmoidf_(g1[e]) * gl[e] + sigmoidf_(g2[e]) * at[e]; if (e < 4) m0[e] = v; else m1[e - 4] = v; }
        *(u32x4*)(MERGED + o) = pack8u(m0, m1);
    }
}

struct Sched3 {
    const char *MERGED, *WO; int G, c;
    __device__ __forceinline__ bool next(int i, Unit& u) const {
        const int L = i * G + c; if (L >= 256) return false;
        u.pm = L >> 3; u.pn = L & 7; u.kind = 0; u.a = MERGED + (size_t)u.pm * 1048576; u.b = WO + (size_t)u.pn * 1048576; return true;
    }
};
struct Sched3b {
    const char *MERGED, *WO; int G, c;
    __device__ __forceinline__ bool next(int i, Unit& u) const {
        const int L = i * G + c; if (L >= 128) return false;
        const int tile = L >> 3, ks = L & 7; u.pm = 32 + (tile >> 3); u.pn = tile & 7; u.kind = ks;
        u.a = MERGED + (size_t)u.pm * 1048576 + (size_t)ks * 512; u.b = WO + (size_t)u.pn * 1048576 + (size_t)ks * 512; return true;
    }
};
struct Epi3 {
    float* out; float* part;
    bool sample;
    __device__ __forceinline__ bool operator()(f32x4 (&acc)[2][2][4][2], const Unit& u, int wr, int wc, int fr, int fq) const {
        const int r0 = u.pm * 256 + wr * 64 + fr, c0 = u.pn * 256 + wc * 32 + 8 * fq;
        float* base = sample ? part + ((size_t)u.kind * 512 - NPROMPT) * DM : out;
#pragma unroll
        for (int ai = 0; ai < 2; ++ai)
#pragma unroll
            for (int m = 0; m < 4; ++m) {
                float* o = base + (size_t)(r0 + ai * 128 + m * 16) * DM + c0;
#pragma unroll
                for (int bj = 0; bj < 2; ++bj)
#pragma unroll
                    for (int n = 0; n < 2; ++n) *(f32x4*)(o + bj * 128 + 4 * n) = acc[ai][bj][m][n];
            }
        return false;
    }
};

__device__ __forceinline__ void transpose_tile(const float* __restrict__ src, const int K, const int N, bf16_t* __restrict__ dst, const int mode, const int t, LAS float* tile) {
    const int tid = otid(); const int tn = N / 256;
    const int r = tid >> 3, c8 = (tid & 7) * 8;
    const int k0 = (t / tn) * 64, n0 = (t % tn) * 256;
    const float* s = src + (size_t)(k0 + r) * N + n0 + c8;
    f32x4 v[8];
#pragma unroll
    for (int j = 0; j < 4; ++j) { v[2 * j] = *(const f32x4*)(s + j * 64); v[2 * j + 1] = *(const f32x4*)(s + j * 64 + 4); }
#pragma unroll
    for (int j = 0; j < 4; ++j)
#pragma unroll
        for (int e = 0; e < 4; ++e) { tile[j * 4160 + r * 65 + c8 + e] = v[2 * j][e]; tile[j * 4160 + r * 65 + c8 + 4 + e] = v[2 * j + 1][e]; }
    __syncthreads();
#pragma unroll
    for (int j = 0; j < 4; ++j) {
        f32x4 a, b;
#pragma unroll
        for (int e = 0; e < 4; ++e) { a[e] = tile[j * 4160 + (c8 + e) * 65 + r]; b[e] = tile[j * 4160 + (c8 + 4 + e) * 65 + r]; }
        const int n = n0 + j * 64 + r;
        const int row = mode == 0 ? n : ((n >> 7) * 256 + (mode - 1) * 128 + (n & 127));
        *(u32x4*)(dst + (size_t)row * K + k0 + c8) = pack8u(a, b);
    }
    __syncthreads();
}
__device__ __forceinline__ void tload_win(const float* w_in, int t, int r, int c8, f32x4 (&v)[8]) {
    const int k0 = (t / 56) * 64, n0 = (t % 56) * 256;
    const float* s = w_in + (size_t)(k0 + r) * NIN + n0 + c8;
#pragma unroll
    for (int j = 0; j < 4; ++j) { v[2 * j] = *(const f32x4*)(s + j * 64); v[2 * j + 1] = *(const f32x4*)(s + j * 64 + 4); }
}
__device__ __forceinline__ void phase0(const P& p, LAS unsigned char* lds) {
    unsigned char* ws = p.ws; LAS float* tile = (LAS float*)lds;
    {
        const int tid = otid(); const int r = tid >> 3, c8 = (tid & 7) * 8;
        bf16_t* dst = (bf16_t*)(ws + WS_WIN);
        int j = blockIdx.x; f32x4 v[8];
        if (j < 1792) tload_win(p.w_in, j, r, c8, v);
        while (j < 1792) {
#pragma unroll
            for (int q = 0; q < 4; ++q)
#pragma unroll
                for (int e = 0; e < 4; ++e) { tile[q * 4160 + r * 65 + c8 + e] = v[2 * q][e]; tile[q * 4160 + r * 65 + c8 + 4 + e] = v[2 * q + 1][e]; }
            const int jn = j + gridDim.x;
            if (jn < 1792) tload_win(p.w_in, jn, r, c8, v);
            __syncthreads();
            const int k0 = (j / 56) * 64, n0 = (j % 56) * 256;
#pragma unroll
            for (int q = 0; q < 4; ++q) {
                f32x4 a, b;
#pragma unroll
                for (int e = 0; e < 4; ++e) { a[e] = tile[q * 4160 + (c8 + e) * 65 + r]; b[e] = tile[q * 4160 + (c8 + 4 + e) * 65 + r]; }
                *(u32x4*)(dst + (size_t)(n0 + q * 64 + r) * 2048 + k0 + c8) = pack8u(a, b);
            }
            __syncthreads();
            j = jn;
        }
    }
    for (int t = blockIdx.x; t < 1024; t += gridDim.x) {
        if (t < 128) transpose_tile(p.w_conv_out, 1024, 2048, (bf16_t*)(ws + WS_WC), 0, t, tile);
        else if (t < 256) transpose_tile(p.w_attn_out, 1024, 2048, (bf16_t*)(ws + WS_WA), 0, t - 128, tile);
        else if (t < 384) transpose_tile(p.w_glu_a, 1024, 2048, (bf16_t*)(ws + WS_WG), 1, t - 256, tile);
        else if (t < 512) transpose_tile(p.w_glu_b, 1024, 2048, (bf16_t*)(ws + WS_WG), 2, t - 384, tile);
        else if (t < 768) transpose_tile(p.w_out, 2048, 2048, (bf16_t*)(ws + WS_WO), 0, t - 512, tile);
        else if (t < 896) transpose_tile(p.w_mem_k, 2048, 1024, (bf16_t*)(ws + WS_WK), 0, t - 768, tile);
        else transpose_tile(p.w_mem_v, 2048, 1024, (bf16_t*)(ws + WS_WV), 0, t - 896, tile);
    }
    const int t0 = otid(); const int lane = t0 & 63, gw = blockIdx.x * 8 + (t0 >> 6), nw = gridDim.x * 8;
    for (int row = gw; row < MTOK + 1024; row += nw) {
        const float* src; const float* g; bf16_t* dst;
        if (row < NPROMPT) { src = p.x_prompt + (size_t)row * DM; g = p.norm_g; dst = (bf16_t*)(ws + WS_H) + (size_t)row * DM; }
        else if (row < MTOK) { src = p.x_sample + (size_t)(row - NPROMPT) * DM; g = p.norm_g; dst = (bf16_t*)(ws + WS_H) + (size_t)row * DM; }
        else { src = p.mem_prompt + (size_t)(row - MTOK) * DM; g = p.mem_norm_g; dst = (bf16_t*)(ws + WS_MEMN) + (size_t)(row - MTOK) * DM; }
        f32x4 v[8]; float s = 0.f;
#pragma unroll
        for (int i = 0; i < 8; ++i) { v[i] = *(const f32x4*)(src + 4 * (lane + 64 * i)); s += (v[i][0] * v[i][0] + v[i][1] * v[i][1]) + (v[i][2] * v[i][2] + v[i][3] * v[i][3]); }
#pragma unroll
        for (int o = 32; o >= 1; o >>= 1) s += __shfl_xor(s, o);
        const float rstd = 1.0f / sqrtf(s * (1.0f / 2048.0f) + 1e-6f);
#pragma unroll
        for (int i = 0; i < 8; ++i) { const f32x4 gv = *(const f32x4*)(g + 4 * (lane + 64 * i));
            u32x2 w; w.x = cvt_pk_bf16(v[i][0] * rstd * gv[0], v[i][1] * rstd * gv[1]); w.y = cvt_pk_bf16(v[i][2] * rstd * gv[2], v[i][3] * rstd * gv[3]);
            *(u32x2*)(dst + 4 * (lane + 64 * i)) = w; }
    }
}

template <int LEN, bool PROMPT>
__device__ __forceinline__ void conv_task(const P& p, const int r0, const int cgp, const int bs) {
    const bf16_t* PROJ = (const bf16_t*)(p.ws + WS_PROJ); bf16_t* ACONV = (bf16_t*)(p.ws + WS_ACONV);
    const int c0 = cgp * 8;
    const bf16_t* pr = PROJ + (size_t)r0 * NIN + c0;
    u32x4 lcb[LEN], lcz[LEN], lcc[LEN + 2], lch[LEN + 2];
    const bool has_halo = PROMPT && (r0 & 2047) != 0;
#pragma unroll
    for (int i = 0; i < LEN; ++i) { lcb[i] = *(const u32x4*)(pr + (size_t)i * NIN + OFF_CB); lcz[i] = *(const u32x4*)(pr + (size_t)i * NIN + OFF_CZ);
        lcc[i + 2] = *(const u32x4*)(pr + (size_t)i * NIN + OFF_CC); lch[i + 2] = *(const u32x4*)(pr + (size_t)i * NIN + OFF_CH); }
#pragma unroll
    for (int i = 0; i < 2; ++i) { lcc[i] = (u32x4){0u, 0u, 0u, 0u}; lch[i] = lcc[i];
        if (has_halo) { lcc[i] = *(const u32x4*)(pr - (size_t)(2 - i) * NIN + OFF_CC); lch[i] = *(const u32x4*)(pr - (size_t)(2 - i) * NIN + OFF_CH); } }
    float w0[8], w1[8], w2[8], vm2[8], vm1[8];
    { const f32x4 a0 = *(const f32x4*)(p.conv_w + c0), a1 = *(const f32x4*)(p.conv_w + c0 + 4), b0 = *(const f32x4*)(p.conv_w + 1024 + c0), b1 = *(const f32x4*)(p.conv_w + 1024 + c0 + 4),
          d0 = *(const f32x4*)(p.conv_w + 2048 + c0), d1 = *(const f32x4*)(p.conv_w + 2048 + c0 + 4);
#pragma unroll
      for (int e = 0; e < 4; ++e) { w0[e] = a0[e]; w0[e + 4] = a1[e]; w1[e] = b0[e]; w1[e + 4] = b1[e]; w2[e] = d0[e]; w2[e + 4] = d1[e]; } }
    if (PROMPT) {
        float a[8], b[8];
        unpack8(lcc[0], a); unpack8(lch[0], b);
#pragma unroll
        for (int e = 0; e < 8; ++e) vm2[e] = a[e] * b[e];
        unpack8(lcc[1], a); unpack8(lch[1], b);
#pragma unroll
        for (int e = 0; e < 8; ++e) vm1[e] = a[e] * b[e];
    } else {
        const float* sc = p.state_conv + (size_t)bs * 2048 + c0;
        const f32x4 a0 = *(const f32x4*)sc, a1 = *(const f32x4*)(sc + 4), b0 = *(const f32x4*)(sc + 1024), b1 = *(const f32x4*)(sc + 1028);
#pragma unroll
        for (int e = 0; e < 4; ++e) { vm2[e] = a0[e]; vm2[e + 4] = a1[e]; vm1[e] = b0[e]; vm1[e + 4] = b1[e]; }
    }
#pragma unroll
    for (int i = 0; i < LEN; ++i) {
        const size_t row = (size_t)(r0 + i);
        float cb[8], cc[8], ch[8], cz[8], v[8];
        unpack8(lcb[i], cb); unpack8(lcc[i + 2], cc); unpack8(lch[i + 2], ch); unpack8(lcz[i], cz);
        f32x4 o0, o1;
#pragma unroll
        for (int e = 0; e < 8; ++e) { v[e] = cc[e] * ch[e]; const float cv = w0[e] * vm2[e] + w1[e] * vm1[e] + w2[e] * v[e]; const float r = cb[e] * cv * siluf_(cz[e]);
            if (e < 4) o0[e] = r; else o1[e - 4] = r; vm2[e] = vm1[e]; vm1[e] = v[e]; }
        *(u32x4*)(ACONV + row * 1024 + c0) = pack8u(o0, o1);
        float* dst = nullptr;
        if (PROMPT) { const int pos = (r0 + i) & 2047; if (pos >= 2046) dst = p.out + O_CP + ((size_t)((r0 + i) >> 11) * 2 + (pos - 2046)) * 1024 + c0; }
        else if (i >= 2) dst = p.out + O_CS + ((size_t)bs * 2 + (i - 2)) * 1024 + c0;
        if (dst) { *(f32x4*)dst = (f32x4){v[0], v[1], v[2], v[3]}; *(f32x4*)(dst + 4) = (f32x4){v[4], v[5], v[6], v[7]}; }
    }
}
__device__ __forceinline__ void conv_phase(const P& p) {
    const int t0 = blockIdx.x * 512 + otid(), nt = gridDim.x * 512;
    for (int task = t0; task < 262144; task += nt) conv_task<4, true>(p, (task >> 7) * 4, task & 127, 0);
    for (int task = t0; task < 16384; task += nt) conv_task<4, false>(p, NPROMPT + 4 * (task >> 7), task & 127, task >> 7);
}

struct S5In { bf16x8 U[4]; u32x2 u4[4], z4[4]; };
__device__ __forceinline__ void s5_load4(S5In& in, const bf16_t* PROJ, const size_t row0, const int g, const int g4) {
    const bf16_t* base = PROJ + row0 * NIN + g * 16;
#pragma unroll
    for (int i = 0; i < 4; ++i) {
        in.U[i] = *(const bf16x8*)(base + (size_t)i * NIN + OFF_SU + 8 * (g4 & 1));
        in.u4[i] = *(const u32x2*)(base + (size_t)i * NIN + OFF_SU + 4 * g4); in.z4[i] = *(const u32x2*)(base + (size_t)i * NIN + OFF_SZ + 4 * g4);
    }
}
__device__ __forceinline__ void s5_steps4(const S5In& in, bf16_t* YS, const size_t row0, const int g, const int g4, const bool Y,
                                          const bf16x8 (&bre)[4], const bf16x8 (&bim)[4], const bf16x8 (&cf)[4], const float (&ar)[16], const float (&ai)[16], const f32x4 dsk,
                                          float (&sr)[16], float (&si)[16]) {
    const f32x4 zero4 = (f32x4){0.f, 0.f, 0.f, 0.f};
#pragma unroll
    for (int i = 0; i < 4; ++i) {
#pragma unroll
        for (int pb = 0; pb < 4; ++pb) {
            const f32x4 xr = MFMA16(bre[pb], in.U[i], zero4), xi = MFMA16(bim[pb], in.U[i], zero4);
#pragma unroll
            for (int j = 0; j < 4; ++j) { const int k = pb * 4 + j; const float nr = ar[k] * sr[k] - ai[k] * si[k] + xr[j]; const float ni = ar[k] * si[k] + ai[k] * sr[k] + xi[j]; sr[k] = nr; si[k] = ni; }
        }
        if (Y) {
            f32x4 y = zero4;
            y = MFMA16(cf[0], pack8((f32x4){sr[0], sr[1], sr[2], sr[3]}, (f32x4){sr[4], sr[5], sr[6], sr[7]}), y);
            y = MFMA16(cf[1], pack8((f32x4){sr[8], sr[9], sr[10], sr[11]}, (f32x4){sr[12], sr[13], sr[14], sr[15]}), y);
            y = MFMA16(cf[2], pack8((f32x4){si[0], si[1], si[2], si[3]}, (f32x4){si[4], si[5], si[6], si[7]}), y);
            y = MFMA16(cf[3], pack8((f32x4){si[8], si[9], si[10], si[11]}, (f32x4){si[12], si[13], si[14], si[15]}), y);
            const float uu[4] = {bf_lo(in.u4[i].x), bf_hi(in.u4[i].x), bf_lo(in.u4[i].y), bf_hi(in.u4[i].y)};
            const float zz[4] = {bf_lo(in.z4[i].x), bf_hi(in.z4[i].x), bf_lo(in.z4[i].y), bf_hi(in.z4[i].y)};
            float o[4];
#pragma unroll
            for (int j = 0; j < 4; ++j) { const float ysv = y[j] + dsk[j] * uu[j]; o[j] = gelu_tanh(ysv * siluf_(zz[j])); }
            u32x2 w; w.x = cvt_pk_bf16(o[0], o[1]); w.y = cvt_pk_bf16(o[2], o[3]);
            *(u32x2*)(YS + (row0 + i) * 1024 + g * 16 + 4 * g4) = w;
        }
    }
}
__device__ __forceinline__ void s5_coef(const P& p, int g, int pp, float dt, float& ar, float& ai, float& fr, float& fi) {
    const float lr = p.lam_re[g * 64 + pp], li = p.lam_im[g * 64 + pp];
    const float mag = expf(lr * dt), ang = li * dt; float sn, cs; sincosf(ang, &sn, &cs);
    ar = mag * cs; ai = mag * sn; const float den = lr * lr + li * li;
    fr = ((ar - 1.0f) * lr + ai * li) / den; fi = (ai * lr - (ar - 1.0f) * li) / den;
}
__device__ __forceinline__ void s5_unit(const P& p, const int unit, LAS unsigned char* lds) {
    const bf16_t* PROJ = (const bf16_t*)(p.ws + WS_PROJ); bf16_t* YS = (bf16_t*)(p.ws + WS_YS);
    const int tid = otid(), lane = tid & 63, w = tid >> 6, cl = lane & 15, g4 = lane >> 4;
    const bool prompt = unit < 256; const int g = prompt ? (unit & 63) : (unit - 256); const int b = unit >> 6;
    const float dt = expf(p.log_dt[g]);
    LAS float* E = (LAS float*)lds;
    LAS f32x4* CT = (LAS f32x4*)(lds + 65536);
    if (tid < 64) { float a_r, a_i, fr_, fi_; s5_coef(p, g, tid, dt, a_r, a_i, fr_, fi_); CT[tid] = (f32x4){a_r, a_i, fr_, fi_}; }
    __syncthreads();
    float ar[16], ai[16];
#pragma unroll
    for (int pb = 0; pb < 4; ++pb)
#pragma unroll
        for (int j = 0; j < 4; ++j) { const f32x4 t = CT[16 * pb + 4 * g4 + j]; ar[pb * 4 + j] = t[0]; ai[pb * 4 + j] = t[1]; }
    bf16x8 bre[4], bim[4], cf[4];
    const float bmask = g4 < 2 ? 1.0f : 0.0f;
#pragma unroll
    for (int pb = 0; pb < 4; ++pb) {
        const int pp = 16 * pb + cl; const f32x4 t = CT[pp]; const float fr_ = t[2] * bmask, fi_ = t[3] * bmask;
        const float* br = p.b_re + ((size_t)(g * 64 + pp)) * 16 + 8 * (g4 & 1); const float* bi = p.b_im + ((size_t)(g * 64 + pp)) * 16 + 8 * (g4 & 1);
        const f32x4 r0 = *(const f32x4*)br, r1 = *(const f32x4*)(br + 4), i0 = *(const f32x4*)bi, i1 = *(const f32x4*)(bi + 4);
        bre[pb] = pack8(fr_ * r0 - fi_ * i0, fr_ * r1 - fi_ * i1);
        bim[pb] = pack8(fr_ * i0 + fi_ * r0, fr_ * i1 + fi_ * r1);
    }
#pragma unroll
    for (int ks = 0; ks < 4; ++ks) {
        const float* cp = (ks < 2 ? p.c_re : p.c_im) + ((size_t)(g * 16 + cl)) * 64 + 32 * (ks & 1) + 4 * g4;
        f32x4 a = *(const f32x4*)cp, c = *(const f32x4*)(cp + 16);
        if (ks >= 2) { a = -a; c = -c; }
        cf[ks] = pack8(a, c);
    }
    const f32x4 dsk = *(const f32x4*)(p.ssm_d + g * 16 + 4 * g4);
    const int chain = 16 * w + cl;
    const size_t row0 = prompt ? (size_t)b * 2048 + (size_t)chain * 16 : (size_t)NPROMPT + 4 * chain;
    const size_t so = ((size_t)chain * 64 + g) * 64 + 4 * g4;
    const int nq = prompt ? 4 : 1;
    float sr[16], si[16];
#pragma unroll
    for (int k = 0; k < 16; ++k) { sr[k] = 0.f; si[k] = 0.f; }
    if (!prompt) {
#pragma unroll
        for (int pb = 0; pb < 4; ++pb) { const f32x4 a = *(const f32x4*)(p.state_re + so + 16 * pb), c = *(const f32x4*)(p.state_im + so + 16 * pb);
#pragma unroll
            for (int j = 0; j < 4; ++j) { sr[pb * 4 + j] = a[j]; si[pb * 4 + j] = c[j]; } }
    }
#pragma unroll 1
    for (int pass = prompt ? 0 : 1; pass < 2; ++pass) {
        if (pass == 1 && prompt) {
#pragma unroll
            for (int pb = 0; pb < 4; ++pb) {
                *(LAS f32x4*)(E + (chain * 2 + 0) * 64 + 16 * pb + 4 * g4) = (f32x4){sr[pb * 4], sr[pb * 4 + 1], sr[pb * 4 + 2], sr[pb * 4 + 3]};
                *(LAS f32x4*)(E + (chain * 2 + 1) * 64 + 16 * pb + 4 * g4) = (f32x4){si[pb * 4], si[pb * 4 + 1], si[pb * 4 + 2], si[pb * 4 + 3]};
            }
            __syncthreads();
            if (w == 0) {
                float a_r, a_i; { const f32x4 t = CT[lane]; a_r = t[0]; a_i = t[1]; }
#pragma unroll
                for (int q = 0; q < 4; ++q) { const float nr = a_r * a_r - a_i * a_i, ni = 2.0f * a_r * a_i; a_r = nr; a_i = ni; }
                float Fr = 0.f, Fi = 0.f;
#pragma unroll 8
                for (int k = 0; k < 128; ++k) {
                    const float er = E[(2 * k) * 64 + lane], ei = E[(2 * k + 1) * 64 + lane];
                    E[(2 * k) * 64 + lane] = Fr; E[(2 * k + 1) * 64 + lane] = Fi;
                    const float nr = a_r * Fr - a_i * Fi + er; Fi = a_r * Fi + a_i * Fr + ei; Fr = nr;
                }
                p.out[O_RP + (size_t)(b * 64 + g) * 64 + lane] = Fr; p.out[O_IP + (size_t)(b * 64 + g) * 64 + lane] = Fi;
            }
            __syncthreads();
#pragma unroll
            for (int pb = 0; pb < 4; ++pb) {
                const f32x4 a = *(LAS f32x4*)(E + (chain * 2 + 0) * 64 + 16 * pb + 4 * g4), c = *(LAS f32x4*)(E + (chain * 2 + 1) * 64 + 16 * pb + 4 * g4);
#pragma unroll
                for (int j = 0; j < 4; ++j) { sr[pb * 4 + j] = a[j]; si[pb * 4 + j] = c[j]; }
            }
        }
        S5In cur; s5_load4(cur, PROJ, row0, g, g4);
#pragma unroll 1
        for (int q = 0; q < nq; ++q) {
            S5In nxt = cur;
            if (q + 1 < nq) s5_load4(nxt, PROJ, row0 + 4 * (q + 1), g, g4);
            s5_steps4(cur, YS, row0 + 4 * q, g, g4, pass == 1, bre, bim, cf, ar, ai, dsk, sr, si);
            cur = nxt;
        }
    }
    if (!prompt) {
#pragma unroll
        for (int pb = 0; pb < 4; ++pb) {
            *(f32x4*)(p.out + O_RS + so + 16 * pb) = (f32x4){sr[pb * 4], sr[pb * 4 + 1], sr[pb * 4 + 2], sr[pb * 4 + 3]};
            *(f32x4*)(p.out + O_IS + so + 16 * pb) = (f32x4){si[pb * 4], si[pb * 4 + 1], si[pb * 4 + 2], si[pb * 4 + 3]};
        }
    }
    __syncthreads();
}

__device__ __forceinline__ void attn_prompt_unit(const P& p, const int unit, LAS unsigned char* lds) {
    const bf16_t* PROJ = (const bf16_t*)(p.ws + WS_PROJ); const bf16_t* KB = (const bf16_t*)(p.ws + WS_KB); const bf16_t* VT = (const bf16_t*)(p.ws + WS_VT);
    bf16_t* OATT = (bf16_t*)(p.ws + WS_OATT);
    const int tid = otid(), lane = tid & 63, w = tid >> 6, cl = lane & 15, g4 = lane >> 4;
    const int b = unit >> 6, h = (unit >> 4) & 3, qb = unit & 15;
    const bf16_t* kbase = KB + (size_t)(b * 256) * 1024 + h * 256;
#pragma unroll
    for (int i = 0; i < 16; ++i) { const int idx = tid + 512 * i, r = idx >> 5, m = idx & 31;
        const u32x4 v = *(const u32x4*)(kbase + (size_t)r * 1024 + m * 8); *(LAS u32x4*)(lds + r * 512 + ((m ^ (r & 15)) << 4)) = v; }
    const size_t qrow = (size_t)b * 2048 + qb * 128 + w * 16 + cl;
    const bf16_t* qp = PROJ + qrow * NIN + OFF_AQ + h * 256 + 8 * g4;
    bf16x8 qf[8];
#pragma unroll
    for (int ks = 0; ks < 8; ++ks) qf[ks] = *(const bf16x8*)(qp + 32 * ks);
    __syncthreads();
    f32x4 s[16];
#pragma unroll
    for (int kb = 0; kb < 16; ++kb) { s[kb] = (f32x4){0.f, 0.f, 0.f, 0.f};
#pragma unroll
        for (int ks = 0; ks < 8; ++ks) { const int key = 16 * kb + cl, m = 4 * ks + g4;
            const bf16x8 kf = *(const LAS bf16x8*)(lds + key * 512 + ((m ^ cl) << 4)); s[kb] = MFMA16(kf, qf[ks], s[kb]); }
        __builtin_amdgcn_sched_barrier(0); }
    __syncthreads();
    const bf16_t* vbase = VT + (size_t)((b * 4 + h) * 256) * 256;
    u32x4 vst[16];
#pragma unroll
    for (int i = 0; i < 16; ++i) { const int idx = tid + 512 * i, r = idx >> 5, m = idx & 31; vst[i] = *(const u32x4*)(vbase + (size_t)r * 256 + m * 8); }
    float mx = -3.0e38f;
#pragma unroll
    for (int kb = 0; kb < 16; ++kb)
#pragma unroll
        for (int j = 0; j < 4; ++j) mx = fmaxf(mx, s[kb][j]);
    mx = fmaxf(mx, __shfl_xor(mx, 16)); mx = fmaxf(mx, __shfl_xor(mx, 32));
    float sum = 0.f;
#pragma unroll
    for (int kb = 0; kb < 16; ++kb)
#pragma unroll
        for (int j = 0; j < 4; ++j) { const float e = __expf((s[kb][j] - mx) * 0.0625f); s[kb][j] = e; sum += e; }
    sum += __shfl_xor(sum, 16); sum += __shfl_xor(sum, 32);
    const float inv = rcp_(sum);
    bf16x8 pf[8];
#pragma unroll
    for (int kk = 0; kk < 8; ++kk) pf[kk] = pack8(s[2 * kk], s[2 * kk + 1]);
#pragma unroll
    for (int i = 0; i < 16; ++i) { const int idx = tid + 512 * i, r = idx >> 5, m = idx & 31; *(LAS u32x4*)(lds + r * 512 + ((m ^ (r & 15)) << 4)) = vst[i]; }
    __syncthreads();
    const bf16_t* azp = PROJ + qrow * NIN + OFF_AZ + h * 256 + 4 * g4;
    bf16_t* op = OATT + qrow * 1024 + h * 256 + 4 * g4;
#pragma unroll
    for (int db = 0; db < 16; ++db) {
        f32x4 o = (f32x4){0.f, 0.f, 0.f, 0.f}; const int d = 16 * db + cl;
#pragma unroll
        for (int kk = 0; kk < 8; ++kk) {
            const int ch0 = 8 * kk + g4, ch1 = ch0 + 4;
            const u32x2 lo = *(const LAS u32x2*)(lds + d * 512 + (((ch0 >> 1) ^ cl) << 4) + (ch0 & 1) * 8);
            const u32x2 hi = *(const LAS u32x2*)(lds + d * 512 + (((ch1 >> 1) ^ cl) << 4) + (ch1 & 1) * 8);
            const u32x4 vv = (u32x4){lo.x, lo.y, hi.x, hi.y};
            o = MFMA16(__builtin_bit_cast(bf16x8, vv), pf[kk], o);
        }
        const u32x2 az = *(const u32x2*)(azp + 16 * db);
        const float z[4] = {bf_lo(az.x), bf_hi(az.x), bf_lo(az.y), bf_hi(az.y)};
        u32x2 wv; wv.x = cvt_pk_bf16(o[0] * inv * siluf_(z[0]), o[1] * inv * siluf_(z[1])); wv.y = cvt_pk_bf16(o[2] * inv * siluf_(z[2]), o[3] * inv * siluf_(z[3]));
        *(u32x2*)(op + 16 * db) = wv;
        __builtin_amdgcn_sched_barrier(0);
    }
    __syncthreads();
}

__device__ __forceinline__ void attn_sample_unit(const P& p, const int unit, LAS unsigned char* lds) {
    const bf16_t* PROJ = (const bf16_t*)(p.ws + WS_PROJ); bf16_t* OATT = (bf16_t*)(p.ws + WS_OATT);
    const int tid = otid(), lane = tid & 63, w = tid >> 6, cl = lane & 15, g4 = lane >> 4;
    const int b = unit >> 2, h = unit & 3;
    LAS float* sc = (LAS float*)lds;
    LAS float* po = (LAS float*)(lds + 4096);
    const float* kbase = p.cache_k + ((size_t)b * 1024 + h) * 256;
    const float* vbase = p.cache_v + ((size_t)b * 1024 + h) * 256;
    const size_t qrow = (size_t)NPROMPT + 4 * b + (cl & 3);
    const bf16_t* qp = PROJ + qrow * NIN + OFF_AQ + h * 256 + 8 * g4;
    bf16x8 qf[8];
#pragma unroll
    for (int ks = 0; ks < 8; ++ks) qf[ks] = *(const bf16x8*)(qp + 32 * ks);
#pragma unroll
    for (int kblk = 0; kblk < 2; ++kblk) {
        const int key = 32 * w + 16 * kblk + cl; const float* kr = kbase + (size_t)key * 1024 + 8 * g4;
        f32x4 ka[8], kc[8];
#pragma unroll
        for (int ks = 0; ks < 8; ++ks) { ka[ks] = *(const f32x4*)(kr + 32 * ks); kc[ks] = *(const f32x4*)(kr + 32 * ks + 4); }
        f32x4 s = (f32x4){0.f, 0.f, 0.f, 0.f};
#pragma unroll
        for (int ks = 0; ks < 8; ++ks) s = MFMA16(pack8(ka[ks], kc[ks]), qf[ks], s);
        if (cl < 4) *(LAS f32x4*)(sc + cl * 256 + 32 * w + 16 * kblk + 4 * g4) = s;
    }
    f32x4 vv[32];
#pragma unroll
    for (int i = 0; i < 32; ++i) vv[i] = *(const f32x4*)(vbase + (size_t)(32 * w + i) * 1024 + 4 * lane);
    __syncthreads();
    if (w == 0) {
#pragma unroll
        for (int q = 0; q < 4; ++q) {
            f32x4 v = *(LAS f32x4*)(sc + q * 256 + 4 * lane);
            float mx = fmaxf(fmaxf(v[0], v[1]), fmaxf(v[2], v[3]));
#pragma unroll
            for (int o = 32; o >= 1; o >>= 1) mx = fmaxf(mx, __shfl_xor(mx, o));
            float sum = 0.f;
#pragma unroll
            for (int e = 0; e < 4; ++e) { v[e] = __expf((v[e] - mx) * 0.0625f); sum += v[e]; }
#pragma unroll
            for (int o = 32; o >= 1; o >>= 1) sum += __shfl_xor(sum, o);
            const float inv = rcp_(sum);
            *(LAS f32x4*)(sc + q * 256 + 4 * lane) = v * inv;
        }
    }
    __syncthreads();
    f32x4 o[4];
#pragma unroll
    for (int q = 0; q < 4; ++q) o[q] = (f32x4){0.f, 0.f, 0.f, 0.f};
#pragma unroll
    for (int ii = 0; ii < 8; ++ii)
#pragma unroll
        for (int q = 0; q < 4; ++q) { const f32x4 pv = *(LAS f32x4*)(sc + q * 256 + 32 * w + 4 * ii);
            o[q] += pv[0] * vv[4 * ii] + pv[1] * vv[4 * ii + 1] + pv[2] * vv[4 * ii + 2] + pv[3] * vv[4 * ii + 3]; }
#pragma unroll
    for (int q = 0; q < 4; ++q) *(LAS f32x4*)(po + (w * 4 + q) * 256 + 4 * lane) = o[q];
    __syncthreads();
    {
        const int q = tid >> 7, d = (tid & 127) * 2; float a0 = 0.f, a1 = 0.f;
#pragma unroll
        for (int ww = 0; ww < 8; ++ww) { a0 += po[(ww * 4 + q) * 256 + d]; a1 += po[(ww * 4 + q) * 256 + d + 1]; }
        const size_t row = (size_t)NPROMPT + 4 * b + q;
        const unsigned az = *(const unsigned*)(PROJ + row * NIN + OFF_AZ + h * 256 + d);
        *(unsigned*)(OATT + row * 1024 + h * 256 + d) = cvt_pk_bf16(a0 * siluf_(bf_lo(az)), a1 * siluf_(bf_hi(az)));
    }
    __syncthreads();
}

__device__ __forceinline__ void phase5(const P& p) {
    const float* part = (const float*)(p.ws + WS_PART);
    const int t0 = otid(); const int lane = t0 & 63, gw = blockIdx.x * 8 + (t0 >> 6), nw = gridDim.x * 8;
    for (int row = gw; row < MTOK; row += nw) {
        float* orow = p.out + (size_t)row * DM;
        f32x4 v[8]; float s = 0.f;
        if (row < NPROMPT) {
            const float* xr = p.x_prompt + (size_t)row * DM;
#pragma unroll
            for (int i = 0; i < 8; ++i) v[i] = *(const f32x4*)(xr + 4 * (lane + 64 * i)) + *(const f32x4*)(orow + 4 * (lane + 64 * i));
        } else {
            const float* xr = p.x_sample + (size_t)(row - NPROMPT) * DM;
#pragma unroll
            for (int i = 0; i < 8; ++i) v[i] = *(const f32x4*)(xr + 4 * (lane + 64 * i));
#pragma unroll 2
            for (int ks = 0; ks < 8; ++ks) { const float* pr = part + ((size_t)ks * 512 + (row - NPROMPT)) * DM;
#pragma unroll
                for (int i = 0; i < 8; ++i) v[i] += *(const f32x4*)(pr + 4 * (lane + 64 * i)); }
        }
#pragma unroll
        for (int i = 0; i < 8; ++i) s += (v[i][0] * v[i][0] + v[i][1] * v[i][1]) + (v[i][2] * v[i][2] + v[i][3] * v[i][3]);
#pragma unroll
        for (int o = 32; o >= 1; o >>= 1) s += __shfl_xor(s, o);
        const float rstd = 1.0f / sqrtf(s * (1.0f / 2048.0f) + 1e-6f);
#pragma unroll
        for (int i = 0; i < 8; ++i) { const f32x4 gv = *(const f32x4*)(p.final_g + 4 * (lane + 64 * i)); *(f32x4*)(orow + 4 * (lane + 64 * i)) = v[i] * rstd * gv; }
    }
}

#define XB_TMO      128
#define XB_XCNT(j)  (256  + 64 * (j))
#define XB_XSUB(j)  (1280 + 64 * (j))
#define XB_XGEN(j)  (2304 + 64 * (j))
#define XB_TOP      3328
#define XB_TOPGEN   3392
#define XB_SPIN_CAP (1u << 20)
__device__ __forceinline__ unsigned xb_ld(unsigned* p)              { return __hip_atomic_load(p, __ATOMIC_RELAXED, __HIP_MEMORY_SCOPE_AGENT); }
__device__ __forceinline__ unsigned xb_add(unsigned* p, unsigned v) { return __hip_atomic_fetch_add(p, v, __ATOMIC_RELAXED, __HIP_MEMORY_SCOPE_AGENT); }
__device__ __forceinline__ unsigned xb_xcc_id() { return (unsigned)__builtin_amdgcn_s_getreg((3 << 11) | 20) & 0xFu; }
#define XB_SPIN(cond, bar) do { unsigned _sp = 0; while (cond) { __builtin_amdgcn_s_sleep(1); \
    if ((++_sp & 255u) == 0u) { if (xb_ld(&(bar)[XB_TMO])) break; if (_sp > XB_SPIN_CAP) { atomicAdd(&(bar)[XB_TMO], 1u); break; } } } } while (0)
struct XcdBarrier { unsigned* bar; unsigned x; volatile LAS unsigned* st; };
__device__ __forceinline__ XcdBarrier xcd_barrier_post(unsigned* bar, volatile LAS unsigned* st) {
    XcdBarrier b; b.bar = bar; b.x = xb_xcc_id(); b.st = st;
    if (threadIdx.x == 0) (void)xb_add(&bar[XB_XCNT(b.x)], 1u);
    return b;
}
__device__ __forceinline__ void xcd_barrier_complete(unsigned* bar, unsigned x, unsigned& nloc, unsigned& nx) {
    const unsigned G = gridDim.x * gridDim.y * gridDim.z;
    unsigned sum, cnt, mine, sp = 0u;
    for (;;) {
        sum = 0u; cnt = 0u; mine = 0u;
#pragma unroll
        for (unsigned j = 0; j < 16; ++j) { const unsigned c = xb_ld(&bar[XB_XCNT(j)]); sum += c; cnt += (c > 0u) ? 1u : 0u; mine = (j == x) ? c : mine; }
        if (sum == G) break;
        __builtin_amdgcn_s_sleep(1);
        if ((++sp & 255u) == 0u) { if (xb_ld(&bar[XB_TMO])) break; if (sp > XB_SPIN_CAP) { atomicAdd(&bar[XB_TMO], 1u); break; } }
    }
    nloc = mine > 0u ? mine : 1u; nx = cnt > 0u ? cnt : 1u;
}
__device__ __forceinline__ void xcd_barrier(const XcdBarrier& b) {
    asm volatile("s_waitcnt vmcnt(0)" ::: "memory");
    __syncthreads();
    if (threadIdx.x == 0) {
        unsigned* bar = b.bar;
        __builtin_amdgcn_s_waitcnt(0);
        unsigned nloc = b.st[0], nx = b.st[1];
        if (nloc == 0u) { xcd_barrier_complete(bar, b.x, nloc, nx); b.st[0] = nloc; b.st[1] = nx; }
        const unsigned old = xb_add(&bar[XB_XSUB(b.x)], 1u);
        const unsigned gen = old / nloc;
        if (old + 1u == (gen + 1u) * nloc) {
            __builtin_amdgcn_fence(__ATOMIC_RELEASE, "agent");
            asm volatile("s_waitcnt vmcnt(0)" ::: "memory");
            const unsigned og = xb_add(&bar[XB_TOP], 1u);
            const unsigned tg = og / nx;
            if (og + 1u == (tg + 1u) * nx) xb_add(&bar[XB_TOPGEN], 1u);
            else XB_SPIN(xb_ld(&bar[XB_TOPGEN]) == tg, bar);
            __builtin_amdgcn_fence(__ATOMIC_ACQUIRE, "agent");
            xb_add(&bar[XB_XGEN(b.x)], 1u);
            asm volatile("s_waitcnt vmcnt(0)" ::: "memory");
        } else {
            XB_SPIN(xb_ld(&bar[XB_XGEN(b.x)]) == gen, bar);
            __builtin_amdgcn_fence(__ATOMIC_ACQUIRE, "agent");
            asm volatile("s_waitcnt vmcnt(0)" ::: "memory");
        }
    }
    __syncthreads();
}

__global__ void __launch_bounds__(512, 2) mega_fwd(P p) {
    extern __shared__ __attribute__((aligned(16))) unsigned char shm[];
    LAS unsigned char* lds = (LAS unsigned char*)shm;
    cg::grid_group grid = cg::this_grid();
    unsigned char* ws = p.ws;
    const int G = gridDim.x, c = blockIdx.x;
    volatile LAS unsigned* bst = (volatile LAS unsigned*)(lds + 131072);
    if (threadIdx.x == 0) { bst[0] = 0u; bst[1] = 0u; }
    __syncthreads();
    const XcdBarrier xbar = xcd_barrier_post((unsigned*)(ws + WS_BAR), bst);
    if (p.out == nullptr) grid.sync();
#define GSYNC() xcd_barrier(xbar)

#ifndef PHMASK
#define PHMASK 0xffff
#endif
#ifndef REPMASK
#define REPMASK 0
#endif
#define NREP(bit) ((REPMASK & (bit)) ? 2 : 1)
#ifndef TPHASE
#define TPHASE -1
#endif
#ifndef TMULT
#define TMULT 4
#endif
    unsigned long long ts[8]; int nts = 0;
#define STAMP() do { if (TPHASE >= 0 && TPHASE < 10) { ts[nts] = wall_clock64(); } ++nts; } while (0)
    STAMP();
    for (int rep = 0; rep < NREP(1); ++rep) if (PHMASK & 1) phase0(p, lds);
    GSYNC(); STAMP();

    for (int rep = 0; rep < NREP(2); ++rep) if (PHMASK & 2) {
        Sched1 S{(const char*)(ws + WS_H), (const char*)(ws + WS_WIN), (const char*)(ws + WS_MEMN), (const char*)(ws + WS_WK), (const char*)(ws + WS_WV), G, c};
        Epi1 E{(bf16_t*)(ws + WS_PROJ), p.out + O_MK, (bf16_t*)(ws + WS_KB), p.out + O_MV, (bf16_t*)(ws + WS_VT)};
        pg8::gemm_phase(lds, 2048, 2048, S, E);
    }
    GSYNC(); STAMP();

    for (int rep = 0; rep < NREP(4); ++rep) {
        unsigned long long m0 = 0, m1 = 0, m2 = 0, m3 = 0, m4 = 0;
        if (TPHASE >= 10) m0 = wall_clock64();
        if ((c & 1) == 0) for (int u = c; u < 512; u += G) attn_sample_unit(p, u, lds);
        if (TPHASE >= 10) m1 = wall_clock64();
        for (int u = c; u < 256; u += G) s5_unit(p, u, lds);
        for (int u = 256 + (G - 1 - c); u < 320; u += G) s5_unit(p, u, lds);
        if (TPHASE >= 10) m2 = wall_clock64();
        for (int u = c; u < 256; u += G) attn_prompt_unit(p, u, lds);
        if (TPHASE >= 10) m3 = wall_clock64();
        conv_phase(p);
        if (TPHASE >= 10) { m4 = wall_clock64(); ts[0] = 0; ts[1] = TPHASE == 10 ? m1 - m0 : (TPHASE == 11 ? m2 - m1 : (TPHASE == 12 ? m3 - m2 : m4 - m3)); }
        if ((c & 1) != 0) for (int u = c; u < 512; u += G) attn_sample_unit(p, u, lds);
    }
    GSYNC(); STAMP();

    for (int rep = 0; rep < NREP(8); ++rep) if (PHMASK & 64) {
        Sched2 S{(const char*)ws, G, c};
        Epi2 E{(bf16_t*)(ws + WS_GLU), (bf16_t*)(ws + WS_CONVO), (bf16_t*)(ws + WS_ATTO)};
        pg8::gemm_phase(lds, 1024, 1024, S, E);
    }
    GSYNC(); STAMP();

    for (int rep = 0; rep < NREP(32); ++rep) merge_phase(p);
    GSYNC(); STAMP();

    for (int rep = 0; rep < NREP(16); ++rep) if (PHMASK & 128) {
        { Sched3 S{(const char*)(ws + WS_MERGED), (const char*)(ws + WS_WO), G, c}; Epi3 E{p.out + O_Y, (float*)(ws + WS_PART), false}; pg8::gemm_phase(lds, 2048, 2048, S, E); }
        { Sched3b S{(const char*)(ws + WS_MERGED), (const char*)(ws + WS_WO), G, c}; Epi3 E{p.out + O_Y, (float*)(ws + WS_PART), true}; pg8::gemm_phase(lds, 256, 2048, S, E); }
    }
    GSYNC(); STAMP();

    if (PHMASK & 256) phase5(p);
    STAMP();
    if (TPHASE >= 0 && blockIdx.x == 0 && threadIdx.x == 0) {
        const unsigned long long d = (TPHASE >= 10 ? ts[1] - ts[0] : ts[TPHASE + 1] - ts[TPHASE]) * TMULT, t0 = wall_clock64();
        while (wall_clock64() - t0 < d) __builtin_amdgcn_s_sleep(16);
    }
}

extern "C" void kernel_launch(void* const* d_in, const int* in_sizes, int n_in, void* d_out, int out_size, void* d_ws, size_t ws_size, hipStream_t stream) {
    static int grid = 0;
    if (grid == 0) {
        int dev = 0, cus = 0, per_cu = 0;
        hipGetDevice(&dev);
        hipDeviceGetAttribute(&cus, hipDeviceAttributeMultiprocessorCount, dev);
        if (hipFuncSetAttribute((const void*)mega_fwd, hipFuncAttributeMaxDynamicSharedMemorySize, LDS_BYTES) != hipSuccess) fprintf(stderr, "kernel_launch: hipFuncSetAttribute failed\n");
        if (hipOccupancyMaxActiveBlocksPerMultiprocessor(&per_cu, (const void*)mega_fwd, 512, LDS_BYTES) != hipSuccess || per_cu < 1) per_cu = 1;
        (void)hipGetLastError();
        grid = cus * per_cu;
        if (ws_size < WS_END) fprintf(stderr, "kernel_launch: workspace too small (%zu < %zu)\n", ws_size, (size_t)WS_END);
    }
    P p{};
    const float** pp = (const float**)&p;
    for (int i = 0; i < 28; ++i) pp[i] = (const float*)d_in[i];
    p.out = (float*)d_out; p.ws = (unsigned char*)d_ws;
    void* args[] = {&p};
    (void)hipMemsetAsync((unsigned char*)d_ws + WS_BAR, 0, 16384, stream);
    hipError_t e = hipLaunchCooperativeKernel((const void*)mega_fwd, dim3(grid), dim3(512), args, LDS_BYTES, stream);
    if (e != hipSuccess) fprintf(stderr, "cooperative launch failed: %s (grid %d)\n", hipGetErrorString(e), grid);
}
```

```cpp
#include <hip/hip_runtime.h>
#include <hip/hip_cooperative_groups.h>
#include <cstdio>
namespace cg = cooperative_groups;

#define LAS __attribute__((address_space(3)))
typedef unsigned short bf16_t;
typedef short bf16x8 __attribute__((ext_vector_type(8)));
typedef float f32x4 __attribute__((ext_vector_type(4)));
typedef unsigned u32x4 __attribute__((ext_vector_type(4)));
typedef unsigned u32x2 __attribute__((ext_vector_type(2)));

constexpr int DM = 2048, NPROMPT = 8192, NSAMPLE = 512, MTOK = 8704, NIN = 14336;
constexpr int OFF_CB = 0, OFF_CC = 1024, OFF_CH = 2048, OFF_CZ = 3072, OFF_SU = 4096, OFF_SZ = 5120, OFF_AQ = 6144, OFF_AZ = 7168, OFF_G = 8192;
constexpr int LDS_BYTES = 131072 + 16;
constexpr size_t O_Y = 0, O_MK = 17825792, O_MV = 18874368, O_CP = 19922944, O_RP = 19931136, O_IP = 19947520, O_CS = 19963904, O_RS = 20226048, O_IS = 20750336;
constexpr size_t WS_WIN = 0;
constexpr size_t WS_WG = WS_WIN + (size_t)NIN * DM * 2;
constexpr size_t WS_WC = WS_WG + 8388608;
constexpr size_t WS_WA = WS_WC + 4194304;
constexpr size_t WS_WO = WS_WA + 4194304;
constexpr size_t WS_WK = WS_WO + 8388608;
constexpr size_t WS_WV = WS_WK + 4194304;
constexpr size_t WS_H = WS_WV + 4194304;
constexpr size_t WS_MEMN = WS_H + (size_t)MTOK * DM * 2;
constexpr size_t WS_PROJ = WS_MEMN + 4194304;
constexpr size_t WS_KB = WS_PROJ + (size_t)MTOK * NIN * 2;
constexpr size_t WS_VT = WS_KB + 2097152;
constexpr size_t WS_YS = WS_VT + 2097152;
constexpr size_t WS_ACONV = WS_YS + (size_t)MTOK * 1024 * 2;
constexpr size_t WS_OATT = WS_ACONV + (size_t)MTOK * 1024 * 2;
constexpr size_t WS_SS = WS_OATT + (size_t)MTOK * 1024 * 2;
constexpr size_t WS_GLU = WS_SS + (size_t)MTOK * 32 * 4;
constexpr size_t WS_MERGED = WS_GLU + (size_t)MTOK * DM * 2;
constexpr size_t WS_BAR = WS_MERGED + (size_t)MTOK * DM * 2;
constexpr size_t WS_END = WS_BAR + 16384;
constexpr size_t WS_CONVO = WS_H, WS_ATTO = WS_WIN, WS_PART = WS_PROJ;
static_assert(WS_END <= 536870912, "workspace");

struct P {
    const float *x_prompt, *x_sample, *mem_prompt, *cache_k, *cache_v, *state_conv, *state_re, *state_im, *norm_g, *mem_norm_g, *w_in, *conv_w, *w_conv_out,
        *lam_re, *lam_im, *log_dt, *b_re, *b_im, *c_re, *c_im, *ssm_d, *w_glu_a, *w_glu_b, *w_mem_k, *w_mem_v, *w_attn_out, *w_out, *final_g;
    float* out; unsigned char* ws;
};

__device__ __forceinline__ unsigned cvt_pk_bf16(float lo, float hi) { unsigned r; asm("v_cvt_pk_bf16_f32 %0, %1, %2" : "=v"(r) : "v"(lo), "v"(hi)); return r; }
__device__ __forceinline__ float bf_lo(unsigned w) { return __uint_as_float(w << 16); }
__device__ __forceinline__ float bf_hi(unsigned w) { return __uint_as_float(w & 0xffff0000u); }
__device__ __forceinline__ float rcp_(float x) { return __builtin_amdgcn_rcpf(x); }
__device__ __forceinline__ float sigmoidf_(float x) { return rcp_(1.0f + __expf(-x)); }
__device__ __forceinline__ float siluf_(float x) { return x * rcp_(1.0f + __expf(-x)); }
__device__ __forceinline__ float gelu_tanh(float x) { const float u = 1.5957691216057308f * (x + 0.044715f * x * x * x); return x * rcp_(1.0f + __expf(-u)); }
__device__ __forceinline__ bf16x8 pack8(const f32x4 a, const f32x4 b) {
    u32x4 w; w.x = cvt_pk_bf16(a[0], a[1]); w.y = cvt_pk_bf16(a[2], a[3]); w.z = cvt_pk_bf16(b[0], b[1]); w.w = cvt_pk_bf16(b[2], b[3]);
    return __builtin_bit_cast(bf16x8, w);
}
__device__ __forceinline__ u32x4 pack8u(const f32x4 a, const f32x4 b) {
    u32x4 w; w.x = cvt_pk_bf16(a[0], a[1]); w.y = cvt_pk_bf16(a[2], a[3]); w.z = cvt_pk_bf16(b[0], b[1]); w.w = cvt_pk_bf16(b[2], b[3]); return w;
}
__device__ __forceinline__ void unpack8(const u32x4 w, float (&f)[8]) {
    f[0] = bf_lo(w.x); f[1] = bf_hi(w.x); f[2] = bf_lo(w.y); f[3] = bf_hi(w.y); f[4] = bf_lo(w.z); f[5] = bf_hi(w.z); f[6] = bf_lo(w.w); f[7] = bf_hi(w.w);
}
__device__ __forceinline__ int otid() { int t = threadIdx.x; asm volatile("" : "+v"(t)); return t; }
#define MFMA16(a, b, c) __builtin_amdgcn_mfma_f32_16x16x32_bf16((a), (b), (c), 0, 0, 0)

namespace pg8 {
constexpr int BM = 256, BK = 64, HALF = 128, HTB = HALF * BK * 2, STAGE_BYTES = 8 * HTB;
__device__ __forceinline__ int lds_byte(int r, int c) { const int st = (r >> 4) * 2 + (c >> 5), rr = r & 15, cc = c & 31, ob = rr * 64 + cc * 2; return st * 1024 + (ob ^ (((ob >> 9) & 1) << 5)); }
__device__ __forceinline__ void stage_rc(int b, int& R, int& C) { const int st = b / 1024, sb = b % 1024, swz = sb ^ (((sb >> 9) & 1) << 5); R = (st >> 1) * 16 + swz / 64; C = (st & 1) * 32 + (swz % 64) / 2; }
__device__ __forceinline__ int perm32(int rho) { const int n = rho >> 4, i = rho & 15; return 8 * (i >> 2) + 4 * n + (i & 3); }
struct Unit { const char* a; const char* b; int pm, pn, kind; };

template <class Sched, class Epi>
__device__ __forceinline__ void gemm_phase(LAS unsigned char* lds, const int K, const int ld, const Sched& S, const Epi& E) {
    const int tid = otid(), wid = __builtin_amdgcn_readfirstlane(tid >> 6), lane = tid & 63, wr = wid >> 2, wc = wid & 3, fr = lane & 15, fq = lane >> 4;
    const int nt = K / BK;
    unsigned voffA[2], voffB[2];
#pragma unroll
    for (int i = 0; i < 2; ++i) { int R, C; stage_rc(tid * 16 + i * 8192, R, C); const int Rb = (R & ~31) + perm32(R & 31);
        voffA[i] = (unsigned)(R * ld + C) * 2u; voffB[i] = (unsigned)(Rb * ld + C) * 2u; }
    const size_t kstep = (size_t)(BK * 2);
    const size_t hstep = (size_t)HALF * ld * 2;
    const unsigned ldsw = (unsigned)wid * 1024u;
    const int aoff = lds_byte(wr * 64 + fr, fq * 8), boff = lds_byte(wc * 32 + fr, fq * 8);
#define PG8_SA(b, h) (((b) * 2 + (h)) * HTB)
#define PG8_SB(b, h) ((4 + (b) * 2 + (h)) * HTB)
#define PG8_STAGE(bufoff, gbase, voff) do { _Pragma("unroll") for (int _i = 0; _i < 2; ++_i) \
        __builtin_amdgcn_global_load_lds((const unsigned*)((const char*)(gbase) + (voff)[_i]), (LAS unsigned*)(lds + (bufoff) + ldsw + _i * 8192), 16, 0, 0); } while (0)
#define PG8_LDA(dst, b, h) do { _Pragma("unroll") for (int m = 0; m < 4; ++m) _Pragma("unroll") for (int k = 0; k < 2; ++k) dst[m][k] = *(const LAS bf16x8*)(lds + PG8_SA(b, h) + aoff + m * 2048 + k * 1024); } while (0)
#define PG8_LDB(dst, b, h) do { _Pragma("unroll") for (int n = 0; n < 2; ++n) _Pragma("unroll") for (int k = 0; k < 2; ++k) dst[n][k] = *(const LAS bf16x8*)(lds + PG8_SB(b, h) + boff + n * 2048 + k * 1024); } while (0)
#define PG8_MMA(ai, bj, At, Bt) do { __builtin_amdgcn_s_setprio(1); _Pragma("unroll") for (int m = 0; m < 4; ++m) _Pragma("unroll") for (int n = 0; n < 2; ++n) _Pragma("unroll") for (int k = 0; k < 2; ++k) \
        acc[ai][bj][m][n] = __builtin_amdgcn_mfma_f32_16x16x32_bf16(Bt[n][k], At[m][k], acc[ai][bj][m][n], 0, 0, 0); __builtin_amdgcn_s_setprio(0); } while (0)
#define PG8_WAIT_V(n) asm volatile("s_waitcnt vmcnt(" #n ")" ::: "memory")
#define PG8_WAIT_L(n) asm volatile("s_waitcnt lgkmcnt(" #n ")" ::: "memory")
#define PG8_BAR __builtin_amdgcn_s_barrier()
#define PG8_SCHED __builtin_amdgcn_sched_barrier(0)
    Unit cur, nxt; int ui = 0;
    if (!S.next(0, cur)) return;
    f32x4 acc[2][2][4][2];
#pragma unroll
    for (int a = 0; a < 2; ++a)
#pragma unroll
        for (int b = 0; b < 2; ++b)
#pragma unroll
            for (int m = 0; m < 4; ++m)
#pragma unroll
                for (int n = 0; n < 2; ++n) acc[a][b][m][n] = (f32x4){0.f, 0.f, 0.f, 0.f};
    bf16x8 At[4][2], B0[2][2], B1[2][2];
    const char* cA = cur.a; const char* cB = cur.b;
    PG8_STAGE(PG8_SB(0, 0), cB, voffB); PG8_STAGE(PG8_SA(0, 0), cA, voffA); PG8_STAGE(PG8_SB(0, 1), cB + hstep, voffB); PG8_STAGE(PG8_SA(0, 1), cA + hstep, voffA);
    if (wr == 1) PG8_BAR;
    PG8_WAIT_V(4); PG8_BAR;
    PG8_STAGE(PG8_SB(1, 0), cB + kstep, voffB); PG8_STAGE(PG8_SA(1, 0), cA + kstep, voffA); PG8_STAGE(PG8_SB(1, 1), cB + hstep + kstep, voffB);
    PG8_WAIT_V(6); PG8_BAR;
    for (;;) {
        const bool has_next = S.next(ui + 1, nxt);
        const char* nA = has_next ? nxt.a : cA; const char* nB = has_next ? nxt.b : cB;
        for (int t = 0; t < nt; t += 2) {
            const bool last = (t == nt - 2);
            const char* a1 = cA + (size_t)(t + 1) * kstep;
            const char* a2 = last ? nA : cA + (size_t)(t + 2) * kstep; const char* b2 = last ? nB : cB + (size_t)(t + 2) * kstep;
            const char* a3 = a2 + kstep; const char* b3 = b2 + kstep;
            PG8_LDB(B0, 0, 0); PG8_SCHED; PG8_LDA(At, 0, 0); PG8_STAGE(PG8_SA(1, 1), a1 + hstep, voffA);
            PG8_WAIT_L(8); PG8_BAR; PG8_WAIT_L(0); PG8_MMA(0, 0, At, B0); PG8_BAR; PG8_SCHED;
            PG8_LDB(B1, 0, 1); PG8_STAGE(PG8_SB(0, 0), b2, voffB);
            PG8_BAR; PG8_WAIT_L(0); PG8_MMA(0, 1, At, B1); PG8_BAR;
            PG8_LDA(At, 0, 1); PG8_STAGE(PG8_SA(0, 0), a2, voffA);
            PG8_BAR; PG8_WAIT_L(0); PG8_MMA(1, 0, At, B0); PG8_BAR; PG8_SCHED;
            PG8_STAGE(PG8_SB(0, 1), b2 + hstep, voffB);
            PG8_WAIT_V(6); PG8_BAR; PG8_MMA(1, 1, At, B1); PG8_BAR;
            PG8_LDB(B0, 1, 0); PG8_SCHED; PG8_LDA(At, 1, 0); PG8_STAGE(PG8_SA(0, 1), a2 + hstep, voffA);
            PG8_WAIT_L(8); PG8_BAR; PG8_WAIT_L(0); PG8_MMA(0, 0, At, B0); PG8_BAR; PG8_SCHED;
            PG8_LDB(B1, 1, 1); PG8_STAGE(PG8_SB(1, 0), b3, voffB);
            PG8_BAR; PG8_WAIT_L(0); PG8_MMA(0, 1, At, B1); PG8_BAR;
            PG8_LDA(At, 1, 1); PG8_STAGE(PG8_SA(1, 0), a3, voffA);
            PG8_BAR; PG8_WAIT_L(0); PG8_MMA(1, 0, At, B0); PG8_BAR; PG8_SCHED;
            PG8_STAGE(PG8_SB(1, 1), b3 + hstep, voffB);
            PG8_WAIT_V(6); PG8_BAR; PG8_MMA(1, 1, At, B1); PG8_BAR;
        }
        const bool keep = E(acc, cur, wr, wc, fr, fq);
        if (!has_next) break;
        if (!keep) {
#pragma unroll
            for (int a = 0; a < 2; ++a)
#pragma unroll
                for (int b = 0; b < 2; ++b)
#pragma unroll
                    for (int m = 0; m < 4; ++m)
#pragma unroll
                        for (int n = 0; n < 2; ++n) acc[a][b][m][n] = (f32x4){0.f, 0.f, 0.f, 0.f};
        }
        cur = nxt; cA = nA; cB = nB; ++ui;
    }
    PG8_WAIT_V(0);
    if (wr == 0) PG8_BAR;
    PG8_BAR;
#undef PG8_SA
#undef PG8_SB
#undef PG8_STAGE
#undef PG8_LDA
#undef PG8_LDB
#undef PG8_MMA
#undef PG8_WAIT_V
#undef PG8_WAIT_L
#undef PG8_BAR
#undef PG8_SCHED
}
}
using pg8::Unit;

struct Sched1 {
    const char *H, *WIN, *MEMN, *WK, *WV; int G, c;
    __device__ __forceinline__ bool next(int i, Unit& u) const {
        const int L = i * G + c; if (L >= 1936) return false;
        if (L < 1904) {
            const int nM = 34, nN = 56, nwg = 1904, NX = 8, WGM = 8;
            int wgid = L; { const int q = nwg / NX, r = nwg % NX, xcd = wgid % NX, off = wgid / NX; wgid = (xcd < r ? xcd * (q + 1) : r * (q + 1) + (xcd - r) * q) + off; }
            const int nig = WGM * nN, gid = wgid / nig, fm = gid * WGM, gsz = (nM - fm) < WGM ? (nM - fm) : WGM;
            u.pm = fm + ((wgid % nig) % gsz); u.pn = (wgid % nig) / gsz; u.kind = 0;
            u.a = H + (size_t)u.pm * 1048576; u.b = WIN + (size_t)u.pn * 1048576;
        } else if (L < 1920) { const int j = L - 1904; u.pm = j >> 2; u.pn = j & 3; u.kind = 1; u.a = MEMN + (size_t)u.pm * 1048576; u.b = WK + (size_t)u.pn * 1048576; }
        else { const int j = L - 1920; u.pm = j >> 2; u.pn = j & 3; u.kind = 2; u.a = WV + (size_t)u.pm * 1048576; u.b = MEMN + (size_t)u.pn * 1048576; }
        return true;
    }
};
struct Epi1 {
    bf16_t* PROJ; float* outK; bf16_t* KB; float* outV; bf16_t* VT;
    __device__ __forceinline__ bool operator()(f32x4 (&acc)[2][2][4][2], const Unit& u, int wr, int wc, int fr, int fq) const {
        const int r0 = u.pm * 256 + wr * 64 + fr, c0 = u.pn * 256 + wc * 32 + 8 * fq;
        if (u.kind == 0) {
#pragma unroll
            for (int ai = 0; ai < 2; ++ai)
#pragma unroll
                for (int m = 0; m < 4; ++m) { bf16_t* rowp = PROJ + (size_t)(r0 + ai * 128 + m * 16) * NIN + c0;
#pragma unroll
                    for (int bj = 0; bj < 2; ++bj) *(u32x4*)(rowp + bj * 128) = pack8u(acc[ai][bj][m][0], acc[ai][bj][m][1]); }
        } else if (u.kind == 1) {
#pragma unroll
            for (int ai = 0; ai < 2; ++ai)
#pragma unroll
                for (int m = 0; m < 4; ++m) { const size_t off = (size_t)(r0 + ai * 128 + m * 16) * 1024 + c0;
#pragma unroll
                    for (int bj = 0; bj < 2; ++bj) { *(f32x4*)(outK + off + bj * 128) = acc[ai][bj][m][0]; *(f32x4*)(outK + off + bj * 128 + 4) = acc[ai][bj][m][1];
                        *(u32x4*)(KB + off + bj * 128) = pack8u(acc[ai][bj][m][0], acc[ai][bj][m][1]); } }
        } else {
            const int h = u.pm, b = u.pn;
#pragma unroll
            for (int ai = 0; ai < 2; ++ai)
#pragma unroll
                for (int m = 0; m < 4; ++m) { const int d = wr * 64 + fr + ai * 128 + m * 16;
#pragma unroll
                    for (int bj = 0; bj < 2; ++bj) { const int key0 = wc * 32 + 8 * fq + bj * 128;
                        *(u32x4*)(VT + ((size_t)((b * 4 + h) * 256 + d)) * 256 + key0) = pack8u(acc[ai][bj][m][0], acc[ai][bj][m][1]);
                        float* fp = outV + ((size_t)(b * 256 + key0)) * 1024 + h * 256 + d;
#pragma unroll
                        for (int e = 0; e < 4; ++e) { fp[(size_t)e * 1024] = acc[ai][bj][m][0][e]; fp[(size_t)(e + 4) * 1024] = acc[ai][bj][m][1][e]; } } }
        }
        return false;
    }
};

struct Sched2 {
    const char* ws; int G, c;
    __device__ __forceinline__ bool next(int i, Unit& u) const {
        const int L = i * G + c; if (L >= 1088) return false;
        if (L < 544) { u.pm = L >> 4; u.pn = L & 15; u.kind = 0; u.a = ws + WS_YS + (size_t)u.pm * 524288; u.b = ws + WS_WG + (size_t)u.pn * 524288; }
        else { const int j = L - 544, k = j >= 272 ? 1 : 0, jj = j - 272 * k; u.pm = jj >> 3; u.pn = jj & 7; u.kind = 1 + k;
            u.a = ws + WS_ACONV + (size_t)k * ((size_t)MTOK * 1024 * 2) + (size_t)u.pm * 524288; u.b = ws + WS_WC + (size_t)k * 4194304 + (size_t)u.pn * 524288; }
        return true;
    }
};
struct Epi2 {
    bf16_t* GLU; bf16_t* CONVO; bf16_t* ATTO;
    __device__ __forceinline__ bool operator()(f32x4 (&acc)[2][2][4][2], const Unit& u, int wr, int wc, int fr, int fq) const {
        const int r0 = u.pm * 256 + wr * 64 + fr;
        if (u.kind == 0) {
            const int c0 = u.pn * 128 + wc * 32 + 8 * fq;
#pragma unroll
            for (int ai = 0; ai < 2; ++ai)
#pragma unroll
                for (int m = 0; m < 4; ++m) {
                    f32x4 t0, t1;
#pragma unroll
                    for (int e = 0; e < 4; ++e) { t0[e] = acc[ai][0][m][0][e] * sigmoidf_(acc[ai][1][m][0][e]); t1[e] = acc[ai][0][m][1][e] * sigmoidf_(acc[ai][1][m][1][e]); }
                    *(u32x4*)(GLU + (size_t)(r0 + ai * 128 + m * 16) * 2048 + c0) = pack8u(t0, t1);
                }
        } else {
            bf16_t* O = u.kind == 1 ? CONVO : ATTO; const int c0 = u.pn * 256 + wc * 32 + 8 * fq;
#pragma unroll
            for (int ai = 0; ai < 2; ++ai)
#pragma unroll
                for (int m = 0; m < 4; ++m) { bf16_t* rowp = O + (size_t)(r0 + ai * 128 + m * 16) * 2048 + c0;
#pragma unroll
                    for (int bj = 0; bj < 2; ++bj) *(u32x4*)(rowp + bj * 128) = pack8u(acc[ai][bj][m][0], acc[ai][bj][m][1]); }
        }
        return false;
    }
};
__device__ __forceinline__ void merge_phase(const P& p) {
    const bf16_t* PROJ = (const bf16_t*)(p.ws + WS_PROJ); const bf16_t* GLU = (const bf16_t*)(p.ws + WS_GLU); const bf16_t* CONVO = (const bf16_t*)(p.ws + WS_CONVO);
    const bf16_t* ATTO = (const bf16_t*)(p.ws + WS_ATTO); bf16_t* MERGED = (bf16_t*)(p.ws + WS_MERGED);
    const int NT = MTOK * 256;
    for (int t = blockIdx.x * 512 + otid(); t < NT; t += gridDim.x * 512) {
        const size_t row = (size_t)(t >> 8); const int c0 = (t & 255) * 8;
        const bf16_t* pr = PROJ + row * NIN + OFF_G + c0; const size_t o = row * 2048 + c0;
        float g0[8], g1[8], g2[8], cv[8], gl[8], at[8];
        unpack8(*(const u32x4*)pr, g0); unpack8(*(const u32x4*)(pr + 2048), g1); unpack8(*(const u32x4*)(pr + 4096), g2);
        unpack8(*(const u32x4*)(CONVO + o), cv); unpack8(*(const u32x4*)(GLU + o), gl); unpack8(*(const u32x4*)(ATTO + o), at);
        f32x4 m0, m1;
#pragma unroll
        for (int e = 0; e < 8; ++e) { const float v = sigmoidf_(g0[e]) * cv[e] + sigmoidf_(g1[e]) * gl[e] + sigmoidf_(g2[e]) * at[e]; if (e < 4) m0[e] = v; else m1[e - 4] = v; }
        *(u32x4*)(MERGED + o) = pack8u(m0, m1);
    }
}

struct Sched3 {
    const char *MERGED, *WO; int G, c;
    __device__ __forceinline__ bool next(int i, Unit& u) const {
        const int L = i * G + c; if (L >= 256) return false;
        u.pm = L >> 3; u.pn = L & 7; u.kind = 0; u.a = MERGED + (size_t)u.pm * 1048576; u.b = WO + (size_t)u.pn * 1048576; return true;
    }
};
struct Sched3b {
    const char *MERGED, *WO; int G, c;
    __device__ __forceinline__ bool next(int i, Unit& u) const {
        const int L = i * G + c; if (L >= 128) return false;
        const int tile = L >> 3, ks = L & 7; u.pm = 32 + (tile >> 3); u.pn = tile & 7; u.kind = ks;
        u.a = MERGED + (size_t)u.pm * 1048576 + (size_t)ks * 512; u.b = WO + (size_t)u.pn * 1048576 + (size_t)ks * 512; return true;
    }
};
struct Epi3 {
    float* out; float* part;
    bool sample;
    __device__ __forceinline__ bool operator()(f32x4 (&acc)[2][2][4][2], const Unit& u, int wr, int wc, int fr, int fq) const {
        const int r0 = u.pm * 256 + wr * 64 + fr, c0 = u.pn * 256 + wc * 32 + 8 * fq;
        float* base = sample ? part + ((size_t)u.kind * 512 - NPROMPT) * DM : out;
#pragma unroll
        for (int ai = 0; ai < 2; ++ai)
#pragma unroll
            for (int m = 0; m < 4; ++m) {
                float* o = base + (size_t)(r0 + ai * 128 + m * 16) * DM + c0;
#pragma unroll
                for (int bj = 0; bj < 2; ++bj)
#pragma unroll
                    for (int n = 0; n < 2; ++n) *(f32x4*)(o + bj * 128 + 4 * n) = acc[ai][bj][m][n];
            }
        return false;
    }
};

__device__ __forceinline__ void transpose_tile(const float* __restrict__ src, const int K, const int N, bf16_t* __restrict__ dst, const int mode, const int t, LAS float* tile) {
    const int tid = otid(); const int tn = N / 256;
    const int r = tid >> 3, c8 = (tid & 7) * 8;
    const int k0 = (t / tn) * 64, n0 = (t % tn) * 256;
    const float* s = src + (size_t)(k0 + r) * N + n0 + c8;
    f32x4 v[8];
#pragma unroll
    for (int j = 0; j < 4; ++j) { v[2 * j] = *(const f32x4*)(s + j * 64); v[2 * j + 1] = *(const f32x4*)(s + j * 64 + 4); }
#pragma unroll
    for (int j = 0; j < 4; ++j)
#pragma unroll
        for (int e = 0; e < 4; ++e) { tile[j * 4160 + r * 65 + c8 + e] = v[2 * j][e]; tile[j * 4160 + r * 65 + c8 + 4 + e] = v[2 * j + 1][e]; }
    __syncthreads();
#pragma unroll
    for (int j = 0; j < 4; ++j) {
        f32x4 a, b;
#pragma unroll
        for (int e = 0; e < 4; ++e) { a[e] = tile[j * 4160 + (c8 + e) * 65 + r]; b[e] = tile[j * 4160 + (c8 + 4 + e) * 65 + r]; }
        const int n = n0 + j * 64 + r;
        const int row = mode == 0 ? n : ((n >> 7) * 256 + (mode - 1) * 128 + (n & 127));
        *(u32x4*)(dst + (size_t)row * K + k0 + c8) = pack8u(a, b);
    }
    __syncthreads();
}
__device__ __forceinline__ void tload_win(const float* w_in, int t, int r, int c8, f32x4 (&v)[8]) {
    const int k0 = (t / 56) * 64, n0 = (t % 56) * 256;
    const float* s = w_in + (size_t)(k0 + r) * NIN + n0 + c8;
#pragma unroll
    for (int j = 0; j < 4; ++j) { v[2 * j] = *(const f32x4*)(s + j * 64); v[2 * j + 1] = *(const f32x4*)(s + j * 64 + 4); }
}
__device__ __forceinline__ void phase0(const P& p, LAS unsigned char* lds) {
    unsigned char* ws = p.ws; LAS float* tile = (LAS float*)lds;
    {
        const int tid = otid(); const int r = tid >> 3, c8 = (tid & 7) * 8;
        bf16_t* dst = (bf16_t*)(ws + WS_WIN);
        int j = blockIdx.x; f32x4 v[8];
        if (j < 1792) tload_win(p.w_in, j, r, c8, v);
        while (j < 1792) {
#pragma unroll
            for (int q = 0; q < 4; ++q)
#pragma unroll
                for (int e = 0; e < 4; ++e) { tile[q * 4160 + r * 65 + c8 + e] = v[2 * q][e]; tile[q * 4160 + r * 65 + c8 + 4 + e] = v[2 * q + 1][e]; }
            const int jn = j + gridDim.x;
            if (jn < 1792) tload_win(p.w_in, jn, r, c8, v);
            __syncthreads();
            const int k0 = (j / 56) * 64, n0 = (j % 56) * 256;
#pragma unroll
            for (int q = 0; q < 4; ++q) {
                f32x4 a, b;
#pragma unroll
                for (int e = 0; e < 4; ++e) { a[e] = tile[q * 4160 + (c8 + e) * 65 + r]; b[e] = tile[q * 4160 + (c8 + 4 + e) * 65 + r]; }
                *(u32x4*)(dst + (size_t)(n0 + q * 64 + r) * 2048 + k0 + c8) = pack8u(a, b);
            }
            __syncthreads();
            j = jn;
        }
    }
    for (int t = blockIdx.x; t < 256; t += gridDim.x) {
        if (t < 128) transpose_tile(p.w_mem_k, 2048, 1024, (bf16_t*)(ws + WS_WK), 0, t, tile);
        else transpose_tile(p.w_mem_v, 2048, 1024, (bf16_t*)(ws + WS_WV), 0, t - 128, tile);
    }
    const int t0 = otid(); const int lane = t0 & 63, gw = blockIdx.x * 8 + (t0 >> 6), nw = gridDim.x * 8;
    auto rowsrc = [&](int row) -> const float* { return row < NPROMPT ? p.x_prompt + (size_t)row * DM : (row < MTOK ? p.x_sample + (size_t)(row - NPROMPT) * DM : p.mem_prompt + (size_t)(row - MTOK) * DM); };
    f32x4 v[8], vn[8];
    if (gw < MTOK + 1024) { const float* src = rowsrc(gw);
#pragma unroll
        for (int i = 0; i < 8; ++i) v[i] = *(const f32x4*)(src + 4 * (lane + 64 * i)); }
    for (int row = gw; row < MTOK + 1024; row += nw) {
        const float* g = row < MTOK ? p.norm_g : p.mem_norm_g;
        bf16_t* dst = row < MTOK ? (bf16_t*)(ws + WS_H) + (size_t)row * DM : (bf16_t*)(ws + WS_MEMN) + (size_t)(row - MTOK) * DM;
        if (row + nw < MTOK + 1024) { const float* src = rowsrc(row + nw);
#pragma unroll
            for (int i = 0; i < 8; ++i) vn[i] = *(const f32x4*)(src + 4 * (lane + 64 * i)); }
        float s = 0.f;
#pragma unroll
        for (int i = 0; i < 8; ++i) s += (v[i][0] * v[i][0] + v[i][1] * v[i][1]) + (v[i][2] * v[i][2] + v[i][3] * v[i][3]);
#pragma unroll
        for (int o = 32; o >= 1; o >>= 1) s += __shfl_xor(s, o);
        const float rstd = 1.0f / sqrtf(s * (1.0f / 2048.0f) + 1e-6f);
#pragma unroll
        for (int i = 0; i < 8; ++i) { const f32x4 gv = *(const f32x4*)(g + 4 * (lane + 64 * i));
            u32x2 w; w.x = cvt_pk_bf16(v[i][0] * rstd * gv[0], v[i][1] * rstd * gv[1]); w.y = cvt_pk_bf16(v[i][2] * rstd * gv[2], v[i][3] * rstd * gv[3]);
            *(u32x2*)(dst + 4 * (lane + 64 * i)) = w; }
#pragma unroll
        for (int i = 0; i < 8; ++i) v[i] = vn[i];
    }
}

__device__ __forceinline__ void late_transposes(const P& p, LAS unsigned char* lds, const int first, const int stride) {
    unsigned char* ws = p.ws; LAS float* tile = (LAS float*)lds;
    for (int t = first; t < 768; t += stride) {
        if (t < 128) transpose_tile(p.w_conv_out, 1024, 2048, (bf16_t*)(ws + WS_WC), 0, t, tile);
        else if (t < 256) transpose_tile(p.w_attn_out, 1024, 2048, (bf16_t*)(ws + WS_WA), 0, t - 128, tile);
        else if (t < 384) transpose_tile(p.w_glu_a, 1024, 2048, (bf16_t*)(ws + WS_WG), 1, t - 256, tile);
        else if (t < 512) transpose_tile(p.w_glu_b, 1024, 2048, (bf16_t*)(ws + WS_WG), 2, t - 384, tile);
        else transpose_tile(p.w_out, 2048, 2048, (bf16_t*)(ws + WS_WO), 0, t - 512, tile);
    }
}

template <int LEN, bool PROMPT>
__device__ __forceinline__ void conv_task(const P& p, const int r0, const int cgp, const int bs) {
    const bf16_t* PROJ = (const bf16_t*)(p.ws + WS_PROJ); bf16_t* ACONV = (bf16_t*)(p.ws + WS_ACONV);
    const int c0 = cgp * 8;
    const bf16_t* pr = PROJ + (size_t)r0 * NIN + c0;
    u32x4 lcb[LEN], lcz[LEN], lcc[LEN + 2], lch[LEN + 2];
    const bool has_halo = PROMPT && (r0 & 2047) != 0;
#pragma unroll
    for (int i = 0; i < LEN; ++i) { lcb[i] = *(const u32x4*)(pr + (size_t)i * NIN + OFF_CB); lcz[i] = *(const u32x4*)(pr + (size_t)i * NIN + OFF_CZ);
        lcc[i + 2] = *(const u32x4*)(pr + (size_t)i * NIN + OFF_CC); lch[i + 2] = *(const u32x4*)(pr + (size_t)i * NIN + OFF_CH); }
#pragma unroll
    for (int i = 0; i < 2; ++i) { lcc[i] = (u32x4){0u, 0u, 0u, 0u}; lch[i] = lcc[i];
        if (has_halo) { lcc[i] = *(const u32x4*)(pr - (size_t)(2 - i) * NIN + OFF_CC); lch[i] = *(const u32x4*)(pr - (size_t)(2 - i) * NIN + OFF_CH); } }
    float w0[8], w1[8], w2[8], vm2[8], vm1[8];
    { const f32x4 a0 = *(const f32x4*)(p.conv_w + c0), a1 = *(const f32x4*)(p.conv_w + c0 + 4), b0 = *(const f32x4*)(p.conv_w + 1024 + c0), b1 = *(const f32x4*)(p.conv_w + 1024 + c0 + 4),
          d0 = *(const f32x4*)(p.conv_w + 2048 + c0), d1 = *(const f32x4*)(p.conv_w + 2048 + c0 + 4);
#pragma unroll
      for (int e = 0; e < 4; ++e) { w0[e] = a0[e]; w0[e + 4] = a1[e]; w1[e] = b0[e]; w1[e + 4] = b1[e]; w2[e] = d0[e]; w2[e + 4] = d1[e]; } }
    if (PROMPT) {
        float a[8], b[8];
        unpack8(lcc[0], a); unpack8(lch[0], b);
#pragma unroll
        for (int e = 0; e < 8; ++e) vm2[e] = a[e] * b[e];
        unpack8(lcc[1], a); unpack8(lch[1], b);
#pragma unroll
        for (int e = 0; e < 8; ++e) vm1[e] = a[e] * b[e];
    } else {
        const float* sc = p.state_conv + (size_t)bs * 2048 + c0;
        const f32x4 a0 = *(const f32x4*)sc, a1 = *(const f32x4*)(sc + 4), b0 = *(const f32x4*)(sc + 1024), b1 = *(const f32x4*)(sc + 1028);
#pragma unroll
        for (int e = 0; e < 4; ++e) { vm2[e] = a0[e]; vm2[e + 4] = a1[e]; vm1[e] = b0[e]; vm1[e + 4] = b1[e]; }
    }
#pragma unroll
    for (int i = 0; i < LEN; ++i) {
        const size_t row = (size_t)(r0 + i);
        float cb[8], cc[8], ch[8], cz[8], v[8];
        unpack8(lcb[i], cb); unpack8(lcc[i + 2], cc); unpack8(lch[i + 2], ch); unpack8(lcz[i], cz);
        f32x4 o0, o1;
#pragma unroll
        for (int e = 0; e < 8; ++e) { v[e] = cc[e] * ch[e]; const float cv = w0[e] * vm2[e] + w1[e] * vm1[e] + w2[e] * v[e]; const float r = cb[e] * cv * siluf_(cz[e]);
            if (e < 4) o0[e] = r; else o1[e - 4] = r; vm2[e] = vm1[e]; vm1[e] = v[e]; }
        *(u32x4*)(ACONV + row * 1024 + c0) = pack8u(o0, o1);
        float* dst = nullptr;
        if (PROMPT) { const int pos = (r0 + i) & 2047; if (pos >= 2046) dst = p.out + O_CP + ((size_t)((r0 + i) >> 11) * 2 + (pos - 2046)) * 1024 + c0; }
        else if (i >= 2) dst = p.out + O_CS + ((size_t)bs * 2 + (i - 2)) * 1024 + c0;
        if (dst) { *(f32x4*)dst = (f32x4){v[0], v[1], v[2], v[3]}; *(f32x4*)(dst + 4) = (f32x4){v[4], v[5], v[6], v[7]}; }
    }
}
__device__ __forceinline__ void conv_phase(const P& p) {
    const int t0 = blockIdx.x * 512 + otid(), nt = gridDim.x * 512;
    for (int task = t0; task < 262144; task += nt) conv_task<4, true>(p, (task >> 7) * 4, task & 127, 0);
    for (int task = t0; task < 16384; task += nt) conv_task<4, false>(p, NPROMPT + 4 * (task >> 7), task & 127, task >> 7);
}

struct S5In { bf16x8 U[4]; u32x2 u4[4], z4[4]; };
__device__ __forceinline__ void s5_load4(S5In& in, const bf16_t* PROJ, const size_t row0, const int g, const int g4) {
    const bf16_t* base = PROJ + row0 * NIN + g * 16;
#pragma unroll
    for (int i = 0; i < 4; ++i) {
        in.U[i] = *(const bf16x8*)(base + (size_t)i * NIN + OFF_SU + 8 * (g4 & 1));
        in.u4[i] = *(const u32x2*)(base + (size_t)i * NIN + OFF_SU + 4 * g4); in.z4[i] = *(const u32x2*)(base + (size_t)i * NIN + OFF_SZ + 4 * g4);
    }
}
__device__ __forceinline__ void s5_steps4(const S5In& in, bf16_t* YS, const size_t row0, const int g, const int g4, const bool Y,
                                          const bf16x8 (&bre)[4], const bf16x8 (&bim)[4], const bf16x8 (&cf)[4], const float (&ar)[16], const float (&ai)[16], const f32x4 dsk,
                                          float (&sr)[16], float (&si)[16]) {
    const f32x4 zero4 = (f32x4){0.f, 0.f, 0.f, 0.f};
#pragma unroll
    for (int i = 0; i < 4; ++i) {
#pragma unroll
        for (int pb = 0; pb < 4; ++pb) {
            const f32x4 xr = MFMA16(bre[pb], in.U[i], zero4), xi = MFMA16(bim[pb], in.U[i], zero4);
#pragma unroll
            for (int j = 0; j < 4; ++j) { const int k = pb * 4 + j; const float nr = ar[k] * sr[k] - ai[k] * si[k] + xr[j]; const float ni = ar[k] * si[k] + ai[k] * sr[k] + xi[j]; sr[k] = nr; si[k] = ni; }
        }
        if (Y) {
            f32x4 y = zero4;
            y = MFMA16(cf[0], pack8((f32x4){sr[0], sr[1], sr[2], sr[3]}, (f32x4){sr[4], sr[5], sr[6], sr[7]}), y);
            y = MFMA16(cf[1], pack8((f32x4){sr[8], sr[9], sr[10], sr[11]}, (f32x4){sr[12], sr[13], sr[14], sr[15]}), y);
            y = MFMA16(cf[2], pack8((f32x4){si[0], si[1], si[2], si[3]}, (f32x4){si[4], si[5], si[6], si[7]}), y);
            y = MFMA16(cf[3], pack8((f32x4){si[8], si[9], si[10], si[11]}, (f32x4){si[12], si[13], si[14], si[15]}), y);
            const float uu[4] = {bf_lo(in.u4[i].x), bf_hi(in.u4[i].x), bf_lo(in.u4[i].y), bf_hi(in.u4[i].y)};
            const float zz[4] = {bf_lo(in.z4[i].x), bf_hi(in.z4[i].x), bf_lo(in.z4[i].y), bf_hi(in.z4[i].y)};
            float o[4];
#pragma unroll
            for (int j = 0; j < 4; ++j) { const float ysv = y[j] + dsk[j] * uu[j]; o[j] = gelu_tanh(ysv * siluf_(zz[j])); }
            u32x2 w; w.x = cvt_pk_bf16(o[0], o[1]); w.y = cvt_pk_bf16(o[2], o[3]);
            *(u32x2*)(YS + (row0 + i) * 1024 + g * 16 + 4 * g4) = w;
        }
    }
}
__device__ __forceinline__ void s5_coef(const P& p, int g, int pp, float dt, float& ar, float& ai, float& fr, float& fi) {
    const float lr = p.lam_re[g * 64 + pp], li = p.lam_im[g * 64 + pp];
    const float mag = expf(lr * dt), ang = li * dt; float sn, cs; sincosf(ang, &sn, &cs);
    ar = mag * cs; ai = mag * sn; const float den = lr * lr + li * li;
    fr = ((ar - 1.0f) * lr + ai * li) / den; fi = (ai * lr - (ar - 1.0f) * li) / den;
}
__device__ __forceinline__ void s5_unit(const P& p, const int unit, LAS unsigned char* lds) {
    const bf16_t* PROJ = (const bf16_t*)(p.ws + WS_PROJ); bf16_t* YS = (bf16_t*)(p.ws + WS_YS);
    const int tid = otid(), lane = tid & 63, w = tid >> 6, cl = lane & 15, g4 = lane >> 4;
    const bool prompt = unit < 256; const int g = prompt ? (unit & 63) : (unit - 256); const int b = unit >> 6;
    const float dt = expf(p.log_dt[g]);
    LAS float* E = (LAS float*)lds;
    LAS f32x4* CT = (LAS f32x4*)(lds + 65536);
    if (tid < 64) { float a_r, a_i, fr_, fi_; s5_coef(p, g, tid, dt, a_r, a_i, fr_, fi_); CT[tid] = (f32x4){a_r, a_i, fr_, fi_}; }
    __syncthreads();
    float ar[16], ai[16];
#pragma unroll
    for (int pb = 0; pb < 4; ++pb)
#pragma unroll
        for (int j = 0; j < 4; ++j) { const f32x4 t = CT[16 * pb + 4 * g4 + j]; ar[pb * 4 + j] = t[0]; ai[pb * 4 + j] = t[1]; }
    bf16x8 bre[4], bim[4], cf[4];
    const float bmask = g4 < 2 ? 1.0f : 0.0f;
#pragma unroll
    for (int pb = 0; pb < 4; ++pb) {
        const int pp = 16 * pb + cl; const f32x4 t = CT[pp]; const float fr_ = t[2] * bmask, fi_ = t[3] * bmask;
        const float* br = p.b_re + ((size_t)(g * 64 + pp)) * 16 + 8 * (g4 & 1); const float* bi = p.b_im + ((size_t)(g * 64 + pp)) * 16 + 8 * (g4 & 1);
        const f32x4 r0 = *(const f32x4*)br, r1 = *(const f32x4*)(br + 4), i0 = *(const f32x4*)bi, i1 = *(const f32x4*)(bi + 4);
        bre[pb] = pack8(fr_ * r0 - fi_ * i0, fr_ * r1 - fi_ * i1);
        bim[pb] = pack8(fr_ * i0 + fi_ * r0, fr_ * i1 + fi_ * r1);
    }
#pragma unroll
    for (int ks = 0; ks < 4; ++ks) {
        const float* cp = (ks < 2 ? p.c_re : p.c_im) + ((size_t)(g * 16 + cl)) * 64 + 32 * (ks & 1) + 4 * g4;
        f32x4 a = *(const f32x4*)cp, c = *(const f32x4*)(cp + 16);
        if (ks >= 2) { a = -a; c = -c; }
        cf[ks] = pack8(a, c);
    }
    const f32x4 dsk = *(const f32x4*)(p.ssm_d + g * 16 + 4 * g4);
    const int chain = 16 * w + cl;
    const size_t row0 = prompt ? (size_t)b * 2048 + (size_t)chain * 16 : (size_t)NPROMPT + 4 * chain;
    const size_t so = ((size_t)chain * 64 + g) * 64 + 4 * g4;
    const int nq = prompt ? 4 : 1;
    float sr[16], si[16];
#pragma unroll
    for (int k = 0; k < 16; ++k) { sr[k] = 0.f; si[k] = 0.f; }
    if (!prompt) {
#pragma unroll
        for (int pb = 0; pb < 4; ++pb) { const f32x4 a = *(const f32x4*)(p.state_re + so + 16 * pb), c = *(const f32x4*)(p.state_im + so + 16 * pb);
#pragma unroll
            for (int j = 0; j < 4; ++j) { sr[pb * 4 + j] = a[j]; si[pb * 4 + j] = c[j]; } }
    }
#pragma unroll 1
    for (int pass = prompt ? 0 : 1; pass < 2; ++pass) {
        if (pass == 1 && prompt) {
#pragma unroll
            for (int pb = 0; pb < 4; ++pb) {
                *(LAS f32x4*)(E + (chain * 2 + 0) * 64 + 16 * pb + 4 * g4) = (f32x4){sr[pb * 4], sr[pb * 4 + 1], sr[pb * 4 + 2], sr[pb * 4 + 3]};
                *(LAS f32x4*)(E + (chain * 2 + 1) * 64 + 16 * pb + 4 * g4) = (f32x4){si[pb * 4], si[pb * 4 + 1], si[pb * 4 + 2], si[pb * 4 + 3]};
            }
            __syncthreads();
            if (w == 0) {
                float a_r, a_i; { const f32x4 t = CT[lane]; a_r = t[0]; a_i = t[1]; }
#pragma unroll
                for (int q = 0; q < 4; ++q) { const float nr = a_r * a_r - a_i * a_i, ni = 2.0f * a_r * a_i; a_r = nr; a_i = ni; }
                float Fr = 0.f, Fi = 0.f;
#pragma unroll 8
                for (int k = 0; k < 128; ++k) {
                    const float er = E[(2 * k) * 64 + lane], ei = E[(2 * k + 1) * 64 + lane];
                    E[(2 * k) * 64 + lane] = Fr; E[(2 * k + 1) * 64 + lane] = Fi;
                    const float nr = a_r * Fr - a_i * Fi + er; Fi = a_r * Fi + a_i * Fr + ei; Fr = nr;
                }
                p.out[O_RP + (size_t)(b * 64 + g) * 64 + lane] = Fr; p.out[O_IP + (size_t)(b * 64 + g) * 64 + lane] = Fi;
            }
            __syncthreads();
#pragma unroll
            for (int pb = 0; pb < 4; ++pb) {
                const f32x4 a = *(LAS f32x4*)(E + (chain * 2 + 0) * 64 + 16 * pb + 4 * g4), c = *(LAS f32x4*)(E + (chain * 2 + 1) * 64 + 16 * pb + 4 * g4);
#pragma unroll
                for (int j = 0; j < 4; ++j) { sr[pb * 4 + j] = a[j]; si[pb * 4 + j] = c[j]; }
            }
        }
        S5In cur; s5_load4(cur, PROJ, row0, g, g4);
#pragma unroll 1
        for (int q = 0; q < nq; ++q) {
            S5In nxt = cur;
            if (q + 1 < nq) s5_load4(nxt, PROJ, row0 + 4 * (q + 1), g, g4);
            s5_steps4(cur, YS, row0 + 4 * q, g, g4, pass == 1, bre, bim, cf, ar, ai, dsk, sr, si);
            cur = nxt;
        }
    }
    if (!prompt) {
#pragma unroll
        for (int pb = 0; pb < 4; ++pb) {
            *(f32x4*)(p.out + O_RS + so + 16 * pb) = (f32x4){sr[pb * 4], sr[pb * 4 + 1], sr[pb * 4 + 2], sr[pb * 4 + 3]};
            *(f32x4*)(p.out + O_IS + so + 16 * pb) = (f32x4){si[pb * 4], si[pb * 4 + 1], si[pb * 4 + 2], si[pb * 4 + 3]};
        }
    }
    __syncthreads();
}

__device__ __forceinline__ void attn_prompt_unit(const P& p, const int unit, LAS unsigned char* lds) {
    const bf16_t* PROJ = (const bf16_t*)(p.ws + WS_PROJ); const bf16_t* KB = (const bf16_t*)(p.ws + WS_KB); const bf16_t* VT = (const bf16_t*)(p.ws + WS_VT);
    bf16_t* OATT = (bf16_t*)(p.ws + WS_OATT);
    const int tid = otid(), lane = tid & 63, w = tid >> 6, cl = lane & 15, g4 = lane >> 4;
    const int b = unit >> 6, h = (unit >> 4) & 3, qb = unit & 15;
    const bf16_t* kbase = KB + (size_t)(b * 256) * 1024 + h * 256;
#pragma unroll
    for (int i = 0; i < 16; ++i) { const int idx = tid + 512 * i, r = idx >> 5, m = idx & 31;
        const u32x4 v = *(const u32x4*)(kbase + (size_t)r * 1024 + m * 8); *(LAS u32x4*)(lds + r * 512 + ((m ^ (r & 15)) << 4)) = v; }
    const size_t qrow = (size_t)b * 2048 + qb * 128 + w * 16 + cl;
    const bf16_t* qp = PROJ + qrow * NIN + OFF_AQ + h * 256 + 8 * g4;
    bf16x8 qf[8];
#pragma unroll
    for (int ks = 0; ks < 8; ++ks) qf[ks] = *(const bf16x8*)(qp + 32 * ks);
    __syncthreads();
    f32x4 s[16];
#pragma unroll
    for (int kb = 0; kb < 16; ++kb) { s[kb] = (f32x4){0.f, 0.f, 0.f, 0.f};
#pragma unroll
        for (int ks = 0; ks < 8; ++ks) { const int key = 16 * kb + cl, m = 4 * ks + g4;
            const bf16x8 kf = *(const LAS bf16x8*)(lds + key * 512 + ((m ^ cl) << 4)); s[kb] = MFMA16(kf, qf[ks], s[kb]); }
        __builtin_amdgcn_sched_barrier(0); }
    __syncthreads();
    const bf16_t* vbase = VT + (size_t)((b * 4 + h) * 256) * 256;
    u32x4 vst[16];
#pragma unroll
    for (int i = 0; i < 16; ++i) { const int idx = tid + 512 * i, r = idx >> 5, m = idx & 31; vst[i] = *(const u32x4*)(vbase + (size_t)r * 256 + m * 8); }
    float mx = -3.0e38f;
#pragma unroll
    for (int kb = 0; kb < 16; ++kb)
#pragma unroll
        for (int j = 0; j < 4; ++j) mx = fmaxf(mx, s[kb][j]);
    mx = fmaxf(mx, __shfl_xor(mx, 16)); mx = fmaxf(mx, __shfl_xor(mx, 32));
    float sum = 0.f;
#pragma unroll
    for (int kb = 0; kb < 16; ++kb)
#pragma unroll
        for (int j = 0; j < 4; ++j) { const float e = __expf((s[kb][j] - mx) * 0.0625f); s[kb][j] = e; sum += e; }
    sum += __shfl_xor(sum, 16); sum += __shfl_xor(sum, 32);
    const float inv = rcp_(sum);
    bf16x8 pf[8];
#pragma unroll
    for (int kk = 0; kk < 8; ++kk) pf[kk] = pack8(s[2 * kk], s[2 * kk + 1]);
#pragma unroll
    for (int i = 0; i < 16; ++i) { const int idx = tid + 512 * i, r = idx >> 5, m = idx & 31; *(LAS u32x4*)(lds + r * 512 + ((m ^ (r & 15)) << 4)) = vst[i]; }
    __syncthreads();
    const bf16_t* azp = PROJ + qrow * NIN + OFF_AZ + h * 256 + 4 * g4;
    bf16_t* op = OATT + qrow * 1024 + h * 256 + 4 * g4;
#pragma unroll
    for (int db = 0; db < 16; ++db) {
        f32x4 o = (f32x4){0.f, 0.f, 0.f, 0.f}; const int d = 16 * db + cl;
#pragma unroll
        for (int kk = 0; kk < 8; ++kk) {
            const int ch0 = 8 * kk + g4, ch1 = ch0 + 4;
            const u32x2 lo = *(const LAS u32x2*)(lds + d * 512 + (((ch0 >> 1) ^ cl) << 4) + (ch0 & 1) * 8);
            const u32x2 hi = *(const LAS u32x2*)(lds + d * 512 + (((ch1 >> 1) ^ cl) << 4) + (ch1 & 1) * 8);
            const u32x4 vv = (u32x4){lo.x, lo.y, hi.x, hi.y};
            o = MFMA16(__builtin_bit_cast(bf16x8, vv), pf[kk], o);
        }
        const u32x2 az = *(const u32x2*)(azp + 16 * db);
        const float z[4] = {bf_lo(az.x), bf_hi(az.x), bf_lo(az.y), bf_hi(az.y)};
        u32x2 wv; wv.x = cvt_pk_bf16(o[0] * inv * siluf_(z[0]), o[1] * inv * siluf_(z[1])); wv.y = cvt_pk_bf16(o[2] * inv * siluf_(z[2]), o[3] * inv * siluf_(z[3]));
        *(u32x2*)(op + 16 * db) = wv;
        __builtin_amdgcn_sched_barrier(0);
    }
    __syncthreads();
}

__device__ __forceinline__ void attn_sample_pair(const P& p, const int u0, const int u1_, LAS unsigned char* lds) {
    const int u1 = u1_ < 512 ? u1_ : u0;
    const bf16_t* PROJ = (const bf16_t*)(p.ws + WS_PROJ); bf16_t* OATT = (bf16_t*)(p.ws + WS_OATT);
    const int tid = otid(), lane = tid & 63, w = tid >> 6, cl = lane & 15, g4 = lane >> 4;
    LAS float* Pw = (LAS float*)(lds + w * 512);
    LAS float* ST = (LAS float*)(lds + 4096);
    LAS float* OW = (LAS float*)(lds + 8192);
    f32x4 bA[16], bB[16], o[4], s0, s1;
    bf16x8 qf[8];
#define SA_LOADQ(unit) do { const bf16_t* qp_ = PROJ + ((size_t)NPROMPT + 4 * ((unit) >> 2) + (cl & 3)) * NIN + OFF_AQ + ((unit) & 3) * 256 + 8 * g4; \
        _Pragma("unroll") for (int ks = 0; ks < 8; ++ks) qf[ks] = *(const bf16x8*)(qp_ + 32 * ks); } while (0)
#define SA_LOADK(buf, unit, kblk) do { const float* kr_ = p.cache_k + ((size_t)((unit) >> 2) * 1024 + ((unit) & 3)) * 256 + (size_t)(32 * w + 16 * (kblk) + cl) * 1024 + 8 * g4; \
        _Pragma("unroll") for (int ks = 0; ks < 8; ++ks) { buf[2 * ks] = *(const f32x4*)(kr_ + 32 * ks); buf[2 * ks + 1] = *(const f32x4*)(kr_ + 32 * ks + 4); } } while (0)
#define SA_LOADV(buf, unit, half) do { const float* vr_ = p.cache_v + ((size_t)((unit) >> 2) * 1024 + ((unit) & 3)) * 256 + (size_t)(32 * w + 16 * (half)) * 1024 + 4 * lane; \
        _Pragma("unroll") for (int i = 0; i < 16; ++i) buf[i] = *(const f32x4*)(vr_ + (size_t)i * 1024); } while (0)
#define SA_QK(buf, sv) do { sv = (f32x4){0.f, 0.f, 0.f, 0.f}; _Pragma("unroll") for (int ks = 0; ks < 8; ++ks) sv = MFMA16(pack8(buf[2 * ks], buf[2 * ks + 1]), qf[ks], sv); } while (0)
#define SA_PV(buf, half) do { _Pragma("unroll") for (int ii = 0; ii < 4; ++ii) _Pragma("unroll") for (int q = 0; q < 4; ++q) { const f32x4 pv_ = *(const LAS f32x4*)(Pw + q * 32 + 16 * (half) + 4 * ii); \
        o[q] += pv_[0] * buf[4 * ii] + pv_[1] * buf[4 * ii + 1] + pv_[2] * buf[4 * ii + 2] + pv_[3] * buf[4 * ii + 3]; } } while (0)
#define SA_SOFTMAX(slot) do { float m_ = fmaxf(fmaxf(fmaxf(s0[0], s0[1]), fmaxf(s0[2], s0[3])), fmaxf(fmaxf(s1[0], s1[1]), fmaxf(s1[2], s1[3]))); \
        m_ = fmaxf(m_, __shfl_xor(m_, 16)); m_ = fmaxf(m_, __shfl_xor(m_, 32)); float l_ = 0.f; \
        _Pragma("unroll") for (int j = 0; j < 4; ++j) { s0[j] = __expf((s0[j] - m_) * 0.0625f); s1[j] = __expf((s1[j] - m_) * 0.0625f); l_ += s0[j] + s1[j]; } \
        l_ += __shfl_xor(l_, 16); l_ += __shfl_xor(l_, 32); \
        if (cl < 4) { *(LAS f32x4*)(Pw + cl * 32 + 4 * g4) = s0; *(LAS f32x4*)(Pw + cl * 32 + 16 + 4 * g4) = s1; \
            if (g4 == 0) { ST[(((slot) * 8 + w) * 4 + cl) * 2] = m_; ST[(((slot) * 8 + w) * 4 + cl) * 2 + 1] = l_; } } } while (0)
#define SA_OZERO() do { _Pragma("unroll") for (int q = 0; q < 4; ++q) o[q] = (f32x4){0.f, 0.f, 0.f, 0.f}; } while (0)
#define SA_OWRITE(slot) do { _Pragma("unroll") for (int q = 0; q < 4; ++q) *(LAS f32x4*)(OW + (size_t)((((slot) * 8 + w) * 4 + q) * 256) + 4 * lane) = o[q]; } while (0)
#define SA_SB() __builtin_amdgcn_sched_barrier(0)
    SA_LOADQ(u0);
    SA_LOADK(bA, u0, 0); SA_LOADK(bB, u0, 1); SA_SB();
    SA_QK(bA, s0); SA_LOADV(bA, u0, 0); SA_SB();
    SA_QK(bB, s1); SA_LOADV(bB, u0, 1); SA_SB();
    SA_SOFTMAX(0);
    SA_LOADQ(u1);
    SA_OZERO(); SA_SB();
    SA_PV(bA, 0); SA_LOADK(bA, u1, 0); SA_SB();
    SA_PV(bB, 1); SA_LOADK(bB, u1, 1); SA_SB();
    SA_OWRITE(0);
    {
        SA_QK(bA, s0); SA_LOADV(bA, u1, 0); SA_SB();
        SA_QK(bB, s1); SA_LOADV(bB, u1, 1); SA_SB();
        SA_SOFTMAX(1);
        SA_OZERO(); SA_SB();
        SA_PV(bA, 0); SA_SB();
        SA_PV(bB, 1);
        SA_OWRITE(1);
    }
    __syncthreads();
    {
        const int slot = tid >> 8, q = (tid >> 6) & 3, d = (tid & 63) * 4;
        const int unit = slot == 0 ? u0 : u1;
        {
            float M = -3.0e38f;
#pragma unroll
            for (int ww = 0; ww < 8; ++ww) M = fmaxf(M, ST[((slot * 8 + ww) * 4 + q) * 2]);
            float L = 0.f; f32x4 a = (f32x4){0.f, 0.f, 0.f, 0.f};
#pragma unroll
            for (int ww = 0; ww < 8; ++ww) { const float f = __expf((ST[((slot * 8 + ww) * 4 + q) * 2] - M) * 0.0625f); L += f * ST[((slot * 8 + ww) * 4 + q) * 2 + 1];
                a += f * *(const LAS f32x4*)(OW + (size_t)(((slot * 8 + ww) * 4 + q) * 256) + d); }
            const float inv = rcp_(L);
            const size_t row = (size_t)NPROMPT + 4 * (unit >> 2) + q; const int h = unit & 3;
            const u32x2 az = *(const u32x2*)(PROJ + row * NIN + OFF_AZ + h * 256 + d);
            u32x2 wv; wv.x = cvt_pk_bf16(a[0] * inv * siluf_(bf_lo(az.x)), a[1] * inv * siluf_(bf_hi(az.x))); wv.y = cvt_pk_bf16(a[2] * inv * siluf_(bf_lo(az.y)), a[3] * inv * siluf_(bf_hi(az.y)));
            *(u32x2*)(OATT + row * 1024 + h * 256 + d) = wv;
        }
    }
    __syncthreads();
#undef SA_LOADQ
#undef SA_LOADK
#undef SA_LOADV
#undef SA_QK
#undef SA_PV
#undef SA_SOFTMAX
#undef SA_OZERO
#undef SA_OWRITE
#undef SA_SB
}

__device__ __forceinline__ void phase5(const P& p) {
    const float* part = (const float*)(p.ws + WS_PART);
    const int t0 = otid(); const int lane = t0 & 63, gw = blockIdx.x * 8 + (t0 >> 6), nw = gridDim.x * 8;
    for (int row = gw; row < MTOK; row += nw) {
        float* orow = p.out + (size_t)row * DM;
        f32x4 v[8]; float s = 0.f;
        if (row < NPROMPT) {
            const float* xr = p.x_prompt + (size_t)row * DM;
#pragma unroll
            for (int i = 0; i < 8; ++i) v[i] = *(const f32x4*)(xr + 4 * (lane + 64 * i)) + *(const f32x4*)(orow + 4 * (lane + 64 * i));
        } else {
            const float* xr = p.x_sample + (size_t)(row - NPROMPT) * DM;
#pragma unroll
            for (int i = 0; i < 8; ++i) v[i] = *(const f32x4*)(xr + 4 * (lane + 64 * i));
#pragma unroll 2
            for (int ks = 0; ks < 8; ++ks) { const float* pr = part + ((size_t)ks * 512 + (row - NPROMPT)) * DM;
#pragma unroll
                for (int i = 0; i < 8; ++i) v[i] += *(const f32x4*)(pr + 4 * (lane + 64 * i)); }
        }
#pragma unroll
        for (int i = 0; i < 8; ++i) s += (v[i][0] * v[i][0] + v[i][1] * v[i][1]) + (v[i][2] * v[i][2] + v[i][3] * v[i][3]);
#pragma unroll
        for (int o = 32; o >= 1; o >>= 1) s += __shfl_xor(s, o);
        const float rstd = 1.0f / sqrtf(s * (1.0f / 2048.0f) + 1e-6f);
#pragma unroll
        for (int i = 0; i < 8; ++i) { const f32x4 gv = *(const f32x4*)(p.final_g + 4 * (lane + 64 * i)); *(f32x4*)(orow + 4 * (lane + 64 * i)) = v[i] * rstd * gv; }
    }
}

#define XB_TMO      128
#define XB_XCNT(j)  (256  + 64 * (j))
#define XB_XSUB(j)  (1280 + 64 * (j))
#define XB_XGEN(j)  (2304 + 64 * (j))
#define XB_TOP      3328
#define XB_TOPGEN   3392
#define XB_SPIN_CAP (1u << 20)
__device__ __forceinline__ unsigned xb_ld(unsigned* p)              { return __hip_atomic_load(p, __ATOMIC_RELAXED, __HIP_MEMORY_SCOPE_AGENT); }
__device__ __forceinline__ unsigned xb_add(unsigned* p, unsigned v) { return __hip_atomic_fetch_add(p, v, __ATOMIC_RELAXED, __HIP_MEMORY_SCOPE_AGENT); }
__device__ __forceinline__ unsigned xb_xcc_id() { return (unsigned)__builtin_amdgcn_s_getreg((3 << 11) | 20) & 0xFu; }
#define XB_SPIN(cond, bar) do { unsigned _sp = 0; while (cond) { __builtin_amdgcn_s_sleep(1); \
    if ((++_sp & 255u) == 0u) { if (xb_ld(&(bar)[XB_TMO])) break; if (_sp > XB_SPIN_CAP) { atomicAdd(&(bar)[XB_TMO], 1u); break; } } } } while (0)
struct XcdBarrier { unsigned* bar; unsigned x; volatile LAS unsigned* st; };
__device__ __forceinline__ XcdBarrier xcd_barrier_post(unsigned* bar, volatile LAS unsigned* st) {
    XcdBarrier b; b.bar = bar; b.x = xb_xcc_id(); b.st = st;
    if (threadIdx.x == 0) (void)xb_add(&bar[XB_XCNT(b.x)], 1u);
    return b;
}
__device__ __forceinline__ void xcd_barrier_complete(unsigned* bar, unsigned x, unsigned& nloc, unsigned& nx) {
    const unsigned G = gridDim.x * gridDim.y * gridDim.z;
    unsigned sum, cnt, mine, sp = 0u;
    for (;;) {
        sum = 0u; cnt = 0u; mine = 0u;
#pragma unroll
        for (unsigned j = 0; j < 16; ++j) { const unsigned c = xb_ld(&bar[XB_XCNT(j)]); sum += c; cnt += (c > 0u) ? 1u : 0u; mine = (j == x) ? c : mine; }
        if (sum == G) break;
        __builtin_amdgcn_s_sleep(1);
        if ((++sp & 255u) == 0u) { if (xb_ld(&bar[XB_TMO])) break; if (sp > XB_SPIN_CAP) { atomicAdd(&bar[XB_TMO], 1u); break; } }
    }
    nloc = mine > 0u ? mine : 1u; nx = cnt > 0u ? cnt : 1u;
}
__device__ __forceinline__ void xcd_barrier(const XcdBarrier& b) {
    asm volatile("s_waitcnt vmcnt(0)" ::: "memory");
    __syncthreads();
    if (threadIdx.x == 0) {
        unsigned* bar = b.bar;
        __builtin_amdgcn_s_waitcnt(0);
        unsigned nloc = b.st[0], nx = b.st[1];
        if (nloc == 0u) { xcd_barrier_complete(bar, b.x, nloc, nx); b.st[0] = nloc; b.st[1] = nx; }
        const unsigned old = xb_add(&bar[XB_XSUB(b.x)], 1u);
        const unsigned gen = old / nloc;
        if (old + 1u == (gen + 1u) * nloc) {
            __builtin_amdgcn_fence(__ATOMIC_RELEASE, "agent");
            asm volatile("s_waitcnt vmcnt(0)" ::: "memory");
            const unsigned og = xb_add(&bar[XB_TOP], 1u);
            const unsigned tg = og / nx;
            if (og + 1u == (tg + 1u) * nx) xb_add(&bar[XB_TOPGEN], 1u);
            else XB_SPIN(xb_ld(&bar[XB_TOPGEN]) == tg, bar);
            __builtin_amdgcn_fence(__ATOMIC_ACQUIRE, "agent");
            xb_add(&bar[XB_XGEN(b.x)], 1u);
            asm volatile("s_waitcnt vmcnt(0)" ::: "memory");
        } else {
            XB_SPIN(xb_ld(&bar[XB_XGEN(b.x)]) == gen, bar);
            __builtin_amdgcn_fence(__ATOMIC_ACQUIRE, "agent");
            asm volatile("s_waitcnt vmcnt(0)" ::: "memory");
        }
    }
    __syncthreads();
}

__global__ void __launch_bounds__(512, 2) mega_fwd(P p) {
    extern __shared__ __attribute__((aligned(16))) unsigned char shm[];
    LAS unsigned char* lds = (LAS unsigned char*)shm;
    cg::grid_group grid = cg::this_grid();
    unsigned char* ws = p.ws;
    const int G = gridDim.x, c = blockIdx.x;
    volatile LAS unsigned* bst = (volatile LAS unsigned*)(lds + 131072);
    if (threadIdx.x == 0) { bst[0] = 0u; bst[1] = 0u; }
    __syncthreads();
    const XcdBarrier xbar = xcd_barrier_post((unsigned*)(ws + WS_BAR), bst);
    if (p.out == nullptr) grid.sync();
#define GSYNC() xcd_barrier(xbar)

#ifndef PHMASK
#define PHMASK 0xffff
#endif
#ifndef REPMASK
#define REPMASK 0
#endif
#define NREP(bit) ((REPMASK & (bit)) ? 2 : 1)
#ifndef TPHASE
#define TPHASE -1
#endif
#ifndef TMULT
#define TMULT 4
#endif
    unsigned long long ts[8]; int nts = 0;
#define STAMP() do { if (TPHASE >= 0 && TPHASE < 10) { ts[nts] = wall_clock64(); } ++nts; } while (0)
    STAMP();
    for (int rep = 0; rep < NREP(1); ++rep) if (PHMASK & 1) phase0(p, lds);
    GSYNC(); STAMP();

    for (int rep = 0; rep < NREP(2); ++rep) if (PHMASK & 2) {
        Sched1 S{(const char*)(ws + WS_H), (const char*)(ws + WS_WIN), (const char*)(ws + WS_MEMN), (const char*)(ws + WS_WK), (const char*)(ws + WS_WV), G, c};
        Epi1 E{(bf16_t*)(ws + WS_PROJ), p.out + O_MK, (bf16_t*)(ws + WS_KB), p.out + O_MV, (bf16_t*)(ws + WS_VT)};
        pg8::gemm_phase(lds, 2048, 2048, S, E);
        const int nfull = 1936 % G;
        if (nfull > 0 && c >= nfull) late_transposes(p, lds, c - nfull, G - nfull); else if (nfull == 0) late_transposes(p, lds, c, G);
    }
    GSYNC(); STAMP();

    for (int rep = 0; rep < NREP(4); ++rep) {
        unsigned long long m0 = 0, m1 = 0, m2 = 0, m3 = 0, m4 = 0;
        if (TPHASE >= 10) m0 = wall_clock64();
        const int sg = (c >> 3) & 3;
        if (sg == 0) for (int u = c; u < 512; u += 2 * G) attn_sample_pair(p, u, u + G, lds);
        if (TPHASE >= 10) m1 = wall_clock64();
        for (int u = c; u < 256; u += G) s5_unit(p, u, lds);
        for (int u = 256 + (G - 1 - c); u < 320; u += G) s5_unit(p, u, lds);
        if (TPHASE >= 10) m2 = wall_clock64();
        if (sg == 1) for (int u = c; u < 512; u += 2 * G) attn_sample_pair(p, u, u + G, lds);
        for (int u = c; u < 256; u += G) attn_prompt_unit(p, u, lds);
        if (TPHASE >= 10) m3 = wall_clock64();
        if (sg == 2) for (int u = c; u < 512; u += 2 * G) attn_sample_pair(p, u, u + G, lds);
        conv_phase(p);
        if (sg == 3) for (int u = c; u < 512; u += 2 * G) attn_sample_pair(p, u, u + G, lds);
        if (TPHASE >= 10) { m4 = wall_clock64(); ts[0] = 0; ts[1] = TPHASE == 10 ? m1 - m0 : (TPHASE == 11 ? m2 - m1 : (TPHASE == 12 ? m3 - m2 : m4 - m3)); }
    }
    GSYNC(); STAMP();

    for (int rep = 0; rep < NREP(8); ++rep) if (PHMASK & 64) {
        Sched2 S{(const char*)ws, G, c};
        Epi2 E{(bf16_t*)(ws + WS_GLU), (bf16_t*)(ws + WS_CONVO), (bf16_t*)(ws + WS_ATTO)};
        pg8::gemm_phase(lds, 1024, 1024, S, E);
    }
    GSYNC(); STAMP();

    for (int rep = 0; rep < NREP(32); ++rep) merge_phase(p);
    GSYNC(); STAMP();

    for (int rep = 0; rep < NREP(16); ++rep) if (PHMASK & 128) {
        { Sched3 S{(const char*)(ws + WS_MERGED), (const char*)(ws + WS_WO), G, c}; Epi3 E{p.out + O_Y, (float*)(ws + WS_PART), false}; pg8::gemm_phase(lds, 2048, 2048, S, E); }
        { Sched3b S{(const char*)(ws + WS_MERGED), (const char*)(ws + WS_WO), G, c}; Epi3 E{p.out + O_Y, (float*)(ws + WS_PART), true}; pg8::gemm_phase(lds, 256, 2048, S, E); }
    }
    GSYNC(); STAMP();

    if (PHMASK & 256) phase5(p);
    STAMP();
    if (TPHASE >= 0 && blockIdx.x == 0 && threadIdx.x == 0) {
        const unsigned long long d = (TPHASE >= 10 ? ts[1] - ts[0] : ts[TPHASE + 1] - ts[TPHASE]) * TMULT, t0 = wall_clock64();
        while (wall_clock64() - t0 < d) __builtin_amdgcn_s_sleep(16);
    }
}

extern "C" void kernel_launch(void* const* d_in, const int* in_sizes, int n_in, void* d_out, int out_size, void* d_ws, size_t ws_size, hipStream_t stream) {
    static int grid = 0;
    if (grid == 0) {
        int dev = 0, cus = 0, per_cu = 0;
        hipGetDevice(&dev);
        hipDeviceGetAttribute(&cus, hipDeviceAttributeMultiprocessorCount, dev);
        if (hipFuncSetAttribute((const void*)mega_fwd, hipFuncAttributeMaxDynamicSharedMemorySize, LDS_BYTES) != hipSuccess) fprintf(stderr, "kernel_launch: hipFuncSetAttribute failed\n");
        if (hipOccupancyMaxActiveBlocksPerMultiprocessor(&per_cu, (const void*)mega_fwd, 512, LDS_BYTES) != hipSuccess || per_cu < 1) per_cu = 1;
        (void)hipGetLastError();
        grid = cus * per_cu;
        if (ws_size < WS_END) fprintf(stderr, "kernel_launch: workspace too small (%zu < %zu)\n", ws_size, (size_t)WS_END);
    }
    P p{};
    const float** pp = (const float**)&p;
    for (int i = 0; i < 28; ++i) pp[i] = (const float*)d_in[i];
    p.out = (float*)d_out; p.ws = (unsigned char*)d_ws;
    void* args[] = {&p};
    (void)hipMemsetAsync((unsigned char*)d_ws + WS_BAR, 0, 16384, stream);
    hipError_t e = hipLaunchCooperativeKernel((const void*)mega_fwd, dim3(grid), dim3(512), args, LDS_BYTES, stream);
    if (e != hipSuccess) fprintf(stderr, "cooperative launch failed: %s (grid %d)\n", hipGetErrorString(e), grid);
}
```

```cpp
#include <hip/hip_runtime.h>
#include <hip/hip_cooperative_groups.h>
#include <cstdio>
namespace cg = cooperative_groups;

#define LAS __attribute__((address_space(3)))
typedef unsigned short bf16_t;
typedef short bf16x8 __attribute__((ext_vector_type(8)));
typedef float f32x4 __attribute__((ext_vector_type(4)));
typedef unsigned u32x4 __attribute__((ext_vector_type(4)));
typedef unsigned u32x2 __attribute__((ext_vector_type(2)));

constexpr int DM = 2048, NPROMPT = 8192, NSAMPLE = 512, MTOK = 8704, NIN = 14336;
constexpr int OFF_CB = 0, OFF_CC = 1024, OFF_CH = 2048, OFF_CZ = 3072, OFF_SU = 4096, OFF_SZ = 5120, OFF_AQ = 6144, OFF_AZ = 7168, OFF_G = 8192;
constexpr int LDS_BYTES = 131072 + 16;
constexpr size_t O_Y = 0, O_MK = 17825792, O_MV = 18874368, O_CP = 19922944, O_RP = 19931136, O_IP = 19947520, O_CS = 19963904, O_RS = 20226048, O_IS = 20750336;
constexpr size_t WS_WIN = 0;
constexpr size_t WS_WG = WS_WIN + (size_t)NIN * DM * 2;
constexpr size_t WS_WC = WS_WG + 8388608;
constexpr size_t WS_WA = WS_WC + 4194304;
constexpr size_t WS_WO = WS_WA + 4194304;
constexpr size_t WS_WK = WS_WO + 8388608;
constexpr size_t WS_WV = WS_WK + 4194304;
constexpr size_t WS_H = WS_WV + 4194304;
constexpr size_t WS_MEMN = WS_H + (size_t)MTOK * DM * 2;
constexpr size_t WS_PROJ = WS_MEMN + 4194304;
constexpr size_t WS_KB = WS_PROJ + (size_t)MTOK * NIN * 2;
constexpr size_t WS_VT = WS_KB + 2097152;
constexpr size_t WS_YS = WS_VT + 2097152;
constexpr size_t WS_ACONV = WS_YS + (size_t)MTOK * 1024 * 2;
constexpr size_t WS_OATT = WS_ACONV + (size_t)MTOK * 1024 * 2;
constexpr size_t WS_SS = WS_OATT + (size_t)MTOK * 1024 * 2;
constexpr size_t WS_GLU = WS_SS + (size_t)MTOK * 32 * 4;
constexpr size_t WS_MERGED = WS_GLU + (size_t)MTOK * DM * 2;
constexpr size_t WS_BAR = WS_MERGED + (size_t)MTOK * DM * 2;
constexpr size_t WS_END = WS_BAR + 16384;
constexpr size_t WS_CONVO = WS_H, WS_ATTO = WS_WIN, WS_PART = WS_PROJ, WS_DELTA = WS_PROJ + 67108864;
static_assert(WS_END <= 536870912, "workspace");

struct P {
    const float *x_prompt, *x_sample, *mem_prompt, *cache_k, *cache_v, *state_conv, *state_re, *state_im, *norm_g, *mem_norm_g, *w_in, *conv_w, *w_conv_out,
        *lam_re, *lam_im, *log_dt, *b_re, *b_im, *c_re, *c_im, *ssm_d, *w_glu_a, *w_glu_b, *w_mem_k, *w_mem_v, *w_attn_out, *w_out, *final_g;
    float* out; unsigned char* ws;
};

__device__ __forceinline__ unsigned cvt_pk_bf16(float lo, float hi) { unsigned r; asm("v_cvt_pk_bf16_f32 %0, %1, %2" : "=v"(r) : "v"(lo), "v"(hi)); return r; }
__device__ __forceinline__ float bf_lo(unsigned w) { return __uint_as_float(w << 16); }
__device__ __forceinline__ float bf_hi(unsigned w) { return __uint_as_float(w & 0xffff0000u); }
__device__ __forceinline__ float rcp_(float x) { return __builtin_amdgcn_rcpf(x); }
__device__ __forceinline__ float sigmoidf_(float x) { return rcp_(1.0f + __expf(-x)); }
__device__ __forceinline__ float siluf_(float x) { return x * rcp_(1.0f + __expf(-x)); }
__device__ __forceinline__ float gelu_tanh(float x) { const float u = 1.5957691216057308f * (x + 0.044715f * x * x * x); return x * rcp_(1.0f + __expf(-u)); }
__device__ __forceinline__ bf16x8 pack8(const f32x4 a, const f32x4 b) {
    u32x4 w; w.x = cvt_pk_bf16(a[0], a[1]); w.y = cvt_pk_bf16(a[2], a[3]); w.z = cvt_pk_bf16(b[0], b[1]); w.w = cvt_pk_bf16(b[2], b[3]);
    return __builtin_bit_cast(bf16x8, w);
}
__device__ __forceinline__ u32x4 pack8u(const f32x4 a, const f32x4 b) {
    u32x4 w; w.x = cvt_pk_bf16(a[0], a[1]); w.y = cvt_pk_bf16(a[2], a[3]); w.z = cvt_pk_bf16(b[0], b[1]); w.w = cvt_pk_bf16(b[2], b[3]); return w;
}
__device__ __forceinline__ void unpack8(const u32x4 w, float (&f)[8]) {
    f[0] = bf_lo(w.x); f[1] = bf_hi(w.x); f[2] = bf_lo(w.y); f[3] = bf_hi(w.y); f[4] = bf_lo(w.z); f[5] = bf_hi(w.z); f[6] = bf_lo(w.w); f[7] = bf_hi(w.w);
}
__device__ __forceinline__ int otid() { int t = threadIdx.x; asm volatile("" : "+v"(t)); return t; }
#define MFMA16(a, b, c) __builtin_amdgcn_mfma_f32_16x16x32_bf16((a), (b), (c), 0, 0, 0)

namespace pg8 {
constexpr int BM = 256, BK = 64, HALF = 128, HTB = HALF * BK * 2, STAGE_BYTES = 8 * HTB;
__device__ __forceinline__ int lds_byte(int r, int c) { const int st = (r >> 4) * 2 + (c >> 5), rr = r & 15, cc = c & 31, ob = rr * 64 + cc * 2; return st * 1024 + (ob ^ (((ob >> 9) & 1) << 5)); }
__device__ __forceinline__ void stage_rc(int b, int& R, int& C) { const int st = b / 1024, sb = b % 1024, swz = sb ^ (((sb >> 9) & 1) << 5); R = (st >> 1) * 16 + swz / 64; C = (st & 1) * 32 + (swz % 64) / 2; }
__device__ __forceinline__ int perm32(int rho) { const int n = rho >> 4, i = rho & 15; return 8 * (i >> 2) + 4 * n + (i & 3); }
struct Unit { const char* a; const char* b; int pm, pn, kind; };

template <class Sched, class Epi>
__device__ __forceinline__ void gemm_phase(LAS unsigned char* lds, const int K, const int ld, const Sched& S, const Epi& E) {
    const int tid = otid(), wid = __builtin_amdgcn_readfirstlane(tid >> 6), lane = tid & 63, wr = wid >> 2, wc = wid & 3, fr = lane & 15, fq = lane >> 4;
    const int nt = K / BK;
    unsigned voffA[2], voffB[2];
#pragma unroll
    for (int i = 0; i < 2; ++i) { int R, C; stage_rc(tid * 16 + i * 8192, R, C); const int Rb = (R & ~31) + perm32(R & 31);
        voffA[i] = (unsigned)(R * ld + C) * 2u; voffB[i] = (unsigned)(Rb * ld + C) * 2u; }
    const size_t kstep = (size_t)(BK * 2);
    const size_t hstep = (size_t)HALF * ld * 2;
    const unsigned ldsw = (unsigned)wid * 1024u;
    const int aoff = lds_byte(wr * 64 + fr, fq * 8), boff = lds_byte(wc * 32 + fr, fq * 8);
#define PG8_SA(b, h) (((b) * 2 + (h)) * HTB)
#define PG8_SB(b, h) ((4 + (b) * 2 + (h)) * HTB)
#define PG8_STAGE(bufoff, gbase, voff) do { _Pragma("unroll") for (int _i = 0; _i < 2; ++_i) \
        __builtin_amdgcn_global_load_lds((const unsigned*)((const char*)(gbase) + (voff)[_i]), (LAS unsigned*)(lds + (bufoff) + ldsw + _i * 8192), 16, 0, 0); } while (0)
#define PG8_LDA(dst, b, h) do { _Pragma("unroll") for (int m = 0; m < 4; ++m) _Pragma("unroll") for (int k = 0; k < 2; ++k) dst[m][k] = *(const LAS bf16x8*)(lds + PG8_SA(b, h) + aoff + m * 2048 + k * 1024); } while (0)
#define PG8_LDB(dst, b, h) do { _Pragma("unroll") for (int n = 0; n < 2; ++n) _Pragma("unroll") for (int k = 0; k < 2; ++k) dst[n][k] = *(const LAS bf16x8*)(lds + PG8_SB(b, h) + boff + n * 2048 + k * 1024); } while (0)
#define PG8_MMA(ai, bj, At, Bt) do { __builtin_amdgcn_s_setprio(1); _Pragma("unroll") for (int m = 0; m < 4; ++m) _Pragma("unroll") for (int n = 0; n < 2; ++n) _Pragma("unroll") for (int k = 0; k < 2; ++k) \
        acc[ai][bj][m][n] = __builtin_amdgcn_mfma_f32_16x16x32_bf16(Bt[n][k], At[m][k], acc[ai][bj][m][n], 0, 0, 0); __builtin_amdgcn_s_setprio(0); } while (0)
#define PG8_WAIT_V(n) asm volatile("s_waitcnt vmcnt(" #n ")" ::: "memory")
#define PG8_WAIT_L(n) asm volatile("s_waitcnt lgkmcnt(" #n ")" ::: "memory")
#define PG8_BAR __builtin_amdgcn_s_barrier()
#define PG8_SCHED __builtin_amdgcn_sched_barrier(0)
    Unit cur, nxt; int ui = 0;
    if (!S.next(0, cur)) return;
    f32x4 acc[2][2][4][2];
#pragma unroll
    for (int a = 0; a < 2; ++a)
#pragma unroll
        for (int b = 0; b < 2; ++b)
#pragma unroll
            for (int m = 0; m < 4; ++m)
#pragma unroll
                for (int n = 0; n < 2; ++n) acc[a][b][m][n] = (f32x4){0.f, 0.f, 0.f, 0.f};
    bf16x8 At[4][2], B0[2][2], B1[2][2];
    const char* cA = cur.a; const char* cB = cur.b;
    PG8_STAGE(PG8_SB(0, 0), cB, voffB); PG8_STAGE(PG8_SA(0, 0), cA, voffA); PG8_STAGE(PG8_SB(0, 1), cB + hstep, voffB); PG8_STAGE(PG8_SA(0, 1), cA + hstep, voffA);
    if (wr == 1) PG8_BAR;
    PG8_WAIT_V(4); PG8_BAR;
    PG8_STAGE(PG8_SB(1, 0), cB + kstep, voffB); PG8_STAGE(PG8_SA(1, 0), cA + kstep, voffA); PG8_STAGE(PG8_SB(1, 1), cB + hstep + kstep, voffB);
    PG8_WAIT_V(6); PG8_BAR;
    for (;;) {
        const bool has_next = S.next(ui + 1, nxt);
        const char* nA = has_next ? nxt.a : cA; const char* nB = has_next ? nxt.b : cB;
        for (int t = 0; t < nt; t += 2) {
            const bool last = (t == nt - 2);
            const char* a1 = cA + (size_t)(t + 1) * kstep;
            const char* a2 = last ? nA : cA + (size_t)(t + 2) * kstep; const char* b2 = last ? nB : cB + (size_t)(t + 2) * kstep;
            const char* a3 = a2 + kstep; const char* b3 = b2 + kstep;
            PG8_LDB(B0, 0, 0); PG8_SCHED; PG8_LDA(At, 0, 0); PG8_STAGE(PG8_SA(1, 1), a1 + hstep, voffA);
            PG8_WAIT_L(8); PG8_BAR; PG8_WAIT_L(0); PG8_MMA(0, 0, At, B0); PG8_BAR; PG8_SCHED;
            PG8_LDB(B1, 0, 1); PG8_STAGE(PG8_SB(0, 0), b2, voffB);
            PG8_BAR; PG8_WAIT_L(0); PG8_MMA(0, 1, At, B1); PG8_BAR;
            PG8_LDA(At, 0, 1); PG8_STAGE(PG8_SA(0, 0), a2, voffA);
            PG8_BAR; PG8_WAIT_L(0); PG8_MMA(1, 0, At, B0); PG8_BAR; PG8_SCHED;
            PG8_STAGE(PG8_SB(0, 1), b2 + hstep, voffB);
            PG8_WAIT_V(6); PG8_BAR; PG8_MMA(1, 1, At, B1); PG8_BAR;
            PG8_LDB(B0, 1, 0); PG8_SCHED; PG8_LDA(At, 1, 0); PG8_STAGE(PG8_SA(0, 1), a2 + hstep, voffA);
            PG8_WAIT_L(8); PG8_BAR; PG8_WAIT_L(0); PG8_MMA(0, 0, At, B0); PG8_BAR; PG8_SCHED;
            PG8_LDB(B1, 1, 1); PG8_STAGE(PG8_SB(1, 0), b3, voffB);
            PG8_BAR; PG8_WAIT_L(0); PG8_MMA(0, 1, At, B1); PG8_BAR;
            PG8_LDA(At, 1, 1); PG8_STAGE(PG8_SA(1, 0), a3, voffA);
            PG8_BAR; PG8_WAIT_L(0); PG8_MMA(1, 0, At, B0); PG8_BAR; PG8_SCHED;
            PG8_STAGE(PG8_SB(1, 1), b3 + hstep, voffB);
            PG8_WAIT_V(6); PG8_BAR; PG8_MMA(1, 1, At, B1); PG8_BAR;
        }
        const bool keep = E(acc, cur, wr, wc, fr, fq);
        if (!has_next) break;
        if (!keep) {
#pragma unroll
            for (int a = 0; a < 2; ++a)
#pragma unroll
                for (int b = 0; b < 2; ++b)
#pragma unroll
                    for (int m = 0; m < 4; ++m)
#pragma unroll
                        for (int n = 0; n < 2; ++n) acc[a][b][m][n] = (f32x4){0.f, 0.f, 0.f, 0.f};
        }
        cur = nxt; cA = nA; cB = nB; ++ui;
    }
    PG8_WAIT_V(0);
    if (wr == 0) PG8_BAR;
    PG8_BAR;
#undef PG8_SA
#undef PG8_SB
#undef PG8_STAGE
#undef PG8_LDA
#undef PG8_LDB
#undef PG8_MMA
#undef PG8_WAIT_V
#undef PG8_WAIT_L
#undef PG8_BAR
#undef PG8_SCHED
}
}
using pg8::Unit;

struct Sched1 {
    const char *H, *WIN, *MEMN, *WK, *WV; int G, c;
    __device__ __forceinline__ bool next(int i, Unit& u) const {
        const int L = i * G + c; if (L >= 1936) return false;
        if (L < 1904) {
            const int nM = 34, nN = 56, nwg = 1904, NX = 8, WGM = 8;
            int wgid = L; { const int q = nwg / NX, r = nwg % NX, xcd = wgid % NX, off = wgid / NX; wgid = (xcd < r ? xcd * (q + 1) : r * (q + 1) + (xcd - r) * q) + off; }
            const int nig = WGM * nN, gid = wgid / nig, fm = gid * WGM, gsz = (nM - fm) < WGM ? (nM - fm) : WGM;
            u.pm = fm + ((wgid % nig) % gsz); u.pn = (wgid % nig) / gsz; u.kind = 0;
            u.a = H + (size_t)u.pm * 1048576; u.b = WIN + (size_t)u.pn * 1048576;
        } else if (L < 1920) { const int j = L - 1904; u.pm = j >> 2; u.pn = j & 3; u.kind = 1; u.a = MEMN + (size_t)u.pm * 1048576; u.b = WK + (size_t)u.pn * 1048576; }
        else { const int j = L - 1920; u.pm = j >> 2; u.pn = j & 3; u.kind = 2; u.a = WV + (size_t)u.pm * 1048576; u.b = MEMN + (size_t)u.pn * 1048576; }
        return true;
    }
};
struct Epi1 {
    bf16_t* PROJ; float* outK; bf16_t* KB; float* outV; bf16_t* VT;
    __device__ __forceinline__ bool operator()(f32x4 (&acc)[2][2][4][2], const Unit& u, int wr, int wc, int fr, int fq) const {
        const int r0 = u.pm * 256 + wr * 64 + fr, c0 = u.pn * 256 + wc * 32 + 8 * fq;
        if (u.kind == 0) {
#pragma unroll
            for (int ai = 0; ai < 2; ++ai)
#pragma unroll
                for (int m = 0; m < 4; ++m) { bf16_t* rowp = PROJ + (size_t)(r0 + ai * 128 + m * 16) * NIN + c0;
#pragma unroll
                    for (int bj = 0; bj < 2; ++bj) *(u32x4*)(rowp + bj * 128) = pack8u(acc[ai][bj][m][0], acc[ai][bj][m][1]); }
        } else if (u.kind == 1) {
#pragma unroll
            for (int ai = 0; ai < 2; ++ai)
#pragma unroll
                for (int m = 0; m < 4; ++m) { const size_t off = (size_t)(r0 + ai * 128 + m * 16) * 1024 + c0;
#pragma unroll
                    for (int bj = 0; bj < 2; ++bj) { *(f32x4*)(outK + off + bj * 128) = acc[ai][bj][m][0]; *(f32x4*)(outK + off + bj * 128 + 4) = acc[ai][bj][m][1];
                        *(u32x4*)(KB + off + bj * 128) = pack8u(acc[ai][bj][m][0], acc[ai][bj][m][1]); } }
        } else {
            const int h = u.pm, b = u.pn;
#pragma unroll
            for (int ai = 0; ai < 2; ++ai)
#pragma unroll
                for (int m = 0; m < 4; ++m) { const int d = wr * 64 + fr + ai * 128 + m * 16;
#pragma unroll
                    for (int bj = 0; bj < 2; ++bj) { const int key0 = wc * 32 + 8 * fq + bj * 128;
                        *(u32x4*)(VT + ((size_t)((b * 4 + h) * 256 + d)) * 256 + key0) = pack8u(acc[ai][bj][m][0], acc[ai][bj][m][1]);
                        float* fp = outV + ((size_t)(b * 256 + key0)) * 1024 + h * 256 + d;
#pragma unroll
                        for (int e = 0; e < 4; ++e) { fp[(size_t)e * 1024] = acc[ai][bj][m][0][e]; fp[(size_t)(e + 4) * 1024] = acc[ai][bj][m][1][e]; } } }
        }
        return false;
    }
};

struct Sched2 {
    const char* ws; int G, c;
    __device__ __forceinline__ bool next(int i, Unit& u) const {
        const int L = i * G + c; if (L >= 1088) return false;
        if (L < 544) { u.pm = L >> 4; u.pn = L & 15; u.kind = 0; u.a = ws + WS_YS + (size_t)u.pm * 524288; u.b = ws + WS_WG + (size_t)u.pn * 524288; }
        else { const int j = L - 544, k = j >= 272 ? 1 : 0, jj = j - 272 * k; u.pm = jj >> 3; u.pn = jj & 7; u.kind = 1 + k;
            u.a = ws + WS_ACONV + (size_t)k * ((size_t)MTOK * 1024 * 2) + (size_t)u.pm * 524288; u.b = ws + WS_WC + (size_t)k * 4194304 + (size_t)u.pn * 524288; }
        return true;
    }
};
struct Epi2 {
    bf16_t* GLU; bf16_t* CONVO; bf16_t* ATTO;
    __device__ __forceinline__ bool operator()(f32x4 (&acc)[2][2][4][2], const Unit& u, int wr, int wc, int fr, int fq) const {
        const int r0 = u.pm * 256 + wr * 64 + fr;
        if (u.kind == 0) {
            const int c0 = u.pn * 128 + wc * 32 + 8 * fq;
#pragma unroll
            for (int ai = 0; ai < 2; ++ai)
#pragma unroll
                for (int m = 0; m < 4; ++m) {
                    f32x4 t0, t1;
#pragma unroll
                    for (int e = 0; e < 4; ++e) { t0[e] = acc[ai][0][m][0][e] * sigmoidf_(acc[ai][1][m][0][e]); t1[e] = acc[ai][0][m][1][e] * sigmoidf_(acc[ai][1][m][1][e]); }
                    *(u32x4*)(GLU + (size_t)(r0 + ai * 128 + m * 16) * 2048 + c0) = pack8u(t0, t1);
                }
        } else {
            bf16_t* O = u.kind == 1 ? CONVO : ATTO; const int c0 = u.pn * 256 + wc * 32 + 8 * fq;
#pragma unroll
            for (int ai = 0; ai < 2; ++ai)
#pragma unroll
                for (int m = 0; m < 4; ++m) { bf16_t* rowp = O + (size_t)(r0 + ai * 128 + m * 16) * 2048 + c0;
#pragma unroll
                    for (int bj = 0; bj < 2; ++bj) *(u32x4*)(rowp + bj * 128) = pack8u(acc[ai][bj][m][0], acc[ai][bj][m][1]); }
        }
        return false;
    }
};
__device__ __forceinline__ void merge_phase(const P& p) {
    const bf16_t* PROJ = (const bf16_t*)(p.ws + WS_PROJ); const bf16_t* GLU = (const bf16_t*)(p.ws + WS_GLU); const bf16_t* CONVO = (const bf16_t*)(p.ws + WS_CONVO);
    const bf16_t* ATTO = (const bf16_t*)(p.ws + WS_ATTO); bf16_t* MERGED = (bf16_t*)(p.ws + WS_MERGED);
    const int NT = MTOK * 256;
    for (int t = blockIdx.x * 512 + otid(); t < NT; t += gridDim.x * 512) {
        const size_t row = (size_t)(t >> 8); const int c0 = (t & 255) * 8;
        const bf16_t* pr = PROJ + row * NIN + OFF_G + c0; const size_t o = row * 2048 + c0;
        float g0[8], g1[8], g2[8], cv[8], gl[8], at[8];
        unpack8(*(const u32x4*)pr, g0); unpack8(*(const u32x4*)(pr + 2048), g1); unpack8(*(const u32x4*)(pr + 4096), g2);
        unpack8(*(const u32x4*)(CONVO + o), cv); unpack8(*(const u32x4*)(GLU + o), gl); unpack8(*(const u32x4*)(ATTO + o), at);
        f32x4 m0, m1;
#pragma unroll
        for (int e = 0; e < 8; ++e) { const float v = sigmoidf_(g0[e]) * cv[e] + sigmoidf_(g1[e]) * gl[e] + sigmoidf_(g2[e]) * at[e]; if (e < 4) m0[e] = v; else m1[e - 4] = v; }
        *(u32x4*)(MERGED + o) = pack8u(m0, m1);
    }
}

struct Sched3 {
    const char *MERGED, *WO; int G, c;
    __device__ __forceinline__ bool next(int i, Unit& u) const {
        const int L = i * G + c; if (L >= 256) return false;
        u.pm = L >> 3; u.pn = L & 7; u.kind = 0; u.a = MERGED + (size_t)u.pm * 1048576; u.b = WO + (size_t)u.pn * 1048576; return true;
    }
};
struct Sched3b {
    const char *MERGED, *WO; int G, c;
    __device__ __forceinline__ bool next(int i, Unit& u) const {
        const int L = i * G + c; if (L >= 128) return false;
        const int tile = L >> 3, ks = L & 7; u.pm = 32 + (tile >> 3); u.pn = tile & 7; u.kind = ks;
        u.a = MERGED + (size_t)u.pm * 1048576 + (size_t)ks * 512; u.b = WO + (size_t)u.pn * 1048576 + (size_t)ks * 512; return true;
    }
};
struct Epi3 {
    bf16_t* delta; float* part;
    bool sample;
    __device__ __forceinline__ bool operator()(f32x4 (&acc)[2][2][4][2], const Unit& u, int wr, int wc, int fr, int fq) const {
        const int r0 = u.pm * 256 + wr * 64 + fr, c0 = u.pn * 256 + wc * 32 + 8 * fq;
        if (!sample) {
#pragma unroll
            for (int ai = 0; ai < 2; ++ai)
#pragma unroll
                for (int m = 0; m < 4; ++m) { bf16_t* o = delta + (size_t)(r0 + ai * 128 + m * 16) * DM + c0;
#pragma unroll
                    for (int bj = 0; bj < 2; ++bj) *(u32x4*)(o + bj * 128) = pack8u(acc[ai][bj][m][0], acc[ai][bj][m][1]); }
        } else {
            float* base = part + ((size_t)u.kind * 512 - NPROMPT) * DM;
#pragma unroll
            for (int ai = 0; ai < 2; ++ai)
#pragma unroll
                for (int m = 0; m < 4; ++m) {
                    float* o = base + (size_t)(r0 + ai * 128 + m * 16) * DM + c0;
#pragma unroll
                    for (int bj = 0; bj < 2; ++bj)
#pragma unroll
                        for (int n = 0; n < 2; ++n) *(f32x4*)(o + bj * 128 + 4 * n) = acc[ai][bj][m][n];
                }
        }
        return false;
    }
};

__device__ __forceinline__ void transpose_tile(const float* __restrict__ src, const int K, const int N, bf16_t* __restrict__ dst, const int mode, const int t, LAS float* tile) {
    const int tid = otid(); const int tn = N / 256;
    const int r = tid >> 3, c8 = (tid & 7) * 8;
    const int k0 = (t / tn) * 64, n0 = (t % tn) * 256;
    const float* s = src + (size_t)(k0 + r) * N + n0 + c8;
    f32x4 v[8];
#pragma unroll
    for (int j = 0; j < 4; ++j) { v[2 * j] = *(const f32x4*)(s + j * 64); v[2 * j + 1] = *(const f32x4*)(s + j * 64 + 4); }
#pragma unroll
    for (int j = 0; j < 4; ++j)
#pragma unroll
        for (int e = 0; e < 4; ++e) { tile[j * 4160 + r * 65 + c8 + e] = v[2 * j][e]; tile[j * 4160 + r * 65 + c8 + 4 + e] = v[2 * j + 1][e]; }
    __syncthreads();
#pragma unroll
    for (int j = 0; j < 4; ++j) {
        f32x4 a, b;
#pragma unroll
        for (int e = 0; e < 4; ++e) { a[e] = tile[j * 4160 + (c8 + e) * 65 + r]; b[e] = tile[j * 4160 + (c8 + 4 + e) * 65 + r]; }
        const int n = n0 + j * 64 + r;
        const int row = mode == 0 ? n : ((n >> 7) * 256 + (mode - 1) * 128 + (n & 127));
        *(u32x4*)(dst + (size_t)row * K + k0 + c8) = pack8u(a, b);
    }
    __syncthreads();
}
__device__ __forceinline__ void tload_win(const float* w_in, int t, int r, int c8, f32x4 (&v)[8]) {
    const int k0 = (t / 56) * 64, n0 = (t % 56) * 256;
    const float* s = w_in + (size_t)(k0 + r) * NIN + n0 + c8;
#pragma unroll
    for (int j = 0; j < 4; ++j) { v[2 * j] = *(const f32x4*)(s + j * 64); v[2 * j + 1] = *(const f32x4*)(s + j * 64 + 4); }
}
__device__ __forceinline__ void phase0(const P& p, LAS unsigned char* lds) {
    unsigned char* ws = p.ws; LAS float* tile = (LAS float*)lds;
    {
        const int tid = otid(); const int r = tid >> 3, c8 = (tid & 7) * 8;
        bf16_t* dst = (bf16_t*)(ws + WS_WIN);
        int j = blockIdx.x; f32x4 v[8];
        if (j < 1792) tload_win(p.w_in, j, r, c8, v);
        while (j < 1792) {
#pragma unroll
            for (int q = 0; q < 4; ++q)
#pragma unroll
                for (int e = 0; e < 4; ++e) { tile[q * 4160 + r * 65 + c8 + e] = v[2 * q][e]; tile[q * 4160 + r * 65 + c8 + 4 + e] = v[2 * q + 1][e]; }
            const int jn = j + gridDim.x;
            if (jn < 1792) tload_win(p.w_in, jn, r, c8, v);
            __syncthreads();
            const int k0 = (j / 56) * 64, n0 = (j % 56) * 256;
#pragma unroll
            for (int q = 0; q < 4; ++q) {
                f32x4 a, b;
#pragma unroll
                for (int e = 0; e < 4; ++e) { a[e] = tile[q * 4160 + (c8 + e) * 65 + r]; b[e] = tile[q * 4160 + (c8 + 4 + e) * 65 + r]; }
                *(u32x4*)(dst + (size_t)(n0 + q * 64 + r) * 2048 + k0 + c8) = pack8u(a, b);
            }
            __syncthreads();
            j = jn;
        }
    }
    for (int t = blockIdx.x; t < 256; t += gridDim.x) {
        if (t < 128) transpose_tile(p.w_mem_k, 2048, 1024, (bf16_t*)(ws + WS_WK), 0, t, tile);
        else transpose_tile(p.w_mem_v, 2048, 1024, (bf16_t*)(ws + WS_WV), 0, t - 128, tile);
    }
    const int t0 = otid(); const int lane = t0 & 63, gw = blockIdx.x * 8 + (t0 >> 6), nw = gridDim.x * 8;
    auto rowsrc = [&](int row) -> const float* { return row < NPROMPT ? p.x_prompt + (size_t)row * DM : (row < MTOK ? p.x_sample + (size_t)(row - NPROMPT) * DM : p.mem_prompt + (size_t)(row - MTOK) * DM); };
    f32x4 v[8], vn[8];
    if (gw < MTOK + 1024) { const float* src = rowsrc(gw);
#pragma unroll
        for (int i = 0; i < 8; ++i) v[i] = *(const f32x4*)(src + 4 * (lane + 64 * i)); }
    for (int row = gw; row < MTOK + 1024; row += nw) {
        const float* g = row < MTOK ? p.norm_g : p.mem_norm_g;
        bf16_t* dst = row < MTOK ? (bf16_t*)(ws + WS_H) + (size_t)row * DM : (bf16_t*)(ws + WS_MEMN) + (size_t)(row - MTOK) * DM;
        if (row + nw < MTOK + 1024) { const float* src = rowsrc(row + nw);
#pragma unroll
            for (int i = 0; i < 8; ++i) vn[i] = *(const f32x4*)(src + 4 * (lane + 64 * i)); }
        float s = 0.f;
#pragma unroll
        for (int i = 0; i < 8; ++i) s += (v[i][0] * v[i][0] + v[i][1] * v[i][1]) + (v[i][2] * v[i][2] + v[i][3] * v[i][3]);
#pragma unroll
        for (int o = 32; o >= 1; o >>= 1) s += __shfl_xor(s, o);
        const float rstd = 1.0f / sqrtf(s * (1.0f / 2048.0f) + 1e-6f);
#pragma unroll
        for (int i = 0; i < 8; ++i) { const f32x4 gv = *(const f32x4*)(g + 4 * (lane + 64 * i));
            u32x2 w; w.x = cvt_pk_bf16(v[i][0] * rstd * gv[0], v[i][1] * rstd * gv[1]); w.y = cvt_pk_bf16(v[i][2] * rstd * gv[2], v[i][3] * rstd * gv[3]);
            *(u32x2*)(dst + 4 * (lane + 64 * i)) = w; }
#pragma unroll
        for (int i = 0; i < 8; ++i) v[i] = vn[i];
    }
}

__device__ __forceinline__ void late_transposes(const P& p, LAS unsigned char* lds, const int first, const int stride) {
    unsigned char* ws = p.ws; LAS float* tile = (LAS float*)lds;
    for (int t = first; t < 768; t += stride) {
        if (t < 128) transpose_tile(p.w_conv_out, 1024, 2048, (bf16_t*)(ws + WS_WC), 0, t, tile);
        else if (t < 256) transpose_tile(p.w_attn_out, 1024, 2048, (bf16_t*)(ws + WS_WA), 0, t - 128, tile);
        else if (t < 384) transpose_tile(p.w_glu_a, 1024, 2048, (bf16_t*)(ws + WS_WG), 1, t - 256, tile);
        else if (t < 512) transpose_tile(p.w_glu_b, 1024, 2048, (bf16_t*)(ws + WS_WG), 2, t - 384, tile);
        else transpose_tile(p.w_out, 2048, 2048, (bf16_t*)(ws + WS_WO), 0, t - 512, tile);
    }
}

template <int LEN, bool PROMPT>
__device__ __forceinline__ void conv_task(const P& p, const int r0, const int cgp, const int bs) {
    const bf16_t* PROJ = (const bf16_t*)(p.ws + WS_PROJ); bf16_t* ACONV = (bf16_t*)(p.ws + WS_ACONV);
    const int c0 = cgp * 8;
    const bf16_t* pr = PROJ + (size_t)r0 * NIN + c0;
    u32x4 lcb[LEN], lcz[LEN], lcc[LEN + 2], lch[LEN + 2];
    const bool has_halo = PROMPT && (r0 & 2047) != 0;
#pragma unroll
    for (int i = 0; i < LEN; ++i) { lcb[i] = *(const u32x4*)(pr + (size_t)i * NIN + OFF_CB); lcz[i] = *(const u32x4*)(pr + (size_t)i * NIN + OFF_CZ);
        lcc[i + 2] = *(const u32x4*)(pr + (size_t)i * NIN + OFF_CC); lch[i + 2] = *(const u32x4*)(pr + (size_t)i * NIN + OFF_CH); }
#pragma unroll
    for (int i = 0; i < 2; ++i) { lcc[i] = (u32x4){0u, 0u, 0u, 0u}; lch[i] = lcc[i];
        if (has_halo) { lcc[i] = *(const u32x4*)(pr - (size_t)(2 - i) * NIN + OFF_CC); lch[i] = *(const u32x4*)(pr - (size_t)(2 - i) * NIN + OFF_CH); } }
    float w0[8], w1[8], w2[8], vm2[8], vm1[8];
    { const f32x4 a0 = *(const f32x4*)(p.conv_w + c0), a1 = *(const f32x4*)(p.conv_w + c0 + 4), b0 = *(const f32x4*)(p.conv_w + 1024 + c0), b1 = *(const f32x4*)(p.conv_w + 1024 + c0 + 4),
          d0 = *(const f32x4*)(p.conv_w + 2048 + c0), d1 = *(const f32x4*)(p.conv_w + 2048 + c0 + 4);
#pragma unroll
      for (int e = 0; e < 4; ++e) { w0[e] = a0[e]; w0[e + 4] = a1[e]; w1[e] = b0[e]; w1[e + 4] = b1[e]; w2[e] = d0[e]; w2[e + 4] = d1[e]; } }
    if (PROMPT) {
        float a[8], b[8];
        unpack8(lcc[0], a); unpack8(lch[0], b);
#pragma unroll
        for (int e = 0; e < 8; ++e) vm2[e] = a[e] * b[e];
        unpack8(lcc[1], a); unpack8(lch[1], b);
#pragma unroll
        for (int e = 0; e < 8; ++e) vm1[e] = a[e] * b[e];
    } else {
        const float* sc = p.state_conv + (size_t)bs * 2048 + c0;
        const f32x4 a0 = *(const f32x4*)sc, a1 = *(const f32x4*)(sc + 4), b0 = *(const f32x4*)(sc + 1024), b1 = *(const f32x4*)(sc + 1028);
#pragma unroll
        for (int e = 0; e < 4; ++e) { vm2[e] = a0[e]; vm2[e + 4] = a1[e]; vm1[e] = b0[e]; vm1[e + 4] = b1[e]; }
    }
#pragma unroll
    for (int i = 0; i < LEN; ++i) {
        const size_t row = (size_t)(r0 + i);
        float cb[8], cc[8], ch[8], cz[8], v[8];
        unpack8(lcb[i], cb); unpack8(lcc[i + 2], cc); unpack8(lch[i + 2], ch); unpack8(lcz[i], cz);
        f32x4 o0, o1;
#pragma unroll
        for (int e = 0; e < 8; ++e) { v[e] = cc[e] * ch[e]; const float cv = w0[e] * vm2[e] + w1[e] * vm1[e] + w2[e] * v[e]; const float r = cb[e] * cv * siluf_(cz[e]);
            if (e < 4) o0[e] = r; else o1[e - 4] = r; vm2[e] = vm1[e]; vm1[e] = v[e]; }
        *(u32x4*)(ACONV + row * 1024 + c0) = pack8u(o0, o1);
        float* dst = nullptr;
        if (PROMPT) { const int pos = (r0 + i) & 2047; if (pos >= 2046) dst = p.out + O_CP + ((size_t)((r0 + i) >> 11) * 2 + (pos - 2046)) * 1024 + c0; }
        else if (i >= 2) dst = p.out + O_CS + ((size_t)bs * 2 + (i - 2)) * 1024 + c0;
        if (dst) { *(f32x4*)dst = (f32x4){v[0], v[1], v[2], v[3]}; *(f32x4*)(dst + 4) = (f32x4){v[4], v[5], v[6], v[7]}; }
    }
}
__device__ __forceinline__ void conv_phase(const P& p) {
    const int t0 = blockIdx.x * 512 + otid(), nt = gridDim.x * 512;
    for (int task = t0; task < 262144; task += nt) conv_task<4, true>(p, (task >> 7) * 4, task & 127, 0);
    for (int task = t0; task < 16384; task += nt) conv_task<4, false>(p, NPROMPT + 4 * (task >> 7), task & 127, task >> 7);
}

struct S5In { bf16x8 U[4]; u32x2 u4[4], z4[4]; };
__device__ __forceinline__ void s5_load4(S5In& in, const bf16_t* PROJ, const size_t row0, const int g, const int g4) {
    const bf16_t* base = PROJ + row0 * NIN + g * 16;
#pragma unroll
    for (int i = 0; i < 4; ++i) {
        in.U[i] = *(const bf16x8*)(base + (size_t)i * NIN + OFF_SU + 8 * (g4 & 1));
        in.u4[i] = *(const u32x2*)(base + (size_t)i * NIN + OFF_SU + 4 * g4); in.z4[i] = *(const u32x2*)(base + (size_t)i * NIN + OFF_SZ + 4 * g4);
    }
}
__device__ __forceinline__ void s5_steps4(const S5In& in, bf16_t* YS, const size_t row0, const int g, const int g4, const bool Y,
                                          const bf16x8 (&bre)[4], const bf16x8 (&bim)[4], const bf16x8 (&cf)[4], const float (&ar)[16], const float (&ai)[16], const f32x4 dsk,
                                          float (&sr)[16], float (&si)[16]) {
    const f32x4 zero4 = (f32x4){0.f, 0.f, 0.f, 0.f};
#pragma unroll
    for (int i = 0; i < 4; ++i) {
#pragma unroll
        for (int pb = 0; pb < 4; ++pb) {
            const f32x4 xr = MFMA16(bre[pb], in.U[i], zero4), xi = MFMA16(bim[pb], in.U[i], zero4);
#pragma unroll
            for (int j = 0; j < 4; ++j) { const int k = pb * 4 + j; const float nr = ar[k] * sr[k] - ai[k] * si[k] + xr[j]; const float ni = ar[k] * si[k] + ai[k] * sr[k] + xi[j]; sr[k] = nr; si[k] = ni; }
        }
        if (Y) {
            f32x4 y = zero4;
            y = MFMA16(cf[0], pack8((f32x4){sr[0], sr[1], sr[2], sr[3]}, (f32x4){sr[4], sr[5], sr[6], sr[7]}), y);
            y = MFMA16(cf[1], pack8((f32x4){sr[8], sr[9], sr[10], sr[11]}, (f32x4){sr[12], sr[13], sr[14], sr[15]}), y);
            y = MFMA16(cf[2], pack8((f32x4){si[0], si[1], si[2], si[3]}, (f32x4){si[4], si[5], si[6], si[7]}), y);
            y = MFMA16(cf[3], pack8((f32x4){si[8], si[9], si[10], si[11]}, (f32x4){si[12], si[13], si[14], si[15]}), y);
            const float uu[4] = {bf_lo(in.u4[i].x), bf_hi(in.u4[i].x), bf_lo(in.u4[i].y), bf_hi(in.u4[i].y)};
            const float zz[4] = {bf_lo(in.z4[i].x), bf_hi(in.z4[i].x), bf_lo(in.z4[i].y), bf_hi(in.z4[i].y)};
            float o[4];
#pragma unroll
            for (int j = 0; j < 4; ++j) { const float ysv = y[j] + dsk[j] * uu[j]; o[j] = gelu_tanh(ysv * siluf_(zz[j])); }
            u32x2 w; w.x = cvt_pk_bf16(o[0], o[1]); w.y = cvt_pk_bf16(o[2], o[3]);
            *(u32x2*)(YS + (row0 + i) * 1024 + g * 16 + 4 * g4) = w;
        }
    }
}
__device__ __forceinline__ void s5_coef(const P& p, int g, int pp, float dt, float& ar, float& ai, float& fr, float& fi) {
    const float lr = p.lam_re[g * 64 + pp], li = p.lam_im[g * 64 + pp];
    const float mag = expf(lr * dt), ang = li * dt; float sn, cs; sincosf(ang, &sn, &cs);
    ar = mag * cs; ai = mag * sn; const float den = lr * lr + li * li;
    fr = ((ar - 1.0f) * lr + ai * li) / den; fi = (ai * lr - (ar - 1.0f) * li) / den;
}
__device__ __forceinline__ void s5_unit(const P& p, const int unit, LAS unsigned char* lds) {
    const bf16_t* PROJ = (const bf16_t*)(p.ws + WS_PROJ); bf16_t* YS = (bf16_t*)(p.ws + WS_YS);
    const int tid = otid(), lane = tid & 63, w = tid >> 6, cl = lane & 15, g4 = lane >> 4;
    const bool prompt = unit < 256; const int g = prompt ? (unit & 63) : (unit - 256); const int b = unit >> 6;
    const float dt = expf(p.log_dt[g]);
    LAS float* E = (LAS float*)lds;
    LAS f32x4* CT = (LAS f32x4*)(lds + 65536);
    if (tid < 64) { float a_r, a_i, fr_, fi_; s5_coef(p, g, tid, dt, a_r, a_i, fr_, fi_); CT[tid] = (f32x4){a_r, a_i, fr_, fi_}; }
    __syncthreads();
    float ar[16], ai[16];
#pragma unroll
    for (int pb = 0; pb < 4; ++pb)
#pragma unroll
        for (int j = 0; j < 4; ++j) { const f32x4 t = CT[16 * pb + 4 * g4 + j]; ar[pb * 4 + j] = t[0]; ai[pb * 4 + j] = t[1]; }
    bf16x8 bre[4], bim[4], cf[4];
    const float bmask = g4 < 2 ? 1.0f : 0.0f;
#pragma unroll
    for (int pb = 0; pb < 4; ++pb) {
        const int pp = 16 * pb + cl; const f32x4 t = CT[pp]; const float fr_ = t[2] * bmask, fi_ = t[3] * bmask;
        const float* br = p.b_re + ((size_t)(g * 64 + pp)) * 16 + 8 * (g4 & 1); const float* bi = p.b_im + ((size_t)(g * 64 + pp)) * 16 + 8 * (g4 & 1);
        const f32x4 r0 = *(const f32x4*)br, r1 = *(const f32x4*)(br + 4), i0 = *(const f32x4*)bi, i1 = *(const f32x4*)(bi + 4);
        bre[pb] = pack8(fr_ * r0 - fi_ * i0, fr_ * r1 - fi_ * i1);
        bim[pb] = pack8(fr_ * i0 + fi_ * r0, fr_ * i1 + fi_ * r1);
    }
#pragma unroll
    for (int ks = 0; ks < 4; ++ks) {
        const float* cp = (ks < 2 ? p.c_re : p.c_im) + ((size_t)(g * 16 + cl)) * 64 + 32 * (ks & 1) + 4 * g4;
        f32x4 a = *(const f32x4*)cp, c = *(const f32x4*)(cp + 16);
        if (ks >= 2) { a = -a; c = -c; }
        cf[ks] = pack8(a, c);
    }
    const f32x4 dsk = *(const f32x4*)(p.ssm_d + g * 16 + 4 * g4);
    const int chain = 16 * w + cl;
    const size_t row0 = prompt ? (size_t)b * 2048 + (size_t)chain * 16 : (size_t)NPROMPT + 4 * chain;
    const size_t so = ((size_t)chain * 64 + g) * 64 + 4 * g4;
    const int nq = prompt ? 4 : 1;
    float sr[16], si[16];
#pragma unroll
    for (int k = 0; k < 16; ++k) { sr[k] = 0.f; si[k] = 0.f; }
    if (!prompt) {
#pragma unroll
        for (int pb = 0; pb < 4; ++pb) { const f32x4 a = *(const f32x4*)(p.state_re + so + 16 * pb), c = *(const f32x4*)(p.state_im + so + 16 * pb);
#pragma unroll
            for (int j = 0; j < 4; ++j) { sr[pb * 4 + j] = a[j]; si[pb * 4 + j] = c[j]; } }
    }
#pragma unroll 1
    for (int pass = prompt ? 0 : 1; pass < 2; ++pass) {
        if (pass == 1 && prompt) {
#pragma unroll
            for (int pb = 0; pb < 4; ++pb) {
                *(LAS f32x4*)(E + (chain * 2 + 0) * 64 + 16 * pb + 4 * g4) = (f32x4){sr[pb * 4], sr[pb * 4 + 1], sr[pb * 4 + 2], sr[pb * 4 + 3]};
                *(LAS f32x4*)(E + (chain * 2 + 1) * 64 + 16 * pb + 4 * g4) = (f32x4){si[pb * 4], si[pb * 4 + 1], si[pb * 4 + 2], si[pb * 4 + 3]};
            }
            __syncthreads();
            if (w == 0) {
                float a_r, a_i; { const f32x4 t = CT[lane]; a_r = t[0]; a_i = t[1]; }
#pragma unroll
                for (int q = 0; q < 4; ++q) { const float nr = a_r * a_r - a_i * a_i, ni = 2.0f * a_r * a_i; a_r = nr; a_i = ni; }
                float Fr = 0.f, Fi = 0.f;
#pragma unroll 8
                for (int k = 0; k < 128; ++k) {
                    const float er = E[(2 * k) * 64 + lane], ei = E[(2 * k + 1) * 64 + lane];
                    E[(2 * k) * 64 + lane] = Fr; E[(2 * k + 1) * 64 + lane] = Fi;
                    const float nr = a_r * Fr - a_i * Fi + er; Fi = a_r * Fi + a_i * Fr + ei; Fr = nr;
                }
                p.out[O_RP + (size_t)(b * 64 + g) * 64 + lane] = Fr; p.out[O_IP + (size_t)(b * 64 + g) * 64 + lane] = Fi;
            }
            __syncthreads();
#pragma unroll
            for (int pb = 0; pb < 4; ++pb) {
                const f32x4 a = *(LAS f32x4*)(E + (chain * 2 + 0) * 64 + 16 * pb + 4 * g4), c = *(LAS f32x4*)(E + (chain * 2 + 1) * 64 + 16 * pb + 4 * g4);
#pragma unroll
                for (int j = 0; j < 4; ++j) { sr[pb * 4 + j] = a[j]; si[pb * 4 + j] = c[j]; }
            }
        }
        S5In cur; s5_load4(cur, PROJ, row0, g, g4);
#pragma unroll 1
        for (int q = 0; q < nq; ++q) {
            S5In nxt = cur;
            if (q + 1 < nq) s5_load4(nxt, PROJ, row0 + 4 * (q + 1), g, g4);
            s5_steps4(cur, YS, row0 + 4 * q, g, g4, pass == 1, bre, bim, cf, ar, ai, dsk, sr, si);
            cur = nxt;
        }
    }
    if (!prompt) {
#pragma unroll
        for (int pb = 0; pb < 4; ++pb) {
            *(f32x4*)(p.out + O_RS + so + 16 * pb) = (f32x4){sr[pb * 4], sr[pb * 4 + 1], sr[pb * 4 + 2], sr[pb * 4 + 3]};
            *(f32x4*)(p.out + O_IS + so + 16 * pb) = (f32x4){si[pb * 4], si[pb * 4 + 1], si[pb * 4 + 2], si[pb * 4 + 3]};
        }
    }
    __syncthreads();
}

__device__ __forceinline__ void attn_prompt_unit(const P& p, const int unit, LAS unsigned char* lds) {
    const bf16_t* PROJ = (const bf16_t*)(p.ws + WS_PROJ); const bf16_t* KB = (const bf16_t*)(p.ws + WS_KB); const bf16_t* VT = (const bf16_t*)(p.ws + WS_VT);
    bf16_t* OATT = (bf16_t*)(p.ws + WS_OATT);
    const int tid = otid(), lane = tid & 63, w = tid >> 6, cl = lane & 15, g4 = lane >> 4;
    const int b = unit >> 6, h = (unit >> 4) & 3, qb = unit & 15;
    const bf16_t* kbase = KB + (size_t)(b * 256) * 1024 + h * 256;
#pragma unroll
    for (int i = 0; i < 16; ++i) { const int idx = tid + 512 * i, r = idx >> 5, m = idx & 31;
        const u32x4 v = *(const u32x4*)(kbase + (size_t)r * 1024 + m * 8); *(LAS u32x4*)(lds + r * 512 + ((m ^ (r & 15)) << 4)) = v; }
    const size_t qrow = (size_t)b * 2048 + qb * 128 + w * 16 + cl;
    const bf16_t* qp = PROJ + qrow * NIN + OFF_AQ + h * 256 + 8 * g4;
    bf16x8 qf[8];
#pragma unroll
    for (int ks = 0; ks < 8; ++ks) qf[ks] = *(const bf16x8*)(qp + 32 * ks);
    __syncthreads();
    f32x4 s[16];
#pragma unroll
    for (int kb = 0; kb < 16; ++kb) { s[kb] = (f32x4){0.f, 0.f, 0.f, 0.f};
#pragma unroll
        for (int ks = 0; ks < 8; ++ks) { const int key = 16 * kb + cl, m = 4 * ks + g4;
            const bf16x8 kf = *(const LAS bf16x8*)(lds + key * 512 + ((m ^ cl) << 4)); s[kb] = MFMA16(kf, qf[ks], s[kb]); }
        __builtin_amdgcn_sched_barrier(0); }
    __syncthreads();
    const bf16_t* vbase = VT + (size_t)((b * 4 + h) * 256) * 256;
    u32x4 vst[16];
#pragma unroll
    for (int i = 0; i < 16; ++i) { const int idx = tid + 512 * i, r = idx >> 5, m = idx & 31; vst[i] = *(const u32x4*)(vbase + (size_t)r * 256 + m * 8); }
    float mx = -3.0e38f;
#pragma unroll
    for (int kb = 0; kb < 16; ++kb)
#pragma unroll
        for (int j = 0; j < 4; ++j) mx = fmaxf(mx, s[kb][j]);
    mx = fmaxf(mx, __shfl_xor(mx, 16)); mx = fmaxf(mx, __shfl_xor(mx, 32));
    float sum = 0.f;
#pragma unroll
    for (int kb = 0; kb < 16; ++kb)
#pragma unroll
        for (int j = 0; j < 4; ++j) { const float e = __expf((s[kb][j] - mx) * 0.0625f); s[kb][j] = e; sum += e; }
    sum += __shfl_xor(sum, 16); sum += __shfl_xor(sum, 32);
    const float inv = rcp_(sum);
    bf16x8 pf[8];
#pragma unroll
    for (int kk = 0; kk < 8; ++kk) pf[kk] = pack8(s[2 * kk], s[2 * kk + 1]);
#pragma unroll
    for (int i = 0; i < 16; ++i) { const int idx = tid + 512 * i, r = idx >> 5, m = idx & 31; *(LAS u32x4*)(lds + r * 512 + ((m ^ (r & 15)) << 4)) = vst[i]; }
    __syncthreads();
    const bf16_t* azp = PROJ + qrow * NIN + OFF_AZ + h * 256 + 4 * g4;
    bf16_t* op = OATT + qrow * 1024 + h * 256 + 4 * g4;
#pragma unroll
    for (int db = 0; db < 16; ++db) {
        f32x4 o = (f32x4){0.f, 0.f, 0.f, 0.f}; const int d = 16 * db + cl;
#pragma unroll
        for (int kk = 0; kk < 8; ++kk) {
            const int ch0 = 8 * kk + g4, ch1 = ch0 + 4;
            const u32x2 lo = *(const LAS u32x2*)(lds + d * 512 + (((ch0 >> 1) ^ cl) << 4) + (ch0 & 1) * 8);
            const u32x2 hi = *(const LAS u32x2*)(lds + d * 512 + (((ch1 >> 1) ^ cl) << 4) + (ch1 & 1) * 8);
            const u32x4 vv = (u32x4){lo.x, lo.y, hi.x, hi.y};
            o = MFMA16(__builtin_bit_cast(bf16x8, vv), pf[kk], o);
        }
        const u32x2 az = *(const u32x2*)(azp + 16 * db);
        const float z[4] = {bf_lo(az.x), bf_hi(az.x), bf_lo(az.y), bf_hi(az.y)};
        u32x2 wv; wv.x = cvt_pk_bf16(o[0] * inv * siluf_(z[0]), o[1] * inv * siluf_(z[1])); wv.y = cvt_pk_bf16(o[2] * inv * siluf_(z[2]), o[3] * inv * siluf_(z[3]));
        *(u32x2*)(op + 16 * db) = wv;
        __builtin_amdgcn_sched_barrier(0);
    }
    __syncthreads();
}

__device__ __forceinline__ void attn_sample_pair(const P& p, const int u0, const int u1_, LAS unsigned char* lds) {
    const int u1 = u1_ < 512 ? u1_ : u0;
    const bf16_t* PROJ = (const bf16_t*)(p.ws + WS_PROJ); bf16_t* OATT = (bf16_t*)(p.ws + WS_OATT);
    const int tid = otid(), lane = tid & 63, w = tid >> 6, cl = lane & 15, g4 = lane >> 4;
    LAS float* Pw = (LAS float*)(lds + w * 512);
    LAS float* ST = (LAS float*)(lds + 4096);
    LAS float* OW = (LAS float*)(lds + 8192);
    f32x4 bA[16], bB[16], o[4], s0, s1;
    bf16x8 qf[8];
#define SA_LOADQ(unit) do { const bf16_t* qp_ = PROJ + ((size_t)NPROMPT + 4 * ((unit) >> 2) + (cl & 3)) * NIN + OFF_AQ + ((unit) & 3) * 256 + 8 * g4; \
        _Pragma("unroll") for (int ks = 0; ks < 8; ++ks) qf[ks] = *(const bf16x8*)(qp_ + 32 * ks); } while (0)
#define SA_LOADK(buf, unit, kblk) do { const float* kr_ = p.cache_k + ((size_t)((unit) >> 2) * 1024 + ((unit) & 3)) * 256 + (size_t)(32 * w + 16 * (kblk) + cl) * 1024 + 8 * g4; \
        _Pragma("unroll") for (int ks = 0; ks < 8; ++ks) { buf[2 * ks] = *(const f32x4*)(kr_ + 32 * ks); buf[2 * ks + 1] = *(const f32x4*)(kr_ + 32 * ks + 4); } } while (0)
#define SA_LOADV(buf, unit, half) do { const float* vr_ = p.cache_v + ((size_t)((unit) >> 2) * 1024 + ((unit) & 3)) * 256 + (size_t)(32 * w + 16 * (half)) * 1024 + 4 * lane; \
        _Pragma("unroll") for (int i = 0; i < 16; ++i) buf[i] = *(const f32x4*)(vr_ + (size_t)i * 1024); } while (0)
#define SA_QK(buf, sv) do { sv = (f32x4){0.f, 0.f, 0.f, 0.f}; _Pragma("unroll") for (int ks = 0; ks < 8; ++ks) sv = MFMA16(pack8(buf[2 * ks], buf[2 * ks + 1]), qf[ks], sv); } while (0)
#define SA_PV(buf, half) do { _Pragma("unroll") for (int ii = 0; ii < 4; ++ii) _Pragma("unroll") for (int q = 0; q < 4; ++q) { const f32x4 pv_ = *(const LAS f32x4*)(Pw + q * 32 + 16 * (half) + 4 * ii); \
        o[q] += pv_[0] * buf[4 * ii] + pv_[1] * buf[4 * ii + 1] + pv_[2] * buf[4 * ii + 2] + pv_[3] * buf[4 * ii + 3]; } } while (0)
#define SA_SOFTMAX(slot) do { float m_ = fmaxf(fmaxf(fmaxf(s0[0], s0[1]), fmaxf(s0[2], s0[3])), fmaxf(fmaxf(s1[0], s1[1]), fmaxf(s1[2], s1[3]))); \
        m_ = fmaxf(m_, __shfl_xor(m_, 16)); m_ = fmaxf(m_, __shfl_xor(m_, 32)); float l_ = 0.f; \
        _Pragma("unroll") for (int j = 0; j < 4; ++j) { s0[j] = __expf((s0[j] - m_) * 0.0625f); s1[j] = __expf((s1[j] - m_) * 0.0625f); l_ += s0[j] + s1[j]; } \
        l_ += __shfl_xor(l_, 16); l_ += __shfl_xor(l_, 32); \
        if (cl < 4) { *(LAS f32x4*)(Pw + cl * 32 + 4 * g4) = s0; *(LAS f32x4*)(Pw + cl * 32 + 16 + 4 * g4) = s1; \
            if (g4 == 0) { ST[(((slot) * 8 + w) * 4 + cl) * 2] = m_; ST[(((slot) * 8 + w) * 4 + cl) * 2 + 1] = l_; } } } while (0)
#define SA_OZERO() do { _Pragma("unroll") for (int q = 0; q < 4; ++q) o[q] = (f32x4){0.f, 0.f, 0.f, 0.f}; } while (0)
#define SA_OWRITE(slot) do { _Pragma("unroll") for (int q = 0; q < 4; ++q) *(LAS f32x4*)(OW + (size_t)((((slot) * 8 + w) * 4 + q) * 256) + 4 * lane) = o[q]; } while (0)
#define SA_SB() __builtin_amdgcn_sched_barrier(0)
    SA_LOADQ(u0);
    SA_LOADK(bA, u0, 0); SA_LOADK(bB, u0, 1); SA_SB();
    SA_QK(bA, s0); SA_LOADV(bA, u0, 0); SA_SB();
    SA_QK(bB, s1); SA_LOADV(bB, u0, 1); SA_SB();
    SA_SOFTMAX(0);
    SA_LOADQ(u1);
    SA_OZERO(); SA_SB();
    SA_PV(bA, 0); SA_LOADK(bA, u1, 0); SA_SB();
    SA_PV(bB, 1); SA_LOADK(bB, u1, 1); SA_SB();
    SA_OWRITE(0);
    {
        SA_QK(bA, s0); SA_LOADV(bA, u1, 0); SA_SB();
        SA_QK(bB, s1); SA_LOADV(bB, u1, 1); SA_SB();
        SA_SOFTMAX(1);
        SA_OZERO(); SA_SB();
        SA_PV(bA, 0); SA_SB();
        SA_PV(bB, 1);
        SA_OWRITE(1);
    }
    __syncthreads();
    {
        const int slot = tid >> 8, q = (tid >> 6) & 3, d = (tid & 63) * 4;
        const int unit = slot == 0 ? u0 : u1;
        {
            float M = -3.0e38f;
#pragma unroll
            for (int ww = 0; ww < 8; ++ww) M = fmaxf(M, ST[((slot * 8 + ww) * 4 + q) * 2]);
            float L = 0.f; f32x4 a = (f32x4){0.f, 0.f, 0.f, 0.f};
#pragma unroll
            for (int ww = 0; ww < 8; ++ww) { const float f = __expf((ST[((slot * 8 + ww) * 4 + q) * 2] - M) * 0.0625f); L += f * ST[((slot * 8 + ww) * 4 + q) * 2 + 1];
                a += f * *(const LAS f32x4*)(OW + (size_t)(((slot * 8 + ww) * 4 + q) * 256) + d); }
            const float inv = rcp_(L);
            const size_t row = (size_t)NPROMPT + 4 * (unit >> 2) + q; const int h = unit & 3;
            const u32x2 az = *(const u32x2*)(PROJ + row * NIN + OFF_AZ + h * 256 + d);
            u32x2 wv; wv.x = cvt_pk_bf16(a[0] * inv * siluf_(bf_lo(az.x)), a[1] * inv * siluf_(bf_hi(az.x))); wv.y = cvt_pk_bf16(a[2] * inv * siluf_(bf_lo(az.y)), a[3] * inv * siluf_(bf_hi(az.y)));
            *(u32x2*)(OATT + row * 1024 + h * 256 + d) = wv;
        }
    }
    __syncthreads();
#undef SA_LOADQ
#undef SA_LOADK
#undef SA_LOADV
#undef SA_QK
#undef SA_PV
#undef SA_SOFTMAX
#undef SA_OZERO
#undef SA_OWRITE
#undef SA_SB
}

__device__ __forceinline__ void phase5(const P& p) {
    const float* part = (const float*)(p.ws + WS_PART);
    const int t0 = otid(); const int lane = t0 & 63, gw = blockIdx.x * 8 + (t0 >> 6), nw = gridDim.x * 8;
    for (int row = gw; row < MTOK; row += nw) {
        float* orow = p.out + (size_t)row * DM;
        f32x4 v[8]; float s = 0.f;
        if (row < NPROMPT) {
            const float* xr = p.x_prompt + (size_t)row * DM; const bf16_t* dr = (const bf16_t*)(p.ws + WS_DELTA) + (size_t)row * DM;
#pragma unroll
            for (int i = 0; i < 8; ++i) { const u32x2 d = *(const u32x2*)(dr + 4 * (lane + 64 * i));
                v[i] = *(const f32x4*)(xr + 4 * (lane + 64 * i)) + (f32x4){bf_lo(d.x), bf_hi(d.x), bf_lo(d.y), bf_hi(d.y)}; }
        } else {
            const float* xr = p.x_sample + (size_t)(row - NPROMPT) * DM;
#pragma unroll
            for (int i = 0; i < 8; ++i) v[i] = *(const f32x4*)(xr + 4 * (lane + 64 * i));
#pragma unroll 2
            for (int ks = 0; ks < 8; ++ks) { const float* pr = part + ((size_t)ks * 512 + (row - NPROMPT)) * DM;
#pragma unroll
                for (int i = 0; i < 8; ++i) v[i] += *(const f32x4*)(pr + 4 * (lane + 64 * i)); }
        }
#pragma unroll
        for (int i = 0; i < 8; ++i) s += (v[i][0] * v[i][0] + v[i][1] * v[i][1]) + (v[i][2] * v[i][2] + v[i][3] * v[i][3]);
#pragma unroll
        for (int o = 32; o >= 1; o >>= 1) s += __shfl_xor(s, o);
        const float rstd = 1.0f / sqrtf(s * (1.0f / 2048.0f) + 1e-6f);
#pragma unroll
        for (int i = 0; i < 8; ++i) { const f32x4 gv = *(const f32x4*)(p.final_g + 4 * (lane + 64 * i)); *(f32x4*)(orow + 4 * (lane + 64 * i)) = v[i] * rstd * gv; }
    }
}

#define XB_TMO      128
#define XB_XCNT(j)  (256  + 64 * (j))
#define XB_XSUB(j)  (1280 + 64 * (j))
#define XB_XGEN(j)  (2304 + 64 * (j))
#define XB_TOP      3328
#define XB_TOPGEN   3392
#define XB_SPIN_CAP (1u << 20)
__device__ __forceinline__ unsigned xb_ld(unsigned* p)              { return __hip_atomic_load(p, __ATOMIC_RELAXED, __HIP_MEMORY_SCOPE_AGENT); }
__device__ __forceinline__ unsigned xb_add(unsigned* p, unsigned v) { return __hip_atomic_fetch_add(p, v, __ATOMIC_RELAXED, __HIP_MEMORY_SCOPE_AGENT); }
__device__ __forceinline__ unsigned xb_xcc_id() { return (unsigned)__builtin_amdgcn_s_getreg((3 << 11) | 20) & 0xFu; }
#define XB_SPIN(cond, bar) do { unsigned _sp = 0; while (cond) { __builtin_amdgcn_s_sleep(1); \
    if ((++_sp & 255u) == 0u) { if (xb_ld(&(bar)[XB_TMO])) break; if (_sp > XB_SPIN_CAP) { atomicAdd(&(bar)[XB_TMO], 1u); break; } } } } while (0)
struct XcdBarrier { unsigned* bar; unsigned x; volatile LAS unsigned* st; };
__device__ __forceinline__ XcdBarrier xcd_barrier_post(unsigned* bar, volatile LAS unsigned* st) {
    XcdBarrier b; b.bar = bar; b.x = xb_xcc_id(); b.st = st;
    if (threadIdx.x == 0) (void)xb_add(&bar[XB_XCNT(b.x)], 1u);
    return b;
}
__device__ __forceinline__ void xcd_barrier_complete(unsigned* bar, unsigned x, unsigned& nloc, unsigned& nx) {
    const unsigned G = gridDim.x * gridDim.y * gridDim.z;
    unsigned sum, cnt, mine, sp = 0u;
    for (;;) {
        sum = 0u; cnt = 0u; mine = 0u;
#pragma unroll
        for (unsigned j = 0; j < 16; ++j) { const unsigned c = xb_ld(&bar[XB_XCNT(j)]); sum += c; cnt += (c > 0u) ? 1u : 0u; mine = (j == x) ? c : mine; }
        if (sum == G) break;
        __builtin_amdgcn_s_sleep(1);
        if ((++sp & 255u) == 0u) { if (xb_ld(&bar[XB_TMO])) break; if (sp > XB_SPIN_CAP) { atomicAdd(&bar[XB_TMO], 1u); break; } }
    }
    nloc = mine > 0u ? mine : 1u; nx = cnt > 0u ? cnt : 1u;
}
__device__ __forceinline__ void xcd_barrier(const XcdBarrier& b) {
    asm volatile("s_waitcnt vmcnt(0)" ::: "memory");
    __syncthreads();
    if (threadIdx.x == 0) {
        unsigned* bar = b.bar;
        __builtin_amdgcn_s_waitcnt(0);
        unsigned nloc = b.st[0], nx = b.st[1];
        if (nloc == 0u) { xcd_barrier_complete(bar, b.x, nloc, nx); b.st[0] = nloc; b.st[1] = nx; }
        const unsigned old = xb_add(&bar[XB_XSUB(b.x)], 1u);
        const unsigned gen = old / nloc;
        if (old + 1u == (gen + 1u) * nloc) {
            __builtin_amdgcn_fence(__ATOMIC_RELEASE, "agent");
            asm volatile("s_waitcnt vmcnt(0)" ::: "memory");
            const unsigned og = xb_add(&bar[XB_TOP], 1u);
            const unsigned tg = og / nx;
            if (og + 1u == (tg + 1u) * nx) xb_add(&bar[XB_TOPGEN], 1u);
            else XB_SPIN(xb_ld(&bar[XB_TOPGEN]) == tg, bar);
            __builtin_amdgcn_fence(__ATOMIC_ACQUIRE, "agent");
            xb_add(&bar[XB_XGEN(b.x)], 1u);
            asm volatile("s_waitcnt vmcnt(0)" ::: "memory");
        } else {
            XB_SPIN(xb_ld(&bar[XB_XGEN(b.x)]) == gen, bar);
            __builtin_amdgcn_fence(__ATOMIC_ACQUIRE, "agent");
            asm volatile("s_waitcnt vmcnt(0)" ::: "memory");
        }
    }
    __syncthreads();
}

__global__ void __launch_bounds__(512, 2) mega_fwd(P p) {
    extern __shared__ __attribute__((aligned(16))) unsigned char shm[];
    LAS unsigned char* lds = (LAS unsigned char*)shm;
    cg::grid_group grid = cg::this_grid();
    unsigned char* ws = p.ws;
    const int G = gridDim.x, c = blockIdx.x;
    volatile LAS unsigned* bst = (volatile LAS unsigned*)(lds + 131072);
    if (threadIdx.x == 0) { bst[0] = 0u; bst[1] = 0u; }
    __syncthreads();
    const XcdBarrier xbar = xcd_barrier_post((unsigned*)(ws + WS_BAR), bst);
    if (p.out == nullptr) grid.sync();
#define GSYNC() xcd_barrier(xbar)

#ifndef PHMASK
#define PHMASK 0xffff
#endif
#ifndef REPMASK
#define REPMASK 0
#endif
#define NREP(bit) ((REPMASK & (bit)) ? 2 : 1)
#ifndef TPHASE
#define TPHASE -1
#endif
#ifndef TMULT
#define TMULT 4
#endif
    unsigned long long ts[8]; int nts = 0;
#define STAMP() do { if (TPHASE >= 0 && TPHASE < 10) { ts[nts] = wall_clock64(); } ++nts; } while (0)
    STAMP();
    for (int rep = 0; rep < NREP(1); ++rep) if (PHMASK & 1) phase0(p, lds);
    GSYNC(); STAMP();

    for (int rep = 0; rep < NREP(2); ++rep) if (PHMASK & 2) {
        Sched1 S{(const char*)(ws + WS_H), (const char*)(ws + WS_WIN), (const char*)(ws + WS_MEMN), (const char*)(ws + WS_WK), (const char*)(ws + WS_WV), G, c};
        Epi1 E{(bf16_t*)(ws + WS_PROJ), p.out + O_MK, (bf16_t*)(ws + WS_KB), p.out + O_MV, (bf16_t*)(ws + WS_VT)};
        pg8::gemm_phase(lds, 2048, 2048, S, E);
        const int nfull = 1936 % G;
        if (nfull > 0 && c >= nfull) late_transposes(p, lds, c - nfull, G - nfull); else if (nfull == 0) late_transposes(p, lds, c, G);
    }
    GSYNC(); STAMP();

    for (int rep = 0; rep < NREP(4); ++rep) {
        unsigned long long m0 = 0, m1 = 0, m2 = 0, m3 = 0, m4 = 0;
        if (TPHASE >= 10) m0 = wall_clock64();
        const int sg = (c >> 3) & 3;
        if (sg == 0) for (int u = c; u < 512; u += 2 * G) attn_sample_pair(p, u, u + G, lds);
        if (TPHASE >= 10) m1 = wall_clock64();
        for (int u = c; u < 256; u += G) s5_unit(p, u, lds);
        for (int u = 256 + (G - 1 - c); u < 320; u += G) s5_unit(p, u, lds);
        if (TPHASE >= 10) m2 = wall_clock64();
        if (sg == 1) for (int u = c; u < 512; u += 2 * G) attn_sample_pair(p, u, u + G, lds);
        for (int u = c; u < 256; u += G) attn_prompt_unit(p, u, lds);
        if (TPHASE >= 10) m3 = wall_clock64();
        if (sg == 2) for (int u = c; u < 512; u += 2 * G) attn_sample_pair(p, u, u + G, lds);
        conv_phase(p);
        if (sg == 3) for (int u = c; u < 512; u += 2 * G) attn_sample_pair(p, u, u + G, lds);
        if (TPHASE >= 10) { m4 = wall_clock64(); ts[0] = 0; ts[1] = TPHASE == 10 ? m1 - m0 : (TPHASE == 11 ? m2 - m1 : (TPHASE == 12 ? m3 - m2 : m4 - m3)); }
    }
    GSYNC(); STAMP();

    for (int rep = 0; rep < NREP(8); ++rep) if (PHMASK & 64) {
        Sched2 S{(const char*)ws, G, c};
        Epi2 E{(bf16_t*)(ws + WS_GLU), (bf16_t*)(ws + WS_CONVO), (bf16_t*)(ws + WS_ATTO)};
        pg8::gemm_phase(lds, 1024, 1024, S, E);
    }
    GSYNC(); STAMP();

    for (int rep = 0; rep < NREP(32); ++rep) merge_phase(p);
    GSYNC(); STAMP();

    for (int rep = 0; rep < NREP(16); ++rep) if (PHMASK & 128) {
        { Sched3 S{(const char*)(ws + WS_MERGED), (const char*)(ws + WS_WO), G, c}; Epi3 E{(bf16_t*)(ws + WS_DELTA), (float*)(ws + WS_PART), false}; pg8::gemm_phase(lds, 2048, 2048, S, E); }
        { Sched3b S{(const char*)(ws + WS_MERGED), (const char*)(ws + WS_WO), G, c}; Epi3 E{(bf16_t*)(ws + WS_DELTA), (float*)(ws + WS_PART), true}; pg8::gemm_phase(lds, 256, 2048, S, E); }
    }
    GSYNC(); STAMP();

    if (PHMASK & 256) phase5(p);
    STAMP();
    if (TPHASE >= 0 && blockIdx.x == 0 && threadIdx.x == 0) {
        const unsigned long long d = (TPHASE >= 10 ? ts[1] - ts[0] : ts[TPHASE + 1] - ts[TPHASE]) * TMULT, t0 = wall_clock64();
        while (wall_clock64() - t0 < d) __builtin_amdgcn_s_sleep(16);
    }
}

extern "C" void kernel_launch(void* const* d_in, const int* in_sizes, int n_in, void* d_out, int out_size, void* d_ws, size_t ws_size, hipStream_t stream) {
    static int grid = 0;
    if (grid == 0) {
        int dev = 0, cus = 0, per_cu = 0;
        hipGetDevice(&dev);
        hipDeviceGetAttribute(&cus, hipDeviceAttributeMultiprocessorCount, dev);
        if (hipFuncSetAttribute((const void*)mega_fwd, hipFuncAttributeMaxDynamicSharedMemorySize, LDS_BYTES) != hipSuccess) fprintf(stderr, "kernel_launch: hipFuncSetAttribute failed\n");
        if (hipOccupancyMaxActiveBlocksPerMultiprocessor(&per_cu, (const void*)mega_fwd, 512, LDS_BYTES) != hipSuccess || per_cu < 1) per_cu = 1;
        (void)hipGetLastError();
        grid = cus * per_cu;
        if (ws_size < WS_END) fprintf(stderr, "kernel_launch: workspace too small (%zu < %zu)\n", ws_size, (size_t)WS_END);
    }
    P p{};
    const float** pp = (const float**)&p;
    for (int i = 0; i < 28; ++i) pp[i] = (const float*)d_in[i];
    p.out = (float*)d_out; p.ws = (unsigned char*)d_ws;
    void* args[] = {&p};
    (void)hipMemsetAsync((unsigned char*)d_ws + WS_BAR, 0, 16384, stream);
    hipError_t e = hipLaunchCooperativeKernel((const void*)mega_fwd, dim3(grid), dim3(512), args, LDS_BYTES, stream);
    if (e != hipSuccess) fprintf(stderr, "cooperative launch failed: %s (grid %d)\n", hipGetErrorString(e), grid);
}
```

```cpp
#include <hip/hip_runtime.h>
#include <hip/hip_cooperative_groups.h>
#include <cstdio>
namespace cg = cooperative_groups;

#define LAS __attribute__((address_space(3)))
typedef unsigned short bf16_t;
typedef short bf16x8 __attribute__((ext_vector_type(8)));
typedef float f32x4 __attribute__((ext_vector_type(4)));
typedef unsigned u32x4 __attribute__((ext_vector_type(4)));
typedef unsigned u32x2 __attribute__((ext_vector_type(2)));

constexpr int DM = 2048, NPROMPT = 8192, NSAMPLE = 512, MTOK = 8704, NIN = 14336;
constexpr int OFF_CB = 0, OFF_CC = 1024, OFF_CH = 2048, OFF_CZ = 3072, OFF_SU = 4096, OFF_SZ = 5120, OFF_AQ = 6144, OFF_AZ = 7168, OFF_G = 8192;
constexpr int LDS_BYTES = 131072 + 16;
constexpr size_t O_Y = 0, O_MK = 17825792, O_MV = 18874368, O_CP = 19922944, O_RP = 19931136, O_IP = 19947520, O_CS = 19963904, O_RS = 20226048, O_IS = 20750336;
constexpr size_t WS_WIN = 0;
constexpr size_t WS_WG = WS_WIN + (size_t)NIN * DM * 2;
constexpr size_t WS_WC = WS_WG + 8388608;
constexpr size_t WS_WA = WS_WC + 4194304;
constexpr size_t WS_WO = WS_WA + 4194304;
constexpr size_t WS_WK = WS_WO + 8388608;
constexpr size_t WS_WV = WS_WK + 4194304;
constexpr size_t WS_H = WS_WV + 4194304;
constexpr size_t WS_MEMN = WS_H + (size_t)MTOK * DM * 2;
constexpr size_t WS_PROJ = WS_MEMN + 4194304;
constexpr size_t WS_KB = WS_PROJ + (size_t)MTOK * NIN * 2;
constexpr size_t WS_VT = WS_KB + 2097152;
constexpr size_t WS_YS = WS_VT + 2097152;
constexpr size_t WS_ACONV = WS_YS + (size_t)MTOK * 1024 * 2;
constexpr size_t WS_OATT = WS_ACONV + (size_t)MTOK * 1024 * 2;
constexpr size_t WS_SS = WS_OATT + (size_t)MTOK * 1024 * 2;
constexpr size_t WS_GLU = WS_SS + (size_t)MTOK * 32 * 4;
constexpr size_t WS_MERGED = WS_GLU + (size_t)MTOK * DM * 2;
constexpr size_t WS_BAR = WS_MERGED + (size_t)MTOK * DM * 2;
constexpr size_t WS_END = WS_BAR + 16384;
constexpr size_t WS_CONVO = WS_H, WS_ATTO = WS_WIN, WS_PART = WS_PROJ, WS_DELTA = WS_PROJ + 67108864;
static_assert(WS_END <= 536870912, "workspace");

struct P {
    const float *x_prompt, *x_sample, *mem_prompt, *cache_k, *cache_v, *state_conv, *state_re, *state_im, *norm_g, *mem_norm_g, *w_in, *conv_w, *w_conv_out,
        *lam_re, *lam_im, *log_dt, *b_re, *b_im, *c_re, *c_im, *ssm_d, *w_glu_a, *w_glu_b, *w_mem_k, *w_mem_v, *w_attn_out, *w_out, *final_g;
    float* out; unsigned char* ws;
};

__device__ __forceinline__ unsigned cvt_pk_bf16(float lo, float hi) { unsigned r; asm("v_cvt_pk_bf16_f32 %0, %1, %2" : "=v"(r) : "v"(lo), "v"(hi)); return r; }
__device__ __forceinline__ float bf_lo(unsigned w) { return __uint_as_float(w << 16); }
__device__ __forceinline__ float bf_hi(unsigned w) { return __uint_as_float(w & 0xffff0000u); }
__device__ __forceinline__ float rcp_(float x) { return __builtin_amdgcn_rcpf(x); }
__device__ __forceinline__ float sigmoidf_(float x) { return rcp_(1.0f + __expf(-x)); }
__device__ __forceinline__ float siluf_(float x) { return x * rcp_(1.0f + __expf(-x)); }
__device__ __forceinline__ float gelu_tanh(float x) { const float u = 1.5957691216057308f * (x + 0.044715f * x * x * x); return x * rcp_(1.0f + __expf(-u)); }
__device__ __forceinline__ bf16x8 pack8(const f32x4 a, const f32x4 b) {
    u32x4 w; w.x = cvt_pk_bf16(a[0], a[1]); w.y = cvt_pk_bf16(a[2], a[3]); w.z = cvt_pk_bf16(b[0], b[1]); w.w = cvt_pk_bf16(b[2], b[3]);
    return __builtin_bit_cast(bf16x8, w);
}
__device__ __forceinline__ u32x4 pack8u(const f32x4 a, const f32x4 b) {
    u32x4 w; w.x = cvt_pk_bf16(a[0], a[1]); w.y = cvt_pk_bf16(a[2], a[3]); w.z = cvt_pk_bf16(b[0], b[1]); w.w = cvt_pk_bf16(b[2], b[3]); return w;
}
__device__ __forceinline__ void unpack8(const u32x4 w, float (&f)[8]) {
    f[0] = bf_lo(w.x); f[1] = bf_hi(w.x); f[2] = bf_lo(w.y); f[3] = bf_hi(w.y); f[4] = bf_lo(w.z); f[5] = bf_hi(w.z); f[6] = bf_lo(w.w); f[7] = bf_hi(w.w);
}
__device__ __forceinline__ int otid() { int t = threadIdx.x; asm volatile("" : "+v"(t)); return t; }
#define MFMA16(a, b, c) __builtin_amdgcn_mfma_f32_16x16x32_bf16((a), (b), (c), 0, 0, 0)

namespace pg8 {
constexpr int BM = 256, BK = 64, HALF = 128, HTB = HALF * BK * 2, STAGE_BYTES = 8 * HTB;
__device__ __forceinline__ int lds_byte(int r, int c) { const int st = (r >> 4) * 2 + (c >> 5), rr = r & 15, cc = c & 31, ob = rr * 64 + cc * 2; return st * 1024 + (ob ^ (((ob >> 9) & 1) << 5)); }
__device__ __forceinline__ void stage_rc(int b, int& R, int& C) { const int st = b / 1024, sb = b % 1024, swz = sb ^ (((sb >> 9) & 1) << 5); R = (st >> 1) * 16 + swz / 64; C = (st & 1) * 32 + (swz % 64) / 2; }
__device__ __forceinline__ int perm32(int rho) { const int n = rho >> 4, i = rho & 15; return 8 * (i >> 2) + 4 * n + (i & 3); }
struct Unit { const char* a; const char* b; int pm, pn, kind; };

template <class Sched, class Epi>
__device__ __forceinline__ void gemm_phase(LAS unsigned char* lds, const int K, const int ld, const Sched& S, const Epi& E) {
    const int tid = otid(), wid = __builtin_amdgcn_readfirstlane(tid >> 6), lane = tid & 63, wr = wid >> 2, wc = wid & 3, fr = lane & 15, fq = lane >> 4;
    const int nt = K / BK;
    unsigned voffA[2], voffB[2];
#pragma unroll
    for (int i = 0; i < 2; ++i) { int R, C; stage_rc(tid * 16 + i * 8192, R, C); const int Rb = (R & ~31) + perm32(R & 31);
        voffA[i] = (unsigned)(R * ld + C) * 2u; voffB[i] = (unsigned)(Rb * ld + C) * 2u; }
    const size_t kstep = (size_t)(BK * 2);
    const size_t hstep = (size_t)HALF * ld * 2;
    const unsigned ldsw = (unsigned)wid * 1024u;
    const int aoff = lds_byte(wr * 64 + fr, fq * 8), boff = lds_byte(wc * 32 + fr, fq * 8);
#define PG8_SA(b, h) (((b) * 2 + (h)) * HTB)
#define PG8_SB(b, h) ((4 + (b) * 2 + (h)) * HTB)
#define PG8_STAGE(bufoff, gbase, voff) do { _Pragma("unroll") for (int _i = 0; _i < 2; ++_i) \
        __builtin_amdgcn_global_load_lds((const unsigned*)((const char*)(gbase) + (voff)[_i]), (LAS unsigned*)(lds + (bufoff) + ldsw + _i * 8192), 16, 0, 0); } while (0)
#define PG8_LDA(dst, b, h) do { _Pragma("unroll") for (int m = 0; m < 4; ++m) _Pragma("unroll") for (int k = 0; k < 2; ++k) dst[m][k] = *(const LAS bf16x8*)(lds + PG8_SA(b, h) + aoff + m * 2048 + k * 1024); } while (0)
#define PG8_LDB(dst, b, h) do { _Pragma("unroll") for (int n = 0; n < 2; ++n) _Pragma("unroll") for (int k = 0; k < 2; ++k) dst[n][k] = *(const LAS bf16x8*)(lds + PG8_SB(b, h) + boff + n * 2048 + k * 1024); } while (0)
#define PG8_MMA(ai, bj, At, Bt) do { __builtin_amdgcn_s_setprio(1); _Pragma("unroll") for (int m = 0; m < 4; ++m) _Pragma("unroll") for (int n = 0; n < 2; ++n) _Pragma("unroll") for (int k = 0; k < 2; ++k) \
        acc[ai][bj][m][n] = __builtin_amdgcn_mfma_f32_16x16x32_bf16(Bt[n][k], At[m][k], acc[ai][bj][m][n], 0, 0, 0); __builtin_amdgcn_s_setprio(0); } while (0)
#define PG8_WAIT_V(n) asm volatile("s_waitcnt vmcnt(" #n ")" ::: "memory")
#define PG8_WAIT_L(n) asm volatile("s_waitcnt lgkmcnt(" #n ")" ::: "memory")
#define PG8_BAR __builtin_amdgcn_s_barrier()
#define PG8_SCHED __builtin_amdgcn_sched_barrier(0)
    Unit cur, nxt; int ui = 0;
    if (!S.next(0, cur)) return;
    f32x4 acc[2][2][4][2];
#pragma unroll
    for (int a = 0; a < 2; ++a)
#pragma unroll
        for (int b = 0; b < 2; ++b)
#pragma unroll
            for (int m = 0; m < 4; ++m)
#pragma unroll
                for (int n = 0; n < 2; ++n) acc[a][b][m][n] = (f32x4){0.f, 0.f, 0.f, 0.f};
    bf16x8 At[4][2], B0[2][2], B1[2][2];
    const char* cA = cur.a; const char* cB = cur.b;
    PG8_STAGE(PG8_SB(0, 0), cB, voffB); PG8_STAGE(PG8_SA(0, 0), cA, voffA); PG8_STAGE(PG8_SB(0, 1), cB + hstep, voffB); PG8_STAGE(PG8_SA(0, 1), cA + hstep, voffA);
    if (wr == 1) PG8_BAR;
    PG8_WAIT_V(4); PG8_BAR;
    PG8_STAGE(PG8_SB(1, 0), cB + kstep, voffB); PG8_STAGE(PG8_SA(1, 0), cA + kstep, voffA); PG8_STAGE(PG8_SB(1, 1), cB + hstep + kstep, voffB);
    PG8_WAIT_V(6); PG8_BAR;
    for (;;) {
        const bool has_next = S.next(ui + 1, nxt);
        const char* nA = has_next ? nxt.a : cA; const char* nB = has_next ? nxt.b : cB;
        for (int t = 0; t < nt; t += 2) {
            const bool last = (t == nt - 2);
            const char* a1 = cA + (size_t)(t + 1) * kstep;
            const char* a2 = last ? nA : cA + (size_t)(t + 2) * kstep; const char* b2 = last ? nB : cB + (size_t)(t + 2) * kstep;
            const char* a3 = a2 + kstep; const char* b3 = b2 + kstep;
            PG8_LDB(B0, 0, 0); PG8_SCHED; PG8_LDA(At, 0, 0); PG8_STAGE(PG8_SA(1, 1), a1 + hstep, voffA);
            PG8_WAIT_L(8); PG8_BAR; PG8_WAIT_L(0); PG8_MMA(0, 0, At, B0); PG8_BAR; PG8_SCHED;
            PG8_LDB(B1, 0, 1); PG8_STAGE(PG8_SB(0, 0), b2, voffB);
            PG8_BAR; PG8_WAIT_L(0); PG8_MMA(0, 1, At, B1); PG8_BAR;
            PG8_LDA(At, 0, 1); PG8_STAGE(PG8_SA(0, 0), a2, voffA);
            PG8_BAR; PG8_WAIT_L(0); PG8_MMA(1, 0, At, B0); PG8_BAR; PG8_SCHED;
            PG8_STAGE(PG8_SB(0, 1), b2 + hstep, voffB);
            PG8_WAIT_V(6); PG8_BAR; PG8_MMA(1, 1, At, B1); PG8_BAR;
            PG8_LDB(B0, 1, 0); PG8_SCHED; PG8_LDA(At, 1, 0); PG8_STAGE(PG8_SA(0, 1), a2 + hstep, voffA);
            PG8_WAIT_L(8); PG8_BAR; PG8_WAIT_L(0); PG8_MMA(0, 0, At, B0); PG8_BAR; PG8_SCHED;
            PG8_LDB(B1, 1, 1); PG8_STAGE(PG8_SB(1, 0), b3, voffB);
            PG8_BAR; PG8_WAIT_L(0); PG8_MMA(0, 1, At, B1); PG8_BAR;
            PG8_LDA(At, 1, 1); PG8_STAGE(PG8_SA(1, 0), a3, voffA);
            PG8_BAR; PG8_WAIT_L(0); PG8_MMA(1, 0, At, B0); PG8_BAR; PG8_SCHED;
            PG8_STAGE(PG8_SB(1, 1), b3 + hstep, voffB);
            PG8_WAIT_V(6); PG8_BAR; PG8_MMA(1, 1, At, B1); PG8_BAR;
        }
        const bool keep = E(acc, cur, wr, wc, fr, fq);
        if (!has_next) break;
        if (!keep) {
#pragma unroll
            for (int a = 0; a < 2; ++a)
#pragma unroll
                for (int b = 0; b < 2; ++b)
#pragma unroll
                    for (int m = 0; m < 4; ++m)
#pragma unroll
                        for (int n = 0; n < 2; ++n) acc[a][b][m][n] = (f32x4){0.f, 0.f, 0.f, 0.f};
        }
        cur = nxt; cA = nA; cB = nB; ++ui;
    }
    PG8_WAIT_V(0);
    if (wr == 0) PG8_BAR;
    PG8_BAR;
#undef PG8_SA
#undef PG8_SB
#undef PG8_STAGE
#undef PG8_LDA
#undef PG8_LDB
#undef PG8_MMA
#undef PG8_WAIT_V
#undef PG8_WAIT_L
#undef PG8_BAR
#undef PG8_SCHED
}
}
using pg8::Unit;

struct Sched1 {
    const char *H, *WIN, *MEMN, *WK, *WV; int G, c;
    __device__ __forceinline__ bool next(int i, Unit& u) const {
        const int L = i * G + c; if (L >= 1936) return false;
        if (L < 1904) {
            const int nM = 34, nN = 56, nwg = 1904, NX = 8, WGM = 8;
            int wgid = L; { const int q = nwg / NX, r = nwg % NX, xcd = wgid % NX, off = wgid / NX; wgid = (xcd < r ? xcd * (q + 1) : r * (q + 1) + (xcd - r) * q) + off; }
            const int nig = WGM * nN, gid = wgid / nig, fm = gid * WGM, gsz = (nM - fm) < WGM ? (nM - fm) : WGM;
            u.pm = fm + ((wgid % nig) % gsz); u.pn = (wgid % nig) / gsz; u.kind = 0;
            u.a = H + (size_t)u.pm * 1048576; u.b = WIN + (size_t)u.pn * 1048576;
        } else if (L < 1920) { const int j = L - 1904; u.pm = j >> 2; u.pn = j & 3; u.kind = 1; u.a = MEMN + (size_t)u.pm * 1048576; u.b = WK + (size_t)u.pn * 1048576; }
        else { const int j = L - 1920; u.pm = j >> 2; u.pn = j & 3; u.kind = 2; u.a = WV + (size_t)u.pm * 1048576; u.b = MEMN + (size_t)u.pn * 1048576; }
        return true;
    }
};
struct Epi1 {
    bf16_t* PROJ; float* outK; bf16_t* KB; float* outV; bf16_t* VT;
    __device__ __forceinline__ bool operator()(f32x4 (&acc)[2][2][4][2], const Unit& u, int wr, int wc, int fr, int fq) const {
        const int r0 = u.pm * 256 + wr * 64 + fr, c0 = u.pn * 256 + wc * 32 + 8 * fq;
        if (u.kind == 0) {
#pragma unroll
            for (int ai = 0; ai < 2; ++ai)
#pragma unroll
                for (int m = 0; m < 4; ++m) { bf16_t* rowp = PROJ + (size_t)(r0 + ai * 128 + m * 16) * NIN + c0;
#pragma unroll
                    for (int bj = 0; bj < 2; ++bj) *(u32x4*)(rowp + bj * 128) = pack8u(acc[ai][bj][m][0], acc[ai][bj][m][1]); }
        } else if (u.kind == 1) {
#pragma unroll
            for (int ai = 0; ai < 2; ++ai)
#pragma unroll
                for (int m = 0; m < 4; ++m) { const size_t off = (size_t)(r0 + ai * 128 + m * 16) * 1024 + c0;
#pragma unroll
                    for (int bj = 0; bj < 2; ++bj) { *(f32x4*)(outK + off + bj * 128) = acc[ai][bj][m][0]; *(f32x4*)(outK + off + bj * 128 + 4) = acc[ai][bj][m][1];
                        *(u32x4*)(KB + off + bj * 128) = pack8u(acc[ai][bj][m][0], acc[ai][bj][m][1]); } }
        } else {
            const int h = u.pm, b = u.pn;
#pragma unroll
            for (int ai = 0; ai < 2; ++ai)
#pragma unroll
                for (int m = 0; m < 4; ++m) { const int d = wr * 64 + fr + ai * 128 + m * 16;
#pragma unroll
                    for (int bj = 0; bj < 2; ++bj) { const int key0 = wc * 32 + 8 * fq + bj * 128;
                        *(u32x4*)(VT + ((size_t)((b * 4 + h) * 256 + d)) * 256 + key0) = pack8u(acc[ai][bj][m][0], acc[ai][bj][m][1]);
                        float* fp = outV + ((size_t)(b * 256 + key0)) * 1024 + h * 256 + d;
#pragma unroll
                        for (int e = 0; e < 4; ++e) { fp[(size_t)e * 1024] = acc[ai][bj][m][0][e]; fp[(size_t)(e + 4) * 1024] = acc[ai][bj][m][1][e]; } } }
        }
        return false;
    }
};

struct Sched2 {
    const char* ws; int G, c;
    __device__ __forceinline__ bool next(int i, Unit& u) const {
        const int L = i * G + c; if (L >= 1088) return false;
        if (L < 544) { u.pm = L >> 4; u.pn = L & 15; u.kind = 0; u.a = ws + WS_YS + (size_t)u.pm * 524288; u.b = ws + WS_WG + (size_t)u.pn * 524288; }
        else { const int j = L - 544, k = j >= 272 ? 1 : 0, jj = j - 272 * k; u.pm = jj >> 3; u.pn = jj & 7; u.kind = 1 + k;
            u.a = ws + WS_ACONV + (size_t)k * ((size_t)MTOK * 1024 * 2) + (size_t)u.pm * 524288; u.b = ws + WS_WC + (size_t)k * 4194304 + (size_t)u.pn * 524288; }
        return true;
    }
};
struct Epi2 {
    bf16_t* GLU; bf16_t* CONVO; bf16_t* ATTO;
    __device__ __forceinline__ bool operator()(f32x4 (&acc)[2][2][4][2], const Unit& u, int wr, int wc, int fr, int fq) const {
        const int r0 = u.pm * 256 + wr * 64 + fr;
        if (u.kind == 0) {
            const int c0 = u.pn * 128 + wc * 32 + 8 * fq;
#pragma unroll
            for (int ai = 0; ai < 2; ++ai)
#pragma unroll
                for (int m = 0; m < 4; ++m) {
                    f32x4 t0, t1;
#pragma unroll
                    for (int e = 0; e < 4; ++e) { t0[e] = acc[ai][0][m][0][e] * sigmoidf_(acc[ai][1][m][0][e]); t1[e] = acc[ai][0][m][1][e] * sigmoidf_(acc[ai][1][m][1][e]); }
                    *(u32x4*)(GLU + (size_t)(r0 + ai * 128 + m * 16) * 2048 + c0) = pack8u(t0, t1);
                }
        } else {
            bf16_t* O = u.kind == 1 ? CONVO : ATTO; const int c0 = u.pn * 256 + wc * 32 + 8 * fq;
#pragma unroll
            for (int ai = 0; ai < 2; ++ai)
#pragma unroll
                for (int m = 0; m < 4; ++m) { bf16_t* rowp = O + (size_t)(r0 + ai * 128 + m * 16) * 2048 + c0;
#pragma unroll
                    for (int bj = 0; bj < 2; ++bj) *(u32x4*)(rowp + bj * 128) = pack8u(acc[ai][bj][m][0], acc[ai][bj][m][1]); }
        }
        return false;
    }
};
__device__ __forceinline__ void merge_phase(const P& p) {
    const bf16_t* PROJ = (const bf16_t*)(p.ws + WS_PROJ); const bf16_t* GLU = (const bf16_t*)(p.ws + WS_GLU); const bf16_t* CONVO = (const bf16_t*)(p.ws + WS_CONVO);
    const bf16_t* ATTO = (const bf16_t*)(p.ws + WS_ATTO); bf16_t* MERGED = (bf16_t*)(p.ws + WS_MERGED);
    const int NT = MTOK * 256, stride = gridDim.x * 512;
    for (int t = blockIdx.x * 512 + otid(); t < NT; t += 2 * stride) {
        u32x4 L[2][6]; const int t1 = t + stride; const bool has1 = t1 < NT;
#pragma unroll
        for (int k = 0; k < 2; ++k) { const int tt = k == 0 ? t : (has1 ? t1 : t);
            const size_t row = (size_t)(tt >> 8); const int c0 = (tt & 255) * 8; const bf16_t* pr = PROJ + row * NIN + OFF_G + c0; const size_t o = row * 2048 + c0;
            L[k][0] = *(const u32x4*)pr; L[k][1] = *(const u32x4*)(pr + 2048); L[k][2] = *(const u32x4*)(pr + 4096);
            L[k][3] = *(const u32x4*)(CONVO + o); L[k][4] = *(const u32x4*)(GLU + o); L[k][5] = *(const u32x4*)(ATTO + o); }
#pragma unroll
        for (int k = 0; k < 2; ++k) { if (k == 1 && !has1) break; const int tt = k == 0 ? t : t1;
            const size_t row = (size_t)(tt >> 8); const int c0 = (tt & 255) * 8; const size_t o = row * 2048 + c0;
            float g0[8], g1[8], g2[8], cv[8], gl[8], at[8];
            unpack8(L[k][0], g0); unpack8(L[k][1], g1); unpack8(L[k][2], g2); unpack8(L[k][3], cv); unpack8(L[k][4], gl); unpack8(L[k][5], at);
            f32x4 m0, m1;
#pragma unroll
            for (int e = 0; e < 8; ++e) { const float v = sigmoidf_(g0[e]) * cv[e] + sigmoidf_(g1[e]) * gl[e] + sigmoidf_(g2[e]) * at[e]; if (e < 4) m0[e] = v; else m1[e - 4] = v; }
            *(u32x4*)(MERGED + o) = pack8u(m0, m1); }
    }
}

struct Sched3 {
    const char *MERGED, *WO; int G, c;
    __device__ __forceinline__ bool next(int i, Unit& u) const {
        const int L = i * G + c; if (L >= 256) return false;
        u.pm = L >> 3; u.pn = L & 7; u.kind = 0; u.a = MERGED + (size_t)u.pm * 1048576; u.b = WO + (size_t)u.pn * 1048576; return true;
    }
};
struct Sched3b {
    const char *MERGED, *WO; int G, c;
    __device__ __forceinline__ bool next(int i, Unit& u) const {
        const int L = i * G + c; if (L >= 128) return false;
        const int tile = L >> 3, ks = L & 7; u.pm = 32 + (tile >> 3); u.pn = tile & 7; u.kind = ks;
        u.a = MERGED + (size_t)u.pm * 1048576 + (size_t)ks * 512; u.b = WO + (size_t)u.pn * 1048576 + (size_t)ks * 512; return true;
    }
};
struct Epi3 {
    bf16_t* delta; float* part;
    bool sample;
    __device__ __forceinline__ bool operator()(f32x4 (&acc)[2][2][4][2], const Unit& u, int wr, int wc, int fr, int fq) const {
        const int r0 = u.pm * 256 + wr * 64 + fr, c0 = u.pn * 256 + wc * 32 + 8 * fq;
        if (!sample) {
#pragma unroll
            for (int ai = 0; ai < 2; ++ai)
#pragma unroll
                for (int m = 0; m < 4; ++m) { bf16_t* o = delta + (size_t)(r0 + ai * 128 + m * 16) * DM + c0;
#pragma unroll
                    for (int bj = 0; bj < 2; ++bj) *(u32x4*)(o + bj * 128) = pack8u(acc[ai][bj][m][0], acc[ai][bj][m][1]); }
        } else {
            float* base = part + ((size_t)u.kind * 512 - NPROMPT) * DM;
#pragma unroll
            for (int ai = 0; ai < 2; ++ai)
#pragma unroll
                for (int m = 0; m < 4; ++m) {
                    float* o = base + (size_t)(r0 + ai * 128 + m * 16) * DM + c0;
#pragma unroll
                    for (int bj = 0; bj < 2; ++bj)
#pragma unroll
                        for (int n = 0; n < 2; ++n) *(f32x4*)(o + bj * 128 + 4 * n) = acc[ai][bj][m][n];
                }
        }
        return false;
    }
};

__device__ __forceinline__ void transpose_tile(const float* __restrict__ src, const int K, const int N, bf16_t* __restrict__ dst, const int mode, const int t, LAS float* tile) {
    const int tid = otid(); const int tn = N / 256;
    const int r = tid >> 3, c8 = (tid & 7) * 8;
    const int k0 = (t / tn) * 64, n0 = (t % tn) * 256;
    const float* s = src + (size_t)(k0 + r) * N + n0 + c8;
    f32x4 v[8];
#pragma unroll
    for (int j = 0; j < 4; ++j) { v[2 * j] = *(const f32x4*)(s + j * 64); v[2 * j + 1] = *(const f32x4*)(s + j * 64 + 4); }
#pragma unroll
    for (int j = 0; j < 4; ++j)
#pragma unroll
        for (int e = 0; e < 4; ++e) { tile[j * 4160 + r * 65 + c8 + e] = v[2 * j][e]; tile[j * 4160 + r * 65 + c8 + 4 + e] = v[2 * j + 1][e]; }
    __syncthreads();
#pragma unroll
    for (int j = 0; j < 4; ++j) {
        f32x4 a, b;
#pragma unroll
        for (int e = 0; e < 4; ++e) { a[e] = tile[j * 4160 + (c8 + e) * 65 + r]; b[e] = tile[j * 4160 + (c8 + 4 + e) * 65 + r]; }
        const int n = n0 + j * 64 + r;
        const int row = mode == 0 ? n : ((n >> 7) * 256 + (mode - 1) * 128 + (n & 127));
        *(u32x4*)(dst + (size_t)row * K + k0 + c8) = pack8u(a, b);
    }
    __syncthreads();
}
__device__ __forceinline__ void tload_win(const float* w_in, int t, int r, int c8, f32x4 (&v)[8]) {
    const int k0 = (t / 56) * 64, n0 = (t % 56) * 256;
    const float* s = w_in + (size_t)(k0 + r) * NIN + n0 + c8;
#pragma unroll
    for (int j = 0; j < 4; ++j) { v[2 * j] = *(const f32x4*)(s + j * 64); v[2 * j + 1] = *(const f32x4*)(s + j * 64 + 4); }
}
__device__ __forceinline__ void phase0(const P& p, LAS unsigned char* lds) {
    unsigned char* ws = p.ws; LAS float* tile = (LAS float*)lds;
    {
        const int tid = otid(); const int r = tid >> 3, c8 = (tid & 7) * 8;
        bf16_t* dst = (bf16_t*)(ws + WS_WIN);
        int j = blockIdx.x; f32x4 v[8];
        if (j < 1792) tload_win(p.w_in, j, r, c8, v);
        while (j < 1792) {
#pragma unroll
            for (int q = 0; q < 4; ++q)
#pragma unroll
                for (int e = 0; e < 4; ++e) { tile[q * 4160 + r * 65 + c8 + e] = v[2 * q][e]; tile[q * 4160 + r * 65 + c8 + 4 + e] = v[2 * q + 1][e]; }
            const int jn = j + gridDim.x;
            if (jn < 1792) tload_win(p.w_in, jn, r, c8, v);
            __syncthreads();
            const int k0 = (j / 56) * 64, n0 = (j % 56) * 256;
#pragma unroll
            for (int q = 0; q < 4; ++q) {
                f32x4 a, b;
#pragma unroll
                for (int e = 0; e < 4; ++e) { a[e] = tile[q * 4160 + (c8 + e) * 65 + r]; b[e] = tile[q * 4160 + (c8 + 4 + e) * 65 + r]; }
                *(u32x4*)(dst + (size_t)(n0 + q * 64 + r) * 2048 + k0 + c8) = pack8u(a, b);
            }
            __syncthreads();
            j = jn;
        }
    }
    for (int t = blockIdx.x; t < 256; t += gridDim.x) {
        if (t < 128) transpose_tile(p.w_mem_k, 2048, 1024, (bf16_t*)(ws + WS_WK), 0, t, tile);
        else transpose_tile(p.w_mem_v, 2048, 1024, (bf16_t*)(ws + WS_WV), 0, t - 128, tile);
    }
    const int t0 = otid(); const int lane = t0 & 63, gw = blockIdx.x * 8 + (t0 >> 6), nw = gridDim.x * 8;
    auto rowsrc = [&](int row) -> const float* { return row < NPROMPT ? p.x_prompt + (size_t)row * DM : (row < MTOK ? p.x_sample + (size_t)(row - NPROMPT) * DM : p.mem_prompt + (size_t)(row - MTOK) * DM); };
    f32x4 v[8], vn[8];
    if (gw < MTOK + 1024) { const float* src = rowsrc(gw);
#pragma unroll
        for (int i = 0; i < 8; ++i) v[i] = *(const f32x4*)(src + 4 * (lane + 64 * i)); }
    for (int row = gw; row < MTOK + 1024; row += nw) {
        const float* g = row < MTOK ? p.norm_g : p.mem_norm_g;
        bf16_t* dst = row < MTOK ? (bf16_t*)(ws + WS_H) + (size_t)row * DM : (bf16_t*)(ws + WS_MEMN) + (size_t)(row - MTOK) * DM;
        if (row + nw < MTOK + 1024) { const float* src = rowsrc(row + nw);
#pragma unroll
            for (int i = 0; i < 8; ++i) vn[i] = *(const f32x4*)(src + 4 * (lane + 64 * i)); }
        float s = 0.f;
#pragma unroll
        for (int i = 0; i < 8; ++i) s += (v[i][0] * v[i][0] + v[i][1] * v[i][1]) + (v[i][2] * v[i][2] + v[i][3] * v[i][3]);
#pragma unroll
        for (int o = 32; o >= 1; o >>= 1) s += __shfl_xor(s, o);
        const float rstd = 1.0f / sqrtf(s * (1.0f / 2048.0f) + 1e-6f);
#pragma unroll
        for (int i = 0; i < 8; ++i) { const f32x4 gv = *(const f32x4*)(g + 4 * (lane + 64 * i));
            u32x2 w; w.x = cvt_pk_bf16(v[i][0] * rstd * gv[0], v[i][1] * rstd * gv[1]); w.y = cvt_pk_bf16(v[i][2] * rstd * gv[2], v[i][3] * rstd * gv[3]);
            *(u32x2*)(dst + 4 * (lane + 64 * i)) = w; }
#pragma unroll
        for (int i = 0; i < 8; ++i) v[i] = vn[i];
    }
}

__device__ __forceinline__ void late_transposes(const P& p, LAS unsigned char* lds, const int first, const int stride) {
    unsigned char* ws = p.ws; LAS float* tile = (LAS float*)lds;
    for (int t = first; t < 768; t += stride) {
        if (t < 128) transpose_tile(p.w_conv_out, 1024, 2048, (bf16_t*)(ws + WS_WC), 0, t, tile);
        else if (t < 256) transpose_tile(p.w_attn_out, 1024, 2048, (bf16_t*)(ws + WS_WA), 0, t - 128, tile);
        else if (t < 384) transpose_tile(p.w_glu_a, 1024, 2048, (bf16_t*)(ws + WS_WG), 1, t - 256, tile);
        else if (t < 512) transpose_tile(p.w_glu_b, 1024, 2048, (bf16_t*)(ws + WS_WG), 2, t - 384, tile);
        else transpose_tile(p.w_out, 2048, 2048, (bf16_t*)(ws + WS_WO), 0, t - 512, tile);
    }
}

template <int LEN, bool PROMPT>
__device__ __forceinline__ void conv_task(const P& p, const int r0, const int cgp, const int bs) {
    const bf16_t* PROJ = (const bf16_t*)(p.ws + WS_PROJ); bf16_t* ACONV = (bf16_t*)(p.ws + WS_ACONV);
    const int c0 = cgp * 8;
    const bf16_t* pr = PROJ + (size_t)r0 * NIN + c0;
    u32x4 lcb[LEN], lcz[LEN], lcc[LEN + 2], lch[LEN + 2];
    const bool has_halo = PROMPT && (r0 & 2047) != 0;
#pragma unroll
    for (int i = 0; i < LEN; ++i) { lcb[i] = *(const u32x4*)(pr + (size_t)i * NIN + OFF_CB); lcz[i] = *(const u32x4*)(pr + (size_t)i * NIN + OFF_CZ);
        lcc[i + 2] = *(const u32x4*)(pr + (size_t)i * NIN + OFF_CC); lch[i + 2] = *(const u32x4*)(pr + (size_t)i * NIN + OFF_CH); }
#pragma unroll
    for (int i = 0; i < 2; ++i) { lcc[i] = (u32x4){0u, 0u, 0u, 0u}; lch[i] = lcc[i];
        if (has_halo) { lcc[i] = *(const u32x4*)(pr - (size_t)(2 - i) * NIN + OFF_CC); lch[i] = *(const u32x4*)(pr - (size_t)(2 - i) * NIN + OFF_CH); } }
    float w0[8], w1[8], w2[8], vm2[8], vm1[8];
    { const f32x4 a0 = *(const f32x4*)(p.conv_w + c0), a1 = *(const f32x4*)(p.conv_w + c0 + 4), b0 = *(const f32x4*)(p.conv_w + 1024 + c0), b1 = *(const f32x4*)(p.conv_w + 1024 + c0 + 4),
          d0 = *(const f32x4*)(p.conv_w + 2048 + c0), d1 = *(const f32x4*)(p.conv_w + 2048 + c0 + 4);
#pragma unroll
      for (int e = 0; e < 4; ++e) { w0[e] = a0[e]; w0[e + 4] = a1[e]; w1[e] = b0[e]; w1[e + 4] = b1[e]; w2[e] = d0[e]; w2[e + 4] = d1[e]; } }
    if (PROMPT) {
        float a[8], b[8];
        unpack8(lcc[0], a); unpack8(lch[0], b);
#pragma unroll
        for (int e = 0; e < 8; ++e) vm2[e] = a[e] * b[e];
        unpack8(lcc[1], a); unpack8(lch[1], b);
#pragma unroll
        for (int e = 0; e < 8; ++e) vm1[e] = a[e] * b[e];
    } else {
        const float* sc = p.state_conv + (size_t)bs * 2048 + c0;
        const f32x4 a0 = *(const f32x4*)sc, a1 = *(const f32x4*)(sc + 4), b0 = *(const f32x4*)(sc + 1024), b1 = *(const f32x4*)(sc + 1028);
#pragma unroll
        for (int e = 0; e < 4; ++e) { vm2[e] = a0[e]; vm2[e + 4] = a1[e]; vm1[e] = b0[e]; vm1[e + 4] = b1[e]; }
    }
#pragma unroll
    for (int i = 0; i < LEN; ++i) {
        const size_t row = (size_t)(r0 + i);
        float cb[8], cc[8], ch[8], cz[8], v[8];
        unpack8(lcb[i], cb); unpack8(lcc[i + 2], cc); unpack8(lch[i + 2], ch); unpack8(lcz[i], cz);
        f32x4 o0, o1;
#pragma unroll
        for (int e = 0; e < 8; ++e) { v[e] = cc[e] * ch[e]; const float cv = w0[e] * vm2[e] + w1[e] * vm1[e] + w2[e] * v[e]; const float r = cb[e] * cv * siluf_(cz[e]);
            if (e < 4) o0[e] = r; else o1[e - 4] = r; vm2[e] = vm1[e]; vm1[e] = v[e]; }
        *(u32x4*)(ACONV + row * 1024 + c0) = pack8u(o0, o1);
        float* dst = nullptr;
        if (PROMPT) { const int pos = (r0 + i) & 2047; if (pos >= 2046) dst = p.out + O_CP + ((size_t)((r0 + i) >> 11) * 2 + (pos - 2046)) * 1024 + c0; }
        else if (i >= 2) dst = p.out + O_CS + ((size_t)bs * 2 + (i - 2)) * 1024 + c0;
        if (dst) { *(f32x4*)dst = (f32x4){v[0], v[1], v[2], v[3]}; *(f32x4*)(dst + 4) = (f32x4){v[4], v[5], v[6], v[7]}; }
    }
}
__device__ __forceinline__ void conv_phase(const P& p) {
    const int t0 = blockIdx.x * 512 + otid(), nt = gridDim.x * 512;
    for (int task = t0; task < 262144; task += nt) conv_task<4, true>(p, (task >> 7) * 4, task & 127, 0);
    for (int task = t0; task < 16384; task += nt) conv_task<4, false>(p, NPROMPT + 4 * (task >> 7), task & 127, task >> 7);
}

struct S5In { bf16x8 U[4]; u32x2 u4[4], z4[4]; };
__device__ __forceinline__ void s5_load4(S5In& in, const bf16_t* PROJ, const size_t row0, const int g, const int g4) {
    const bf16_t* base = PROJ + row0 * NIN + g * 16;
#pragma unroll
    for (int i = 0; i < 4; ++i) {
        in.U[i] = *(const bf16x8*)(base + (size_t)i * NIN + OFF_SU + 8 * (g4 & 1));
        in.u4[i] = *(const u32x2*)(base + (size_t)i * NIN + OFF_SU + 4 * g4); in.z4[i] = *(const u32x2*)(base + (size_t)i * NIN + OFF_SZ + 4 * g4);
    }
}
__device__ __forceinline__ void s5_steps4(const S5In& in, bf16_t* YS, const size_t row0, const int g, const int g4, const bool Y,
                                          const bf16x8 (&bre)[4], const bf16x8 (&bim)[4], const bf16x8 (&cf)[4], const float (&ar)[16], const float (&ai)[16], const f32x4 dsk,
                                          float (&sr)[16], float (&si)[16]) {
    const f32x4 zero4 = (f32x4){0.f, 0.f, 0.f, 0.f};
#pragma unroll
    for (int i = 0; i < 4; ++i) {
#pragma unroll
        for (int pb = 0; pb < 4; ++pb) {
            const f32x4 xr = MFMA16(bre[pb], in.U[i], zero4), xi = MFMA16(bim[pb], in.U[i], zero4);
#pragma unroll
            for (int j = 0; j < 4; ++j) { const int k = pb * 4 + j; const float nr = ar[k] * sr[k] - ai[k] * si[k] + xr[j]; const float ni = ar[k] * si[k] + ai[k] * sr[k] + xi[j]; sr[k] = nr; si[k] = ni; }
        }
        if (Y) {
            f32x4 y = zero4;
            y = MFMA16(cf[0], pack8((f32x4){sr[0], sr[1], sr[2], sr[3]}, (f32x4){sr[4], sr[5], sr[6], sr[7]}), y);
            y = MFMA16(cf[1], pack8((f32x4){sr[8], sr[9], sr[10], sr[11]}, (f32x4){sr[12], sr[13], sr[14], sr[15]}), y);
            y = MFMA16(cf[2], pack8((f32x4){si[0], si[1], si[2], si[3]}, (f32x4){si[4], si[5], si[6], si[7]}), y);
            y = MFMA16(cf[3], pack8((f32x4){si[8], si[9], si[10], si[11]}, (f32x4){si[12], si[13], si[14], si[15]}), y);
            const float uu[4] = {bf_lo(in.u4[i].x), bf_hi(in.u4[i].x), bf_lo(in.u4[i].y), bf_hi(in.u4[i].y)};
            const float zz[4] = {bf_lo(in.z4[i].x), bf_hi(in.z4[i].x), bf_lo(in.z4[i].y), bf_hi(in.z4[i].y)};
            float o[4];
#pragma unroll
            for (int j = 0; j < 4; ++j) { const float ysv = y[j] + dsk[j] * uu[j]; o[j] = gelu_tanh(ysv * siluf_(zz[j])); }
            u32x2 w; w.x = cvt_pk_bf16(o[0], o[1]); w.y = cvt_pk_bf16(o[2], o[3]);
            *(u32x2*)(YS + (row0 + i) * 1024 + g * 16 + 4 * g4) = w;
        }
    }
}
__device__ __forceinline__ void s5_coef(const P& p, int g, int pp, float dt, float& ar, float& ai, float& fr, float& fi) {
    const float lr = p.lam_re[g * 64 + pp], li = p.lam_im[g * 64 + pp];
    const float mag = expf(lr * dt), ang = li * dt; float sn, cs; sincosf(ang, &sn, &cs);
    ar = mag * cs; ai = mag * sn; const float den = lr * lr + li * li;
    fr = ((ar - 1.0f) * lr + ai * li) / den; fi = (ai * lr - (ar - 1.0f) * li) / den;
}
__device__ __forceinline__ void s5_unit(const P& p, const int unit, LAS unsigned char* lds) {
    const bf16_t* PROJ = (const bf16_t*)(p.ws + WS_PROJ); bf16_t* YS = (bf16_t*)(p.ws + WS_YS);
    const int tid = otid(), lane = tid & 63, w = tid >> 6, cl = lane & 15, g4 = lane >> 4;
    const bool prompt = unit < 256; const int g = prompt ? (unit & 63) : (unit - 256); const int b = unit >> 6;
    const float dt = expf(p.log_dt[g]);
    LAS float* E = (LAS float*)lds;
    LAS f32x4* CT = (LAS f32x4*)(lds + 65536);
    if (tid < 64) { float a_r, a_i, fr_, fi_; s5_coef(p, g, tid, dt, a_r, a_i, fr_, fi_); CT[tid] = (f32x4){a_r, a_i, fr_, fi_}; }
    __syncthreads();
    float ar[16], ai[16];
#pragma unroll
    for (int pb = 0; pb < 4; ++pb)
#pragma unroll
        for (int j = 0; j < 4; ++j) { const f32x4 t = CT[16 * pb + 4 * g4 + j]; ar[pb * 4 + j] = t[0]; ai[pb * 4 + j] = t[1]; }
    bf16x8 bre[4], bim[4], cf[4];
    const float bmask = g4 < 2 ? 1.0f : 0.0f;
#pragma unroll
    for (int pb = 0; pb < 4; ++pb) {
        const int pp = 16 * pb + cl; const f32x4 t = CT[pp]; const float fr_ = t[2] * bmask, fi_ = t[3] * bmask;
        const float* br = p.b_re + ((size_t)(g * 64 + pp)) * 16 + 8 * (g4 & 1); const float* bi = p.b_im + ((size_t)(g * 64 + pp)) * 16 + 8 * (g4 & 1);
        const f32x4 r0 = *(const f32x4*)br, r1 = *(const f32x4*)(br + 4), i0 = *(const f32x4*)bi, i1 = *(const f32x4*)(bi + 4);
        bre[pb] = pack8(fr_ * r0 - fi_ * i0, fr_ * r1 - fi_ * i1);
        bim[pb] = pack8(fr_ * i0 + fi_ * r0, fr_ * i1 + fi_ * r1);
    }
#pragma unroll
    for (int ks = 0; ks < 4; ++ks) {
        const float* cp = (ks < 2 ? p.c_re : p.c_im) + ((size_t)(g * 16 + cl)) * 64 + 32 * (ks & 1) + 4 * g4;
        f32x4 a = *(const f32x4*)cp, c = *(const f32x4*)(cp + 16);
        if (ks >= 2) { a = -a; c = -c; }
        cf[ks] = pack8(a, c);
    }
    const f32x4 dsk = *(const f32x4*)(p.ssm_d + g * 16 + 4 * g4);
    const int chain = 16 * w + cl;
    const size_t row0 = prompt ? (size_t)b * 2048 + (size_t)chain * 16 : (size_t)NPROMPT + 4 * chain;
    const size_t so = ((size_t)chain * 64 + g) * 64 + 4 * g4;
    const int nq = prompt ? 4 : 1;
    float sr[16], si[16];
#pragma unroll
    for (int k = 0; k < 16; ++k) { sr[k] = 0.f; si[k] = 0.f; }
    if (!prompt) {
#pragma unroll
        for (int pb = 0; pb < 4; ++pb) { const f32x4 a = *(const f32x4*)(p.state_re + so + 16 * pb), c = *(const f32x4*)(p.state_im + so + 16 * pb);
#pragma unroll
            for (int j = 0; j < 4; ++j) { sr[pb * 4 + j] = a[j]; si[pb * 4 + j] = c[j]; } }
    }
#pragma unroll 1
    for (int pass = prompt ? 0 : 1; pass < 2; ++pass) {
        if (pass == 1 && prompt) {
#pragma unroll
            for (int pb = 0; pb < 4; ++pb) {
                *(LAS f32x4*)(E + (chain * 2 + 0) * 64 + 16 * pb + 4 * g4) = (f32x4){sr[pb * 4], sr[pb * 4 + 1], sr[pb * 4 + 2], sr[pb * 4 + 3]};
                *(LAS f32x4*)(E + (chain * 2 + 1) * 64 + 16 * pb + 4 * g4) = (f32x4){si[pb * 4], si[pb * 4 + 1], si[pb * 4 + 2], si[pb * 4 + 3]};
            }
            __syncthreads();
            if (w == 0) {
                float a_r, a_i; { const f32x4 t = CT[lane]; a_r = t[0]; a_i = t[1]; }
#pragma unroll
                for (int q = 0; q < 4; ++q) { const float nr = a_r * a_r - a_i * a_i, ni = 2.0f * a_r * a_i; a_r = nr; a_i = ni; }
                float Fr = 0.f, Fi = 0.f;
#pragma unroll 8
                for (int k = 0; k < 128; ++k) {
                    const float er = E[(2 * k) * 64 + lane], ei = E[(2 * k + 1) * 64 + lane];
                    E[(2 * k) * 64 + lane] = Fr; E[(2 * k + 1) * 64 + lane] = Fi;
                    const float nr = a_r * Fr - a_i * Fi + er; Fi = a_r * Fi + a_i * Fr + ei; Fr = nr;
                }
                p.out[O_RP + (size_t)(b * 64 + g) * 64 + lane] = Fr; p.out[O_IP + (size_t)(b * 64 + g) * 64 + lane] = Fi;
            }
            __syncthreads();
#pragma unroll
            for (int pb = 0; pb < 4; ++pb) {
                const f32x4 a = *(LAS f32x4*)(E + (chain * 2 + 0) * 64 + 16 * pb + 4 * g4), c = *(LAS f32x4*)(E + (chain * 2 + 1) * 64 + 16 * pb + 4 * g4);
#pragma unroll
                for (int j = 0; j < 4; ++j) { sr[pb * 4 + j] = a[j]; si[pb * 4 + j] = c[j]; }
            }
        }
        S5In cur; s5_load4(cur, PROJ, row0, g, g4);
#pragma unroll 1
        for (int q = 0; q < nq; ++q) {
            S5In nxt = cur;
            if (q + 1 < nq) s5_load4(nxt, PROJ, row0 + 4 * (q + 1), g, g4);
            s5_steps4(cur, YS, row0 + 4 * q, g, g4, pass == 1, bre, bim, cf, ar, ai, dsk, sr, si);
            cur = nxt;
        }
    }
    if (!prompt) {
#pragma unroll
        for (int pb = 0; pb < 4; ++pb) {
            *(f32x4*)(p.out + O_RS + so + 16 * pb) = (f32x4){sr[pb * 4], sr[pb * 4 + 1], sr[pb * 4 + 2], sr[pb * 4 + 3]};
            *(f32x4*)(p.out + O_IS + so + 16 * pb) = (f32x4){si[pb * 4], si[pb * 4 + 1], si[pb * 4 + 2], si[pb * 4 + 3]};
        }
    }
    __syncthreads();
}

__device__ __forceinline__ void attn_prompt_unit(const P& p, const int unit, LAS unsigned char* lds) {
    const bf16_t* PROJ = (const bf16_t*)(p.ws + WS_PROJ); const bf16_t* KB = (const bf16_t*)(p.ws + WS_KB); const bf16_t* VT = (const bf16_t*)(p.ws + WS_VT);
    bf16_t* OATT = (bf16_t*)(p.ws + WS_OATT);
    const int tid = otid(), lane = tid & 63, w = tid >> 6, cl = lane & 15, g4 = lane >> 4;
    const int b = unit >> 6, h = (unit >> 4) & 3, qb = unit & 15;
    const bf16_t* kbase = KB + (size_t)(b * 256) * 1024 + h * 256;
#pragma unroll
    for (int i = 0; i < 16; ++i) { const int idx = tid + 512 * i, r = idx >> 5, m = idx & 31;
        const u32x4 v = *(const u32x4*)(kbase + (size_t)r * 1024 + m * 8); *(LAS u32x4*)(lds + r * 512 + ((m ^ (r & 15)) << 4)) = v; }
    const size_t qrow = (size_t)b * 2048 + qb * 128 + w * 16 + cl;
    const bf16_t* qp = PROJ + qrow * NIN + OFF_AQ + h * 256 + 8 * g4;
    bf16x8 qf[8];
#pragma unroll
    for (int ks = 0; ks < 8; ++ks) qf[ks] = *(const bf16x8*)(qp + 32 * ks);
    __syncthreads();
    f32x4 s[16];
#pragma unroll
    for (int kb = 0; kb < 16; ++kb) { s[kb] = (f32x4){0.f, 0.f, 0.f, 0.f};
#pragma unroll
        for (int ks = 0; ks < 8; ++ks) { const int key = 16 * kb + cl, m = 4 * ks + g4;
            const bf16x8 kf = *(const LAS bf16x8*)(lds + key * 512 + ((m ^ cl) << 4)); s[kb] = MFMA16(kf, qf[ks], s[kb]); }
        __builtin_amdgcn_sched_barrier(0); }
    __syncthreads();
    const bf16_t* vbase = VT + (size_t)((b * 4 + h) * 256) * 256;
    u32x4 vst[16];
#pragma unroll
    for (int i = 0; i < 16; ++i) { const int idx = tid + 512 * i, r = idx >> 5, m = idx & 31; vst[i] = *(const u32x4*)(vbase + (size_t)r * 256 + m * 8); }
    float mx = -3.0e38f;
#pragma unroll
    for (int kb = 0; kb < 16; ++kb)
#pragma unroll
        for (int j = 0; j < 4; ++j) mx = fmaxf(mx, s[kb][j]);
    mx = fmaxf(mx, __shfl_xor(mx, 16)); mx = fmaxf(mx, __shfl_xor(mx, 32));
    float sum = 0.f;
#pragma unroll
    for (int kb = 0; kb < 16; ++kb)
#pragma unroll
        for (int j = 0; j < 4; ++j) { const float e = __expf((s[kb][j] - mx) * 0.0625f); s[kb][j] = e; sum += e; }
    sum += __shfl_xor(sum, 16); sum += __shfl_xor(sum, 32);
    const float inv = rcp_(sum);
    bf16x8 pf[8];
#pragma unroll
    for (int kk = 0; kk < 8; ++kk) pf[kk] = pack8(s[2 * kk], s[2 * kk + 1]);
#pragma unroll
    for (int i = 0; i < 16; ++i) { const int idx = tid + 512 * i, r = idx >> 5, m = idx & 31; *(LAS u32x4*)(lds + r * 512 + ((m ^ (r & 15)) << 4)) = vst[i]; }
    __syncthreads();
    const bf16_t* azp = PROJ + qrow * NIN + OFF_AZ + h * 256 + 4 * g4;
    bf16_t* op = OATT + qrow * 1024 + h * 256 + 4 * g4;
#pragma unroll
    for (int db = 0; db < 16; ++db) {
        f32x4 o = (f32x4){0.f, 0.f, 0.f, 0.f}; const int d = 16 * db + cl;
#pragma unroll
        for (int kk = 0; kk < 8; ++kk) {
            const int ch0 = 8 * kk + g4, ch1 = ch0 + 4;
            const u32x2 lo = *(const LAS u32x2*)(lds + d * 512 + (((ch0 >> 1) ^ cl) << 4) + (ch0 & 1) * 8);
            const u32x2 hi = *(const LAS u32x2*)(lds + d * 512 + (((ch1 >> 1) ^ cl) << 4) + (ch1 & 1) * 8);
            const u32x4 vv = (u32x4){lo.x, lo.y, hi.x, hi.y};
            o = MFMA16(__builtin_bit_cast(bf16x8, vv), pf[kk], o);
        }
        const u32x2 az = *(const u32x2*)(azp + 16 * db);
        const float z[4] = {bf_lo(az.x), bf_hi(az.x), bf_lo(az.y), bf_hi(az.y)};
        u32x2 wv; wv.x = cvt_pk_bf16(o[0] * inv * siluf_(z[0]), o[1] * inv * siluf_(z[1])); wv.y = cvt_pk_bf16(o[2] * inv * siluf_(z[2]), o[3] * inv * siluf_(z[3]));
        *(u32x2*)(op + 16 * db) = wv;
        __builtin_amdgcn_sched_barrier(0);
    }
    __syncthreads();
}

__device__ __forceinline__ void attn_sample_pair(const P& p, const int u0, const int u1_, LAS unsigned char* lds) {
    const int u1 = u1_ < 512 ? u1_ : u0;
    const bf16_t* PROJ = (const bf16_t*)(p.ws + WS_PROJ); bf16_t* OATT = (bf16_t*)(p.ws + WS_OATT);
    const int tid = otid(), lane = tid & 63, w = tid >> 6, cl = lane & 15, g4 = lane >> 4;
    LAS float* Pw = (LAS float*)(lds + w * 512);
    LAS float* ST = (LAS float*)(lds + 4096);
    LAS float* OW = (LAS float*)(lds + 8192);
    f32x4 bA[16], bB[16], o[4], s0, s1;
    bf16x8 qf[8];
#define SA_LOADQ(unit) do { const bf16_t* qp_ = PROJ + ((size_t)NPROMPT + 4 * ((unit) >> 2) + (cl & 3)) * NIN + OFF_AQ + ((unit) & 3) * 256 + 8 * g4; \
        _Pragma("unroll") for (int ks = 0; ks < 8; ++ks) qf[ks] = *(const bf16x8*)(qp_ + 32 * ks); } while (0)
#define SA_LOADK(buf, unit, kblk) do { const float* kr_ = p.cache_k + ((size_t)((unit) >> 2) * 1024 + ((unit) & 3)) * 256 + (size_t)(32 * w + 16 * (kblk) + cl) * 1024 + 8 * g4; \
        _Pragma("unroll") for (int ks = 0; ks < 8; ++ks) { buf[2 * ks] = *(const f32x4*)(kr_ + 32 * ks); buf[2 * ks + 1] = *(const f32x4*)(kr_ + 32 * ks + 4); } } while (0)
#define SA_LOADV(buf, unit, half) do { const float* vr_ = p.cache_v + ((size_t)((unit) >> 2) * 1024 + ((unit) & 3)) * 256 + (size_t)(32 * w + 16 * (half)) * 1024 + 4 * lane; \
        _Pragma("unroll") for (int i = 0; i < 16; ++i) buf[i] = *(const f32x4*)(vr_ + (size_t)i * 1024); } while (0)
#define SA_QK(buf, sv) do { sv = (f32x4){0.f, 0.f, 0.f, 0.f}; _Pragma("unroll") for (int ks = 0; ks < 8; ++ks) sv = MFMA16(pack8(buf[2 * ks], buf[2 * ks + 1]), qf[ks], sv); } while (0)
#define SA_PV(buf, half) do { _Pragma("unroll") for (int ii = 0; ii < 4; ++ii) _Pragma("unroll") for (int q = 0; q < 4; ++q) { const f32x4 pv_ = *(const LAS f32x4*)(Pw + q * 32 + 16 * (half) + 4 * ii); \
        o[q] += pv_[0] * buf[4 * ii] + pv_[1] * buf[4 * ii + 1] + pv_[2] * buf[4 * ii + 2] + pv_[3] * buf[4 * ii + 3]; } } while (0)
#define SA_SOFTMAX(slot) do { float m_ = fmaxf(fmaxf(fmaxf(s0[0], s0[1]), fmaxf(s0[2], s0[3])), fmaxf(fmaxf(s1[0], s1[1]), fmaxf(s1[2], s1[3]))); \
        m_ = fmaxf(m_, __shfl_xor(m_, 16)); m_ = fmaxf(m_, __shfl_xor(m_, 32)); float l_ = 0.f; \
        _Pragma("unroll") for (int j = 0; j < 4; ++j) { s0[j] = __expf((s0[j] - m_) * 0.0625f); s1[j] = __expf((s1[j] - m_) * 0.0625f); l_ += s0[j] + s1[j]; } \
        l_ += __shfl_xor(l_, 16); l_ += __shfl_xor(l_, 32); \
        if (cl < 4) { *(LAS f32x4*)(Pw + cl * 32 + 4 * g4) = s0; *(LAS f32x4*)(Pw + cl * 32 + 16 + 4 * g4) = s1; \
            if (g4 == 0) { ST[(((slot) * 8 + w) * 4 + cl) * 2] = m_; ST[(((slot) * 8 + w) * 4 + cl) * 2 + 1] = l_; } } } while (0)
#define SA_OZERO() do { _Pragma("unroll") for (int q = 0; q < 4; ++q) o[q] = (f32x4){0.f, 0.f, 0.f, 0.f}; } while (0)
#define SA_OWRITE(slot) do { _Pragma("unroll") for (int q = 0; q < 4; ++q) *(LAS f32x4*)(OW + (size_t)((((slot) * 8 + w) * 4 + q) * 256) + 4 * lane) = o[q]; } while (0)
#define SA_SB() __builtin_amdgcn_sched_barrier(0)
    SA_LOADQ(u0);
    SA_LOADK(bA, u0, 0); SA_LOADK(bB, u0, 1); SA_SB();
    SA_QK(bA, s0); SA_LOADV(bA, u0, 0); SA_SB();
    SA_QK(bB, s1); SA_LOADV(bB, u0, 1); SA_SB();
    SA_SOFTMAX(0);
    SA_LOADQ(u1);
    SA_OZERO(); SA_SB();
    SA_PV(bA, 0); SA_LOADK(bA, u1, 0); SA_SB();
    SA_PV(bB, 1); SA_LOADK(bB, u1, 1); SA_SB();
    SA_OWRITE(0);
    {
        SA_QK(bA, s0); SA_LOADV(bA, u1, 0); SA_SB();
        SA_QK(bB, s1); SA_LOADV(bB, u1, 1); SA_SB();
        SA_SOFTMAX(1);
        SA_OZERO(); SA_SB();
        SA_PV(bA, 0); SA_SB();
        SA_PV(bB, 1);
        SA_OWRITE(1);
    }
    __syncthreads();
    {
        const int slot = tid >> 8, q = (tid >> 6) & 3, d = (tid & 63) * 4;
        const int unit = slot == 0 ? u0 : u1;
        {
            float M = -3.0e38f;
#pragma unroll
            for (int ww = 0; ww < 8; ++ww) M = fmaxf(M, ST[((slot * 8 + ww) * 4 + q) * 2]);
            float L = 0.f; f32x4 a = (f32x4){0.f, 0.f, 0.f, 0.f};
#pragma unroll
            for (int ww = 0; ww < 8; ++ww) { const float f = __expf((ST[((slot * 8 + ww) * 4 + q) * 2] - M) * 0.0625f); L += f * ST[((slot * 8 + ww) * 4 + q) * 2 + 1];
                a += f * *(const LAS f32x4*)(OW + (size_t)(((slot * 8 + ww) * 4 + q) * 256) + d); }
            const float inv = rcp_(L);
            const size_t row = (size_t)NPROMPT + 4 * (unit >> 2) + q; const int h = unit & 3;
            const u32x2 az = *(const u32x2*)(PROJ + row * NIN + OFF_AZ + h * 256 + d);
            u32x2 wv; wv.x = cvt_pk_bf16(a[0] * inv * siluf_(bf_lo(az.x)), a[1] * inv * siluf_(bf_hi(az.x))); wv.y = cvt_pk_bf16(a[2] * inv * siluf_(bf_lo(az.y)), a[3] * inv * siluf_(bf_hi(az.y)));
            *(u32x2*)(OATT + row * 1024 + h * 256 + d) = wv;
        }
    }
    __syncthreads();
#undef SA_LOADQ
#undef SA_LOADK
#undef SA_LOADV
#undef SA_QK
#undef SA_PV
#undef SA_SOFTMAX
#undef SA_OZERO
#undef SA_OWRITE
#undef SA_SB
}

__device__ __forceinline__ void phase5(const P& p) {
    const float* part = (const float*)(p.ws + WS_PART);
    const int t0 = otid(); const int lane = t0 & 63, gw = blockIdx.x * 8 + (t0 >> 6), nw = gridDim.x * 8;
    for (int row = gw; row < MTOK; row += nw) {
        float* orow = p.out + (size_t)row * DM;
        f32x4 v[8]; float s = 0.f;
        if (row < NPROMPT) {
            const float* xr = p.x_prompt + (size_t)row * DM; const bf16_t* dr = (const bf16_t*)(p.ws + WS_DELTA) + (size_t)row * DM;
#pragma unroll
            for (int i = 0; i < 8; ++i) { const u32x2 d = *(const u32x2*)(dr + 4 * (lane + 64 * i));
                v[i] = *(const f32x4*)(xr + 4 * (lane + 64 * i)) + (f32x4){bf_lo(d.x), bf_hi(d.x), bf_lo(d.y), bf_hi(d.y)}; }
        } else {
            const float* xr = p.x_sample + (size_t)(row - NPROMPT) * DM;
#pragma unroll
            for (int i = 0; i < 8; ++i) v[i] = *(const f32x4*)(xr + 4 * (lane + 64 * i));
#pragma unroll 2
            for (int ks = 0; ks < 8; ++ks) { const float* pr = part + ((size_t)ks * 512 + (row - NPROMPT)) * DM;
#pragma unroll
                for (int i = 0; i < 8; ++i) v[i] += *(const f32x4*)(pr + 4 * (lane + 64 * i)); }
        }
#pragma unroll
        for (int i = 0; i < 8; ++i) s += (v[i][0] * v[i][0] + v[i][1] * v[i][1]) + (v[i][2] * v[i][2] + v[i][3] * v[i][3]);
#pragma unroll
        for (int o = 32; o >= 1; o >>= 1) s += __shfl_xor(s, o);
        const float rstd = 1.0f / sqrtf(s * (1.0f / 2048.0f) + 1e-6f);
#pragma unroll
        for (int i = 0; i < 8; ++i) { const f32x4 gv = *(const f32x4*)(p.final_g + 4 * (lane + 64 * i)); *(f32x4*)(orow + 4 * (lane + 64 * i)) = v[i] * rstd * gv; }
    }
}

#define XB_TMO      128
#define XB_XCNT(j)  (256  + 64 * (j))
#define XB_XSUB(j)  (1280 + 64 * (j))
#define XB_XGEN(j)  (2304 + 64 * (j))
#define XB_TOP      3328
#define XB_TOPGEN   3392
#define XB_SPIN_CAP (1u << 20)
__device__ __forceinline__ unsigned xb_ld(unsigned* p)              { return __hip_atomic_load(p, __ATOMIC_RELAXED, __HIP_MEMORY_SCOPE_AGENT); }
__device__ __forceinline__ unsigned xb_add(unsigned* p, unsigned v) { return __hip_atomic_fetch_add(p, v, __ATOMIC_RELAXED, __HIP_MEMORY_SCOPE_AGENT); }
__device__ __forceinline__ unsigned xb_xcc_id() { return (unsigned)__builtin_amdgcn_s_getreg((3 << 11) | 20) & 0xFu; }
#define XB_SPIN(cond, bar) do { unsigned _sp = 0; while (cond) { __builtin_amdgcn_s_sleep(1); \
    if ((++_sp & 255u) == 0u) { if (xb_ld(&(bar)[XB_TMO])) break; if (_sp > XB_SPIN_CAP) { atomicAdd(&(bar)[XB_TMO], 1u); break; } } } } while (0)
struct XcdBarrier { unsigned* bar; unsigned x; volatile LAS unsigned* st; };
__device__ __forceinline__ XcdBarrier xcd_barrier_post(unsigned* bar, volatile LAS unsigned* st) {
    XcdBarrier b; b.bar = bar; b.x = xb_xcc_id(); b.st = st;
    if (threadIdx.x == 0) (void)xb_add(&bar[XB_XCNT(b.x)], 1u);
    return b;
}
__device__ __forceinline__ void xcd_barrier_complete(unsigned* bar, unsigned x, unsigned& nloc, unsigned& nx) {
    const unsigned G = gridDim.x * gridDim.y * gridDim.z;
    unsigned sum, cnt, mine, sp = 0u;
    for (;;) {
        sum = 0u; cnt = 0u; mine = 0u;
#pragma unroll
        for (unsigned j = 0; j < 16; ++j) { const unsigned c = xb_ld(&bar[XB_XCNT(j)]); sum += c; cnt += (c > 0u) ? 1u : 0u; mine = (j == x) ? c : mine; }
        if (sum == G) break;
        __builtin_amdgcn_s_sleep(1);
        if ((++sp & 255u) == 0u) { if (xb_ld(&bar[XB_TMO])) break; if (sp > XB_SPIN_CAP) { atomicAdd(&bar[XB_TMO], 1u); break; } }
    }
    nloc = mine > 0u ? mine : 1u; nx = cnt > 0u ? cnt : 1u;
}
__device__ __forceinline__ void xcd_barrier(const XcdBarrier& b) {
    asm volatile("s_waitcnt vmcnt(0)" ::: "memory");
    __syncthreads();
    if (threadIdx.x == 0) {
        unsigned* bar = b.bar;
        __builtin_amdgcn_s_waitcnt(0);
        unsigned nloc = b.st[0], nx = b.st[1];
        if (nloc == 0u) { xcd_barrier_complete(bar, b.x, nloc, nx); b.st[0] = nloc; b.st[1] = nx; }
        const unsigned old = xb_add(&bar[XB_XSUB(b.x)], 1u);
        const unsigned gen = old / nloc;
        if (old + 1u == (gen + 1u) * nloc) {
            __builtin_amdgcn_fence(__ATOMIC_RELEASE, "agent");
            asm volatile("s_waitcnt vmcnt(0)" ::: "memory");
            const unsigned og = xb_add(&bar[XB_TOP], 1u);
            const unsigned tg = og / nx;
            if (og + 1u == (tg + 1u) * nx) xb_add(&bar[XB_TOPGEN], 1u);
            else XB_SPIN(xb_ld(&bar[XB_TOPGEN]) == tg, bar);
            __builtin_amdgcn_fence(__ATOMIC_ACQUIRE, "agent");
            xb_add(&bar[XB_XGEN(b.x)], 1u);
            asm volatile("s_waitcnt vmcnt(0)" ::: "memory");
        } else {
            XB_SPIN(xb_ld(&bar[XB_XGEN(b.x)]) == gen, bar);
            __builtin_amdgcn_fence(__ATOMIC_ACQUIRE, "agent");
            asm volatile("s_waitcnt vmcnt(0)" ::: "memory");
        }
    }
    __syncthreads();
}

__global__ void __launch_bounds__(512, 2) mega_fwd(P p) {
    extern __shared__ __attribute__((aligned(16))) unsigned char shm[];
    LAS unsigned char* lds = (LAS unsigned char*)shm;
    cg::grid_group grid = cg::this_grid();
    unsigned char* ws = p.ws;
    const int G = gridDim.x, c = blockIdx.x;
    volatile LAS unsigned* bst = (volatile LAS unsigned*)(lds + 131072);
    if (threadIdx.x == 0) { bst[0] = 0u; bst[1] = 0u; }
    __syncthreads();
    const XcdBarrier xbar = xcd_barrier_post((unsigned*)(ws + WS_BAR), bst);
    if (p.out == nullptr) grid.sync();
#define GSYNC() xcd_barrier(xbar)

#ifndef PHMASK
#define PHMASK 0xffff
#endif
#ifndef REPMASK
#define REPMASK 0
#endif
#define NREP(bit) ((REPMASK & (bit)) ? 2 : 1)
#ifndef TPHASE
#define TPHASE -1
#endif
#ifndef TMULT
#define TMULT 4
#endif
    unsigned long long ts[8]; int nts = 0;
#define STAMP() do { if (TPHASE >= 0 && TPHASE < 10) { ts[nts] = wall_clock64(); } ++nts; } while (0)
    STAMP();
    for (int rep = 0; rep < NREP(1); ++rep) if (PHMASK & 1) phase0(p, lds);
    GSYNC(); STAMP();

    for (int rep = 0; rep < NREP(2); ++rep) if (PHMASK & 2) {
        Sched1 S{(const char*)(ws + WS_H), (const char*)(ws + WS_WIN), (const char*)(ws + WS_MEMN), (const char*)(ws + WS_WK), (const char*)(ws + WS_WV), G, c};
        Epi1 E{(bf16_t*)(ws + WS_PROJ), p.out + O_MK, (bf16_t*)(ws + WS_KB), p.out + O_MV, (bf16_t*)(ws + WS_VT)};
        pg8::gemm_phase(lds, 2048, 2048, S, E);
        const int nfull = 1936 % G;
        if (nfull > 0 && c >= nfull) late_transposes(p, lds, c - nfull, G - nfull); else if (nfull == 0) late_transposes(p, lds, c, G);
    }
    GSYNC(); STAMP();

    for (int rep = 0; rep < NREP(4); ++rep) {
        unsigned long long m0 = 0, m1 = 0, m2 = 0, m3 = 0, m4 = 0;
        if (TPHASE >= 10) m0 = wall_clock64();
        const int sg = (c >> 3) & 3;
        if (sg == 0) for (int u = c; u < 512; u += 2 * G) attn_sample_pair(p, u, u + G, lds);
        if (TPHASE >= 10) m1 = wall_clock64();
        for (int u = c; u < 256; u += G) s5_unit(p, u, lds);
        for (int u = 256 + (G - 1 - c); u < 320; u += G) s5_unit(p, u, lds);
        if (TPHASE >= 10) m2 = wall_clock64();
        if (sg == 1) for (int u = c; u < 512; u += 2 * G) attn_sample_pair(p, u, u + G, lds);
        for (int u = c; u < 256; u += G) attn_prompt_unit(p, u, lds);
        if (TPHASE >= 10) m3 = wall_clock64();
        if (sg == 2) for (int u = c; u < 512; u += 2 * G) attn_sample_pair(p, u, u + G, lds);
        conv_phase(p);
        if (sg == 3) for (int u = c; u < 512; u += 2 * G) attn_sample_pair(p, u, u + G, lds);
        if (TPHASE >= 10) { m4 = wall_clock64(); ts[0] = 0; ts[1] = TPHASE == 10 ? m1 - m0 : (TPHASE == 11 ? m2 - m1 : (TPHASE == 12 ? m3 - m2 : m4 - m3)); }
    }
    GSYNC(); STAMP();

    for (int rep = 0; rep < NREP(8); ++rep) if (PHMASK & 64) {
        Sched2 S{(const char*)ws, G, c};
        Epi2 E{(bf16_t*)(ws + WS_GLU), (bf16_t*)(ws + WS_CONVO), (bf16_t*)(ws + WS_ATTO)};
        pg8::gemm_phase(lds, 1024, 1024, S, E);
    }
    GSYNC(); STAMP();

    for (int rep = 0; rep < NREP(32); ++rep) merge_phase(p);
    GSYNC(); STAMP();

    for (int rep = 0; rep < NREP(16); ++rep) if (PHMASK & 128) {
        { Sched3 S{(const char*)(ws + WS_MERGED), (const char*)(ws + WS_WO), G, c}; Epi3 E{(bf16_t*)(ws + WS_DELTA), (float*)(ws + WS_PART), false}; pg8::gemm_phase(lds, 2048, 2048, S, E); }
        { Sched3b S{(const char*)(ws + WS_MERGED), (const char*)(ws + WS_WO), G, c}; Epi3 E{(bf16_t*)(ws + WS_DELTA), (float*)(ws + WS_PART), true}; pg8::gemm_phase(lds, 256, 2048, S, E); }
    }
    GSYNC(); STAMP();

    if (PHMASK & 256) phase5(p);
    STAMP();
    if (TPHASE >= 0 && blockIdx.x == 0 && threadIdx.x == 0) {
        const unsigned long long d = (TPHASE >= 10 ? ts[1] - ts[0] : ts[TPHASE + 1] - ts[TPHASE]) * TMULT, t0 = wall_clock64();
        while (wall_clock64() - t0 < d) __builtin_amdgcn_s_sleep(16);
    }
}

extern "C" void kernel_launch(void* const* d_in, const int* in_sizes, int n_in, void* d_out, int out_size, void* d_ws, size_t ws_size, hipStream_t stream) {
    static int grid = 0;
    if (grid == 0) {
        int dev = 0, cus = 0, per_cu = 0;
        hipGetDevice(&dev);
        hipDeviceGetAttribute(&cus, hipDeviceAttributeMultiprocessorCount, dev);
        if (hipFuncSetAttribute((const void*)mega_fwd, hipFuncAttributeMaxDynamicSharedMemorySize, LDS_BYTES) != hipSuccess) fprintf(stderr, "kernel_launch: hipFuncSetAttribute failed\n");
        if (hipOccupancyMaxActiveBlocksPerMultiprocessor(&per_cu, (const void*)mega_fwd, 512, LDS_BYTES) != hipSuccess || per_cu < 1) per_cu = 1;
        (void)hipGetLastError();
        grid = cus * per_cu;
        if (ws_size < WS_END) fprintf(stderr, "kernel_launch: workspace too small (%zu < %zu)\n", ws_size, (size_t)WS_END);
    }
    P p{};
    const float** pp = (const float**)&p;
    for (int i = 0; i < 28; ++i) pp[i] = (const float*)d_in[i];
    p.out = (float*)d_out; p.ws = (unsigned char*)d_ws;
    void* args[] = {&p};
    (void)hipMemsetAsync((unsigned char*)d_ws + WS_BAR, 0, 16384, stream);
    hipError_t e = hipLaunchCooperativeKernel((const void*)mega_fwd, dim3(grid), dim3(512), args, LDS_BYTES, stream);
    if (e != hipSuccess) fprintf(stderr, "cooperative launch failed: %s (grid %d)\n", hipGetErrorString(e), grid);
}
```

```cpp
#include <hip/hip_runtime.h>
#include <hip/hip_cooperative_groups.h>
#include <cstdio>
namespace cg = cooperative_groups;

#define LAS __attribute__((address_space(3)))
typedef unsigned short bf16_t;
typedef short bf16x8 __attribute__((ext_vector_type(8)));
typedef float f32x4 __attribute__((ext_vector_type(4)));
typedef unsigned u32x4 __attribute__((ext_vector_type(4)));
typedef unsigned u32x2 __attribute__((ext_vector_type(2)));

constexpr int DM = 2048, NPROMPT = 8192, NSAMPLE = 512, MTOK = 8704, NIN = 14336;
constexpr int OFF_CB = 0, OFF_CC = 1024, OFF_CH = 2048, OFF_CZ = 3072, OFF_SU = 4096, OFF_SZ = 5120, OFF_AQ = 6144, OFF_AZ = 7168, OFF_G = 8192;
constexpr int LDS_BYTES = 131072 + 16;
constexpr size_t O_Y = 0, O_MK = 17825792, O_MV = 18874368, O_CP = 19922944, O_RP = 19931136, O_IP = 19947520, O_CS = 19963904, O_RS = 20226048, O_IS = 20750336;
constexpr size_t WS_WIN = 0;
constexpr size_t WS_WG = WS_WIN + (size_t)NIN * DM * 2;
constexpr size_t WS_WC = WS_WG + 8388608;
constexpr size_t WS_WA = WS_WC + 4194304;
constexpr size_t WS_WO = WS_WA + 4194304;
constexpr size_t WS_H = WS_WO + 8388608;
constexpr size_t WS_PROJ = WS_H + (size_t)MTOK * DM * 2;
constexpr size_t WS_YS = WS_PROJ + (size_t)MTOK * NIN * 2;
constexpr size_t WS_ACONV = WS_YS + (size_t)MTOK * 1024 * 2;
constexpr size_t WS_OATT = WS_ACONV + (size_t)MTOK * 1024 * 2;
constexpr size_t WS_SS = WS_OATT + (size_t)MTOK * 1024 * 2;
constexpr size_t WS_GLU = WS_SS + (size_t)MTOK * 32 * 4;
constexpr size_t WS_MERGED = WS_GLU + (size_t)MTOK * DM * 2;
constexpr size_t WS_BAR = WS_MERGED + (size_t)MTOK * DM * 2;
constexpr size_t WS_MEMN = WS_BAR + 16384;
constexpr size_t WS_WK = WS_MEMN + 4194304;
constexpr size_t WS_WV = WS_WK + 4194304;
constexpr size_t WS_KB = WS_WV + 4194304;
constexpr size_t WS_VT = WS_KB + 2097152;
constexpr size_t WS_ATTO = WS_MEMN;
constexpr size_t WS_END = WS_ATTO + (size_t)MTOK * DM * 2;
constexpr size_t WS_CONVO = WS_WIN, WS_PART = WS_PROJ, WS_DELTA = WS_PROJ + 67108864;
static_assert(WS_END <= 536870912, "workspace");
static_assert(WS_VT + 2097152 <= WS_END && (size_t)MTOK * DM * 2 <= 38u * 1048576u, "aliases");

struct P {
    const float *x_prompt, *x_sample, *mem_prompt, *cache_k, *cache_v, *state_conv, *state_re, *state_im, *norm_g, *mem_norm_g, *w_in, *conv_w, *w_conv_out,
        *lam_re, *lam_im, *log_dt, *b_re, *b_im, *c_re, *c_im, *ssm_d, *w_glu_a, *w_glu_b, *w_mem_k, *w_mem_v, *w_attn_out, *w_out, *final_g;
    float* out; unsigned char* ws;
};

__device__ __forceinline__ unsigned cvt_pk_bf16(float lo, float hi) { unsigned r; asm("v_cvt_pk_bf16_f32 %0, %1, %2" : "=v"(r) : "v"(lo), "v"(hi)); return r; }
__device__ __forceinline__ float bf_lo(unsigned w) { return __uint_as_float(w << 16); }
__device__ __forceinline__ float bf_hi(unsigned w) { return __uint_as_float(w & 0xffff0000u); }
__device__ __forceinline__ float rcp_(float x) { return __builtin_amdgcn_rcpf(x); }
__device__ __forceinline__ float sigmoidf_(float x) { return rcp_(1.0f + __expf(-x)); }
__device__ __forceinline__ float siluf_(float x) { return x * rcp_(1.0f + __expf(-x)); }
__device__ __forceinline__ float gelu_tanh(float x) { const float u = 1.5957691216057308f * (x + 0.044715f * x * x * x); return x * rcp_(1.0f + __expf(-u)); }
__device__ __forceinline__ bf16x8 pack8(const f32x4 a, const f32x4 b) {
    u32x4 w; w.x = cvt_pk_bf16(a[0], a[1]); w.y = cvt_pk_bf16(a[2], a[3]); w.z = cvt_pk_bf16(b[0], b[1]); w.w = cvt_pk_bf16(b[2], b[3]);
    return __builtin_bit_cast(bf16x8, w);
}
__device__ __forceinline__ u32x4 pack8u(const f32x4 a, const f32x4 b) {
    u32x4 w; w.x = cvt_pk_bf16(a[0], a[1]); w.y = cvt_pk_bf16(a[2], a[3]); w.z = cvt_pk_bf16(b[0], b[1]); w.w = cvt_pk_bf16(b[2], b[3]); return w;
}
__device__ __forceinline__ void unpack8(const u32x4 w, float (&f)[8]) {
    f[0] = bf_lo(w.x); f[1] = bf_hi(w.x); f[2] = bf_lo(w.y); f[3] = bf_hi(w.y); f[4] = bf_lo(w.z); f[5] = bf_hi(w.z); f[6] = bf_lo(w.w); f[7] = bf_hi(w.w);
}
__device__ __forceinline__ int otid() { int t = threadIdx.x; asm volatile("" : "+v"(t)); return t; }
#define MFMA16(a, b, c) __builtin_amdgcn_mfma_f32_16x16x32_bf16((a), (b), (c), 0, 0, 0)

namespace pg8 {
constexpr int BM = 256, BK = 64, HALF = 128, HTB = HALF * BK * 2, STAGE_BYTES = 8 * HTB;
__device__ __forceinline__ int lds_byte(int r, int c) { const int st = (r >> 4) * 2 + (c >> 5), rr = r & 15, cc = c & 31, ob = rr * 64 + cc * 2; return st * 1024 + (ob ^ (((ob >> 9) & 1) << 5)); }
__device__ __forceinline__ void stage_rc(int b, int& R, int& C) { const int st = b / 1024, sb = b % 1024, swz = sb ^ (((sb >> 9) & 1) << 5); R = (st >> 1) * 16 + swz / 64; C = (st & 1) * 32 + (swz % 64) / 2; }
__device__ __forceinline__ int perm32(int rho) { const int n = rho >> 4, i = rho & 15; return 8 * (i >> 2) + 4 * n + (i & 3); }
struct Unit { const char* a; const char* b; int pm, pn, kind; };

template <class Sched, class Epi>
__device__ __forceinline__ void gemm_phase(LAS unsigned char* lds, const int K, const int ld, const Sched& S, const Epi& E) {
    const int tid = otid(), wid = __builtin_amdgcn_readfirstlane(tid >> 6), lane = tid & 63, wr = wid >> 2, wc = wid & 3, fr = lane & 15, fq = lane >> 4;
    const int nt = K / BK;
    unsigned voffA[2], voffB[2];
#pragma unroll
    for (int i = 0; i < 2; ++i) { int R, C; stage_rc(tid * 16 + i * 8192, R, C); const int Rb = (R & ~31) + perm32(R & 31);
        voffA[i] = (unsigned)(R * ld + C) * 2u; voffB[i] = (unsigned)(Rb * ld + C) * 2u; }
    const size_t kstep = (size_t)(BK * 2);
    const size_t hstep = (size_t)HALF * ld * 2;
    const unsigned ldsw = (unsigned)wid * 1024u;
    const int aoff = lds_byte(wr * 64 + fr, fq * 8), boff = lds_byte(wc * 32 + fr, fq * 8);
#define PG8_SA(b, h) (((b) * 2 + (h)) * HTB)
#define PG8_SB(b, h) ((4 + (b) * 2 + (h)) * HTB)
#define PG8_STAGE(bufoff, gbase, voff) do { _Pragma("unroll") for (int _i = 0; _i < 2; ++_i) \
        __builtin_amdgcn_global_load_lds((const unsigned*)((const char*)(gbase) + (voff)[_i]), (LAS unsigned*)(lds + (bufoff) + ldsw + _i * 8192), 16, 0, 0); } while (0)
#define PG8_LDA(dst, b, h) do { _Pragma("unroll") for (int m = 0; m < 4; ++m) _Pragma("unroll") for (int k = 0; k < 2; ++k) dst[m][k] = *(const LAS bf16x8*)(lds + PG8_SA(b, h) + aoff + m * 2048 + k * 1024); } while (0)
#define PG8_LDB(dst, b, h) do { _Pragma("unroll") for (int n = 0; n < 2; ++n) _Pragma("unroll") for (int k = 0; k < 2; ++k) dst[n][k] = *(const LAS bf16x8*)(lds + PG8_SB(b, h) + boff + n * 2048 + k * 1024); } while (0)
#define PG8_MMA(ai, bj, At, Bt) do { __builtin_amdgcn_s_setprio(1); _Pragma("unroll") for (int m = 0; m < 4; ++m) _Pragma("unroll") for (int n = 0; n < 2; ++n) _Pragma("unroll") for (int k = 0; k < 2; ++k) \
        acc[ai][bj][m][n] = __builtin_amdgcn_mfma_f32_16x16x32_bf16(Bt[n][k], At[m][k], acc[ai][bj][m][n], 0, 0, 0); __builtin_amdgcn_s_setprio(0); } while (0)
#define PG8_WAIT_V(n) asm volatile("s_waitcnt vmcnt(" #n ")" ::: "memory")
#define PG8_WAIT_L(n) asm volatile("s_waitcnt lgkmcnt(" #n ")" ::: "memory")
#define PG8_BAR __builtin_amdgcn_s_barrier()
#define PG8_SCHED __builtin_amdgcn_sched_barrier(0)
    Unit cur, nxt; int ui = 0;
    if (!S.next(0, cur)) return;
    f32x4 acc[2][2][4][2];
#pragma unroll
    for (int a = 0; a < 2; ++a)
#pragma unroll
        for (int b = 0; b < 2; ++b)
#pragma unroll
            for (int m = 0; m < 4; ++m)
#pragma unroll
                for (int n = 0; n < 2; ++n) acc[a][b][m][n] = (f32x4){0.f, 0.f, 0.f, 0.f};
    bf16x8 At[4][2], B0[2][2], B1[2][2];
    const char* cA = cur.a; const char* cB = cur.b;
    PG8_STAGE(PG8_SB(0, 0), cB, voffB); PG8_STAGE(PG8_SA(0, 0), cA, voffA); PG8_STAGE(PG8_SB(0, 1), cB + hstep, voffB); PG8_STAGE(PG8_SA(0, 1), cA + hstep, voffA);
    if (wr == 1) PG8_BAR;
    PG8_WAIT_V(4); PG8_BAR;
    PG8_STAGE(PG8_SB(1, 0), cB + kstep, voffB); PG8_STAGE(PG8_SA(1, 0), cA + kstep, voffA); PG8_STAGE(PG8_SB(1, 1), cB + hstep + kstep, voffB);
    PG8_WAIT_V(6); PG8_BAR;
    for (;;) {
        const bool has_next = S.next(ui + 1, nxt);
        const char* nA = has_next ? nxt.a : cA; const char* nB = has_next ? nxt.b : cB;
        for (int t = 0; t < nt; t += 2) {
            const bool last = (t == nt - 2);
            const char* a1 = cA + (size_t)(t + 1) * kstep;
            const char* a2 = last ? nA : cA + (size_t)(t + 2) * kstep; const char* b2 = last ? nB : cB + (size_t)(t + 2) * kstep;
            const char* a3 = a2 + kstep; const char* b3 = b2 + kstep;
            PG8_LDB(B0, 0, 0); PG8_SCHED; PG8_LDA(At, 0, 0); PG8_STAGE(PG8_SA(1, 1), a1 + hstep, voffA);
            PG8_WAIT_L(8); PG8_BAR; PG8_WAIT_L(0); PG8_MMA(0, 0, At, B0); PG8_BAR; PG8_SCHED;
            PG8_LDB(B1, 0, 1); PG8_STAGE(PG8_SB(0, 0), b2, voffB);
            PG8_BAR; PG8_WAIT_L(0); PG8_MMA(0, 1, At, B1); PG8_BAR;
            PG8_LDA(At, 0, 1); PG8_STAGE(PG8_SA(0, 0), a2, voffA);
            PG8_BAR; PG8_WAIT_L(0); PG8_MMA(1, 0, At, B0); PG8_BAR; PG8_SCHED;
            PG8_STAGE(PG8_SB(0, 1), b2 + hstep, voffB);
            PG8_WAIT_V(6); PG8_BAR; PG8_MMA(1, 1, At, B1); PG8_BAR;
            PG8_LDB(B0, 1, 0); PG8_SCHED; PG8_LDA(At, 1, 0); PG8_STAGE(PG8_SA(0, 1), a2 + hstep, voffA);
            PG8_WAIT_L(8); PG8_BAR; PG8_WAIT_L(0); PG8_MMA(0, 0, At, B0); PG8_BAR; PG8_SCHED;
            PG8_LDB(B1, 1, 1); PG8_STAGE(PG8_SB(1, 0), b3, voffB);
            PG8_BAR; PG8_WAIT_L(0); PG8_MMA(0, 1, At, B1); PG8_BAR;
            PG8_LDA(At, 1, 1); PG8_STAGE(PG8_SA(1, 0), a3, voffA);
            PG8_BAR; PG8_WAIT_L(0); PG8_MMA(1, 0, At, B0); PG8_BAR; PG8_SCHED;
            PG8_STAGE(PG8_SB(1, 1), b3 + hstep, voffB);
            PG8_WAIT_V(6); PG8_BAR; PG8_MMA(1, 1, At, B1); PG8_BAR;
        }
        const bool keep = E(acc, cur, wr, wc, fr, fq);
        if (!has_next) break;
        if (!keep) {
#pragma unroll
            for (int a = 0; a < 2; ++a)
#pragma unroll
                for (int b = 0; b < 2; ++b)
#pragma unroll
                    for (int m = 0; m < 4; ++m)
#pragma unroll
                        for (int n = 0; n < 2; ++n) acc[a][b][m][n] = (f32x4){0.f, 0.f, 0.f, 0.f};
        }
        cur = nxt; cA = nA; cB = nB; ++ui;
    }
    PG8_WAIT_V(0);
    if (wr == 0) PG8_BAR;
    PG8_BAR;
#undef PG8_SA
#undef PG8_SB
#undef PG8_STAGE
#undef PG8_LDA
#undef PG8_LDB
#undef PG8_MMA
#undef PG8_WAIT_V
#undef PG8_WAIT_L
#undef PG8_BAR
#undef PG8_SCHED
}
}
using pg8::Unit;

__device__ __forceinline__ void xcd_tile_order(int wgid, const int nM, const int nN, int& pm, int& pn) {
    const int nwg = nM * nN, NX = 8, WGM = 8;
    { const int q = nwg / NX, r = nwg % NX, xcd = wgid % NX, off = wgid / NX; wgid = (xcd < r ? xcd * (q + 1) : r * (q + 1) + (xcd - r) * q) + off; }
    const int nig = WGM * nN, gid = wgid / nig, fm = gid * WGM, gsz = (nM - fm) < WGM ? (nM - fm) : WGM;
    pm = fm + ((wgid % nig) % gsz); pn = (wgid % nig) / gsz;
}
struct Sched1 {
    const char *H, *WIN, *MEMN, *WK, *WV; int G, c;
    __device__ __forceinline__ bool next(int i, Unit& u) const {
        const int L = i * G + c; if (L >= 1792) return false;
        if (L < 1760) {
            int pm, pn;
            if (L < 1292) xcd_tile_order(L, 34, 38, pm, pn);
            else { xcd_tile_order(L - 1292, 26, 18, pm, pn); pn += 38; }
            u.pm = pm; u.pn = pn; u.kind = 0; u.a = H + (size_t)pm * 1048576; u.b = WIN + (size_t)pn * 1048576;
        } else if (L < 1776) { const int j = L - 1760; u.pm = j >> 2; u.pn = j & 3; u.kind = 1; u.a = MEMN + (size_t)u.pm * 1048576; u.b = WK + (size_t)u.pn * 1048576; }
        else { const int j = L - 1776; u.pm = j >> 2; u.pn = j & 3; u.kind = 2; u.a = WV + (size_t)u.pm * 1048576; u.b = MEMN + (size_t)u.pn * 1048576; }
        return true;
    }
};
struct Sched1g {
    const char *H, *WIN; int G, c;
    __device__ __forceinline__ bool next(int i, Unit& u) const {
        const int j = i * G + c; if (j >= 144) return false;
        u.pm = 26 + j / 18; u.pn = 38 + j % 18; u.kind = 0; u.a = H + (size_t)u.pm * 1048576; u.b = WIN + (size_t)u.pn * 1048576; return true;
    }
};
struct Epi1 {
    bf16_t* PROJ; float* outK; bf16_t* KB; float* outV; bf16_t* VT;
    __device__ __forceinline__ bool operator()(f32x4 (&acc)[2][2][4][2], const Unit& u, int wr, int wc, int fr, int fq) const {
        const int r0 = u.pm * 256 + wr * 64 + fr, c0 = u.pn * 256 + wc * 32 + 8 * fq;
        if (u.kind == 0) {
#pragma unroll
            for (int ai = 0; ai < 2; ++ai)
#pragma unroll
                for (int m = 0; m < 4; ++m) { bf16_t* rowp = PROJ + (size_t)(r0 + ai * 128 + m * 16) * NIN + c0;
#pragma unroll
                    for (int bj = 0; bj < 2; ++bj) *(u32x4*)(rowp + bj * 128) = pack8u(acc[ai][bj][m][0], acc[ai][bj][m][1]); }
        } else if (u.kind == 1) {
#pragma unroll
            for (int ai = 0; ai < 2; ++ai)
#pragma unroll
                for (int m = 0; m < 4; ++m) { const size_t off = (size_t)(r0 + ai * 128 + m * 16) * 1024 + c0;
#pragma unroll
                    for (int bj = 0; bj < 2; ++bj) { *(f32x4*)(outK + off + bj * 128) = acc[ai][bj][m][0]; *(f32x4*)(outK + off + bj * 128 + 4) = acc[ai][bj][m][1];
                        *(u32x4*)(KB + off + bj * 128) = pack8u(acc[ai][bj][m][0], acc[ai][bj][m][1]); } }
        } else {
            const int h = u.pm, b = u.pn;
#pragma unroll
            for (int ai = 0; ai < 2; ++ai)
#pragma unroll
                for (int m = 0; m < 4; ++m) { const int d = wr * 64 + fr + ai * 128 + m * 16;
#pragma unroll
                    for (int bj = 0; bj < 2; ++bj) { const int key0 = wc * 32 + 8 * fq + bj * 128;
                        *(u32x4*)(VT + ((size_t)((b * 4 + h) * 256 + d)) * 256 + key0) = pack8u(acc[ai][bj][m][0], acc[ai][bj][m][1]);
                        float* fp = outV + ((size_t)(b * 256 + key0)) * 1024 + h * 256 + d;
#pragma unroll
                        for (int e = 0; e < 4; ++e) { fp[(size_t)e * 1024] = acc[ai][bj][m][0][e]; fp[(size_t)(e + 4) * 1024] = acc[ai][bj][m][1][e]; } } }
        }
        return false;
    }
};

struct Sched2 {
    const char* ws; int G, c;
    __device__ __forceinline__ bool next(int i, Unit& u) const {
        int L;
        if (G == 256) { if (c < 144) { if (i >= 4) return false; L = c + 144 * i; } else { L = 576 + (c - 144) + 112 * i; } }
        else L = i * G + c;
        if (L >= 1088) return false;
        if (L < 544) { u.pm = L >> 4; u.pn = L & 15; u.kind = 0; u.a = ws + WS_YS + (size_t)u.pm * 524288; u.b = ws + WS_WG + (size_t)u.pn * 524288; }
        else { const int j = L - 544, k = j >= 272 ? 1 : 0, jj = j - 272 * k; u.pm = jj >> 3; u.pn = jj & 7; u.kind = 1 + k;
            u.a = ws + WS_ACONV + (size_t)k * ((size_t)MTOK * 1024 * 2) + (size_t)u.pm * 524288; u.b = ws + WS_WC + (size_t)k * 4194304 + (size_t)u.pn * 524288; }
        return true;
    }
};
struct Epi2 {
    bf16_t* GLU; bf16_t* CONVO; bf16_t* ATTO;
    __device__ __forceinline__ bool operator()(f32x4 (&acc)[2][2][4][2], const Unit& u, int wr, int wc, int fr, int fq) const {
        const int r0 = u.pm * 256 + wr * 64 + fr;
        if (u.kind == 0) {
            const int c0 = u.pn * 128 + wc * 32 + 8 * fq;
#pragma unroll
            for (int ai = 0; ai < 2; ++ai)
#pragma unroll
                for (int m = 0; m < 4; ++m) {
                    f32x4 t0, t1;
#pragma unroll
                    for (int e = 0; e < 4; ++e) { t0[e] = acc[ai][0][m][0][e] * sigmoidf_(acc[ai][1][m][0][e]); t1[e] = acc[ai][0][m][1][e] * sigmoidf_(acc[ai][1][m][1][e]); }
                    *(u32x4*)(GLU + (size_t)(r0 + ai * 128 + m * 16) * 2048 + c0) = pack8u(t0, t1);
                }
        } else {
            bf16_t* O = u.kind == 1 ? CONVO : ATTO; const int c0 = u.pn * 256 + wc * 32 + 8 * fq;
#pragma unroll
            for (int ai = 0; ai < 2; ++ai)
#pragma unroll
                for (int m = 0; m < 4; ++m) { bf16_t* rowp = O + (size_t)(r0 + ai * 128 + m * 16) * 2048 + c0;
#pragma unroll
                    for (int bj = 0; bj < 2; ++bj) *(u32x4*)(rowp + bj * 128) = pack8u(acc[ai][bj][m][0], acc[ai][bj][m][1]); }
        }
        return false;
    }
};
__device__ __forceinline__ void merge_phase(const P& p) {
    const bf16_t* PROJ = (const bf16_t*)(p.ws + WS_PROJ); const bf16_t* GLU = (const bf16_t*)(p.ws + WS_GLU); const bf16_t* CONVO = (const bf16_t*)(p.ws + WS_CONVO);
    const bf16_t* ATTO = (const bf16_t*)(p.ws + WS_ATTO); bf16_t* MERGED = (bf16_t*)(p.ws + WS_MERGED);
    const int NT = MTOK * 256, stride = gridDim.x * 512;
    for (int t = blockIdx.x * 512 + otid(); t < NT; t += 2 * stride) {
        u32x4 L[2][6]; const int t1 = t + stride; const bool has1 = t1 < NT;
#pragma unroll
        for (int k = 0; k < 2; ++k) { const int tt = k == 0 ? t : (has1 ? t1 : t);
            const size_t row = (size_t)(tt >> 8); const int c0 = (tt & 255) * 8; const bf16_t* pr = PROJ + row * NIN + OFF_G + c0; const size_t o = row * 2048 + c0;
            L[k][0] = *(const u32x4*)pr; L[k][1] = *(const u32x4*)(pr + 2048); L[k][2] = *(const u32x4*)(pr + 4096);
            L[k][3] = *(const u32x4*)(CONVO + o); L[k][4] = *(const u32x4*)(GLU + o); L[k][5] = *(const u32x4*)(ATTO + o); }
#pragma unroll
        for (int k = 0; k < 2; ++k) { if (k == 1 && !has1) break; const int tt = k == 0 ? t : t1;
            const size_t row = (size_t)(tt >> 8); const int c0 = (tt & 255) * 8; const size_t o = row * 2048 + c0;
            float g0[8], g1[8], g2[8], cv[8], gl[8], at[8];
            unpack8(L[k][0], g0); unpack8(L[k][1], g1); unpack8(L[k][2], g2); unpack8(L[k][3], cv); unpack8(L[k][4], gl); unpack8(L[k][5], at);
            f32x4 m0, m1;
#pragma unroll
            for (int e = 0; e < 8; ++e) { const float v = sigmoidf_(g0[e]) * cv[e] + sigmoidf_(g1[e]) * gl[e] + sigmoidf_(g2[e]) * at[e]; if (e < 4) m0[e] = v; else m1[e - 4] = v; }
            *(u32x4*)(MERGED + o) = pack8u(m0, m1); }
    }
}

struct Sched3 {
    const char *MERGED, *WO; int G, c;
    __device__ __forceinline__ bool next(int i, Unit& u) const {
        const int L = i * G + c; if (L >= 256) return false;
        u.pm = L >> 3; u.pn = L & 7; u.kind = 0; u.a = MERGED + (size_t)u.pm * 1048576; u.b = WO + (size_t)u.pn * 1048576; return true;
    }
};
struct Sched3b {
    const char *MERGED, *WO; int G, c;
    __device__ __forceinline__ bool next(int i, Unit& u) const {
        const int L = i * G + c; if (L >= 128) return false;
        const int tile = L >> 3, ks = L & 7; u.pm = 32 + (tile >> 3); u.pn = tile & 7; u.kind = ks;
        u.a = MERGED + (size_t)u.pm * 1048576 + (size_t)ks * 512; u.b = WO + (size_t)u.pn * 1048576 + (size_t)ks * 512; return true;
    }
};
struct Epi3 {
    bf16_t* delta; float* part;
    bool sample;
    __device__ __forceinline__ bool operator()(f32x4 (&acc)[2][2][4][2], const Unit& u, int wr, int wc, int fr, int fq) const {
        const int r0 = u.pm * 256 + wr * 64 + fr, c0 = u.pn * 256 + wc * 32 + 8 * fq;
        if (!sample) {
#pragma unroll
            for (int ai = 0; ai < 2; ++ai)
#pragma unroll
                for (int m = 0; m < 4; ++m) { bf16_t* o = delta + (size_t)(r0 + ai * 128 + m * 16) * DM + c0;
#pragma unroll
                    for (int bj = 0; bj < 2; ++bj) *(u32x4*)(o + bj * 128) = pack8u(acc[ai][bj][m][0], acc[ai][bj][m][1]); }
        } else {
            float* base = part + ((size_t)u.kind * 512 - NPROMPT) * DM;
#pragma unroll
            for (int ai = 0; ai < 2; ++ai)
#pragma unroll
                for (int m = 0; m < 4; ++m) {
                    float* o = base + (size_t)(r0 + ai * 128 + m * 16) * DM + c0;
#pragma unroll
                    for (int bj = 0; bj < 2; ++bj)
#pragma unroll
                        for (int n = 0; n < 2; ++n) *(f32x4*)(o + bj * 128 + 4 * n) = acc[ai][bj][m][n];
                }
        }
        return false;
    }
};

__device__ __forceinline__ void transpose_tile(const float* __restrict__ src, const int K, const int N, bf16_t* __restrict__ dst, const int mode, const int t, LAS float* tile) {
    const int tid = otid(); const int tn = N / 256;
    const int r = tid >> 3, c8 = (tid & 7) * 8;
    const int k0 = (t / tn) * 64, n0 = (t % tn) * 256;
    const float* s = src + (size_t)(k0 + r) * N + n0 + c8;
    f32x4 v[8];
#pragma unroll
    for (int j = 0; j < 4; ++j) { v[2 * j] = *(const f32x4*)(s + j * 64); v[2 * j + 1] = *(const f32x4*)(s + j * 64 + 4); }
#pragma unroll
    for (int j = 0; j < 4; ++j)
#pragma unroll
        for (int e = 0; e < 4; ++e) { tile[j * 4160 + r * 65 + c8 + e] = v[2 * j][e]; tile[j * 4160 + r * 65 + c8 + 4 + e] = v[2 * j + 1][e]; }
    __syncthreads();
#pragma unroll
    for (int j = 0; j < 4; ++j) {
        f32x4 a, b;
#pragma unroll
        for (int e = 0; e < 4; ++e) { a[e] = tile[j * 4160 + (c8 + e) * 65 + r]; b[e] = tile[j * 4160 + (c8 + 4 + e) * 65 + r]; }
        const int n = n0 + j * 64 + r;
        const int row = mode == 0 ? n : ((n >> 7) * 256 + (mode - 1) * 128 + (n & 127));
        *(u32x4*)(dst + (size_t)row * K + k0 + c8) = pack8u(a, b);
    }
    __syncthreads();
}
__device__ __forceinline__ void tload_win(const float* w_in, int t, int r, int c8, f32x4 (&v)[8]) {
    const int k0 = (t / 56) * 64, n0 = (t % 56) * 256;
    const float* s = w_in + (size_t)(k0 + r) * NIN + n0 + c8;
#pragma unroll
    for (int j = 0; j < 4; ++j) { v[2 * j] = *(const f32x4*)(s + j * 64); v[2 * j + 1] = *(const f32x4*)(s + j * 64 + 4); }
}
__device__ __forceinline__ void phase0(const P& p, LAS unsigned char* lds) {
    unsigned char* ws = p.ws; LAS float* tile = (LAS float*)lds;
    {
        const int tid = otid(); const int r = tid >> 3, c8 = (tid & 7) * 8;
        bf16_t* dst = (bf16_t*)(ws + WS_WIN);
        int j = blockIdx.x; f32x4 v[8];
        if (j < 1792) tload_win(p.w_in, j, r, c8, v);
        while (j < 1792) {
#pragma unroll
            for (int q = 0; q < 4; ++q)
#pragma unroll
                for (int e = 0; e < 4; ++e) { tile[q * 4160 + r * 65 + c8 + e] = v[2 * q][e]; tile[q * 4160 + r * 65 + c8 + 4 + e] = v[2 * q + 1][e]; }
            const int jn = j + gridDim.x;
            if (jn < 1792) tload_win(p.w_in, jn, r, c8, v);
            __syncthreads();
            const int k0 = (j / 56) * 64, n0 = (j % 56) * 256;
#pragma unroll
            for (int q = 0; q < 4; ++q) {
                f32x4 a, b;
#pragma unroll
                for (int e = 0; e < 4; ++e) { a[e] = tile[q * 4160 + (c8 + e) * 65 + r]; b[e] = tile[q * 4160 + (c8 + 4 + e) * 65 + r]; }
                *(u32x4*)(dst + (size_t)(n0 + q * 64 + r) * 2048 + k0 + c8) = pack8u(a, b);
            }
            __syncthreads();
            j = jn;
        }
    }
    for (int t = blockIdx.x; t < 256; t += gridDim.x) {
        if (t < 128) transpose_tile(p.w_mem_k, 2048, 1024, (bf16_t*)(ws + WS_WK), 0, t, tile);
        else transpose_tile(p.w_mem_v, 2048, 1024, (bf16_t*)(ws + WS_WV), 0, t - 128, tile);
    }
    const int t0 = otid(); const int lane = t0 & 63, gw = blockIdx.x * 8 + (t0 >> 6), nw = gridDim.x * 8;
    auto rowsrc = [&](int row) -> const float* { return row < NPROMPT ? p.x_prompt + (size_t)row * DM : (row < MTOK ? p.x_sample + (size_t)(row - NPROMPT) * DM : p.mem_prompt + (size_t)(row - MTOK) * DM); };
    f32x4 v[8], vn[8];
    if (gw < MTOK + 1024) { const float* src = rowsrc(gw);
#pragma unroll
        for (int i = 0; i < 8; ++i) v[i] = *(const f32x4*)(src + 4 * (lane + 64 * i)); }
    for (int row = gw; row < MTOK + 1024; row += nw) {
        const float* g = row < MTOK ? p.norm_g : p.mem_norm_g;
        bf16_t* dst = row < MTOK ? (bf16_t*)(ws + WS_H) + (size_t)row * DM : (bf16_t*)(ws + WS_MEMN) + (size_t)(row - MTOK) * DM;
        if (row + nw < MTOK + 1024) { const float* src = rowsrc(row + nw);
#pragma unroll
            for (int i = 0; i < 8; ++i) vn[i] = *(const f32x4*)(src + 4 * (lane + 64 * i)); }
        float s = 0.f;
#pragma unroll
        for (int i = 0; i < 8; ++i) s += (v[i][0] * v[i][0] + v[i][1] * v[i][1]) + (v[i][2] * v[i][2] + v[i][3] * v[i][3]);
#pragma unroll
        for (int o = 32; o >= 1; o >>= 1) s += __shfl_xor(s, o);
        const float rstd = 1.0f / sqrtf(s * (1.0f / 2048.0f) + 1e-6f);
#pragma unroll
        for (int i = 0; i < 8; ++i) { const f32x4 gv = *(const f32x4*)(g + 4 * (lane + 64 * i));
            u32x2 w; w.x = cvt_pk_bf16(v[i][0] * rstd * gv[0], v[i][1] * rstd * gv[1]); w.y = cvt_pk_bf16(v[i][2] * rstd * gv[2], v[i][3] * rstd * gv[3]);
            *(u32x2*)(dst + 4 * (lane + 64 * i)) = w; }
#pragma unroll
        for (int i = 0; i < 8; ++i) v[i] = vn[i];
    }
}

__device__ __forceinline__ void late_transposes(const P& p, LAS unsigned char* lds, const int first, const int stride, const int end) {
    unsigned char* ws = p.ws; LAS float* tile = (LAS float*)lds;
    for (int t = first; t < end; t += stride) {
        if (t < 128) transpose_tile(p.w_conv_out, 1024, 2048, (bf16_t*)(ws + WS_WC), 0, t, tile);
        else if (t < 256) transpose_tile(p.w_attn_out, 1024, 2048, (bf16_t*)(ws + WS_WA), 0, t - 128, tile);
        else if (t < 384) transpose_tile(p.w_glu_a, 1024, 2048, (bf16_t*)(ws + WS_WG), 1, t - 256, tile);
        else if (t < 512) transpose_tile(p.w_glu_b, 1024, 2048, (bf16_t*)(ws + WS_WG), 2, t - 384, tile);
        else transpose_tile(p.w_out, 2048, 2048, (bf16_t*)(ws + WS_WO), 0, t - 512, tile);
    }
}

template <int LEN, bool PROMPT>
__device__ __forceinline__ void conv_task(const P& p, const int r0, const int cgp, const int bs) {
    const bf16_t* PROJ = (const bf16_t*)(p.ws + WS_PROJ); bf16_t* ACONV = (bf16_t*)(p.ws + WS_ACONV);
    const int c0 = cgp * 8;
    const bf16_t* pr = PROJ + (size_t)r0 * NIN + c0;
    u32x4 lcb[LEN], lcz[LEN], lcc[LEN + 2], lch[LEN + 2];
    const bool has_halo = PROMPT && (r0 & 2047) != 0;
#pragma unroll
    for (int i = 0; i < LEN; ++i) { lcb[i] = *(const u32x4*)(pr + (size_t)i * NIN + OFF_CB); lcz[i] = *(const u32x4*)(pr + (size_t)i * NIN + OFF_CZ);
        lcc[i + 2] = *(const u32x4*)(pr + (size_t)i * NIN + OFF_CC); lch[i + 2] = *(const u32x4*)(pr + (size_t)i * NIN + OFF_CH); }
#pragma unroll
    for (int i = 0; i < 2; ++i) { lcc[i] = (u32x4){0u, 0u, 0u, 0u}; lch[i] = lcc[i];
        if (has_halo) { lcc[i] = *(const u32x4*)(pr - (size_t)(2 - i) * NIN + OFF_CC); lch[i] = *(const u32x4*)(pr - (size_t)(2 - i) * NIN + OFF_CH); } }
    float w0[8], w1[8], w2[8], vm2[8], vm1[8];
    { const f32x4 a0 = *(const f32x4*)(p.conv_w + c0), a1 = *(const f32x4*)(p.conv_w + c0 + 4), b0 = *(const f32x4*)(p.conv_w + 1024 + c0), b1 = *(const f32x4*)(p.conv_w + 1024 + c0 + 4),
          d0 = *(const f32x4*)(p.conv_w + 2048 + c0), d1 = *(const f32x4*)(p.conv_w + 2048 + c0 + 4);
#pragma unroll
      for (int e = 0; e < 4; ++e) { w0[e] = a0[e]; w0[e + 4] = a1[e]; w1[e] = b0[e]; w1[e + 4] = b1[e]; w2[e] = d0[e]; w2[e + 4] = d1[e]; } }
    if (PROMPT) {
        float a[8], b[8];
        unpack8(lcc[0], a); unpack8(lch[0], b);
#pragma unroll
        for (int e = 0; e < 8; ++e) vm2[e] = a[e] * b[e];
        unpack8(lcc[1], a); unpack8(lch[1], b);
#pragma unroll
        for (int e = 0; e < 8; ++e) vm1[e] = a[e] * b[e];
    } else {
        const float* sc = p.state_conv + (size_t)bs * 2048 + c0;
        const f32x4 a0 = *(const f32x4*)sc, a1 = *(const f32x4*)(sc + 4), b0 = *(const f32x4*)(sc + 1024), b1 = *(const f32x4*)(sc + 1028);
#pragma unroll
        for (int e = 0; e < 4; ++e) { vm2[e] = a0[e]; vm2[e + 4] = a1[e]; vm1[e] = b0[e]; vm1[e + 4] = b1[e]; }
    }
#pragma unroll
    for (int i = 0; i < LEN; ++i) {
        const size_t row = (size_t)(r0 + i);
        float cb[8], cc[8], ch[8], cz[8], v[8];
        unpack8(lcb[i], cb); unpack8(lcc[i + 2], cc); unpack8(lch[i + 2], ch); unpack8(lcz[i], cz);
        f32x4 o0, o1;
#pragma unroll
        for (int e = 0; e < 8; ++e) { v[e] = cc[e] * ch[e]; const float cv = w0[e] * vm2[e] + w1[e] * vm1[e] + w2[e] * v[e]; const float r = cb[e] * cv * siluf_(cz[e]);
            if (e < 4) o0[e] = r; else o1[e - 4] = r; vm2[e] = vm1[e]; vm1[e] = v[e]; }
        *(u32x4*)(ACONV + row * 1024 + c0) = pack8u(o0, o1);
        float* dst = nullptr;
        if (PROMPT) { const int pos = (r0 + i) & 2047; if (pos >= 2046) dst = p.out + O_CP + ((size_t)((r0 + i) >> 11) * 2 + (pos - 2046)) * 1024 + c0; }
        else if (i >= 2) dst = p.out + O_CS + ((size_t)bs * 2 + (i - 2)) * 1024 + c0;
        if (dst) { *(f32x4*)dst = (f32x4){v[0], v[1], v[2], v[3]}; *(f32x4*)(dst + 4) = (f32x4){v[4], v[5], v[6], v[7]}; }
    }
}
__device__ __forceinline__ void conv_phase(const P& p) {
    const int t0 = blockIdx.x * 512 + otid(), nt = gridDim.x * 512;
    for (int task = t0; task < 262144; task += nt) conv_task<4, true>(p, (task >> 7) * 4, task & 127, 0);
    for (int task = t0; task < 16384; task += nt) conv_task<4, false>(p, NPROMPT + 4 * (task >> 7), task & 127, task >> 7);
}

struct S5In { bf16x8 U[4]; u32x2 u4[4], z4[4]; };
__device__ __forceinline__ void s5_load4(S5In& in, const bf16_t* PROJ, const size_t row0, const int g, const int g4) {
    const bf16_t* base = PROJ + row0 * NIN + g * 16;
#pragma unroll
    for (int i = 0; i < 4; ++i) {
        in.U[i] = *(const bf16x8*)(base + (size_t)i * NIN + OFF_SU + 8 * (g4 & 1));
        in.u4[i] = *(const u32x2*)(base + (size_t)i * NIN + OFF_SU + 4 * g4); in.z4[i] = *(const u32x2*)(base + (size_t)i * NIN + OFF_SZ + 4 * g4);
    }
}
__device__ __forceinline__ void s5_steps4(const S5In& in, bf16_t* YS, const size_t row0, const int g, const int g4, const bool Y,
                                          const bf16x8 (&bre)[4], const bf16x8 (&bim)[4], const bf16x8 (&cf)[4], const float (&ar)[16], const float (&ai)[16], const f32x4 dsk,
                                          float (&sr)[16], float (&si)[16]) {
    const f32x4 zero4 = (f32x4){0.f, 0.f, 0.f, 0.f};
#pragma unroll
    for (int i = 0; i < 4; ++i) {
#pragma unroll
        for (int pb = 0; pb < 4; ++pb) {
            const f32x4 xr = MFMA16(bre[pb], in.U[i], zero4), xi = MFMA16(bim[pb], in.U[i], zero4);
#pragma unroll
            for (int j = 0; j < 4; ++j) { const int k = pb * 4 + j; const float nr = ar[k] * sr[k] - ai[k] * si[k] + xr[j]; const float ni = ar[k] * si[k] + ai[k] * sr[k] + xi[j]; sr[k] = nr; si[k] = ni; }
        }
        if (Y) {
            f32x4 y = zero4;
            y = MFMA16(cf[0], pack8((f32x4){sr[0], sr[1], sr[2], sr[3]}, (f32x4){sr[4], sr[5], sr[6], sr[7]}), y);
            y = MFMA16(cf[1], pack8((f32x4){sr[8], sr[9], sr[10], sr[11]}, (f32x4){sr[12], sr[13], sr[14], sr[15]}), y);
            y = MFMA16(cf[2], pack8((f32x4){si[0], si[1], si[2], si[3]}, (f32x4){si[4], si[5], si[6], si[7]}), y);
            y = MFMA16(cf[3], pack8((f32x4){si[8], si[9], si[10], si[11]}, (f32x4){si[12], si[13], si[14], si[15]}), y);
            const float uu[4] = {bf_lo(in.u4[i].x), bf_hi(in.u4[i].x), bf_lo(in.u4[i].y), bf_hi(in.u4[i].y)};
            const float zz[4] = {bf_lo(in.z4[i].x), bf_hi(in.z4[i].x), bf_lo(in.z4[i].y), bf_hi(in.z4[i].y)};
            float o[4];
#pragma unroll
            for (int j = 0; j < 4; ++j) { const float ysv = y[j] + dsk[j] * uu[j]; o[j] = gelu_tanh(ysv * siluf_(zz[j])); }
            u32x2 w; w.x = cvt_pk_bf16(o[0], o[1]); w.y = cvt_pk_bf16(o[2], o[3]);
            *(u32x2*)(YS + (row0 + i) * 1024 + g * 16 + 4 * g4) = w;
        }
    }
}
__device__ __forceinline__ void s5_coef(const P& p, int g, int pp, float dt, float& ar, float& ai, float& fr, float& fi) {
    const float lr = p.lam_re[g * 64 + pp], li = p.lam_im[g * 64 + pp];
    const float mag = expf(lr * dt), ang = li * dt; float sn, cs; sincosf(ang, &sn, &cs);
    ar = mag * cs; ai = mag * sn; const float den = lr * lr + li * li;
    fr = ((ar - 1.0f) * lr + ai * li) / den; fi = (ai * lr - (ar - 1.0f) * li) / den;
}
__device__ __forceinline__ void s5_unit(const P& p, const int unit, LAS unsigned char* lds) {
    const bf16_t* PROJ = (const bf16_t*)(p.ws + WS_PROJ); bf16_t* YS = (bf16_t*)(p.ws + WS_YS);
    const int tid = otid(), lane = tid & 63, w = tid >> 6, cl = lane & 15, g4 = lane >> 4;
    const bool prompt = unit < 256; const int g = prompt ? (unit & 63) : (unit - 256); const int b = unit >> 6;
    const float dt = expf(p.log_dt[g]);
    LAS float* E = (LAS float*)lds;
    LAS f32x4* CT = (LAS f32x4*)(lds + 65536);
    if (tid < 64) { float a_r, a_i, fr_, fi_; s5_coef(p, g, tid, dt, a_r, a_i, fr_, fi_); CT[tid] = (f32x4){a_r, a_i, fr_, fi_}; }
    __syncthreads();
    float ar[16], ai[16];
#pragma unroll
    for (int pb = 0; pb < 4; ++pb)
#pragma unroll
        for (int j = 0; j < 4; ++j) { const f32x4 t = CT[16 * pb + 4 * g4 + j]; ar[pb * 4 + j] = t[0]; ai[pb * 4 + j] = t[1]; }
    bf16x8 bre[4], bim[4], cf[4];
    const float bmask = g4 < 2 ? 1.0f : 0.0f;
#pragma unroll
    for (int pb = 0; pb < 4; ++pb) {
        const int pp = 16 * pb + cl; const f32x4 t = CT[pp]; const float fr_ = t[2] * bmask, fi_ = t[3] * bmask;
        const float* br = p.b_re + ((size_t)(g * 64 + pp)) * 16 + 8 * (g4 & 1); const float* bi = p.b_im + ((size_t)(g * 64 + pp)) * 16 + 8 * (g4 & 1);
        const f32x4 r0 = *(const f32x4*)br, r1 = *(const f32x4*)(br + 4), i0 = *(const f32x4*)bi, i1 = *(const f32x4*)(bi + 4);
        bre[pb] = pack8(fr_ * r0 - fi_ * i0, fr_ * r1 - fi_ * i1);
        bim[pb] = pack8(fr_ * i0 + fi_ * r0, fr_ * i1 + fi_ * r1);
    }
#pragma unroll
    for (int ks = 0; ks < 4; ++ks) {
        const float* cp = (ks < 2 ? p.c_re : p.c_im) + ((size_t)(g * 16 + cl)) * 64 + 32 * (ks & 1) + 4 * g4;
        f32x4 a = *(const f32x4*)cp, c = *(const f32x4*)(cp + 16);
        if (ks >= 2) { a = -a; c = -c; }
        cf[ks] = pack8(a, c);
    }
    const f32x4 dsk = *(const f32x4*)(p.ssm_d + g * 16 + 4 * g4);
    const int chain = 16 * w + cl;
    const size_t row0 = prompt ? (size_t)b * 2048 + (size_t)chain * 16 : (size_t)NPROMPT + 4 * chain;
    const size_t so = ((size_t)chain * 64 + g) * 64 + 4 * g4;
    const int nq = prompt ? 4 : 1;
    float sr[16], si[16];
#pragma unroll
    for (int k = 0; k < 16; ++k) { sr[k] = 0.f; si[k] = 0.f; }
    if (!prompt) {
#pragma unroll
        for (int pb = 0; pb < 4; ++pb) { const f32x4 a = *(const f32x4*)(p.state_re + so + 16 * pb), c = *(const f32x4*)(p.state_im + so + 16 * pb);
#pragma unroll
            for (int j = 0; j < 4; ++j) { sr[pb * 4 + j] = a[j]; si[pb * 4 + j] = c[j]; } }
    }
#pragma unroll 1
    for (int pass = prompt ? 0 : 1; pass < 2; ++pass) {
        if (pass == 1 && prompt) {
#pragma unroll
            for (int pb = 0; pb < 4; ++pb) {
                *(LAS f32x4*)(E + (chain * 2 + 0) * 64 + 16 * pb + 4 * g4) = (f32x4){sr[pb * 4], sr[pb * 4 + 1], sr[pb * 4 + 2], sr[pb * 4 + 3]};
                *(LAS f32x4*)(E + (chain * 2 + 1) * 64 + 16 * pb + 4 * g4) = (f32x4){si[pb * 4], si[pb * 4 + 1], si[pb * 4 + 2], si[pb * 4 + 3]};
            }
            __syncthreads();
            if (w == 0) {
                float a_r, a_i; { const f32x4 t = CT[lane]; a_r = t[0]; a_i = t[1]; }
#pragma unroll
                for (int q = 0; q < 4; ++q) { const float nr = a_r * a_r - a_i * a_i, ni = 2.0f * a_r * a_i; a_r = nr; a_i = ni; }
                float Fr = 0.f, Fi = 0.f;
#pragma unroll 8
                for (int k = 0; k < 128; ++k) {
                    const float er = E[(2 * k) * 64 + lane], ei = E[(2 * k + 1) * 64 + lane];
                    E[(2 * k) * 64 + lane] = Fr; E[(2 * k + 1) * 64 + lane] = Fi;
                    const float nr = a_r * Fr - a_i * Fi + er; Fi = a_r * Fi + a_i * Fr + ei; Fr = nr;
                }
                p.out[O_RP + (size_t)(b * 64 + g) * 64 + lane] = Fr; p.out[O_IP + (size_t)(b * 64 + g) * 64 + lane] = Fi;
            }
            __syncthreads();
#pragma unroll
            for (int pb = 0; pb < 4; ++pb) {
                const f32x4 a = *(LAS f32x4*)(E + (chain * 2 + 0) * 64 + 16 * pb + 4 * g4), c = *(LAS f32x4*)(E + (chain * 2 + 1) * 64 + 16 * pb + 4 * g4);
#pragma unroll
                for (int j = 0; j < 4; ++j) { sr[pb * 4 + j] = a[j]; si[pb * 4 + j] = c[j]; }
            }
        }
        S5In cur; s5_load4(cur, PROJ, row0, g, g4);
#pragma unroll 1
        for (int q = 0; q < nq; ++q) {
            S5In nxt = cur;
            if (q + 1 < nq) s5_load4(nxt, PROJ, row0 + 4 * (q + 1), g, g4);
            s5_steps4(cur, YS, row0 + 4 * q, g, g4, pass == 1, bre, bim, cf, ar, ai, dsk, sr, si);
            cur = nxt;
        }
    }
    if (!prompt) {
#pragma unroll
        for (int pb = 0; pb < 4; ++pb) {
            *(f32x4*)(p.out + O_RS + so + 16 * pb) = (f32x4){sr[pb * 4], sr[pb * 4 + 1], sr[pb * 4 + 2], sr[pb * 4 + 3]};
            *(f32x4*)(p.out + O_IS + so + 16 * pb) = (f32x4){si[pb * 4], si[pb * 4 + 1], si[pb * 4 + 2], si[pb * 4 + 3]};
        }
    }
    __syncthreads();
}

__device__ __forceinline__ void attn_prompt_unit(const P& p, const int unit, LAS unsigned char* lds) {
    const bf16_t* PROJ = (const bf16_t*)(p.ws + WS_PROJ); const bf16_t* KB = (const bf16_t*)(p.ws + WS_KB); const bf16_t* VT = (const bf16_t*)(p.ws + WS_VT);
    bf16_t* OATT = (bf16_t*)(p.ws + WS_OATT);
    const int tid = otid(), lane = tid & 63, w = tid >> 6, cl = lane & 15, g4 = lane >> 4;
    const int b = unit >> 6, h = (unit >> 4) & 3, qb = unit & 15;
    const bf16_t* kbase = KB + (size_t)(b * 256) * 1024 + h * 256;
#pragma unroll
    for (int i = 0; i < 16; ++i) { const int idx = tid + 512 * i, r = idx >> 5, m = idx & 31;
        const u32x4 v = *(const u32x4*)(kbase + (size_t)r * 1024 + m * 8); *(LAS u32x4*)(lds + r * 512 + ((m ^ (r & 15)) << 4)) = v; }
    const size_t qrow = (size_t)b * 2048 + qb * 128 + w * 16 + cl;
    const bf16_t* qp = PROJ + qrow * NIN + OFF_AQ + h * 256 + 8 * g4;
    bf16x8 qf[8];
#pragma unroll
    for (int ks = 0; ks < 8; ++ks) qf[ks] = *(const bf16x8*)(qp + 32 * ks);
    __syncthreads();
    f32x4 s[16];
#pragma unroll
    for (int kb = 0; kb < 16; ++kb) { s[kb] = (f32x4){0.f, 0.f, 0.f, 0.f};
#pragma unroll
        for (int ks = 0; ks < 8; ++ks) { const int key = 16 * kb + cl, m = 4 * ks + g4;
            const bf16x8 kf = *(const LAS bf16x8*)(lds + key * 512 + ((m ^ cl) << 4)); s[kb] = MFMA16(kf, qf[ks], s[kb]); }
        __builtin_amdgcn_sched_barrier(0); }
    __syncthreads();
    const bf16_t* vbase = VT + (size_t)((b * 4 + h) * 256) * 256;
    u32x4 vst[16];
#pragma unroll
    for (int i = 0; i < 16; ++i) { const int idx = tid + 512 * i, r = idx >> 5, m = idx & 31; vst[i] = *(const u32x4*)(vbase + (size_t)r * 256 + m * 8); }
    float mx = -3.0e38f;
#pragma unroll
    for (int kb = 0; kb < 16; ++kb)
#pragma unroll
        for (int j = 0; j < 4; ++j) mx = fmaxf(mx, s[kb][j]);
    mx = fmaxf(mx, __shfl_xor(mx, 16)); mx = fmaxf(mx, __shfl_xor(mx, 32));
    float sum = 0.f;
#pragma unroll
    for (int kb = 0; kb < 16; ++kb)
#pragma unroll
        for (int j = 0; j < 4; ++j) { const float e = __expf((s[kb][j] - mx) * 0.0625f); s[kb][j] = e; sum += e; }
    sum += __shfl_xor(sum, 16); sum += __shfl_xor(sum, 32);
    const float inv = rcp_(sum);
    bf16x8 pf[8];
#pragma unroll
    for (int kk = 0; kk < 8; ++kk) pf[kk] = pack8(s[2 * kk], s[2 * kk + 1]);
#pragma unroll
    for (int i = 0; i < 16; ++i) { const int idx = tid + 512 * i, r = idx >> 5, m = idx & 31; *(LAS u32x4*)(lds + r * 512 + ((m ^ (r & 15)) << 4)) = vst[i]; }
    __syncthreads();
    const bf16_t* azp = PROJ + qrow * NIN + OFF_AZ + h * 256 + 4 * g4;
    bf16_t* op = OATT + qrow * 1024 + h * 256 + 4 * g4;
#pragma unroll
    for (int db = 0; db < 16; ++db) {
        f32x4 o = (f32x4){0.f, 0.f, 0.f, 0.f}; const int d = 16 * db + cl;
#pragma unroll
        for (int kk = 0; kk < 8; ++kk) {
            const int ch0 = 8 * kk + g4, ch1 = ch0 + 4;
            const u32x2 lo = *(const LAS u32x2*)(lds + d * 512 + (((ch0 >> 1) ^ cl) << 4) + (ch0 & 1) * 8);
            const u32x2 hi = *(const LAS u32x2*)(lds + d * 512 + (((ch1 >> 1) ^ cl) << 4) + (ch1 & 1) * 8);
            const u32x4 vv = (u32x4){lo.x, lo.y, hi.x, hi.y};
            o = MFMA16(__builtin_bit_cast(bf16x8, vv), pf[kk], o);
        }
        const u32x2 az = *(const u32x2*)(azp + 16 * db);
        const float z[4] = {bf_lo(az.x), bf_hi(az.x), bf_lo(az.y), bf_hi(az.y)};
        u32x2 wv; wv.x = cvt_pk_bf16(o[0] * inv * siluf_(z[0]), o[1] * inv * siluf_(z[1])); wv.y = cvt_pk_bf16(o[2] * inv * siluf_(z[2]), o[3] * inv * siluf_(z[3]));
        *(u32x2*)(op + 16 * db) = wv;
        __builtin_amdgcn_sched_barrier(0);
    }
    __syncthreads();
}

__device__ __forceinline__ void attn_sample_pair(const P& p, const int u0, const int u1_, LAS unsigned char* lds) {
    const int u1 = u1_ < 512 ? u1_ : u0;
    const bf16_t* PROJ = (const bf16_t*)(p.ws + WS_PROJ); bf16_t* OATT = (bf16_t*)(p.ws + WS_OATT);
    const int tid = otid(), lane = tid & 63, w = tid >> 6, cl = lane & 15, g4 = lane >> 4;
    LAS float* Pw = (LAS float*)(lds + w * 512);
    LAS float* ST = (LAS float*)(lds + 4096);
    LAS float* OW = (LAS float*)(lds + 8192);
    f32x4 bA[16], bB[16], o[4], s0, s1;
    bf16x8 qf[8];
#define SA_LOADQ(unit) do { const bf16_t* qp_ = PROJ + ((size_t)NPROMPT + 4 * ((unit) >> 2) + (cl & 3)) * NIN + OFF_AQ + ((unit) & 3) * 256 + 8 * g4; \
        _Pragma("unroll") for (int ks = 0; ks < 8; ++ks) qf[ks] = *(const bf16x8*)(qp_ + 32 * ks); } while (0)
#define SA_LOADK(buf, unit, kblk) do { const float* kr_ = p.cache_k + ((size_t)((unit) >> 2) * 1024 + ((unit) & 3)) * 256 + (size_t)(32 * w + 16 * (kblk) + cl) * 1024 + 8 * g4; \
        _Pragma("unroll") for (int ks = 0; ks < 8; ++ks) { buf[2 * ks] = *(const f32x4*)(kr_ + 32 * ks); buf[2 * ks + 1] = *(const f32x4*)(kr_ + 32 * ks + 4); } } while (0)
#define SA_LOADV(buf, unit, half) do { const float* vr_ = p.cache_v + ((size_t)((unit) >> 2) * 1024 + ((unit) & 3)) * 256 + (size_t)(32 * w + 16 * (half)) * 1024 + 4 * lane; \
        _Pragma("unroll") for (int i = 0; i < 16; ++i) buf[i] = *(const f32x4*)(vr_ + (size_t)i * 1024); } while (0)
#define SA_QK(buf, sv) do { sv = (f32x4){0.f, 0.f, 0.f, 0.f}; _Pragma("unroll") for (int ks = 0; ks < 8; ++ks) sv = MFMA16(pack8(buf[2 * ks], buf[2 * ks + 1]), qf[ks], sv); } while (0)
#define SA_PV(buf, half) do { _Pragma("unroll") for (int ii = 0; ii < 4; ++ii) _Pragma("unroll") for (int q = 0; q < 4; ++q) { const f32x4 pv_ = *(const LAS f32x4*)(Pw + q * 32 + 16 * (half) + 4 * ii); \
        o[q] += pv_[0] * buf[4 * ii] + pv_[1] * buf[4 * ii + 1] + pv_[2] * buf[4 * ii + 2] + pv_[3] * buf[4 * ii + 3]; } } while (0)
#define SA_SOFTMAX(slot) do { float m_ = fmaxf(fmaxf(fmaxf(s0[0], s0[1]), fmaxf(s0[2], s0[3])), fmaxf(fmaxf(s1[0], s1[1]), fmaxf(s1[2], s1[3]))); \
        m_ = fmaxf(m_, __shfl_xor(m_, 16)); m_ = fmaxf(m_, __shfl_xor(m_, 32)); float l_ = 0.f; \
        _Pragma("unroll") for (int j = 0; j < 4; ++j) { s0[j] = __expf((s0[j] - m_) * 0.0625f); s1[j] = __expf((s1[j] - m_) * 0.0625f); l_ += s0[j] + s1[j]; } \
        l_ += __shfl_xor(l_, 16); l_ += __shfl_xor(l_, 32); \
        if (cl < 4) { *(LAS f32x4*)(Pw + cl * 32 + 4 * g4) = s0; *(LAS f32x4*)(Pw + cl * 32 + 16 + 4 * g4) = s1; \
            if (g4 == 0) { ST[(((slot) * 8 + w) * 4 + cl) * 2] = m_; ST[(((slot) * 8 + w) * 4 + cl) * 2 + 1] = l_; } } } while (0)
#define SA_OZERO() do { _Pragma("unroll") for (int q = 0; q < 4; ++q) o[q] = (f32x4){0.f, 0.f, 0.f, 0.f}; } while (0)
#define SA_OWRITE(slot) do { _Pragma("unroll") for (int q = 0; q < 4; ++q) *(LAS f32x4*)(OW + (size_t)((((slot) * 8 + w) * 4 + q) * 256) + 4 * lane) = o[q]; } while (0)
#define SA_SB() __builtin_amdgcn_sched_barrier(0)
    SA_LOADQ(u0);
    SA_LOADK(bA, u0, 0); SA_LOADK(bB, u0, 1); SA_SB();
    SA_QK(bA, s0); SA_LOADV(bA, u0, 0); SA_SB();
    SA_QK(bB, s1); SA_LOADV(bB, u0, 1); SA_SB();
    SA_SOFTMAX(0);
    SA_LOADQ(u1);
    SA_OZERO(); SA_SB();
    SA_PV(bA, 0); SA_LOADK(bA, u1, 0); SA_SB();
    SA_PV(bB, 1); SA_LOADK(bB, u1, 1); SA_SB();
    SA_OWRITE(0);
    {
        SA_QK(bA, s0); SA_LOADV(bA, u1, 0); SA_SB();
        SA_QK(bB, s1); SA_LOADV(bB, u1, 1); SA_SB();
        SA_SOFTMAX(1);
        SA_OZERO(); SA_SB();
        SA_PV(bA, 0); SA_SB();
        SA_PV(bB, 1);
        SA_OWRITE(1);
    }
    __syncthreads();
    {
        const int slot = tid >> 8, q = (tid >> 6) & 3, d = (tid & 63) * 4;
        const int unit = slot == 0 ? u0 : u1;
        {
            float M = -3.0e38f;
#pragma unroll
            for (int ww = 0; ww < 8; ++ww) M = fmaxf(M, ST[((slot * 8 + ww) * 4 + q) * 2]);
            float L = 0.f; f32x4 a = (f32x4){0.f, 0.f, 0.f, 0.f};
#pragma unroll
            for (int ww = 0; ww < 8; ++ww) { const float f = __expf((ST[((slot * 8 + ww) * 4 + q) * 2] - M) * 0.0625f); L += f * ST[((slot * 8 + ww) * 4 + q) * 2 + 1];
                a += f * *(const LAS f32x4*)(OW + (size_t)(((slot * 8 + ww) * 4 + q) * 256) + d); }
            const float inv = rcp_(L);
            const size_t row = (size_t)NPROMPT + 4 * (unit >> 2) + q; const int h = unit & 3;
            const u32x2 az = *(const u32x2*)(PROJ + row * NIN + OFF_AZ + h * 256 + d);
            u32x2 wv; wv.x = cvt_pk_bf16(a[0] * inv * siluf_(bf_lo(az.x)), a[1] * inv * siluf_(bf_hi(az.x))); wv.y = cvt_pk_bf16(a[2] * inv * siluf_(bf_lo(az.y)), a[3] * inv * siluf_(bf_hi(az.y)));
            *(u32x2*)(OATT + row * 1024 + h * 256 + d) = wv;
        }
    }
    __syncthreads();
#undef SA_LOADQ
#undef SA_LOADK
#undef SA_LOADV
#undef SA_QK
#undef SA_PV
#undef SA_SOFTMAX
#undef SA_OZERO
#undef SA_OWRITE
#undef SA_SB
}

__device__ __forceinline__ void phase5(const P& p) {
    const float* part = (const float*)(p.ws + WS_PART);
    const int t0 = otid(); const int lane = t0 & 63, gw = blockIdx.x * 8 + (t0 >> 6), nw = gridDim.x * 8;
    for (int row = gw; row < MTOK; row += nw) {
        float* orow = p.out + (size_t)row * DM;
        f32x4 v[8]; float s = 0.f;
        if (row < NPROMPT) {
            const float* xr = p.x_prompt + (size_t)row * DM; const bf16_t* dr = (const bf16_t*)(p.ws + WS_DELTA) + (size_t)row * DM;
#pragma unroll
            for (int i = 0; i < 8; ++i) { const u32x2 d = *(const u32x2*)(dr + 4 * (lane + 64 * i));
                v[i] = *(const f32x4*)(xr + 4 * (lane + 64 * i)) + (f32x4){bf_lo(d.x), bf_hi(d.x), bf_lo(d.y), bf_hi(d.y)}; }
        } else {
            const float* xr = p.x_sample + (size_t)(row - NPROMPT) * DM;
#pragma unroll
            for (int i = 0; i < 8; ++i) v[i] = *(const f32x4*)(xr + 4 * (lane + 64 * i));
#pragma unroll 2
            for (int ks = 0; ks < 8; ++ks) { const float* pr = part + ((size_t)ks * 512 + (row - NPROMPT)) * DM;
#pragma unroll
                for (int i = 0; i < 8; ++i) v[i] += *(const f32x4*)(pr + 4 * (lane + 64 * i)); }
        }
#pragma unroll
        for (int i = 0; i < 8; ++i) s += (v[i][0] * v[i][0] + v[i][1] * v[i][1]) + (v[i][2] * v[i][2] + v[i][3] * v[i][3]);
#pragma unroll
        for (int o = 32; o >= 1; o >>= 1) s += __shfl_xor(s, o);
        const float rstd = 1.0f / sqrtf(s * (1.0f / 2048.0f) + 1e-6f);
#pragma unroll
        for (int i = 0; i < 8; ++i) { const f32x4 gv = *(const f32x4*)(p.final_g + 4 * (lane + 64 * i)); *(f32x4*)(orow + 4 * (lane + 64 * i)) = v[i] * rstd * gv; }
    }
}

#define XB_TMO      128
#define XB_XCNT(j)  (256  + 64 * (j))
#define XB_XSUB(j)  (1280 + 64 * (j))
#define XB_XGEN(j)  (2304 + 64 * (j))
#define XB_TOP      3328
#define XB_TOPGEN   3392
#define XB_SPIN_CAP (1u << 20)
__device__ __forceinline__ unsigned xb_ld(unsigned* p)              { return __hip_atomic_load(p, __ATOMIC_RELAXED, __HIP_MEMORY_SCOPE_AGENT); }
__device__ __forceinline__ unsigned xb_add(unsigned* p, unsigned v) { return __hip_atomic_fetch_add(p, v, __ATOMIC_RELAXED, __HIP_MEMORY_SCOPE_AGENT); }
__device__ __forceinline__ unsigned xb_xcc_id() { return (unsigned)__builtin_amdgcn_s_getreg((3 << 11) | 20) & 0xFu; }
#define XB_SPIN(cond, bar) do { unsigned _sp = 0; while (cond) { __builtin_amdgcn_s_sleep(1); \
    if ((++_sp & 255u) == 0u) { if (xb_ld(&(bar)[XB_TMO])) break; if (_sp > XB_SPIN_CAP) { atomicAdd(&(bar)[XB_TMO], 1u); break; } } } } while (0)
struct XcdBarrier { unsigned* bar; unsigned x; volatile LAS unsigned* st; };
__device__ __forceinline__ XcdBarrier xcd_barrier_post(unsigned* bar, volatile LAS unsigned* st) {
    XcdBarrier b; b.bar = bar; b.x = xb_xcc_id(); b.st = st;
    if (threadIdx.x == 0) (void)xb_add(&bar[XB_XCNT(b.x)], 1u);
    return b;
}
__device__ __forceinline__ void xcd_barrier_complete(unsigned* bar, unsigned x, unsigned& nloc, unsigned& nx) {
    const unsigned G = gridDim.x * gridDim.y * gridDim.z;
    unsigned sum, cnt, mine, sp = 0u;
    for (;;) {
        sum = 0u; cnt = 0u; mine = 0u;
#pragma unroll
        for (unsigned j = 0; j < 16; ++j) { const unsigned c = xb_ld(&bar[XB_XCNT(j)]); sum += c; cnt += (c > 0u) ? 1u : 0u; mine = (j == x) ? c : mine; }
        if (sum == G) break;
        __builtin_amdgcn_s_sleep(1);
        if ((++sp & 255u) == 0u) { if (xb_ld(&bar[XB_TMO])) break; if (sp > XB_SPIN_CAP) { atomicAdd(&bar[XB_TMO], 1u); break; } }
    }
    nloc = mine > 0u ? mine : 1u; nx = cnt > 0u ? cnt : 1u;
}
__device__ __forceinline__ void xcd_barrier(const XcdBarrier& b) {
    asm volatile("s_waitcnt vmcnt(0)" ::: "memory");
    __syncthreads();
    if (threadIdx.x == 0) {
        unsigned* bar = b.bar;
        __builtin_amdgcn_s_waitcnt(0);
        unsigned nloc = b.st[0], nx = b.st[1];
        if (nloc == 0u) { xcd_barrier_complete(bar, b.x, nloc, nx); b.st[0] = nloc; b.st[1] = nx; }
        const unsigned old = xb_add(&bar[XB_XSUB(b.x)], 1u);
        const unsigned gen = old / nloc;
        if (old + 1u == (gen + 1u) * nloc) {
            __builtin_amdgcn_fence(__ATOMIC_RELEASE, "agent");
            asm volatile("s_waitcnt vmcnt(0)" ::: "memory");
            const unsigned og = xb_add(&bar[XB_TOP], 1u);
            const unsigned tg = og / nx;
            if (og + 1u == (tg + 1u) * nx) xb_add(&bar[XB_TOPGEN], 1u);
            else XB_SPIN(xb_ld(&bar[XB_TOPGEN]) == tg, bar);
            __builtin_amdgcn_fence(__ATOMIC_ACQUIRE, "agent");
            xb_add(&bar[XB_XGEN(b.x)], 1u);
            asm volatile("s_waitcnt vmcnt(0)" ::: "memory");
        } else {
            XB_SPIN(xb_ld(&bar[XB_XGEN(b.x)]) == gen, bar);
            __builtin_amdgcn_fence(__ATOMIC_ACQUIRE, "agent");
            asm volatile("s_waitcnt vmcnt(0)" ::: "memory");
        }
    }
    __syncthreads();
}

__global__ void __launch_bounds__(512, 2) mega_fwd(P p) {
    extern __shared__ __attribute__((aligned(16))) unsigned char shm[];
    LAS unsigned char* lds = (LAS unsigned char*)shm;
    cg::grid_group grid = cg::this_grid();
    unsigned char* ws = p.ws;
    const int G = gridDim.x, c = blockIdx.x;
    volatile LAS unsigned* bst = (volatile LAS unsigned*)(lds + 131072);
    if (threadIdx.x == 0) { bst[0] = 0u; bst[1] = 0u; }
    __syncthreads();
    const XcdBarrier xbar = xcd_barrier_post((unsigned*)(ws + WS_BAR), bst);
    if (p.out == nullptr) grid.sync();
#define GSYNC() xcd_barrier(xbar)

#ifndef PHMASK
#define PHMASK 0xffff
#endif
#ifndef REPMASK
#define REPMASK 0
#endif
#define NREP(bit) ((REPMASK & (bit)) ? 2 : 1)
#ifndef TPHASE
#define TPHASE -1
#endif
#ifndef TMULT
#define TMULT 4
#endif
    unsigned long long ts[8]; int nts = 0;
#define STAMP() do { if (TPHASE >= 0 && TPHASE < 10) { ts[nts] = wall_clock64(); } ++nts; } while (0)
    STAMP();
    for (int rep = 0; rep < NREP(1); ++rep) if (PHMASK & 1) phase0(p, lds);
    GSYNC(); STAMP();

    for (int rep = 0; rep < NREP(2); ++rep) if (PHMASK & 2) {
        Sched1 S{(const char*)(ws + WS_H), (const char*)(ws + WS_WIN), (const char*)(ws + WS_MEMN), (const char*)(ws + WS_WK), (const char*)(ws + WS_WV), G, c};
        Epi1 E{(bf16_t*)(ws + WS_PROJ), p.out + O_MK, (bf16_t*)(ws + WS_KB), p.out + O_MV, (bf16_t*)(ws + WS_VT)};
        pg8::gemm_phase(lds, 2048, 2048, S, E);
    }
    GSYNC(); STAMP();

    for (int rep = 0; rep < NREP(4); ++rep) {
        unsigned long long m0 = 0, m1 = 0, m2 = 0, m3 = 0, m4 = 0;
        if (TPHASE >= 10) m0 = wall_clock64();
        const int sg = (c >> 3) & 3;
        if (sg == 0) for (int u = c; u < 512; u += 2 * G) attn_sample_pair(p, u, u + G, lds);
        if (TPHASE >= 10) m1 = wall_clock64();
        for (int u = c; u < 256; u += G) s5_unit(p, u, lds);
        for (int u = 256 + (G - 1 - c); u < 320; u += G) s5_unit(p, u, lds);
        if (TPHASE >= 10) m2 = wall_clock64();
        if (sg == 1) for (int u = c; u < 512; u += 2 * G) attn_sample_pair(p, u, u + G, lds);
        for (int u = c; u < 256; u += G) attn_prompt_unit(p, u, lds);
        if (TPHASE >= 10) m3 = wall_clock64();
        if (sg == 2) for (int u = c; u < 512; u += 2 * G) attn_sample_pair(p, u, u + G, lds);
        conv_phase(p);
        if (sg == 3) for (int u = c; u < 512; u += 2 * G) attn_sample_pair(p, u, u + G, lds);
        late_transposes(p, lds, c, G, G == 256 ? 512 : 768);
        if (TPHASE >= 10) { m4 = wall_clock64(); ts[0] = 0; ts[1] = TPHASE == 10 ? m1 - m0 : (TPHASE == 11 ? m2 - m1 : (TPHASE == 12 ? m3 - m2 : m4 - m3)); }
    }
    GSYNC(); STAMP();

    for (int rep = 0; rep < NREP(8); ++rep) if (PHMASK & 64) {
        { Sched1g Sg{(const char*)(ws + WS_H), (const char*)(ws + WS_WIN), G, c}; Epi1 Eg{(bf16_t*)(ws + WS_PROJ), p.out + O_MK, (bf16_t*)(ws + WS_KB), p.out + O_MV, (bf16_t*)(ws + WS_VT)}; pg8::gemm_phase(lds, 2048, 2048, Sg, Eg); }
        if (G == 256 && c >= 144) late_transposes(p, lds, 512 + (c - 144), 112, 768);
        Sched2 S{(const char*)ws, G, c};
        Epi2 E{(bf16_t*)(ws + WS_GLU), (bf16_t*)(ws + WS_CONVO), (bf16_t*)(ws + WS_ATTO)};
        pg8::gemm_phase(lds, 1024, 1024, S, E);
    }
    GSYNC(); STAMP();

    for (int rep = 0; rep < NREP(32); ++rep) merge_phase(p);
    GSYNC(); STAMP();

    for (int rep = 0; rep < NREP(16); ++rep) if (PHMASK & 128) {
        { Sched3 S{(const char*)(ws + WS_MERGED), (const char*)(ws + WS_WO), G, c}; Epi3 E{(bf16_t*)(ws + WS_DELTA), (float*)(ws + WS_PART), false}; pg8::gemm_phase(lds, 2048, 2048, S, E); }
        { Sched3b S{(const char*)(ws + WS_MERGED), (const char*)(ws + WS_WO), G, c}; Epi3 E{(bf16_t*)(ws + WS_DELTA), (float*)(ws + WS_PART), true}; pg8::gemm_phase(lds, 256, 2048, S, E); }
    }
    GSYNC(); STAMP();

    if (PHMASK & 256) phase5(p);
    STAMP();
    if (TPHASE >= 0 && blockIdx.x == 0 && threadIdx.x == 0) {
        const unsigned long long d = (TPHASE >= 10 ? ts[1] - ts[0] : ts[TPHASE + 1] - ts[TPHASE]) * TMULT, t0 = wall_clock64();
        while (wall_clock64() - t0 < d) __builtin_amdgcn_s_sleep(16);
    }
}

extern "C" void kernel_launch(void* const* d_in, const int* in_sizes, int n_in, void* d_out, int out_size, void* d_ws, size_t ws_size, hipStream_t stream) {
    static int grid = 0;
    if (grid == 0) {
        int dev = 0, cus = 0, per_cu = 0;
        hipGetDevice(&dev);
        hipDeviceGetAttribute(&cus, hipDeviceAttributeMultiprocessorCount, dev);
        if (hipFuncSetAttribute((const void*)mega_fwd, hipFuncAttributeMaxDynamicSharedMemorySize, LDS_BYTES) != hipSuccess) fprintf(stderr, "kernel_launch: hipFuncSetAttribute failed\n");
        if (hipOccupancyMaxActiveBlocksPerMultiprocessor(&per_cu, (const void*)mega_fwd, 512, LDS_BYTES) != hipSuccess || per_cu < 1) per_cu = 1;
        (void)hipGetLastError();
        grid = cus * per_cu;
        if (ws_size < WS_END) fprintf(stderr, "kernel_launch: workspace too small (%zu < %zu)\n", ws_size, (size_t)WS_END);
    }
    P p{};
    const float** pp = (const float**)&p;
    for (int i = 0; i < 28; ++i) pp[i] = (const float*)d_in[i];
    p.out = (float*)d_out; p.ws = (unsigned char*)d_ws;
    void* args[] = {&p};
    (void)hipMemsetAsync((unsigned char*)d_ws + WS_BAR, 0, 16384, stream);
    hipError_t e = hipLaunchCooperativeKernel((const void*)mega_fwd, dim3(grid), dim3(512), args, LDS_BYTES, stream);
    if (e != hipSuccess) fprintf(stderr, "cooperative launch failed: %s (grid %d)\n", hipGetErrorString(e), grid);
}
```

```cpp
#include <hip/hip_runtime.h>
#include <hip/hip_cooperative_groups.h>
#include <cstdio>
namespace cg = cooperative_groups;

#define LAS __attribute__((address_space(3)))
typedef unsigned short bf16_t;
typedef short bf16x8 __attribute__((ext_vector_type(8)));
typedef float f32x4 __attribute__((ext_vector_type(4)));
typedef unsigned u32x4 __attribute__((ext_vector_type(4)));
typedef unsigned u32x2 __attribute__((ext_vector_type(2)));

constexpr int DM = 2048, NPROMPT = 8192, NSAMPLE = 512, MTOK = 8704, NIN = 14336;
constexpr int OFF_CB = 0, OFF_CC = 1024, OFF_CH = 2048, OFF_CZ = 3072, OFF_SU = 4096, OFF_SZ = 5120, OFF_AQ = 6144, OFF_AZ = 7168, OFF_G = 8192;
constexpr int LDS_BYTES = 131072 + 16;
constexpr size_t O_Y = 0, O_MK = 17825792, O_MV = 18874368, O_CP = 19922944, O_RP = 19931136, O_IP = 19947520, O_CS = 19963904, O_RS = 20226048, O_IS = 20750336;
constexpr size_t WS_WIN = 0;
constexpr size_t WS_WG = WS_WIN + (size_t)NIN * DM * 2;
constexpr size_t WS_WC = WS_WG + 8388608;
constexpr size_t WS_WA = WS_WC + 4194304;
constexpr size_t WS_WO = WS_WA + 4194304;
constexpr size_t WS_H = WS_WO + 8388608;
constexpr size_t WS_PROJ = WS_H + (size_t)MTOK * DM * 2;
constexpr size_t WS_YS = WS_PROJ + (size_t)MTOK * NIN * 2;
constexpr size_t WS_ACONV = WS_YS + (size_t)MTOK * 1024 * 2;
constexpr size_t WS_OATT = WS_ACONV + (size_t)MTOK * 1024 * 2;
constexpr size_t WS_SS = WS_OATT + (size_t)MTOK * 1024 * 2;
constexpr size_t WS_GLU = WS_SS + (size_t)MTOK * 32 * 4;
constexpr size_t WS_MERGED = WS_GLU + (size_t)MTOK * DM * 2;
constexpr size_t WS_BAR = WS_MERGED + (size_t)MTOK * DM * 2;
constexpr size_t WS_MEMN = WS_BAR + 16384;
constexpr size_t WS_WK = WS_MEMN + 4194304;
constexpr size_t WS_WV = WS_WK + 4194304;
constexpr size_t WS_KB = WS_WV + 4194304;
constexpr size_t WS_VT = WS_KB + 2097152;
constexpr size_t WS_ATTO = WS_MEMN;
constexpr size_t WS_END = WS_ATTO + (size_t)MTOK * DM * 2;
constexpr size_t WS_CONVO = WS_WIN, WS_PART = WS_PROJ, WS_DELTA = WS_PROJ + 67108864;
static_assert(WS_END <= 536870912, "workspace");
static_assert(WS_VT + 2097152 <= WS_END && (size_t)MTOK * DM * 2 <= 38u * 1048576u, "aliases");

struct P {
    const float *x_prompt, *x_sample, *mem_prompt, *cache_k, *cache_v, *state_conv, *state_re, *state_im, *norm_g, *mem_norm_g, *w_in, *conv_w, *w_conv_out,
        *lam_re, *lam_im, *log_dt, *b_re, *b_im, *c_re, *c_im, *ssm_d, *w_glu_a, *w_glu_b, *w_mem_k, *w_mem_v, *w_attn_out, *w_out, *final_g;
    float* out; unsigned char* ws;
};

__device__ __forceinline__ unsigned cvt_pk_bf16(float lo, float hi) { unsigned r; asm("v_cvt_pk_bf16_f32 %0, %1, %2" : "=v"(r) : "v"(lo), "v"(hi)); return r; }
__device__ __forceinline__ float bf_lo(unsigned w) { return __uint_as_float(w << 16); }
__device__ __forceinline__ float bf_hi(unsigned w) { return __uint_as_float(w & 0xffff0000u); }
__device__ __forceinline__ float rcp_(float x) { return __builtin_amdgcn_rcpf(x); }
__device__ __forceinline__ float sigmoidf_(float x) { return rcp_(1.0f + __expf(-x)); }
__device__ __forceinline__ float siluf_(float x) { return x * rcp_(1.0f + __expf(-x)); }
__device__ __forceinline__ float gelu_tanh(float x) { const float u = 1.5957691216057308f * (x + 0.044715f * x * x * x); return x * rcp_(1.0f + __expf(-u)); }
__device__ __forceinline__ bf16x8 pack8(const f32x4 a, const f32x4 b) {
    u32x4 w; w.x = cvt_pk_bf16(a[0], a[1]); w.y = cvt_pk_bf16(a[2], a[3]); w.z = cvt_pk_bf16(b[0], b[1]); w.w = cvt_pk_bf16(b[2], b[3]);
    return __builtin_bit_cast(bf16x8, w);
}
__device__ __forceinline__ u32x4 pack8u(const f32x4 a, const f32x4 b) {
    u32x4 w; w.x = cvt_pk_bf16(a[0], a[1]); w.y = cvt_pk_bf16(a[2], a[3]); w.z = cvt_pk_bf16(b[0], b[1]); w.w = cvt_pk_bf16(b[2], b[3]); return w;
}
__device__ __forceinline__ void unpack8(const u32x4 w, float (&f)[8]) {
    f[0] = bf_lo(w.x); f[1] = bf_hi(w.x); f[2] = bf_lo(w.y); f[3] = bf_hi(w.y); f[4] = bf_lo(w.z); f[5] = bf_hi(w.z); f[6] = bf_lo(w.w); f[7] = bf_hi(w.w);
}
__device__ __forceinline__ int otid() { int t = threadIdx.x; asm volatile("" : "+v"(t)); return t; }
#define MFMA16(a, b, c) __builtin_amdgcn_mfma_f32_16x16x32_bf16((a), (b), (c), 0, 0, 0)

namespace pg8 {
constexpr int BM = 256, BK = 64, HALF = 128, HTB = HALF * BK * 2, STAGE_BYTES = 8 * HTB;
__device__ __forceinline__ int lds_byte(int r, int c) { const int st = (r >> 4) * 2 + (c >> 5), rr = r & 15, cc = c & 31, ob = rr * 64 + cc * 2; return st * 1024 + (ob ^ (((ob >> 9) & 1) << 5)); }
__device__ __forceinline__ void stage_rc(int b, int& R, int& C) { const int st = b / 1024, sb = b % 1024, swz = sb ^ (((sb >> 9) & 1) << 5); R = (st >> 1) * 16 + swz / 64; C = (st & 1) * 32 + (swz % 64) / 2; }
__device__ __forceinline__ int perm32(int rho) { const int n = rho >> 4, i = rho & 15; return 8 * (i >> 2) + 4 * n + (i & 3); }
struct Unit { const char* a; const char* b; int pm, pn, kind; };

template <class Sched, class Epi>
__device__ __forceinline__ void gemm_phase(LAS unsigned char* lds, const int K, const int ld, const Sched& S, const Epi& E) {
    const int tid = otid(), wid = __builtin_amdgcn_readfirstlane(tid >> 6), lane = tid & 63, wr = wid >> 2, wc = wid & 3, fr = lane & 15, fq = lane >> 4;
    const int nt = K / BK;
    unsigned voffA[2], voffB[2];
#pragma unroll
    for (int i = 0; i < 2; ++i) { int R, C; stage_rc(tid * 16 + i * 8192, R, C); const int Rb = (R & ~31) + perm32(R & 31);
        voffA[i] = (unsigned)(R * ld + C) * 2u; voffB[i] = (unsigned)(Rb * ld + C) * 2u; }
    const size_t kstep = (size_t)(BK * 2);
    const size_t hstep = (size_t)HALF * ld * 2;
    const unsigned ldsw = (unsigned)wid * 1024u;
    const int aoff = lds_byte(wr * 64 + fr, fq * 8), boff = lds_byte(wc * 32 + fr, fq * 8);
#define PG8_SA(b, h) (((b) * 2 + (h)) * HTB)
#define PG8_SB(b, h) ((4 + (b) * 2 + (h)) * HTB)
#define PG8_STAGE(bufoff, gbase, voff) do { _Pragma("unroll") for (int _i = 0; _i < 2; ++_i) \
        __builtin_amdgcn_global_load_lds((const unsigned*)((const char*)(gbase) + (voff)[_i]), (LAS unsigned*)(lds + (bufoff) + ldsw + _i * 8192), 16, 0, 0); } while (0)
#define PG8_LDA(dst, b, h) do { _Pragma("unroll") for (int m = 0; m < 4; ++m) _Pragma("unroll") for (int k = 0; k < 2; ++k) dst[m][k] = *(const LAS bf16x8*)(lds + PG8_SA(b, h) + aoff + m * 2048 + k * 1024); } while (0)
#define PG8_LDB(dst, b, h) do { _Pragma("unroll") for (int n = 0; n < 2; ++n) _Pragma("unroll") for (int k = 0; k < 2; ++k) dst[n][k] = *(const LAS bf16x8*)(lds + PG8_SB(b, h) + boff + n * 2048 + k * 1024); } while (0)
#define PG8_MMA(ai, bj, At, Bt) do { __builtin_amdgcn_s_setprio(1); _Pragma("unroll") for (int m = 0; m < 4; ++m) _Pragma("unroll") for (int n = 0; n < 2; ++n) _Pragma("unroll") for (int k = 0; k < 2; ++k) \
        acc[ai][bj][m][n] = __builtin_amdgcn_mfma_f32_16x16x32_bf16(Bt[n][k], At[m][k], acc[ai][bj][m][n], 0, 0, 0); __builtin_amdgcn_s_setprio(0); } while (0)
#define PG8_WAIT_V(n) asm volatile("s_waitcnt vmcnt(" #n ")" ::: "memory")
#define PG8_WAIT_L(n) asm volatile("s_waitcnt lgkmcnt(" #n ")" ::: "memory")
#define PG8_BAR __builtin_amdgcn_s_barrier()
#define PG8_SCHED __builtin_amdgcn_sched_barrier(0)
    Unit cur, nxt; int ui = 0;
    if (!S.next(0, cur)) return;
    f32x4 acc[2][2][4][2];
#pragma unroll
    for (int a = 0; a < 2; ++a)
#pragma unroll
        for (int b = 0; b < 2; ++b)
#pragma unroll
            for (int m = 0; m < 4; ++m)
#pragma unroll
                for (int n = 0; n < 2; ++n) acc[a][b][m][n] = (f32x4){0.f, 0.f, 0.f, 0.f};
    bf16x8 At[4][2], B0[2][2], B1[2][2];
    const char* cA = cur.a; const char* cB = cur.b;
    PG8_STAGE(PG8_SB(0, 0), cB, voffB); PG8_STAGE(PG8_SA(0, 0), cA, voffA); PG8_STAGE(PG8_SB(0, 1), cB + hstep, voffB); PG8_STAGE(PG8_SA(0, 1), cA + hstep, voffA);
    if (wr == 1) PG8_BAR;
    PG8_WAIT_V(4); PG8_BAR;
    PG8_STAGE(PG8_SB(1, 0), cB + kstep, voffB); PG8_STAGE(PG8_SA(1, 0), cA + kstep, voffA); PG8_STAGE(PG8_SB(1, 1), cB + hstep + kstep, voffB);
    PG8_WAIT_V(6); PG8_BAR;
    for (;;) {
        const bool has_next = S.next(ui + 1, nxt);
        const char* nA = has_next ? nxt.a : cA; const char* nB = has_next ? nxt.b : cB;
        for (int t = 0; t < nt; t += 2) {
            const bool last = (t == nt - 2);
            const char* a1 = cA + (size_t)(t + 1) * kstep;
            const char* a2 = last ? nA : cA + (size_t)(t + 2) * kstep; const char* b2 = last ? nB : cB + (size_t)(t + 2) * kstep;
            const char* a3 = a2 + kstep; const char* b3 = b2 + kstep;
            PG8_LDB(B0, 0, 0); PG8_SCHED; PG8_LDA(At, 0, 0); PG8_STAGE(PG8_SA(1, 1), a1 + hstep, voffA);
            PG8_WAIT_L(8); PG8_BAR; PG8_WAIT_L(0); PG8_MMA(0, 0, At, B0); PG8_BAR; PG8_SCHED;
            PG8_LDB(B1, 0, 1); PG8_STAGE(PG8_SB(0, 0), b2, voffB);
            PG8_BAR; PG8_WAIT_L(0); PG8_MMA(0, 1, At, B1); PG8_BAR;
            PG8_LDA(At, 0, 1); PG8_STAGE(PG8_SA(0, 0), a2, voffA);
            PG8_BAR; PG8_WAIT_L(0); PG8_MMA(1, 0, At, B0); PG8_BAR; PG8_SCHED;
            PG8_STAGE(PG8_SB(0, 1), b2 + hstep, voffB);
            PG8_WAIT_V(6); PG8_BAR; PG8_MMA(1, 1, At, B1); PG8_BAR;
            PG8_LDB(B0, 1, 0); PG8_SCHED; PG8_LDA(At, 1, 0); PG8_STAGE(PG8_SA(0, 1), a2 + hstep, voffA);
            PG8_WAIT_L(8); PG8_BAR; PG8_WAIT_L(0); PG8_MMA(0, 0, At, B0); PG8_BAR; PG8_SCHED;
            PG8_LDB(B1, 1, 1); PG8_STAGE(PG8_SB(1, 0), b3, voffB);
            PG8_BAR; PG8_WAIT_L(0); PG8_MMA(0, 1, At, B1); PG8_BAR;
            PG8_LDA(At, 1, 1); PG8_STAGE(PG8_SA(1, 0), a3, voffA);
            PG8_BAR; PG8_WAIT_L(0); PG8_MMA(1, 0, At, B0); PG8_BAR; PG8_SCHED;
            PG8_STAGE(PG8_SB(1, 1), b3 + hstep, voffB);
            PG8_WAIT_V(6); PG8_BAR; PG8_MMA(1, 1, At, B1); PG8_BAR;
        }
        const bool keep = E(acc, cur, wr, wc, fr, fq);
        if (!has_next) break;
        if (!keep) {
#pragma unroll
            for (int a = 0; a < 2; ++a)
#pragma unroll
                for (int b = 0; b < 2; ++b)
#pragma unroll
                    for (int m = 0; m < 4; ++m)
#pragma unroll
                        for (int n = 0; n < 2; ++n) acc[a][b][m][n] = (f32x4){0.f, 0.f, 0.f, 0.f};
        }
        cur = nxt; cA = nA; cB = nB; ++ui;
    }
    PG8_WAIT_V(0);
    if (wr == 0) PG8_BAR;
    PG8_BAR;
#undef PG8_SA
#undef PG8_SB
#undef PG8_STAGE
#undef PG8_LDA
#undef PG8_LDB
#undef PG8_MMA
#undef PG8_WAIT_V
#undef PG8_WAIT_L
#undef PG8_BAR
#undef PG8_SCHED
}
}
using pg8::Unit;

__device__ __forceinline__ void xcd_tile_order(int wgid, const int nM, const int nN, int& pm, int& pn) {
    const int nwg = nM * nN, NX = 8, WGM = 8;
    { const int q = nwg / NX, r = nwg % NX, xcd = wgid % NX, off = wgid / NX; wgid = (xcd < r ? xcd * (q + 1) : r * (q + 1) + (xcd - r) * q) + off; }
    const int nig = WGM * nN, gid = wgid / nig, fm = gid * WGM, gsz = (nM - fm) < WGM ? (nM - fm) : WGM;
    pm = fm + ((wgid % nig) % gsz); pn = (wgid % nig) / gsz;
}
struct Sched1 {
    const char *H, *WIN, *MEMN, *WK, *WV; int G, c;
    __device__ __forceinline__ bool next(int i, Unit& u) const {
        const int L = i * G + c; if (L >= 1792) return false;
        if (L < 1760) {
            int pm, pn;
            if (L < 1292) xcd_tile_order(L, 34, 38, pm, pn);
            else { xcd_tile_order(L - 1292, 26, 18, pm, pn); pn += 38; }
            u.pm = pm; u.pn = pn; u.kind = 0; u.a = H + (size_t)pm * 1048576; u.b = WIN + (size_t)pn * 1048576;
        } else if (L < 1776) { const int j = L - 1760; u.pm = j >> 2; u.pn = j & 3; u.kind = 1; u.a = MEMN + (size_t)u.pm * 1048576; u.b = WK + (size_t)u.pn * 1048576; }
        else { const int j = L - 1776; u.pm = j >> 2; u.pn = j & 3; u.kind = 2; u.a = WV + (size_t)u.pm * 1048576; u.b = MEMN + (size_t)u.pn * 1048576; }
        return true;
    }
};
struct Sched1g {
    const char *H, *WIN; int G, c;
    __device__ __forceinline__ bool next(int i, Unit& u) const {
        const int j = i * G + c; if (j >= 144) return false;
        u.pm = 26 + j / 18; u.pn = 38 + j % 18; u.kind = 0; u.a = H + (size_t)u.pm * 1048576; u.b = WIN + (size_t)u.pn * 1048576; return true;
    }
};
struct Epi1 {
    bf16_t* PROJ; float* outK; bf16_t* KB; float* outV; bf16_t* VT;
    __device__ __forceinline__ bool operator()(f32x4 (&acc)[2][2][4][2], const Unit& u, int wr, int wc, int fr, int fq) const {
        const int r0 = u.pm * 256 + wr * 64 + fr, c0 = u.pn * 256 + wc * 32 + 8 * fq;
        if (u.kind == 0) {
#pragma unroll
            for (int ai = 0; ai < 2; ++ai)
#pragma unroll
                for (int m = 0; m < 4; ++m) { bf16_t* rowp = PROJ + (size_t)(r0 + ai * 128 + m * 16) * NIN + c0;
#pragma unroll
                    for (int bj = 0; bj < 2; ++bj) *(u32x4*)(rowp + bj * 128) = pack8u(acc[ai][bj][m][0], acc[ai][bj][m][1]); }
        } else if (u.kind == 1) {
#pragma unroll
            for (int ai = 0; ai < 2; ++ai)
#pragma unroll
                for (int m = 0; m < 4; ++m) { const size_t off = (size_t)(r0 + ai * 128 + m * 16) * 1024 + c0;
#pragma unroll
                    for (int bj = 0; bj < 2; ++bj) { *(f32x4*)(outK + off + bj * 128) = acc[ai][bj][m][0]; *(f32x4*)(outK + off + bj * 128 + 4) = acc[ai][bj][m][1];
                        *(u32x4*)(KB + off + bj * 128) = pack8u(acc[ai][bj][m][0], acc[ai][bj][m][1]); } }
        } else {
            const int h = u.pm, b = u.pn;
#pragma unroll
            for (int ai = 0; ai < 2; ++ai)
#pragma unroll
                for (int m = 0; m < 4; ++m) { const int d = wr * 64 + fr + ai * 128 + m * 16;
#pragma unroll
                    for (int bj = 0; bj < 2; ++bj) { const int key0 = wc * 32 + 8 * fq + bj * 128;
                        *(u32x4*)(VT + ((size_t)((b * 4 + h) * 256 + d)) * 256 + key0) = pack8u(acc[ai][bj][m][0], acc[ai][bj][m][1]);
                        float* fp = outV + ((size_t)(b * 256 + key0)) * 1024 + h * 256 + d;
#pragma unroll
                        for (int e = 0; e < 4; ++e) { fp[(size_t)e * 1024] = acc[ai][bj][m][0][e]; fp[(size_t)(e + 4) * 1024] = acc[ai][bj][m][1][e]; } } }
        }
        return false;
    }
};

struct Sched2 {
    const char* ws; int G, c;
    __device__ __forceinline__ bool next(int i, Unit& u) const {
        int L;
        if (G == 256) { if (c < 144) { if (i >= 4) return false; L = c + 144 * i; } else { L = 576 + (c - 144) + 112 * i; } }
        else L = i * G + c;
        if (L >= 1088) return false;
        if (L < 544) { u.pm = L >> 4; u.pn = L & 15; u.kind = 0; u.a = ws + WS_YS + (size_t)u.pm * 524288; u.b = ws + WS_WG + (size_t)u.pn * 524288; }
        else { const int j = L - 544, k = j >= 272 ? 1 : 0, jj = j - 272 * k; u.pm = jj >> 3; u.pn = jj & 7; u.kind = 1 + k;
            u.a = ws + WS_ACONV + (size_t)k * ((size_t)MTOK * 1024 * 2) + (size_t)u.pm * 524288; u.b = ws + WS_WC + (size_t)k * 4194304 + (size_t)u.pn * 524288; }
        return true;
    }
};
struct Epi2 {
    bf16_t* GLU; bf16_t* CONVO; bf16_t* ATTO;
    __device__ __forceinline__ bool operator()(f32x4 (&acc)[2][2][4][2], const Unit& u, int wr, int wc, int fr, int fq) const {
        const int r0 = u.pm * 256 + wr * 64 + fr;
        if (u.kind == 0) {
            const int c0 = u.pn * 128 + wc * 32 + 8 * fq;
#pragma unroll
            for (int ai = 0; ai < 2; ++ai)
#pragma unroll
                for (int m = 0; m < 4; ++m) {
                    f32x4 t0, t1;
#pragma unroll
                    for (int e = 0; e < 4; ++e) { t0[e] = acc[ai][0][m][0][e] * sigmoidf_(acc[ai][1][m][0][e]); t1[e] = acc[ai][0][m][1][e] * sigmoidf_(acc[ai][1][m][1][e]); }
                    *(u32x4*)(GLU + (size_t)(r0 + ai * 128 + m * 16) * 2048 + c0) = pack8u(t0, t1);
                }
        } else {
            bf16_t* O = u.kind == 1 ? CONVO : ATTO; const int c0 = u.pn * 256 + wc * 32 + 8 * fq;
#pragma unroll
            for (int ai = 0; ai < 2; ++ai)
#pragma unroll
                for (int m = 0; m < 4; ++m) { bf16_t* rowp = O + (size_t)(r0 + ai * 128 + m * 16) * 2048 + c0;
#pragma unroll
                    for (int bj = 0; bj < 2; ++bj) *(u32x4*)(rowp + bj * 128) = pack8u(acc[ai][bj][m][0], acc[ai][bj][m][1]); }
        }
        return false;
    }
};
__device__ __forceinline__ void merge_phase(const P& p) {
    const bf16_t* PROJ = (const bf16_t*)(p.ws + WS_PROJ); const bf16_t* GLU = (const bf16_t*)(p.ws + WS_GLU); const bf16_t* CONVO = (const bf16_t*)(p.ws + WS_CONVO);
    const bf16_t* ATTO = (const bf16_t*)(p.ws + WS_ATTO); bf16_t* MERGED = (bf16_t*)(p.ws + WS_MERGED);
    const int NT = MTOK * 256, stride = gridDim.x * 512;
    for (int t = blockIdx.x * 512 + otid(); t < NT; t += 2 * stride) {
        u32x4 L[2][6]; const int t1 = t + stride; const bool has1 = t1 < NT;
#pragma unroll
        for (int k = 0; k < 2; ++k) { const int tt = k == 0 ? t : (has1 ? t1 : t);
            const size_t row = (size_t)(tt >> 8); const int c0 = (tt & 255) * 8; const bf16_t* pr = PROJ + row * NIN + OFF_G + c0; const size_t o = row * 2048 + c0;
            L[k][0] = *(const u32x4*)pr; L[k][1] = *(const u32x4*)(pr + 2048); L[k][2] = *(const u32x4*)(pr + 4096);
            L[k][3] = *(const u32x4*)(CONVO + o); L[k][4] = *(const u32x4*)(GLU + o); L[k][5] = *(const u32x4*)(ATTO + o); }
#pragma unroll
        for (int k = 0; k < 2; ++k) { if (k == 1 && !has1) break; const int tt = k == 0 ? t : t1;
            const size_t row = (size_t)(tt >> 8); const int c0 = (tt & 255) * 8; const size_t o = row * 2048 + c0;
            float g0[8], g1[8], g2[8], cv[8], gl[8], at[8];
            unpack8(L[k][0], g0); unpack8(L[k][1], g1); unpack8(L[k][2], g2); unpack8(L[k][3], cv); unpack8(L[k][4], gl); unpack8(L[k][5], at);
            f32x4 m0, m1;
#pragma unroll
            for (int e = 0; e < 8; ++e) { const float v = sigmoidf_(g0[e]) * cv[e] + sigmoidf_(g1[e]) * gl[e] + sigmoidf_(g2[e]) * at[e]; if (e < 4) m0[e] = v; else m1[e - 4] = v; }
            *(u32x4*)(MERGED + o) = pack8u(m0, m1); }
    }
}

struct Sched3 {
    const char *MERGED, *WO; int G, c;
    __device__ __forceinline__ bool next(int i, Unit& u) const {
        const int L = i * G + c; if (L >= 256) return false;
        u.pm = L >> 3; u.pn = L & 7; u.kind = 0; u.a = MERGED + (size_t)u.pm * 1048576; u.b = WO + (size_t)u.pn * 1048576; return true;
    }
};
struct Sched3b {
    const char *MERGED, *WO; int G, c;
    __device__ __forceinline__ bool next(int i, Unit& u) const {
        const int L = i * G + c; if (L >= 128) return false;
        const int tile = L >> 3, ks = L & 7; u.pm = 32 + (tile >> 3); u.pn = tile & 7; u.kind = ks;
        u.a = MERGED + (size_t)u.pm * 1048576 + (size_t)ks * 512; u.b = WO + (size_t)u.pn * 1048576 + (size_t)ks * 512; return true;
    }
};
struct Epi3 {
    bf16_t* delta; float* part;
    bool sample;
    __device__ __forceinline__ bool operator()(f32x4 (&acc)[2][2][4][2], const Unit& u, int wr, int wc, int fr, int fq) const {
        const int r0 = u.pm * 256 + wr * 64 + fr, c0 = u.pn * 256 + wc * 32 + 8 * fq;
        if (!sample) {
#pragma unroll
            for (int ai = 0; ai < 2; ++ai)
#pragma unroll
                for (int m = 0; m < 4; ++m) { bf16_t* o = delta + (size_t)(r0 + ai * 128 + m * 16) * DM + c0;
#pragma unroll
                    for (int bj = 0; bj < 2; ++bj) *(u32x4*)(o + bj * 128) = pack8u(acc[ai][bj][m][0], acc[ai][bj][m][1]); }
        } else {
            float* base = part + ((size_t)u.kind * 512 - NPROMPT) * DM;
#pragma unroll
            for (int ai = 0; ai < 2; ++ai)
#pragma unroll
                for (int m = 0; m < 4; ++m) {
                    float* o = base + (size_t)(r0 + ai * 128 + m * 16) * DM + c0;
#pragma unroll
                    for (int bj = 0; bj < 2; ++bj)
#pragma unroll
                        for (int n = 0; n < 2; ++n) *(f32x4*)(o + bj * 128 + 4 * n) = acc[ai][bj][m][n];
                }
        }
        return false;
    }
};

__device__ __forceinline__ void transpose_tile(const float* __restrict__ src, const int K, const int N, bf16_t* __restrict__ dst, const int mode, const int t, LAS float* tile) {
    const int tid = otid(); const int tn = N / 256;
    const int r = tid >> 3, c8 = (tid & 7) * 8;
    const int k0 = (t / tn) * 64, n0 = (t % tn) * 256;
    const float* s = src + (size_t)(k0 + r) * N + n0 + c8;
    f32x4 v[8];
#pragma unroll
    for (int j = 0; j < 4; ++j) { v[2 * j] = *(const f32x4*)(s + j * 64); v[2 * j + 1] = *(const f32x4*)(s + j * 64 + 4); }
#pragma unroll
    for (int j = 0; j < 4; ++j)
#pragma unroll
        for (int e = 0; e < 4; ++e) { tile[j * 4160 + r * 65 + c8 + e] = v[2 * j][e]; tile[j * 4160 + r * 65 + c8 + 4 + e] = v[2 * j + 1][e]; }
    __syncthreads();
#pragma unroll
    for (int j = 0; j < 4; ++j) {
        f32x4 a, b;
#pragma unroll
        for (int e = 0; e < 4; ++e) { a[e] = tile[j * 4160 + (c8 + e) * 65 + r]; b[e] = tile[j * 4160 + (c8 + 4 + e) * 65 + r]; }
        const int n = n0 + j * 64 + r;
        const int row = mode == 0 ? n : ((n >> 7) * 256 + (mode - 1) * 128 + (n & 127));
        *(u32x4*)(dst + (size_t)row * K + k0 + c8) = pack8u(a, b);
    }
    __syncthreads();
}
__device__ __forceinline__ void tload_win(const float* w_in, int t, int r, int c8, f32x4 (&v)[8]) {
    const int k0 = (t / 56) * 64, n0 = (t % 56) * 256;
    const float* s = w_in + (size_t)(k0 + r) * NIN + n0 + c8;
#pragma unroll
    for (int j = 0; j < 4; ++j) { v[2 * j] = *(const f32x4*)(s + j * 64); v[2 * j + 1] = *(const f32x4*)(s + j * 64 + 4); }
}
__device__ __forceinline__ void phase0(const P& p, LAS unsigned char* lds) {
    unsigned char* ws = p.ws; LAS float* tile = (LAS float*)lds;
    {
        const int tid = otid(); const int r = tid >> 3, c8 = (tid & 7) * 8;
        bf16_t* dst = (bf16_t*)(ws + WS_WIN);
        int j = blockIdx.x; f32x4 v[8];
        if (j < 1792) tload_win(p.w_in, j, r, c8, v);
        while (j < 1792) {
#pragma unroll
            for (int q = 0; q < 4; ++q)
#pragma unroll
                for (int e = 0; e < 4; ++e) { tile[q * 4160 + r * 65 + c8 + e] = v[2 * q][e]; tile[q * 4160 + r * 65 + c8 + 4 + e] = v[2 * q + 1][e]; }
            const int jn = j + gridDim.x;
            if (jn < 1792) tload_win(p.w_in, jn, r, c8, v);
            __syncthreads();
            const int k0 = (j / 56) * 64, n0 = (j % 56) * 256;
#pragma unroll
            for (int q = 0; q < 4; ++q) {
                f32x4 a, b;
#pragma unroll
                for (int e = 0; e < 4; ++e) { a[e] = tile[q * 4160 + (c8 + e) * 65 + r]; b[e] = tile[q * 4160 + (c8 + 4 + e) * 65 + r]; }
                *(u32x4*)(dst + (size_t)(n0 + q * 64 + r) * 2048 + k0 + c8) = pack8u(a, b);
            }
            __syncthreads();
            j = jn;
        }
    }
    for (int t = blockIdx.x; t < 256; t += gridDim.x) {
        if (t < 128) transpose_tile(p.w_mem_k, 2048, 1024, (bf16_t*)(ws + WS_WK), 0, t, tile);
        else transpose_tile(p.w_mem_v, 2048, 1024, (bf16_t*)(ws + WS_WV), 0, t - 128, tile);
    }
    const int t0 = otid(); const int lane = t0 & 63, gw = blockIdx.x * 8 + (t0 >> 6), nw = gridDim.x * 8;
    auto rowsrc = [&](int row) -> const float* { return row < NPROMPT ? p.x_prompt + (size_t)row * DM : (row < MTOK ? p.x_sample + (size_t)(row - NPROMPT) * DM : p.mem_prompt + (size_t)(row - MTOK) * DM); };
    f32x4 v[8], vn[8];
    if (gw < MTOK + 1024) { const float* src = rowsrc(gw);
#pragma unroll
        for (int i = 0; i < 8; ++i) v[i] = *(const f32x4*)(src + 4 * (lane + 64 * i)); }
    for (int row = gw; row < MTOK + 1024; row += nw) {
        const float* g = row < MTOK ? p.norm_g : p.mem_norm_g;
        bf16_t* dst = row < MTOK ? (bf16_t*)(ws + WS_H) + (size_t)row * DM : (bf16_t*)(ws + WS_MEMN) + (size_t)(row - MTOK) * DM;
        if (row + nw < MTOK + 1024) { const float* src = rowsrc(row + nw);
#pragma unroll
            for (int i = 0; i < 8; ++i) vn[i] = *(const f32x4*)(src + 4 * (lane + 64 * i)); }
        float s = 0.f;
#pragma unroll
        for (int i = 0; i < 8; ++i) s += (v[i][0] * v[i][0] + v[i][1] * v[i][1]) + (v[i][2] * v[i][2] + v[i][3] * v[i][3]);
#pragma unroll
        for (int o = 32; o >= 1; o >>= 1) s += __shfl_xor(s, o);
        const float rstd = 1.0f / sqrtf(s * (1.0f / 2048.0f) + 1e-6f);
#pragma unroll
        for (int i = 0; i < 8; ++i) { const f32x4 gv = *(const f32x4*)(g + 4 * (lane + 64 * i));
            u32x2 w; w.x = cvt_pk_bf16(v[i][0] * rstd * gv[0], v[i][1] * rstd * gv[1]); w.y = cvt_pk_bf16(v[i][2] * rstd * gv[2], v[i][3] * rstd * gv[3]);
            *(u32x2*)(dst + 4 * (lane + 64 * i)) = w; }
#pragma unroll
        for (int i = 0; i < 8; ++i) v[i] = vn[i];
    }
}

__device__ __forceinline__ void late_transposes(const P& p, LAS unsigned char* lds, const int first, const int stride, const int end) {
    unsigned char* ws = p.ws; LAS float* tile = (LAS float*)lds;
    for (int t = first; t < end; t += stride) {
        if (t < 128) transpose_tile(p.w_conv_out, 1024, 2048, (bf16_t*)(ws + WS_WC), 0, t, tile);
        else if (t < 256) transpose_tile(p.w_attn_out, 1024, 2048, (bf16_t*)(ws + WS_WA), 0, t - 128, tile);
        else if (t < 384) transpose_tile(p.w_glu_a, 1024, 2048, (bf16_t*)(ws + WS_WG), 1, t - 256, tile);
        else if (t < 512) transpose_tile(p.w_glu_b, 1024, 2048, (bf16_t*)(ws + WS_WG), 2, t - 384, tile);
        else transpose_tile(p.w_out, 2048, 2048, (bf16_t*)(ws + WS_WO), 0, t - 512, tile);
    }
}

template <int LEN, bool PROMPT>
__device__ __forceinline__ void conv_task(const P& p, const int r0, const int cgp, const int bs) {
    const bf16_t* PROJ = (const bf16_t*)(p.ws + WS_PROJ); bf16_t* ACONV = (bf16_t*)(p.ws + WS_ACONV);
    const int c0 = cgp * 8;
    const bf16_t* pr = PROJ + (size_t)r0 * NIN + c0;
    u32x4 lcb[LEN], lcz[LEN], lcc[LEN + 2], lch[LEN + 2];
    const bool has_halo = PROMPT && (r0 & 2047) != 0;
#pragma unroll
    for (int i = 0; i < LEN; ++i) { lcb[i] = *(const u32x4*)(pr + (size_t)i * NIN + OFF_CB); lcz[i] = *(const u32x4*)(pr + (size_t)i * NIN + OFF_CZ);
        lcc[i + 2] = *(const u32x4*)(pr + (size_t)i * NIN + OFF_CC); lch[i + 2] = *(const u32x4*)(pr + (size_t)i * NIN + OFF_CH); }
#pragma unroll
    for (int i = 0; i < 2; ++i) { lcc[i] = (u32x4){0u, 0u, 0u, 0u}; lch[i] = lcc[i];
        if (has_halo) { lcc[i] = *(const u32x4*)(pr - (size_t)(2 - i) * NIN + OFF_CC); lch[i] = *(const u32x4*)(pr - (size_t)(2 - i) * NIN + OFF_CH); } }
    float w0[8], w1[8], w2[8], vm2[8], vm1[8];
    { const f32x4 a0 = *(const f32x4*)(p.conv_w + c0), a1 = *(const f32x4*)(p.conv_w + c0 + 4), b0 = *(const f32x4*)(p.conv_w + 1024 + c0), b1 = *(const f32x4*)(p.conv_w + 1024 + c0 + 4),
          d0 = *(const f32x4*)(p.conv_w + 2048 + c0), d1 = *(const f32x4*)(p.conv_w + 2048 + c0 + 4);
#pragma unroll
      for (int e = 0; e < 4; ++e) { w0[e] = a0[e]; w0[e + 4] = a1[e]; w1[e] = b0[e]; w1[e + 4] = b1[e]; w2[e] = d0[e]; w2[e + 4] = d1[e]; } }
    if (PROMPT) {
        float a[8], b[8];
        unpack8(lcc[0], a); unpack8(lch[0], b);
#pragma unroll
        for (int e = 0; e < 8; ++e) vm2[e] = a[e] * b[e];
        unpack8(lcc[1], a); unpack8(lch[1], b);
#pragma unroll
        for (int e = 0; e < 8; ++e) vm1[e] = a[e] * b[e];
    } else {
        const float* sc = p.state_conv + (size_t)bs * 2048 + c0;
        const f32x4 a0 = *(const f32x4*)sc, a1 = *(const f32x4*)(sc + 4), b0 = *(const f32x4*)(sc + 1024), b1 = *(const f32x4*)(sc + 1028);
#pragma unroll
        for (int e = 0; e < 4; ++e) { vm2[e] = a0[e]; vm2[e + 4] = a1[e]; vm1[e] = b0[e]; vm1[e + 4] = b1[e]; }
    }
#pragma unroll
    for (int i = 0; i < LEN; ++i) {
        const size_t row = (size_t)(r0 + i);
        float cb[8], cc[8], ch[8], cz[8], v[8];
        unpack8(lcb[i], cb); unpack8(lcc[i + 2], cc); unpack8(lch[i + 2], ch); unpack8(lcz[i], cz);
        f32x4 o0, o1;
#pragma unroll
        for (int e = 0; e < 8; ++e) { v[e] = cc[e] * ch[e]; const float cv = w0[e] * vm2[e] + w1[e] * vm1[e] + w2[e] * v[e]; const float r = cb[e] * cv * siluf_(cz[e]);
            if (e < 4) o0[e] = r; else o1[e - 4] = r; vm2[e] = vm1[e]; vm1[e] = v[e]; }
        *(u32x4*)(ACONV + row * 1024 + c0) = pack8u(o0, o1);
        float* dst = nullptr;
        if (PROMPT) { const int pos = (r0 + i) & 2047; if (pos >= 2046) dst = p.out + O_CP + ((size_t)((r0 + i) >> 11) * 2 + (pos - 2046)) * 1024 + c0; }
        else if (i >= 2) dst = p.out + O_CS + ((size_t)bs * 2 + (i - 2)) * 1024 + c0;
        if (dst) { *(f32x4*)dst = (f32x4){v[0], v[1], v[2], v[3]}; *(f32x4*)(dst + 4) = (f32x4){v[4], v[5], v[6], v[7]}; }
    }
}
__device__ __forceinline__ void conv_phase(const P& p) {
    const int t0 = blockIdx.x * 512 + otid(), nt = gridDim.x * 512;
    for (int task = t0; task < 262144; task += nt) conv_task<4, true>(p, (task >> 7) * 4, task & 127, 0);
    for (int task = t0; task < 16384; task += nt) conv_task<4, false>(p, NPROMPT + 4 * (task >> 7), task & 127, task >> 7);
}

struct S5In { bf16x8 U[4]; u32x2 u4[4], z4[4]; };
__device__ __forceinline__ void s5_load4(S5In& in, const bf16_t* PROJ, const size_t row0, const int g, const int g4) {
    const bf16_t* base = PROJ + row0 * NIN + g * 16;
#pragma unroll
    for (int i = 0; i < 4; ++i) {
        in.U[i] = *(const bf16x8*)(base + (size_t)i * NIN + OFF_SU + 8 * (g4 & 1));
        in.u4[i] = *(const u32x2*)(base + (size_t)i * NIN + OFF_SU + 4 * g4); in.z4[i] = *(const u32x2*)(base + (size_t)i * NIN + OFF_SZ + 4 * g4);
    }
}
__device__ __forceinline__ void s5_steps4(const S5In& in, bf16_t* YS, const size_t row0, const int g, const int g4, const bool Y,
                                          const bf16x8 (&bre)[4], const bf16x8 (&bim)[4], const bf16x8 (&cf)[4], const float (&ar)[16], const float (&ai)[16], const f32x4 dsk,
                                          float (&sr)[16], float (&si)[16]) {
    const f32x4 zero4 = (f32x4){0.f, 0.f, 0.f, 0.f};
#pragma unroll
    for (int i = 0; i < 4; ++i) {
#pragma unroll
        for (int pb = 0; pb < 4; ++pb) {
            const f32x4 xr = MFMA16(bre[pb], in.U[i], zero4), xi = MFMA16(bim[pb], in.U[i], zero4);
#pragma unroll
            for (int j = 0; j < 4; ++j) { const int k = pb * 4 + j; const float nr = ar[k] * sr[k] - ai[k] * si[k] + xr[j]; const float ni = ar[k] * si[k] + ai[k] * sr[k] + xi[j]; sr[k] = nr; si[k] = ni; }
        }
        if (Y) {
            f32x4 y = zero4;
            y = MFMA16(cf[0], pack8((f32x4){sr[0], sr[1], sr[2], sr[3]}, (f32x4){sr[4], sr[5], sr[6], sr[7]}), y);
            y = MFMA16(cf[1], pack8((f32x4){sr[8], sr[9], sr[10], sr[11]}, (f32x4){sr[12], sr[13], sr[14], sr[15]}), y);
            y = MFMA16(cf[2], pack8((f32x4){si[0], si[1], si[2], si[3]}, (f32x4){si[4], si[5], si[6], si[7]}), y);
            y = MFMA16(cf[3], pack8((f32x4){si[8], si[9], si[10], si[11]}, (f32x4){si[12], si[13], si[14], si[15]}), y);
            const float uu[4] = {bf_lo(in.u4[i].x), bf_hi(in.u4[i].x), bf_lo(in.u4[i].y), bf_hi(in.u4[i].y)};
            const float zz[4] = {bf_lo(in.z4[i].x), bf_hi(in.z4[i].x), bf_lo(in.z4[i].y), bf_hi(in.z4[i].y)};
            float o[4];
#pragma unroll
            for (int j = 0; j < 4; ++j) { const float ysv = y[j] + dsk[j] * uu[j]; o[j] = gelu_tanh(ysv * siluf_(zz[j])); }
            u32x2 w; w.x = cvt_pk_bf16(o[0], o[1]); w.y = cvt_pk_bf16(o[2], o[3]);
            *(u32x2*)(YS + (row0 + i) * 1024 + g * 16 + 4 * g4) = w;
        }
    }
}
__device__ __forceinline__ void s5_coef(const P& p, int g, int pp, float dt, float& ar, float& ai, float& fr, float& fi) {
    const float lr = p.lam_re[g * 64 + pp], li = p.lam_im[g * 64 + pp];
    const float mag = expf(lr * dt), ang = li * dt; float sn, cs; sincosf(ang, &sn, &cs);
    ar = mag * cs; ai = mag * sn; const float den = lr * lr + li * li;
    fr = ((ar - 1.0f) * lr + ai * li) / den; fi = (ai * lr - (ar - 1.0f) * li) / den;
}
__device__ __forceinline__ void s5_unit(const P& p, const int unit, LAS unsigned char* lds) {
    const bf16_t* PROJ = (const bf16_t*)(p.ws + WS_PROJ); bf16_t* YS = (bf16_t*)(p.ws + WS_YS);
    const int tid = otid(), lane = tid & 63, w = tid >> 6, cl = lane & 15, g4 = lane >> 4;
    const bool prompt = unit < 256; const int g = prompt ? (unit & 63) : (unit - 256); const int b = unit >> 6;
    const float dt = expf(p.log_dt[g]);
    LAS float* E = (LAS float*)lds;
    LAS f32x4* CT = (LAS f32x4*)(lds + 65536);
    if (tid < 64) { float a_r, a_i, fr_, fi_; s5_coef(p, g, tid, dt, a_r, a_i, fr_, fi_); CT[tid] = (f32x4){a_r, a_i, fr_, fi_}; }
    __syncthreads();
    float ar[16], ai[16];
#pragma unroll
    for (int pb = 0; pb < 4; ++pb)
#pragma unroll
        for (int j = 0; j < 4; ++j) { const f32x4 t = CT[16 * pb + 4 * g4 + j]; ar[pb * 4 + j] = t[0]; ai[pb * 4 + j] = t[1]; }
    bf16x8 bre[4], bim[4], cf[4];
    const float bmask = g4 < 2 ? 1.0f : 0.0f;
#pragma unroll
    for (int pb = 0; pb < 4; ++pb) {
        const int pp = 16 * pb + cl; const f32x4 t = CT[pp]; const float fr_ = t[2] * bmask, fi_ = t[3] * bmask;
        const float* br = p.b_re + ((size_t)(g * 64 + pp)) * 16 + 8 * (g4 & 1); const float* bi = p.b_im + ((size_t)(g * 64 + pp)) * 16 + 8 * (g4 & 1);
        const f32x4 r0 = *(const f32x4*)br, r1 = *(const f32x4*)(br + 4), i0 = *(const f32x4*)bi, i1 = *(const f32x4*)(bi + 4);
        bre[pb] = pack8(fr_ * r0 - fi_ * i0, fr_ * r1 - fi_ * i1);
        bim[pb] = pack8(fr_ * i0 + fi_ * r0, fr_ * i1 + fi_ * r1);
    }
#pragma unroll
    for (int ks = 0; ks < 4; ++ks) {
        const float* cp = (ks < 2 ? p.c_re : p.c_im) + ((size_t)(g * 16 + cl)) * 64 + 32 * (ks & 1) + 4 * g4;
        f32x4 a = *(const f32x4*)cp, c = *(const f32x4*)(cp + 16);
        if (ks >= 2) { a = -a; c = -c; }
        cf[ks] = pack8(a, c);
    }
    const f32x4 dsk = *(const f32x4*)(p.ssm_d + g * 16 + 4 * g4);
    const int chain = 16 * w + cl;
    const size_t row0 = prompt ? (size_t)b * 2048 + (size_t)chain * 16 : (size_t)NPROMPT + 4 * chain;
    const size_t so = ((size_t)chain * 64 + g) * 64 + 4 * g4;
    const int nq = prompt ? 4 : 1;
    float sr[16], si[16];
#pragma unroll
    for (int k = 0; k < 16; ++k) { sr[k] = 0.f; si[k] = 0.f; }
    if (!prompt) {
#pragma unroll
        for (int pb = 0; pb < 4; ++pb) { const f32x4 a = *(const f32x4*)(p.state_re + so + 16 * pb), c = *(const f32x4*)(p.state_im + so + 16 * pb);
#pragma unroll
            for (int j = 0; j < 4; ++j) { sr[pb * 4 + j] = a[j]; si[pb * 4 + j] = c[j]; } }
    }
#pragma unroll 1
    for (int pass = prompt ? 0 : 1; pass < 2; ++pass) {
        if (pass == 1 && prompt) {
#pragma unroll
            for (int pb = 0; pb < 4; ++pb) {
                *(LAS f32x4*)(E + (chain * 2 + 0) * 64 + 16 * pb + 4 * g4) = (f32x4){sr[pb * 4], sr[pb * 4 + 1], sr[pb * 4 + 2], sr[pb * 4 + 3]};
                *(LAS f32x4*)(E + (chain * 2 + 1) * 64 + 16 * pb + 4 * g4) = (f32x4){si[pb * 4], si[pb * 4 + 1], si[pb * 4 + 2], si[pb * 4 + 3]};
            }
            __syncthreads();
            if (w == 0) {
                float a_r, a_i; { const f32x4 t = CT[lane]; a_r = t[0]; a_i = t[1]; }
#pragma unroll
                for (int q = 0; q < 4; ++q) { const float nr = a_r * a_r - a_i * a_i, ni = 2.0f * a_r * a_i; a_r = nr; a_i = ni; }
                float Fr = 0.f, Fi = 0.f;
#pragma unroll 8
                for (int k = 0; k < 128; ++k) {
                    const float er = E[(2 * k) * 64 + lane], ei = E[(2 * k + 1) * 64 + lane];
                    E[(2 * k) * 64 + lane] = Fr; E[(2 * k + 1) * 64 + lane] = Fi;
                    const float nr = a_r * Fr - a_i * Fi + er; Fi = a_r * Fi + a_i * Fr + ei; Fr = nr;
                }
                p.out[O_RP + (size_t)(b * 64 + g) * 64 + lane] = Fr; p.out[O_IP + (size_t)(b * 64 + g) * 64 + lane] = Fi;
            }
            __syncthreads();
#pragma unroll
            for (int pb = 0; pb < 4; ++pb) {
                const f32x4 a = *(LAS f32x4*)(E + (chain * 2 + 0) * 64 + 16 * pb + 4 * g4), c = *(LAS f32x4*)(E + (chain * 2 + 1) * 64 + 16 * pb + 4 * g4);
#pragma unroll
                for (int j = 0; j < 4; ++j) { sr[pb * 4 + j] = a[j]; si[pb * 4 + j] = c[j]; }
            }
        }
        S5In cur; s5_load4(cur, PROJ, row0, g, g4);
#pragma unroll 1
        for (int q = 0; q < nq; ++q) {
            S5In nxt = cur;
            if (q + 1 < nq) s5_load4(nxt, PROJ, row0 + 4 * (q + 1), g, g4);
            s5_steps4(cur, YS, row0 + 4 * q, g, g4, pass == 1, bre, bim, cf, ar, ai, dsk, sr, si);
            cur = nxt;
        }
    }
    if (!prompt) {
#pragma unroll
        for (int pb = 0; pb < 4; ++pb) {
            *(f32x4*)(p.out + O_RS + so + 16 * pb) = (f32x4){sr[pb * 4], sr[pb * 4 + 1], sr[pb * 4 + 2], sr[pb * 4 + 3]};
            *(f32x4*)(p.out + O_IS + so + 16 * pb) = (f32x4){si[pb * 4], si[pb * 4 + 1], si[pb * 4 + 2], si[pb * 4 + 3]};
        }
    }
    __syncthreads();
}

__device__ __forceinline__ void attn_prompt_unit(const P& p, const int unit, LAS unsigned char* lds) {
    const bf16_t* PROJ = (const bf16_t*)(p.ws + WS_PROJ); const bf16_t* KB = (const bf16_t*)(p.ws + WS_KB); const bf16_t* VT = (const bf16_t*)(p.ws + WS_VT);
    bf16_t* OATT = (bf16_t*)(p.ws + WS_OATT);
    const int tid = otid(), lane = tid & 63, w = tid >> 6, cl = lane & 15, g4 = lane >> 4;
    const int b = unit >> 6, h = (unit >> 4) & 3, qb = unit & 15;
    const bf16_t* kbase = KB + (size_t)(b * 256) * 1024 + h * 256;
#pragma unroll
    for (int i = 0; i < 16; ++i) { const int idx = tid + 512 * i, r = idx >> 5, m = idx & 31;
        const u32x4 v = *(const u32x4*)(kbase + (size_t)r * 1024 + m * 8); *(LAS u32x4*)(lds + r * 512 + ((m ^ (r & 15)) << 4)) = v; }
    const size_t qrow = (size_t)b * 2048 + qb * 128 + w * 16 + cl;
    const bf16_t* qp = PROJ + qrow * NIN + OFF_AQ + h * 256 + 8 * g4;
    bf16x8 qf[8];
#pragma unroll
    for (int ks = 0; ks < 8; ++ks) qf[ks] = *(const bf16x8*)(qp + 32 * ks);
    __syncthreads();
    f32x4 s[16];
#pragma unroll
    for (int kb = 0; kb < 16; ++kb) { s[kb] = (f32x4){0.f, 0.f, 0.f, 0.f};
#pragma unroll
        for (int ks = 0; ks < 8; ++ks) { const int key = 16 * kb + cl, m = 4 * ks + g4;
            const bf16x8 kf = *(const LAS bf16x8*)(lds + key * 512 + ((m ^ cl) << 4)); s[kb] = MFMA16(kf, qf[ks], s[kb]); }
        __builtin_amdgcn_sched_barrier(0); }
    __syncthreads();
    const bf16_t* vbase = VT + (size_t)((b * 4 + h) * 256) * 256;
    u32x4 vst[16];
#pragma unroll
    for (int i = 0; i < 16; ++i) { const int idx = tid + 512 * i, r = idx >> 5, m = idx & 31; vst[i] = *(const u32x4*)(vbase + (size_t)r * 256 + m * 8); }
    float mx = -3.0e38f;
#pragma unroll
    for (int kb = 0; kb < 16; ++kb)
#pragma unroll
        for (int j = 0; j < 4; ++j) mx = fmaxf(mx, s[kb][j]);
    mx = fmaxf(mx, __shfl_xor(mx, 16)); mx = fmaxf(mx, __shfl_xor(mx, 32));
    float sum = 0.f;
#pragma unroll
    for (int kb = 0; kb < 16; ++kb)
#pragma unroll
        for (int j = 0; j < 4; ++j) { const float e = __expf((s[kb][j] - mx) * 0.0625f); s[kb][j] = e; sum += e; }
    sum += __shfl_xor(sum, 16); sum += __shfl_xor(sum, 32);
    const float inv = rcp_(sum);
    bf16x8 pf[8];
#pragma unroll
    for (int kk = 0; kk < 8; ++kk) pf[kk] = pack8(s[2 * kk], s[2 * kk + 1]);
#pragma unroll
    for (int i = 0; i < 16; ++i) { const int idx = tid + 512 * i, r = idx >> 5, m = idx & 31; *(LAS u32x4*)(lds + r * 512 + ((m ^ (r & 15)) << 4)) = vst[i]; }
    __syncthreads();
    const bf16_t* azp = PROJ + qrow * NIN + OFF_AZ + h * 256 + 4 * g4;
    bf16_t* op = OATT + qrow * 1024 + h * 256 + 4 * g4;
    u32x2 azv[16];
#pragma unroll
    for (int db = 0; db < 16; ++db) azv[db] = *(const u32x2*)(azp + 16 * db);
#pragma unroll
    for (int db = 0; db < 16; ++db) {
        f32x4 o = (f32x4){0.f, 0.f, 0.f, 0.f}; const int d = 16 * db + cl;
#pragma unroll
        for (int kk = 0; kk < 8; ++kk) {
            const int ch0 = 8 * kk + g4, ch1 = ch0 + 4;
            const u32x2 lo = *(const LAS u32x2*)(lds + d * 512 + (((ch0 >> 1) ^ cl) << 4) + (ch0 & 1) * 8);
            const u32x2 hi = *(const LAS u32x2*)(lds + d * 512 + (((ch1 >> 1) ^ cl) << 4) + (ch1 & 1) * 8);
            const u32x4 vv = (u32x4){lo.x, lo.y, hi.x, hi.y};
            o = MFMA16(__builtin_bit_cast(bf16x8, vv), pf[kk], o);
        }
        const u32x2 az = azv[db];
        const float z[4] = {bf_lo(az.x), bf_hi(az.x), bf_lo(az.y), bf_hi(az.y)};
        u32x2 wv; wv.x = cvt_pk_bf16(o[0] * inv * siluf_(z[0]), o[1] * inv * siluf_(z[1])); wv.y = cvt_pk_bf16(o[2] * inv * siluf_(z[2]), o[3] * inv * siluf_(z[3]));
        *(u32x2*)(op + 16 * db) = wv;
        __builtin_amdgcn_sched_barrier(0);
    }
    __syncthreads();
}

__device__ __forceinline__ void attn_sample_pair(const P& p, const int u0, const int u1_, LAS unsigned char* lds) {
    const int u1 = u1_ < 512 ? u1_ : u0;
    const bf16_t* PROJ = (const bf16_t*)(p.ws + WS_PROJ); bf16_t* OATT = (bf16_t*)(p.ws + WS_OATT);
    const int tid = otid(), lane = tid & 63, w = tid >> 6, cl = lane & 15, g4 = lane >> 4;
    LAS float* Pw = (LAS float*)(lds + w * 512);
    LAS float* ST = (LAS float*)(lds + 4096);
    LAS float* OW = (LAS float*)(lds + 8192);
    f32x4 bA[16], bB[16], o[4], s0, s1;
    bf16x8 qf[8];
#define SA_LOADQ(unit) do { const bf16_t* qp_ = PROJ + ((size_t)NPROMPT + 4 * ((unit) >> 2) + (cl & 3)) * NIN + OFF_AQ + ((unit) & 3) * 256 + 8 * g4; \
        _Pragma("unroll") for (int ks = 0; ks < 8; ++ks) qf[ks] = *(const bf16x8*)(qp_ + 32 * ks); } while (0)
#define SA_LOADK(buf, unit, kblk) do { const float* kr_ = p.cache_k + ((size_t)((unit) >> 2) * 1024 + ((unit) & 3)) * 256 + (size_t)(32 * w + 16 * (kblk) + cl) * 1024 + 8 * g4; \
        _Pragma("unroll") for (int ks = 0; ks < 8; ++ks) { buf[2 * ks] = *(const f32x4*)(kr_ + 32 * ks); buf[2 * ks + 1] = *(const f32x4*)(kr_ + 32 * ks + 4); } } while (0)
#define SA_LOADV(buf, unit, half) do { const float* vr_ = p.cache_v + ((size_t)((unit) >> 2) * 1024 + ((unit) & 3)) * 256 + (size_t)(32 * w + 16 * (half)) * 1024 + 4 * lane; \
        _Pragma("unroll") for (int i = 0; i < 16; ++i) buf[i] = *(const f32x4*)(vr_ + (size_t)i * 1024); } while (0)
#define SA_QK(buf, sv) do { sv = (f32x4){0.f, 0.f, 0.f, 0.f}; _Pragma("unroll") for (int ks = 0; ks < 8; ++ks) sv = MFMA16(pack8(buf[2 * ks], buf[2 * ks + 1]), qf[ks], sv); } while (0)
#define SA_PV(buf, half) do { _Pragma("unroll") for (int ii = 0; ii < 4; ++ii) _Pragma("unroll") for (int q = 0; q < 4; ++q) { const f32x4 pv_ = *(const LAS f32x4*)(Pw + q * 32 + 16 * (half) + 4 * ii); \
        o[q] += pv_[0] * buf[4 * ii] + pv_[1] * buf[4 * ii + 1] + pv_[2] * buf[4 * ii + 2] + pv_[3] * buf[4 * ii + 3]; } } while (0)
#define SA_SOFTMAX(slot) do { float m_ = fmaxf(fmaxf(fmaxf(s0[0], s0[1]), fmaxf(s0[2], s0[3])), fmaxf(fmaxf(s1[0], s1[1]), fmaxf(s1[2], s1[3]))); \
        m_ = fmaxf(m_, __shfl_xor(m_, 16)); m_ = fmaxf(m_, __shfl_xor(m_, 32)); float l_ = 0.f; \
        _Pragma("unroll") for (int j = 0; j < 4; ++j) { s0[j] = __expf((s0[j] - m_) * 0.0625f); s1[j] = __expf((s1[j] - m_) * 0.0625f); l_ += s0[j] + s1[j]; } \
        l_ += __shfl_xor(l_, 16); l_ += __shfl_xor(l_, 32); \
        if (cl < 4) { *(LAS f32x4*)(Pw + cl * 32 + 4 * g4) = s0; *(LAS f32x4*)(Pw + cl * 32 + 16 + 4 * g4) = s1; \
            if (g4 == 0) { ST[(((slot) * 8 + w) * 4 + cl) * 2] = m_; ST[(((slot) * 8 + w) * 4 + cl) * 2 + 1] = l_; } } } while (0)
#define SA_OZERO() do { _Pragma("unroll") for (int q = 0; q < 4; ++q) o[q] = (f32x4){0.f, 0.f, 0.f, 0.f}; } while (0)
#define SA_OWRITE(slot) do { _Pragma("unroll") for (int q = 0; q < 4; ++q) *(LAS f32x4*)(OW + (size_t)((((slot) * 8 + w) * 4 + q) * 256) + 4 * lane) = o[q]; } while (0)
#define SA_SB() __builtin_amdgcn_sched_barrier(0)
    SA_LOADQ(u0);
    SA_LOADK(bA, u0, 0); SA_LOADK(bB, u0, 1); SA_SB();
    SA_QK(bA, s0); SA_LOADV(bA, u0, 0); SA_SB();
    SA_QK(bB, s1); SA_LOADV(bB, u0, 1); SA_SB();
    SA_SOFTMAX(0);
    SA_LOADQ(u1);
    SA_OZERO(); SA_SB();
    SA_PV(bA, 0); SA_LOADK(bA, u1, 0); SA_SB();
    SA_PV(bB, 1); SA_LOADK(bB, u1, 1); SA_SB();
    SA_OWRITE(0);
    {
        SA_QK(bA, s0); SA_LOADV(bA, u1, 0); SA_SB();
        SA_QK(bB, s1); SA_LOADV(bB, u1, 1); SA_SB();
        SA_SOFTMAX(1);
        SA_OZERO(); SA_SB();
        SA_PV(bA, 0); SA_SB();
        SA_PV(bB, 1);
        SA_OWRITE(1);
    }
    __syncthreads();
    {
        const int slot = tid >> 8, q = (tid >> 6) & 3, d = (tid & 63) * 4;
        const int unit = slot == 0 ? u0 : u1;
        {
            float M = -3.0e38f;
#pragma unroll
            for (int ww = 0; ww < 8; ++ww) M = fmaxf(M, ST[((slot * 8 + ww) * 4 + q) * 2]);
            float L = 0.f; f32x4 a = (f32x4){0.f, 0.f, 0.f, 0.f};
#pragma unroll
            for (int ww = 0; ww < 8; ++ww) { const float f = __expf((ST[((slot * 8 + ww) * 4 + q) * 2] - M) * 0.0625f); L += f * ST[((slot * 8 + ww) * 4 + q) * 2 + 1];
                a += f * *(const LAS f32x4*)(OW + (size_t)(((slot * 8 + ww) * 4 + q) * 256) + d); }
            const float inv = rcp_(L);
            const size_t row = (size_t)NPROMPT + 4 * (unit >> 2) + q; const int h = unit & 3;
            const u32x2 az = *(const u32x2*)(PROJ + row * NIN + OFF_AZ + h * 256 + d);
            u32x2 wv; wv.x = cvt_pk_bf16(a[0] * inv * siluf_(bf_lo(az.x)), a[1] * inv * siluf_(bf_hi(az.x))); wv.y = cvt_pk_bf16(a[2] * inv * siluf_(bf_lo(az.y)), a[3] * inv * siluf_(bf_hi(az.y)));
            *(u32x2*)(OATT + row * 1024 + h * 256 + d) = wv;
        }
    }
    __syncthreads();
#undef SA_LOADQ
#undef SA_LOADK
#undef SA_LOADV
#undef SA_QK
#undef SA_PV
#undef SA_SOFTMAX
#undef SA_OZERO
#undef SA_OWRITE
#undef SA_SB
}

__device__ __forceinline__ void phase5(const P& p) {
    const float* part = (const float*)(p.ws + WS_PART);
    const int t0 = otid(); const int lane = t0 & 63, gw = blockIdx.x * 8 + (t0 >> 6), nw = gridDim.x * 8;
    for (int row = gw; row < MTOK; row += nw) {
        float* orow = p.out + (size_t)row * DM;
        f32x4 v[8]; float s = 0.f;
        if (row < NPROMPT) {
            const float* xr = p.x_prompt + (size_t)row * DM; const bf16_t* dr = (const bf16_t*)(p.ws + WS_DELTA) + (size_t)row * DM;
#pragma unroll
            for (int i = 0; i < 8; ++i) { const u32x2 d = *(const u32x2*)(dr + 4 * (lane + 64 * i));
                v[i] = *(const f32x4*)(xr + 4 * (lane + 64 * i)) + (f32x4){bf_lo(d.x), bf_hi(d.x), bf_lo(d.y), bf_hi(d.y)}; }
        } else {
            const float* xr = p.x_sample + (size_t)(row - NPROMPT) * DM;
#pragma unroll
            for (int i = 0; i < 8; ++i) v[i] = *(const f32x4*)(xr + 4 * (lane + 64 * i));
#pragma unroll 2
            for (int ks = 0; ks < 8; ++ks) { const float* pr = part + ((size_t)ks * 512 + (row - NPROMPT)) * DM;
#pragma unroll
                for (int i = 0; i < 8; ++i) v[i] += *(const f32x4*)(pr + 4 * (lane + 64 * i)); }
        }
#pragma unroll
        for (int i = 0; i < 8; ++i) s += (v[i][0] * v[i][0] + v[i][1] * v[i][1]) + (v[i][2] * v[i][2] + v[i][3] * v[i][3]);
#pragma unroll
        for (int o = 32; o >= 1; o >>= 1) s += __shfl_xor(s, o);
        const float rstd = 1.0f / sqrtf(s * (1.0f / 2048.0f) + 1e-6f);
#pragma unroll
        for (int i = 0; i < 8; ++i) { const f32x4 gv = *(const f32x4*)(p.final_g + 4 * (lane + 64 * i)); *(f32x4*)(orow + 4 * (lane + 64 * i)) = v[i] * rstd * gv; }
    }
}

#define XB_TMO      128
#define XB_XCNT(j)  (256  + 64 * (j))
#define XB_XSUB(j)  (1280 + 64 * (j))
#define XB_XGEN(j)  (2304 + 64 * (j))
#define XB_TOP      3328
#define XB_TOPGEN   3392
#define XB_SPIN_CAP (1u << 20)
__device__ __forceinline__ unsigned xb_ld(unsigned* p)              { return __hip_atomic_load(p, __ATOMIC_RELAXED, __HIP_MEMORY_SCOPE_AGENT); }
__device__ __forceinline__ unsigned xb_add(unsigned* p, unsigned v) { return __hip_atomic_fetch_add(p, v, __ATOMIC_RELAXED, __HIP_MEMORY_SCOPE_AGENT); }
__device__ __forceinline__ unsigned xb_xcc_id() { return (unsigned)__builtin_amdgcn_s_getreg((3 << 11) | 20) & 0xFu; }
#define XB_SPIN(cond, bar) do { unsigned _sp = 0; while (cond) { __builtin_amdgcn_s_sleep(1); \
    if ((++_sp & 255u) == 0u) { if (xb_ld(&(bar)[XB_TMO])) break; if (_sp > XB_SPIN_CAP) { atomicAdd(&(bar)[XB_TMO], 1u); break; } } } } while (0)
struct XcdBarrier { unsigned* bar; unsigned x; volatile LAS unsigned* st; };
__device__ __forceinline__ XcdBarrier xcd_barrier_post(unsigned* bar, volatile LAS unsigned* st) {
    XcdBarrier b; b.bar = bar; b.x = xb_xcc_id(); b.st = st;
    if (threadIdx.x == 0) (void)xb_add(&bar[XB_XCNT(b.x)], 1u);
    return b;
}
__device__ __forceinline__ void xcd_barrier_complete(unsigned* bar, unsigned x, unsigned& nloc, unsigned& nx) {
    const unsigned G = gridDim.x * gridDim.y * gridDim.z;
    unsigned sum, cnt, mine, sp = 0u;
    for (;;) {
        sum = 0u; cnt = 0u; mine = 0u;
#pragma unroll
        for (unsigned j = 0; j < 16; ++j) { const unsigned c = xb_ld(&bar[XB_XCNT(j)]); sum += c; cnt += (c > 0u) ? 1u : 0u; mine = (j == x) ? c : mine; }
        if (sum == G) break;
        __builtin_amdgcn_s_sleep(1);
        if ((++sp & 255u) == 0u) { if (xb_ld(&bar[XB_TMO])) break; if (sp > XB_SPIN_CAP) { atomicAdd(&bar[XB_TMO], 1u); break; } }
    }
    nloc = mine > 0u ? mine : 1u; nx = cnt > 0u ? cnt : 1u;
}
__device__ __forceinline__ void xcd_barrier(const XcdBarrier& b) {
    asm volatile("s_waitcnt vmcnt(0)" ::: "memory");
    __syncthreads();
    if (threadIdx.x == 0) {
        unsigned* bar = b.bar;
        __builtin_amdgcn_s_waitcnt(0);
        unsigned nloc = b.st[0], nx = b.st[1];
        if (nloc == 0u) { xcd_barrier_complete(bar, b.x, nloc, nx); b.st[0] = nloc; b.st[1] = nx; }
        const unsigned old = xb_add(&bar[XB_XSUB(b.x)], 1u);
        const unsigned gen = old / nloc;
        if (old + 1u == (gen + 1u) * nloc) {
            __builtin_amdgcn_fence(__ATOMIC_RELEASE, "agent");
            asm volatile("s_waitcnt vmcnt(0)" ::: "memory");
            const unsigned og = xb_add(&bar[XB_TOP], 1u);
            const unsigned tg = og / nx;
            if (og + 1u == (tg + 1u) * nx) xb_add(&bar[XB_TOPGEN], 1u);
            else XB_SPIN(xb_ld(&bar[XB_TOPGEN]) == tg, bar);
            __builtin_amdgcn_fence(__ATOMIC_ACQUIRE, "agent");
            xb_add(&bar[XB_XGEN(b.x)], 1u);
            asm volatile("s_waitcnt vmcnt(0)" ::: "memory");
        } else {
            XB_SPIN(xb_ld(&bar[XB_XGEN(b.x)]) == gen, bar);
            __builtin_amdgcn_fence(__ATOMIC_ACQUIRE, "agent");
            asm volatile("s_waitcnt vmcnt(0)" ::: "memory");
        }
    }
    __syncthreads();
}

__global__ void __launch_bounds__(512, 2) mega_fwd(P p) {
    extern __shared__ __attribute__((aligned(16))) unsigned char shm[];
    LAS unsigned char* lds = (LAS unsigned char*)shm;
    cg::grid_group grid = cg::this_grid();
    unsigned char* ws = p.ws;
    const int G = gridDim.x, c = blockIdx.x;
    volatile LAS unsigned* bst = (volatile LAS unsigned*)(lds + 131072);
    if (threadIdx.x == 0) { bst[0] = 0u; bst[1] = 0u; }
    __syncthreads();
    const XcdBarrier xbar = xcd_barrier_post((unsigned*)(ws + WS_BAR), bst);
    if (p.out == nullptr) grid.sync();
#define GSYNC() xcd_barrier(xbar)

#ifndef PHMASK
#define PHMASK 0xffff
#endif
#ifndef REPMASK
#define REPMASK 0
#endif
#define NREP(bit) ((REPMASK & (bit)) ? 2 : 1)
#ifndef TPHASE
#define TPHASE -1
#endif
#ifndef TMULT
#define TMULT 4
#endif
    unsigned long long ts[8]; int nts = 0;
#define STAMP() do { if (TPHASE >= 0 && TPHASE < 10) { ts[nts] = wall_clock64(); } ++nts; } while (0)
    STAMP();
    for (int rep = 0; rep < NREP(1); ++rep) if (PHMASK & 1) phase0(p, lds);
    GSYNC(); STAMP();

    for (int rep = 0; rep < NREP(2); ++rep) if (PHMASK & 2) {
        Sched1 S{(const char*)(ws + WS_H), (const char*)(ws + WS_WIN), (const char*)(ws + WS_MEMN), (const char*)(ws + WS_WK), (const char*)(ws + WS_WV), G, c};
        Epi1 E{(bf16_t*)(ws + WS_PROJ), p.out + O_MK, (bf16_t*)(ws + WS_KB), p.out + O_MV, (bf16_t*)(ws + WS_VT)};
        pg8::gemm_phase(lds, 2048, 2048, S, E);
    }
    GSYNC(); STAMP();

    for (int rep = 0; rep < NREP(4); ++rep) {
        unsigned long long m0 = 0, m1 = 0, m2 = 0, m3 = 0, m4 = 0;
        if (TPHASE >= 10) m0 = wall_clock64();
        const int sg = (c >> 3) & 3;
        if (sg == 0) for (int u = c; u < 512; u += 2 * G) attn_sample_pair(p, u, u + G, lds);
        if (TPHASE >= 10) m1 = wall_clock64();
        for (int u = c; u < 256; u += G) s5_unit(p, u, lds);
        for (int u = 256 + (G - 1 - c); u < 320; u += G) s5_unit(p, u, lds);
        if (TPHASE >= 10) m2 = wall_clock64();
        if (sg == 1) for (int u = c; u < 512; u += 2 * G) attn_sample_pair(p, u, u + G, lds);
        for (int u = c; u < 256; u += G) attn_prompt_unit(p, u, lds);
        if (TPHASE >= 10) m3 = wall_clock64();
        if (sg == 2) for (int u = c; u < 512; u += 2 * G) attn_sample_pair(p, u, u + G, lds);
        conv_phase(p);
        if (sg == 3) for (int u = c; u < 512; u += 2 * G) attn_sample_pair(p, u, u + G, lds);
        late_transposes(p, lds, c, G, G == 256 ? 512 : 768);
        if (TPHASE >= 10) { m4 = wall_clock64(); ts[0] = 0; ts[1] = TPHASE == 10 ? m1 - m0 : (TPHASE == 11 ? m2 - m1 : (TPHASE == 12 ? m3 - m2 : m4 - m3)); }
    }
    GSYNC(); STAMP();

    for (int rep = 0; rep < NREP(8); ++rep) if (PHMASK & 64) {
        { Sched1g Sg{(const char*)(ws + WS_H), (const char*)(ws + WS_WIN), G, c}; Epi1 Eg{(bf16_t*)(ws + WS_PROJ), p.out + O_MK, (bf16_t*)(ws + WS_KB), p.out + O_MV, (bf16_t*)(ws + WS_VT)}; pg8::gemm_phase(lds, 2048, 2048, Sg, Eg); }
        if (G == 256 && c >= 144) late_transposes(p, lds, 512 + (c - 144), 112, 768);
        Sched2 S{(const char*)ws, G, c};
        Epi2 E{(bf16_t*)(ws + WS_GLU), (bf16_t*)(ws + WS_CONVO), (bf16_t*)(ws + WS_ATTO)};
        pg8::gemm_phase(lds, 1024, 1024, S, E);
    }
    GSYNC(); STAMP();

    for (int rep = 0; rep < NREP(32); ++rep) merge_phase(p);
    GSYNC(); STAMP();

    for (int rep = 0; rep < NREP(16); ++rep) if (PHMASK & 128) {
        { Sched3 S{(const char*)(ws + WS_MERGED), (const char*)(ws + WS_WO), G, c}; Epi3 E{(bf16_t*)(ws + WS_DELTA), (float*)(ws + WS_PART), false}; pg8::gemm_phase(lds, 2048, 2048, S, E); }
        { Sched3b S{(const char*)(ws + WS_MERGED), (const char*)(ws + WS_WO), G, c}; Epi3 E{(bf16_t*)(ws + WS_DELTA), (float*)(ws + WS_PART), true}; pg8::gemm_phase(lds, 256, 2048, S, E); }
    }
    GSYNC(); STAMP();

    if (PHMASK & 256) phase5(p);
    STAMP();
    if (TPHASE >= 0 && blockIdx.x == 0 && threadIdx.x == 0) {
        const unsigned long long d = (TPHASE >= 10 ? ts[1] - ts[0] : ts[TPHASE + 1] - ts[TPHASE]) * TMULT, t0 = wall_clock64();
        while (wall_clock64() - t0 < d) __builtin_amdgcn_s_sleep(16);
    }
}

extern "C" void kernel_launch(void* const* d_in, const int* in_sizes, int n_in, void* d_out, int out_size, void* d_ws, size_t ws_size, hipStream_t stream) {
    static int grid = 0;
    if (grid == 0) {
        int dev = 0, cus = 0, per_cu = 0;
        hipGetDevice(&dev);
        hipDeviceGetAttribute(&cus, hipDeviceAttributeMultiprocessorCount, dev);
        if (hipFuncSetAttribute((const void*)mega_fwd, hipFuncAttributeMaxDynamicSharedMemorySize, LDS_BYTES) != hipSuccess) fprintf(stderr, "kernel_launch: hipFuncSetAttribute failed\n");
        if (hipOccupancyMaxActiveBlocksPerMultiprocessor(&per_cu, (const void*)mega_fwd, 512, LDS_BYTES) != hipSuccess || per_cu < 1) per_cu = 1;
        (void)hipGetLastError();
        grid = cus * per_cu;
        if (ws_size < WS_END) fprintf(stderr, "kernel_launch: workspace too small (%zu < %zu)\n", ws_size, (size_t)WS_END);
    }
    P p{};
    const float** pp = (const float**)&p;
    for (int i = 0; i < 28; ++i) pp[i] = (const float*)d_in[i];
    p.out = (float*)d_out; p.ws = (unsigned char*)d_ws;
    void* args[] = {&p};
    (void)hipMemsetAsync((unsigned char*)d_ws + WS_BAR, 0, 16384, stream);
    hipError_t e = hipLaunchCooperativeKernel((const void*)mega_fwd, dim3(grid), dim3(512), args, LDS_BYTES, stream);
    if (e != hipSuccess) fprintf(stderr, "cooperative launch failed: %s (grid %d)\n", hipGetErrorString(e), grid);
}
```

```cpp
#include <hip/hip_runtime.h>
#include <hip/hip_cooperative_groups.h>
#include <cstdio>
namespace cg = cooperative_groups;

#define LAS __attribute__((address_space(3)))
typedef unsigned short bf16_t;
typedef short bf16x8 __attribute__((ext_vector_type(8)));
typedef float f32x4 __attribute__((ext_vector_type(4)));
typedef unsigned u32x4 __attribute__((ext_vector_type(4)));
typedef unsigned u32x2 __attribute__((ext_vector_type(2)));

constexpr int DM = 2048, NPROMPT = 8192, NSAMPLE = 512, MTOK = 8704, NIN = 14336;
constexpr int OFF_CB = 0, OFF_CC = 1024, OFF_CH = 2048, OFF_CZ = 3072, OFF_SU = 4096, OFF_SZ = 5120, OFF_AQ = 6144, OFF_AZ = 7168, OFF_G = 8192;
constexpr int LDS_BYTES = 131072 + 16;
constexpr size_t O_Y = 0, O_MK = 17825792, O_MV = 18874368, O_CP = 19922944, O_RP = 19931136, O_IP = 19947520, O_CS = 19963904, O_RS = 20226048, O_IS = 20750336;
constexpr size_t WS_WIN = 0;
constexpr size_t WS_WG = WS_WIN + (size_t)NIN * DM * 2;
constexpr size_t WS_WC = WS_WG + 8388608;
constexpr size_t WS_WA = WS_WC + 4194304;
constexpr size_t WS_WO = WS_WA + 4194304;
constexpr size_t WS_H = WS_WO + 8388608;
constexpr size_t WS_PROJ = WS_H + (size_t)MTOK * DM * 2;
constexpr size_t WS_YS = WS_PROJ + (size_t)MTOK * NIN * 2;
constexpr size_t WS_ACONV = WS_YS + (size_t)MTOK * 1024 * 2;
constexpr size_t WS_OATT = WS_ACONV + (size_t)MTOK * 1024 * 2;
constexpr size_t WS_SS = WS_OATT + (size_t)MTOK * 1024 * 2;
constexpr size_t WS_GLU = WS_SS + (size_t)MTOK * 32 * 4;
constexpr size_t WS_MERGED = WS_GLU + (size_t)MTOK * DM * 2;
constexpr size_t WS_BAR = WS_MERGED + (size_t)MTOK * DM * 2;
constexpr size_t WS_MEMN = WS_BAR + 16384;
constexpr size_t WS_WK = WS_MEMN + 4194304;
constexpr size_t WS_WV = WS_WK + 4194304;
constexpr size_t WS_KB = WS_WV + 4194304;
constexpr size_t WS_VT = WS_KB + 2097152;
constexpr size_t WS_ATTO = WS_MEMN;
constexpr size_t WS_END = WS_ATTO + (size_t)MTOK * DM * 2;
constexpr size_t WS_CONVO = WS_WIN, WS_PART = WS_PROJ, WS_DELTA = WS_PROJ + 67108864;
static_assert(WS_END <= 536870912, "workspace");
static_assert(WS_VT + 2097152 <= WS_END && (size_t)MTOK * DM * 2 <= 38u * 1048576u, "aliases");

struct P {
    const float *x_prompt, *x_sample, *mem_prompt, *cache_k, *cache_v, *state_conv, *state_re, *state_im, *norm_g, *mem_norm_g, *w_in, *conv_w, *w_conv_out,
        *lam_re, *lam_im, *log_dt, *b_re, *b_im, *c_re, *c_im, *ssm_d, *w_glu_a, *w_glu_b, *w_mem_k, *w_mem_v, *w_attn_out, *w_out, *final_g;
    float* out; unsigned char* ws;
};

__device__ __forceinline__ unsigned cvt_pk_bf16(float lo, float hi) { unsigned r; asm("v_cvt_pk_bf16_f32 %0, %1, %2" : "=v"(r) : "v"(lo), "v"(hi)); return r; }
__device__ __forceinline__ float bf_lo(unsigned w) { return __uint_as_float(w << 16); }
__device__ __forceinline__ float bf_hi(unsigned w) { return __uint_as_float(w & 0xffff0000u); }
__device__ __forceinline__ float rcp_(float x) { return __builtin_amdgcn_rcpf(x); }
__device__ __forceinline__ float sigmoidf_(float x) { return rcp_(1.0f + __expf(-x)); }
__device__ __forceinline__ float siluf_(float x) { return x * rcp_(1.0f + __expf(-x)); }
__device__ __forceinline__ float gelu_tanh(float x) { const float u = 1.5957691216057308f * (x + 0.044715f * x * x * x); return x * rcp_(1.0f + __expf(-u)); }
__device__ __forceinline__ bf16x8 pack8(const f32x4 a, const f32x4 b) {
    u32x4 w; w.x = cvt_pk_bf16(a[0], a[1]); w.y = cvt_pk_bf16(a[2], a[3]); w.z = cvt_pk_bf16(b[0], b[1]); w.w = cvt_pk_bf16(b[2], b[3]);
    return __builtin_bit_cast(bf16x8, w);
}
__device__ __forceinline__ u32x4 pack8u(const f32x4 a, const f32x4 b) {
    u32x4 w; w.x = cvt_pk_bf16(a[0], a[1]); w.y = cvt_pk_bf16(a[2], a[3]); w.z = cvt_pk_bf16(b[0], b[1]); w.w = cvt_pk_bf16(b[2], b[3]); return w;
}
__device__ __forceinline__ void unpack8(const u32x4 w, float (&f)[8]) {
    f[0] = bf_lo(w.x); f[1] = bf_hi(w.x); f[2] = bf_lo(w.y); f[3] = bf_hi(w.y); f[4] = bf_lo(w.z); f[5] = bf_hi(w.z); f[6] = bf_lo(w.w); f[7] = bf_hi(w.w);
}
__device__ __forceinline__ int otid() { int t = threadIdx.x; asm volatile("" : "+v"(t)); return t; }
#define NTL(p) __builtin_nontemporal_load(p)
#define MFMA16(a, b, c) __builtin_amdgcn_mfma_f32_16x16x32_bf16((a), (b), (c), 0, 0, 0)

namespace pg8 {
constexpr int BM = 256, BK = 64, HALF = 128, HTB = HALF * BK * 2, STAGE_BYTES = 8 * HTB;
__device__ __forceinline__ int lds_byte(int r, int c) { const int st = (r >> 4) * 2 + (c >> 5), rr = r & 15, cc = c & 31, ob = rr * 64 + cc * 2; return st * 1024 + (ob ^ (((ob >> 9) & 1) << 5)); }
__device__ __forceinline__ void stage_rc(int b, int& R, int& C) { const int st = b / 1024, sb = b % 1024, swz = sb ^ (((sb >> 9) & 1) << 5); R = (st >> 1) * 16 + swz / 64; C = (st & 1) * 32 + (swz % 64) / 2; }
__device__ __forceinline__ int perm32(int rho) { const int n = rho >> 4, i = rho & 15; return 8 * (i >> 2) + 4 * n + (i & 3); }
struct Unit { const char* a; const char* b; int pm, pn, kind; };

template <class Sched, class Epi>
__device__ __forceinline__ void gemm_phase(LAS unsigned char* lds, const int K, const int ld, const Sched& S, const Epi& E) {
    const int tid = otid(), wid = __builtin_amdgcn_readfirstlane(tid >> 6), lane = tid & 63, wr = wid >> 2, wc = wid & 3, fr = lane & 15, fq = lane >> 4;
    const int nt = K / BK;
    unsigned voffA[2], voffB[2];
#pragma unroll
    for (int i = 0; i < 2; ++i) { int R, C; stage_rc(tid * 16 + i * 8192, R, C); const int Rb = (R & ~31) + perm32(R & 31);
        voffA[i] = (unsigned)(R * ld + C) * 2u; voffB[i] = (unsigned)(Rb * ld + C) * 2u; }
    const size_t kstep = (size_t)(BK * 2);
    const size_t hstep = (size_t)HALF * ld * 2;
    const unsigned ldsw = (unsigned)wid * 1024u;
    const int aoff = lds_byte(wr * 64 + fr, fq * 8), boff = lds_byte(wc * 32 + fr, fq * 8);
#define PG8_SA(b, h) (((b) * 2 + (h)) * HTB)
#define PG8_SB(b, h) ((4 + (b) * 2 + (h)) * HTB)
#define PG8_STAGE(bufoff, gbase, voff) do { _Pragma("unroll") for (int _i = 0; _i < 2; ++_i) \
        __builtin_amdgcn_global_load_lds((const unsigned*)((const char*)(gbase) + (voff)[_i]), (LAS unsigned*)(lds + (bufoff) + ldsw + _i * 8192), 16, 0, 0); } while (0)
#define PG8_LDA(dst, b, h) do { _Pragma("unroll") for (int m = 0; m < 4; ++m) _Pragma("unroll") for (int k = 0; k < 2; ++k) dst[m][k] = *(const LAS bf16x8*)(lds + PG8_SA(b, h) + aoff + m * 2048 + k * 1024); } while (0)
#define PG8_LDB(dst, b, h) do { _Pragma("unroll") for (int n = 0; n < 2; ++n) _Pragma("unroll") for (int k = 0; k < 2; ++k) dst[n][k] = *(const LAS bf16x8*)(lds + PG8_SB(b, h) + boff + n * 2048 + k * 1024); } while (0)
#define PG8_MMA(ai, bj, At, Bt) do { __builtin_amdgcn_s_setprio(1); _Pragma("unroll") for (int m = 0; m < 4; ++m) _Pragma("unroll") for (int n = 0; n < 2; ++n) _Pragma("unroll") for (int k = 0; k < 2; ++k) \
        acc[ai][bj][m][n] = __builtin_amdgcn_mfma_f32_16x16x32_bf16(Bt[n][k], At[m][k], acc[ai][bj][m][n], 0, 0, 0); __builtin_amdgcn_s_setprio(0); } while (0)
#define PG8_WAIT_V(n) asm volatile("s_waitcnt vmcnt(" #n ")" ::: "memory")
#define PG8_WAIT_L(n) asm volatile("s_waitcnt lgkmcnt(" #n ")" ::: "memory")
#define PG8_BAR __builtin_amdgcn_s_barrier()
#define PG8_SCHED __builtin_amdgcn_sched_barrier(0)
    Unit cur, nxt; int ui = 0;
    if (!S.next(0, cur)) return;
    f32x4 acc[2][2][4][2];
#pragma unroll
    for (int a = 0; a < 2; ++a)
#pragma unroll
        for (int b = 0; b < 2; ++b)
#pragma unroll
            for (int m = 0; m < 4; ++m)
#pragma unroll
                for (int n = 0; n < 2; ++n) acc[a][b][m][n] = (f32x4){0.f, 0.f, 0.f, 0.f};
    bf16x8 At[4][2], B0[2][2], B1[2][2];
    const char* cA = cur.a; const char* cB = cur.b;
    PG8_STAGE(PG8_SB(0, 0), cB, voffB); PG8_STAGE(PG8_SA(0, 0), cA, voffA); PG8_STAGE(PG8_SB(0, 1), cB + hstep, voffB); PG8_STAGE(PG8_SA(0, 1), cA + hstep, voffA);
    if (wr == 1) PG8_BAR;
    PG8_WAIT_V(4); PG8_BAR;
    PG8_STAGE(PG8_SB(1, 0), cB + kstep, voffB); PG8_STAGE(PG8_SA(1, 0), cA + kstep, voffA); PG8_STAGE(PG8_SB(1, 1), cB + hstep + kstep, voffB);
    PG8_WAIT_V(6); PG8_BAR;
    for (;;) {
        const bool has_next = S.next(ui + 1, nxt);
        const char* nA = has_next ? nxt.a : cA; const char* nB = has_next ? nxt.b : cB;
        for (int t = 0; t < nt; t += 2) {
            const bool last = (t == nt - 2);
            const char* a1 = cA + (size_t)(t + 1) * kstep;
            const char* a2 = last ? nA : cA + (size_t)(t + 2) * kstep; const char* b2 = last ? nB : cB + (size_t)(t + 2) * kstep;
            const char* a3 = a2 + kstep; const char* b3 = b2 + kstep;
            PG8_LDB(B0, 0, 0); PG8_SCHED; PG8_LDA(At, 0, 0); PG8_STAGE(PG8_SA(1, 1), a1 + hstep, voffA);
            PG8_WAIT_L(8); PG8_BAR; PG8_WAIT_L(0); PG8_MMA(0, 0, At, B0); PG8_BAR; PG8_SCHED;
            PG8_LDB(B1, 0, 1); PG8_STAGE(PG8_SB(0, 0), b2, voffB);
            PG8_BAR; PG8_WAIT_L(0); PG8_MMA(0, 1, At, B1); PG8_BAR;
            PG8_LDA(At, 0, 1); PG8_STAGE(PG8_SA(0, 0), a2, voffA);
            PG8_BAR; PG8_WAIT_L(0); PG8_MMA(1, 0, At, B0); PG8_BAR; PG8_SCHED;
            PG8_STAGE(PG8_SB(0, 1), b2 + hstep, voffB);
            PG8_WAIT_V(6); PG8_BAR; PG8_MMA(1, 1, At, B1); PG8_BAR;
            PG8_LDB(B0, 1, 0); PG8_SCHED; PG8_LDA(At, 1, 0); PG8_STAGE(PG8_SA(0, 1), a2 + hstep, voffA);
            PG8_WAIT_L(8); PG8_BAR; PG8_WAIT_L(0); PG8_MMA(0, 0, At, B0); PG8_BAR; PG8_SCHED;
            PG8_LDB(B1, 1, 1); PG8_STAGE(PG8_SB(1, 0), b3, voffB);
            PG8_BAR; PG8_WAIT_L(0); PG8_MMA(0, 1, At, B1); PG8_BAR;
            PG8_LDA(At, 1, 1); PG8_STAGE(PG8_SA(1, 0), a3, voffA);
            PG8_BAR; PG8_WAIT_L(0); PG8_MMA(1, 0, At, B0); PG8_BAR; PG8_SCHED;
            PG8_STAGE(PG8_SB(1, 1), b3 + hstep, voffB);
            PG8_WAIT_V(6); PG8_BAR; PG8_MMA(1, 1, At, B1); PG8_BAR;
        }
        const bool keep = E(acc, cur, wr, wc, fr, fq);
        if (!has_next) break;
        if (!keep) {
#pragma unroll
            for (int a = 0; a < 2; ++a)
#pragma unroll
                for (int b = 0; b < 2; ++b)
#pragma unroll
                    for (int m = 0; m < 4; ++m)
#pragma unroll
                        for (int n = 0; n < 2; ++n) acc[a][b][m][n] = (f32x4){0.f, 0.f, 0.f, 0.f};
        }
        cur = nxt; cA = nA; cB = nB; ++ui;
    }
    PG8_WAIT_V(0);
    if (wr == 0) PG8_BAR;
    PG8_BAR;
#undef PG8_SA
#undef PG8_SB
#undef PG8_STAGE
#undef PG8_LDA
#undef PG8_LDB
#undef PG8_MMA
#undef PG8_WAIT_V
#undef PG8_WAIT_L
#undef PG8_BAR
#undef PG8_SCHED
}
}
using pg8::Unit;

__device__ __forceinline__ void xcd_tile_order(int wgid, const int nM, const int nN, int& pm, int& pn) {
    const int nwg = nM * nN, NX = 8, WGM = 8;
    { const int q = nwg / NX, r = nwg % NX, xcd = wgid % NX, off = wgid / NX; wgid = (xcd < r ? xcd * (q + 1) : r * (q + 1) + (xcd - r) * q) + off; }
    const int nig = WGM * nN, gid = wgid / nig, fm = gid * WGM, gsz = (nM - fm) < WGM ? (nM - fm) : WGM;
    pm = fm + ((wgid % nig) % gsz); pn = (wgid % nig) / gsz;
}
struct Sched1 {
    const char *H, *WIN, *MEMN, *WK, *WV; int G, c;
    __device__ __forceinline__ bool next(int i, Unit& u) const {
        const int L = i * G + c; if (L >= 1792) return false;
        if (L < 1760) {
            int pm, pn;
            if (L < 1292) xcd_tile_order(L, 34, 38, pm, pn);
            else { xcd_tile_order(L - 1292, 26, 18, pm, pn); pn += 38; }
            u.pm = pm; u.pn = pn; u.kind = 0; u.a = H + (size_t)pm * 1048576; u.b = WIN + (size_t)pn * 1048576;
        } else if (L < 1776) { const int j = L - 1760; u.pm = j >> 2; u.pn = j & 3; u.kind = 1; u.a = MEMN + (size_t)u.pm * 1048576; u.b = WK + (size_t)u.pn * 1048576; }
        else { const int j = L - 1776; u.pm = j >> 2; u.pn = j & 3; u.kind = 2; u.a = WV + (size_t)u.pm * 1048576; u.b = MEMN + (size_t)u.pn * 1048576; }
        return true;
    }
};
struct Sched1g {
    const char *H, *WIN; int G, c;
    __device__ __forceinline__ bool next(int i, Unit& u) const {
        const int j = i * G + c; if (j >= 144) return false;
        u.pm = 26 + j / 18; u.pn = 38 + j % 18; u.kind = 0; u.a = H + (size_t)u.pm * 1048576; u.b = WIN + (size_t)u.pn * 1048576; return true;
    }
};
struct Epi1 {
    bf16_t* PROJ; float* outK; bf16_t* KB; float* outV; bf16_t* VT;
    __device__ __forceinline__ bool operator()(f32x4 (&acc)[2][2][4][2], const Unit& u, int wr, int wc, int fr, int fq) const {
        const int r0 = u.pm * 256 + wr * 64 + fr, c0 = u.pn * 256 + wc * 32 + 8 * fq;
        if (u.kind == 0) {
#pragma unroll
            for (int ai = 0; ai < 2; ++ai)
#pragma unroll
                for (int m = 0; m < 4; ++m) { bf16_t* rowp = PROJ + (size_t)(r0 + ai * 128 + m * 16) * NIN + c0;
#pragma unroll
                    for (int bj = 0; bj < 2; ++bj) *(u32x4*)(rowp + bj * 128) = pack8u(acc[ai][bj][m][0], acc[ai][bj][m][1]); }
        } else if (u.kind == 1) {
#pragma unroll
            for (int ai = 0; ai < 2; ++ai)
#pragma unroll
                for (int m = 0; m < 4; ++m) { const size_t off = (size_t)(r0 + ai * 128 + m * 16) * 1024 + c0;
#pragma unroll
                    for (int bj = 0; bj < 2; ++bj) { *(f32x4*)(outK + off + bj * 128) = acc[ai][bj][m][0]; *(f32x4*)(outK + off + bj * 128 + 4) = acc[ai][bj][m][1];
                        *(u32x4*)(KB + off + bj * 128) = pack8u(acc[ai][bj][m][0], acc[ai][bj][m][1]); } }
        } else {
            const int h = u.pm, b = u.pn;
#pragma unroll
            for (int ai = 0; ai < 2; ++ai)
#pragma unroll
                for (int m = 0; m < 4; ++m) { const int d = wr * 64 + fr + ai * 128 + m * 16;
#pragma unroll
                    for (int bj = 0; bj < 2; ++bj) { const int key0 = wc * 32 + 8 * fq + bj * 128;
                        *(u32x4*)(VT + ((size_t)((b * 4 + h) * 256 + d)) * 256 + key0) = pack8u(acc[ai][bj][m][0], acc[ai][bj][m][1]);
                        float* fp = outV + ((size_t)(b * 256 + key0)) * 1024 + h * 256 + d;
#pragma unroll
                        for (int e = 0; e < 4; ++e) { fp[(size_t)e * 1024] = acc[ai][bj][m][0][e]; fp[(size_t)(e + 4) * 1024] = acc[ai][bj][m][1][e]; } } }
        }
        return false;
    }
};

struct Sched2 {
    const char* ws; int G, c;
    __device__ __forceinline__ bool next(int i, Unit& u) const {
        int L;
        if (G == 256) { if (c < 144) { if (i >= 4) return false; L = c + 144 * i; } else { L = 576 + (c - 144) + 112 * i; } }
        else L = i * G + c;
        if (L >= 1088) return false;
        if (L < 544) { u.pm = L >> 4; u.pn = L & 15; u.kind = 0; u.a = ws + WS_YS + (size_t)u.pm * 524288; u.b = ws + WS_WG + (size_t)u.pn * 524288; }
        else { const int j = L - 544, k = j >= 272 ? 1 : 0, jj = j - 272 * k; u.pm = jj >> 3; u.pn = jj & 7; u.kind = 1 + k;
            u.a = ws + WS_ACONV + (size_t)k * ((size_t)MTOK * 1024 * 2) + (size_t)u.pm * 524288; u.b = ws + WS_WC + (size_t)k * 4194304 + (size_t)u.pn * 524288; }
        return true;
    }
};
struct Epi2 {
    bf16_t* GLU; bf16_t* CONVO; bf16_t* ATTO;
    __device__ __forceinline__ bool operator()(f32x4 (&acc)[2][2][4][2], const Unit& u, int wr, int wc, int fr, int fq) const {
        const int r0 = u.pm * 256 + wr * 64 + fr;
        if (u.kind == 0) {
            const int c0 = u.pn * 128 + wc * 32 + 8 * fq;
#pragma unroll
            for (int ai = 0; ai < 2; ++ai)
#pragma unroll
                for (int m = 0; m < 4; ++m) {
                    f32x4 t0, t1;
#pragma unroll
                    for (int e = 0; e < 4; ++e) { t0[e] = acc[ai][0][m][0][e] * sigmoidf_(acc[ai][1][m][0][e]); t1[e] = acc[ai][0][m][1][e] * sigmoidf_(acc[ai][1][m][1][e]); }
                    *(u32x4*)(GLU + (size_t)(r0 + ai * 128 + m * 16) * 2048 + c0) = pack8u(t0, t1);
                }
        } else {
            bf16_t* O = u.kind == 1 ? CONVO : ATTO; const int c0 = u.pn * 256 + wc * 32 + 8 * fq;
#pragma unroll
            for (int ai = 0; ai < 2; ++ai)
#pragma unroll
                for (int m = 0; m < 4; ++m) { bf16_t* rowp = O + (size_t)(r0 + ai * 128 + m * 16) * 2048 + c0;
#pragma unroll
                    for (int bj = 0; bj < 2; ++bj) *(u32x4*)(rowp + bj * 128) = pack8u(acc[ai][bj][m][0], acc[ai][bj][m][1]); }
        }
        return false;
    }
};
__device__ __forceinline__ void merge_phase(const P& p) {
    const bf16_t* PROJ = (const bf16_t*)(p.ws + WS_PROJ); const bf16_t* GLU = (const bf16_t*)(p.ws + WS_GLU); const bf16_t* CONVO = (const bf16_t*)(p.ws + WS_CONVO);
    const bf16_t* ATTO = (const bf16_t*)(p.ws + WS_ATTO); bf16_t* MERGED = (bf16_t*)(p.ws + WS_MERGED);
    const int NT = MTOK * 256, stride = gridDim.x * 512;
    for (int t = blockIdx.x * 512 + otid(); t < NT; t += 2 * stride) {
        u32x4 L[2][6]; const int t1 = t + stride; const bool has1 = t1 < NT;
#pragma unroll
        for (int k = 0; k < 2; ++k) { const int tt = k == 0 ? t : (has1 ? t1 : t);
            const size_t row = (size_t)(tt >> 8); const int c0 = (tt & 255) * 8; const bf16_t* pr = PROJ + row * NIN + OFF_G + c0; const size_t o = row * 2048 + c0;
            L[k][0] = *(const u32x4*)pr; L[k][1] = *(const u32x4*)(pr + 2048); L[k][2] = *(const u32x4*)(pr + 4096);
            L[k][3] = *(const u32x4*)(CONVO + o); L[k][4] = *(const u32x4*)(GLU + o); L[k][5] = *(const u32x4*)(ATTO + o); }
#pragma unroll
        for (int k = 0; k < 2; ++k) { if (k == 1 && !has1) break; const int tt = k == 0 ? t : t1;
            const size_t row = (size_t)(tt >> 8); const int c0 = (tt & 255) * 8; const size_t o = row * 2048 + c0;
            float g0[8], g1[8], g2[8], cv[8], gl[8], at[8];
            unpack8(L[k][0], g0); unpack8(L[k][1], g1); unpack8(L[k][2], g2); unpack8(L[k][3], cv); unpack8(L[k][4], gl); unpack8(L[k][5], at);
            f32x4 m0, m1;
#pragma unroll
            for (int e = 0; e < 8; ++e) { const float v = sigmoidf_(g0[e]) * cv[e] + sigmoidf_(g1[e]) * gl[e] + sigmoidf_(g2[e]) * at[e]; if (e < 4) m0[e] = v; else m1[e - 4] = v; }
            *(u32x4*)(MERGED + o) = pack8u(m0, m1); }
    }
}

struct Sched3 {
    const char *MERGED, *WO; int G, c;
    __device__ __forceinline__ bool next(int i, Unit& u) const {
        const int L = i * G + c; if (L >= 256) return false;
        u.pm = L >> 3; u.pn = L & 7; u.kind = 0; u.a = MERGED + (size_t)u.pm * 1048576; u.b = WO + (size_t)u.pn * 1048576; return true;
    }
};
struct Sched3b {
    const char *MERGED, *WO; int G, c;
    __device__ __forceinline__ bool next(int i, Unit& u) const {
        const int L = i * G + c; if (L >= 128) return false;
        const int tile = L >> 3, ks = L & 7; u.pm = 32 + (tile >> 3); u.pn = tile & 7; u.kind = ks;
        u.a = MERGED + (size_t)u.pm * 1048576 + (size_t)ks * 512; u.b = WO + (size_t)u.pn * 1048576 + (size_t)ks * 512; return true;
    }
};
struct Epi3 {
    bf16_t* delta; float* part;
    bool sample;
    __device__ __forceinline__ bool operator()(f32x4 (&acc)[2][2][4][2], const Unit& u, int wr, int wc, int fr, int fq) const {
        const int r0 = u.pm * 256 + wr * 64 + fr, c0 = u.pn * 256 + wc * 32 + 8 * fq;
        if (!sample) {
#pragma unroll
            for (int ai = 0; ai < 2; ++ai)
#pragma unroll
                for (int m = 0; m < 4; ++m) { bf16_t* o = delta + (size_t)(r0 + ai * 128 + m * 16) * DM + c0;
#pragma unroll
                    for (int bj = 0; bj < 2; ++bj) *(u32x4*)(o + bj * 128) = pack8u(acc[ai][bj][m][0], acc[ai][bj][m][1]); }
        } else {
            float* base = part + ((size_t)u.kind * 512 - NPROMPT) * DM;
#pragma unroll
            for (int ai = 0; ai < 2; ++ai)
#pragma unroll
                for (int m = 0; m < 4; ++m) {
                    float* o = base + (size_t)(r0 + ai * 128 + m * 16) * DM + c0;
#pragma unroll
                    for (int bj = 0; bj < 2; ++bj)
#pragma unroll
                        for (int n = 0; n < 2; ++n) *(f32x4*)(o + bj * 128 + 4 * n) = acc[ai][bj][m][n];
                }
        }
        return false;
    }
};

__device__ __forceinline__ void transpose_tile(const float* __restrict__ src, const int K, const int N, bf16_t* __restrict__ dst, const int mode, const int t, LAS float* tile) {
    const int tid = otid(); const int tn = N / 256;
    const int r = tid >> 3, c8 = (tid & 7) * 8;
    const int k0 = (t / tn) * 64, n0 = (t % tn) * 256;
    const float* s = src + (size_t)(k0 + r) * N + n0 + c8;
    f32x4 v[8];
#pragma unroll
    for (int j = 0; j < 4; ++j) { v[2 * j] = NTL((const f32x4*)(s + j * 64)); v[2 * j + 1] = NTL((const f32x4*)(s + j * 64 + 4)); }
#pragma unroll
    for (int j = 0; j < 4; ++j)
#pragma unroll
        for (int e = 0; e < 4; ++e) { tile[j * 4160 + r * 65 + c8 + e] = v[2 * j][e]; tile[j * 4160 + r * 65 + c8 + 4 + e] = v[2 * j + 1][e]; }
    __syncthreads();
#pragma unroll
    for (int j = 0; j < 4; ++j) {
        f32x4 a, b;
#pragma unroll
        for (int e = 0; e < 4; ++e) { a[e] = tile[j * 4160 + (c8 + e) * 65 + r]; b[e] = tile[j * 4160 + (c8 + 4 + e) * 65 + r]; }
        const int n = n0 + j * 64 + r;
        const int row = mode == 0 ? n : ((n >> 7) * 256 + (mode - 1) * 128 + (n & 127));
        *(u32x4*)(dst + (size_t)row * K + k0 + c8) = pack8u(a, b);
    }
    __syncthreads();
}
__device__ __forceinline__ void tload_win(const float* w_in, int t, int r, int c8, f32x4 (&v)[8]) {
    const int k0 = (t / 56) * 64, n0 = (t % 56) * 256;
    const float* s = w_in + (size_t)(k0 + r) * NIN + n0 + c8;
#pragma unroll
    for (int j = 0; j < 4; ++j) { v[2 * j] = NTL((const f32x4*)(s + j * 64)); v[2 * j + 1] = NTL((const f32x4*)(s + j * 64 + 4)); }
}
__device__ __forceinline__ void phase0(const P& p, LAS unsigned char* lds) {
    unsigned char* ws = p.ws; LAS float* tile = (LAS float*)lds;
    {
        const int tid = otid(); const int r = tid >> 3, c8 = (tid & 7) * 8;
        bf16_t* dst = (bf16_t*)(ws + WS_WIN);
        int j = blockIdx.x; f32x4 v[8];
        if (j < 1792) tload_win(p.w_in, j, r, c8, v);
        while (j < 1792) {
#pragma unroll
            for (int q = 0; q < 4; ++q)
#pragma unroll
                for (int e = 0; e < 4; ++e) { tile[q * 4160 + r * 65 + c8 + e] = v[2 * q][e]; tile[q * 4160 + r * 65 + c8 + 4 + e] = v[2 * q + 1][e]; }
            const int jn = j + gridDim.x;
            if (jn < 1792) tload_win(p.w_in, jn, r, c8, v);
            __syncthreads();
            const int k0 = (j / 56) * 64, n0 = (j % 56) * 256;
#pragma unroll
            for (int q = 0; q < 4; ++q) {
                f32x4 a, b;
#pragma unroll
                for (int e = 0; e < 4; ++e) { a[e] = tile[q * 4160 + (c8 + e) * 65 + r]; b[e] = tile[q * 4160 + (c8 + 4 + e) * 65 + r]; }
                *(u32x4*)(dst + (size_t)(n0 + q * 64 + r) * 2048 + k0 + c8) = pack8u(a, b);
            }
            __syncthreads();
            j = jn;
        }
    }
    for (int t = blockIdx.x; t < 256; t += gridDim.x) {
        if (t < 128) transpose_tile(p.w_mem_k, 2048, 1024, (bf16_t*)(ws + WS_WK), 0, t, tile);
        else transpose_tile(p.w_mem_v, 2048, 1024, (bf16_t*)(ws + WS_WV), 0, t - 128, tile);
    }
    const int t0 = otid(); const int lane = t0 & 63, gw = blockIdx.x * 8 + (t0 >> 6), nw = gridDim.x * 8;
    auto rowsrc = [&](int row) -> const float* { return row < NPROMPT ? p.x_prompt + (size_t)row * DM : (row < MTOK ? p.x_sample + (size_t)(row - NPROMPT) * DM : p.mem_prompt + (size_t)(row - MTOK) * DM); };
    f32x4 v[8], vn[8];
    if (gw < MTOK + 1024) { const float* src = rowsrc(gw);
#pragma unroll
        for (int i = 0; i < 8; ++i) v[i] = NTL((const f32x4*)(src + 4 * (lane + 64 * i))); }
    for (int row = gw; row < MTOK + 1024; row += nw) {
        const float* g = row < MTOK ? p.norm_g : p.mem_norm_g;
        bf16_t* dst = row < MTOK ? (bf16_t*)(ws + WS_H) + (size_t)row * DM : (bf16_t*)(ws + WS_MEMN) + (size_t)(row - MTOK) * DM;
        if (row + nw < MTOK + 1024) { const float* src = rowsrc(row + nw);
#pragma unroll
            for (int i = 0; i < 8; ++i) vn[i] = NTL((const f32x4*)(src + 4 * (lane + 64 * i))); }
        float s = 0.f;
#pragma unroll
        for (int i = 0; i < 8; ++i) s += (v[i][0] * v[i][0] + v[i][1] * v[i][1]) + (v[i][2] * v[i][2] + v[i][3] * v[i][3]);
#pragma unroll
        for (int o = 32; o >= 1; o >>= 1) s += __shfl_xor(s, o);
        const float rstd = 1.0f / sqrtf(s * (1.0f / 2048.0f) + 1e-6f);
#pragma unroll
        for (int i = 0; i < 8; ++i) { const f32x4 gv = *(const f32x4*)(g + 4 * (lane + 64 * i));
            u32x2 w; w.x = cvt_pk_bf16(v[i][0] * rstd * gv[0], v[i][1] * rstd * gv[1]); w.y = cvt_pk_bf16(v[i][2] * rstd * gv[2], v[i][3] * rstd * gv[3]);
            *(u32x2*)(dst + 4 * (lane + 64 * i)) = w; }
#pragma unroll
        for (int i = 0; i < 8; ++i) v[i] = vn[i];
    }
}

__device__ __forceinline__ void late_transposes(const P& p, LAS unsigned char* lds, const int first, const int stride, const int end) {
    unsigned char* ws = p.ws; LAS float* tile = (LAS float*)lds;
    for (int t = first; t < end; t += stride) {
        if (t < 128) transpose_tile(p.w_conv_out, 1024, 2048, (bf16_t*)(ws + WS_WC), 0, t, tile);
        else if (t < 256) transpose_tile(p.w_attn_out, 1024, 2048, (bf16_t*)(ws + WS_WA), 0, t - 128, tile);
        else if (t < 384) transpose_tile(p.w_glu_a, 1024, 2048, (bf16_t*)(ws + WS_WG), 1, t - 256, tile);
        else if (t < 512) transpose_tile(p.w_glu_b, 1024, 2048, (bf16_t*)(ws + WS_WG), 2, t - 384, tile);
        else transpose_tile(p.w_out, 2048, 2048, (bf16_t*)(ws + WS_WO), 0, t - 512, tile);
    }
}

template <int LEN, bool PROMPT>
__device__ __forceinline__ void conv_task(const P& p, const int r0, const int cgp, const int bs) {
    const bf16_t* PROJ = (const bf16_t*)(p.ws + WS_PROJ); bf16_t* ACONV = (bf16_t*)(p.ws + WS_ACONV);
    const int c0 = cgp * 8;
    const bf16_t* pr = PROJ + (size_t)r0 * NIN + c0;
    u32x4 lcb[LEN], lcz[LEN], lcc[LEN + 2], lch[LEN + 2];
    const bool has_halo = PROMPT && (r0 & 2047) != 0;
#pragma unroll
    for (int i = 0; i < LEN; ++i) { lcb[i] = *(const u32x4*)(pr + (size_t)i * NIN + OFF_CB); lcz[i] = *(const u32x4*)(pr + (size_t)i * NIN + OFF_CZ);
        lcc[i + 2] = *(const u32x4*)(pr + (size_t)i * NIN + OFF_CC); lch[i + 2] = *(const u32x4*)(pr + (size_t)i * NIN + OFF_CH); }
#pragma unroll
    for (int i = 0; i < 2; ++i) { lcc[i] = (u32x4){0u, 0u, 0u, 0u}; lch[i] = lcc[i];
        if (has_halo) { lcc[i] = *(const u32x4*)(pr - (size_t)(2 - i) * NIN + OFF_CC); lch[i] = *(const u32x4*)(pr - (size_t)(2 - i) * NIN + OFF_CH); } }
    float w0[8], w1[8], w2[8], vm2[8], vm1[8];
    { const f32x4 a0 = *(const f32x4*)(p.conv_w + c0), a1 = *(const f32x4*)(p.conv_w + c0 + 4), b0 = *(const f32x4*)(p.conv_w + 1024 + c0), b1 = *(const f32x4*)(p.conv_w + 1024 + c0 + 4),
          d0 = *(const f32x4*)(p.conv_w + 2048 + c0), d1 = *(const f32x4*)(p.conv_w + 2048 + c0 + 4);
#pragma unroll
      for (int e = 0; e < 4; ++e) { w0[e] = a0[e]; w0[e + 4] = a1[e]; w1[e] = b0[e]; w1[e + 4] = b1[e]; w2[e] = d0[e]; w2[e + 4] = d1[e]; } }
    if (PROMPT) {
        float a[8], b[8];
        unpack8(lcc[0], a); unpack8(lch[0], b);
#pragma unroll
        for (int e = 0; e < 8; ++e) vm2[e] = a[e] * b[e];
        unpack8(lcc[1], a); unpack8(lch[1], b);
#pragma unroll
        for (int e = 0; e < 8; ++e) vm1[e] = a[e] * b[e];
    } else {
        const float* sc = p.state_conv + (size_t)bs * 2048 + c0;
        const f32x4 a0 = *(const f32x4*)sc, a1 = *(const f32x4*)(sc + 4), b0 = *(const f32x4*)(sc + 1024), b1 = *(const f32x4*)(sc + 1028);
#pragma unroll
        for (int e = 0; e < 4; ++e) { vm2[e] = a0[e]; vm2[e + 4] = a1[e]; vm1[e] = b0[e]; vm1[e + 4] = b1[e]; }
    }
#pragma unroll
    for (int i = 0; i < LEN; ++i) {
        const size_t row = (size_t)(r0 + i);
        float cb[8], cc[8], ch[8], cz[8], v[8];
        unpack8(lcb[i], cb); unpack8(lcc[i + 2], cc); unpack8(lch[i + 2], ch); unpack8(lcz[i], cz);
        f32x4 o0, o1;
#pragma unroll
        for (int e = 0; e < 8; ++e) { v[e] = cc[e] * ch[e]; const float cv = w0[e] * vm2[e] + w1[e] * vm1[e] + w2[e] * v[e]; const float r = cb[e] * cv * siluf_(cz[e]);
            if (e < 4) o0[e] = r; else o1[e - 4] = r; vm2[e] = vm1[e]; vm1[e] = v[e]; }
        *(u32x4*)(ACONV + row * 1024 + c0) = pack8u(o0, o1);
        float* dst = nullptr;
        if (PROMPT) { const int pos = (r0 + i) & 2047; if (pos >= 2046) dst = p.out + O_CP + ((size_t)((r0 + i) >> 11) * 2 + (pos - 2046)) * 1024 + c0; }
        else if (i >= 2) dst = p.out + O_CS + ((size_t)bs * 2 + (i - 2)) * 1024 + c0;
        if (dst) { *(f32x4*)dst = (f32x4){v[0], v[1], v[2], v[3]}; *(f32x4*)(dst + 4) = (f32x4){v[4], v[5], v[6], v[7]}; }
    }
}
__device__ __forceinline__ void conv_phase(const P& p) {
    const int t0 = blockIdx.x * 512 + otid(), nt = gridDim.x * 512;
    for (int task = t0; task < 262144; task += nt) conv_task<4, true>(p, (task >> 7) * 4, task & 127, 0);
    for (int task = t0; task < 16384; task += nt) conv_task<4, false>(p, NPROMPT + 4 * (task >> 7), task & 127, task >> 7);
}

struct S5In { bf16x8 U[4]; u32x2 u4[4], z4[4]; };
__device__ __forceinline__ void s5_load4(S5In& in, const bf16_t* PROJ, const size_t row0, const int g, const int g4) {
    const bf16_t* base = PROJ + row0 * NIN + g * 16;
#pragma unroll
    for (int i = 0; i < 4; ++i) {
        in.U[i] = *(const bf16x8*)(base + (size_t)i * NIN + OFF_SU + 8 * (g4 & 1));
        in.u4[i] = *(const u32x2*)(base + (size_t)i * NIN + OFF_SU + 4 * g4); in.z4[i] = *(const u32x2*)(base + (size_t)i * NIN + OFF_SZ + 4 * g4);
    }
}
__device__ __forceinline__ void s5_steps4(const S5In& in, bf16_t* YS, const size_t row0, const int g, const int g4, const bool Y,
                                          const bf16x8 (&bre)[4], const bf16x8 (&bim)[4], const bf16x8 (&cf)[4], const float (&ar)[16], const float (&ai)[16], const f32x4 dsk,
                                          float (&sr)[16], float (&si)[16]) {
    const f32x4 zero4 = (f32x4){0.f, 0.f, 0.f, 0.f};
#pragma unroll
    for (int i = 0; i < 4; ++i) {
#pragma unroll
        for (int pb = 0; pb < 4; ++pb) {
            const f32x4 xr = MFMA16(bre[pb], in.U[i], zero4), xi = MFMA16(bim[pb], in.U[i], zero4);
#pragma unroll
            for (int j = 0; j < 4; ++j) { const int k = pb * 4 + j; const float nr = ar[k] * sr[k] - ai[k] * si[k] + xr[j]; const float ni = ar[k] * si[k] + ai[k] * sr[k] + xi[j]; sr[k] = nr; si[k] = ni; }
        }
        if (Y) {
            f32x4 y = zero4;
            y = MFMA16(cf[0], pack8((f32x4){sr[0], sr[1], sr[2], sr[3]}, (f32x4){sr[4], sr[5], sr[6], sr[7]}), y);
            y = MFMA16(cf[1], pack8((f32x4){sr[8], sr[9], sr[10], sr[11]}, (f32x4){sr[12], sr[13], sr[14], sr[15]}), y);
            y = MFMA16(cf[2], pack8((f32x4){si[0], si[1], si[2], si[3]}, (f32x4){si[4], si[5], si[6], si[7]}), y);
            y = MFMA16(cf[3], pack8((f32x4){si[8], si[9], si[10], si[11]}, (f32x4){si[12], si[13], si[14], si[15]}), y);
            const float uu[4] = {bf_lo(in.u4[i].x), bf_hi(in.u4[i].x), bf_lo(in.u4[i].y), bf_hi(in.u4[i].y)};
            const float zz[4] = {bf_lo(in.z4[i].x), bf_hi(in.z4[i].x), bf_lo(in.z4[i].y), bf_hi(in.z4[i].y)};
            float o[4];
#pragma unroll
            for (int j = 0; j < 4; ++j) { const float ysv = y[j] + dsk[j] * uu[j]; o[j] = gelu_tanh(ysv * siluf_(zz[j])); }
            u32x2 w; w.x = cvt_pk_bf16(o[0], o[1]); w.y = cvt_pk_bf16(o[2], o[3]);
            *(u32x2*)(YS + (row0 + i) * 1024 + g * 16 + 4 * g4) = w;
        }
    }
}
__device__ __forceinline__ void s5_coef(const P& p, int g, int pp, float dt, float& ar, float& ai, float& fr, float& fi) {
    const float lr = p.lam_re[g * 64 + pp], li = p.lam_im[g * 64 + pp];
    const float mag = expf(lr * dt), ang = li * dt; float sn, cs; sincosf(ang, &sn, &cs);
    ar = mag * cs; ai = mag * sn; const float den = lr * lr + li * li;
    fr = ((ar - 1.0f) * lr + ai * li) / den; fi = (ai * lr - (ar - 1.0f) * li) / den;
}
__device__ __forceinline__ void s5_unit(const P& p, const int unit, LAS unsigned char* lds) {
    const bf16_t* PROJ = (const bf16_t*)(p.ws + WS_PROJ); bf16_t* YS = (bf16_t*)(p.ws + WS_YS);
    const int tid = otid(), lane = tid & 63, w = tid >> 6, cl = lane & 15, g4 = lane >> 4;
    const bool prompt = unit < 256; const int g = prompt ? (unit & 63) : (unit - 256); const int b = unit >> 6;
    const float dt = expf(p.log_dt[g]);
    LAS float* E = (LAS float*)lds;
    LAS f32x4* CT = (LAS f32x4*)(lds + 65536);
    if (tid < 64) { float a_r, a_i, fr_, fi_; s5_coef(p, g, tid, dt, a_r, a_i, fr_, fi_); CT[tid] = (f32x4){a_r, a_i, fr_, fi_}; }
    __syncthreads();
    float ar[16], ai[16];
#pragma unroll
    for (int pb = 0; pb < 4; ++pb)
#pragma unroll
        for (int j = 0; j < 4; ++j) { const f32x4 t = CT[16 * pb + 4 * g4 + j]; ar[pb * 4 + j] = t[0]; ai[pb * 4 + j] = t[1]; }
    bf16x8 bre[4], bim[4], cf[4];
    const float bmask = g4 < 2 ? 1.0f : 0.0f;
#pragma unroll
    for (int pb = 0; pb < 4; ++pb) {
        const int pp = 16 * pb + cl; const f32x4 t = CT[pp]; const float fr_ = t[2] * bmask, fi_ = t[3] * bmask;
        const float* br = p.b_re + ((size_t)(g * 64 + pp)) * 16 + 8 * (g4 & 1); const float* bi = p.b_im + ((size_t)(g * 64 + pp)) * 16 + 8 * (g4 & 1);
        const f32x4 r0 = *(const f32x4*)br, r1 = *(const f32x4*)(br + 4), i0 = *(const f32x4*)bi, i1 = *(const f32x4*)(bi + 4);
        bre[pb] = pack8(fr_ * r0 - fi_ * i0, fr_ * r1 - fi_ * i1);
        bim[pb] = pack8(fr_ * i0 + fi_ * r0, fr_ * i1 + fi_ * r1);
    }
#pragma unroll
    for (int ks = 0; ks < 4; ++ks) {
        const float* cp = (ks < 2 ? p.c_re : p.c_im) + ((size_t)(g * 16 + cl)) * 64 + 32 * (ks & 1) + 4 * g4;
        f32x4 a = *(const f32x4*)cp, c = *(const f32x4*)(cp + 16);
        if (ks >= 2) { a = -a; c = -c; }
        cf[ks] = pack8(a, c);
    }
    const f32x4 dsk = *(const f32x4*)(p.ssm_d + g * 16 + 4 * g4);
    const int chain = 16 * w + cl;
    const size_t row0 = prompt ? (size_t)b * 2048 + (size_t)chain * 16 : (size_t)NPROMPT + 4 * chain;
    const size_t so = ((size_t)chain * 64 + g) * 64 + 4 * g4;
    const int nq = prompt ? 4 : 1;
    float sr[16], si[16];
#pragma unroll
    for (int k = 0; k < 16; ++k) { sr[k] = 0.f; si[k] = 0.f; }
    if (!prompt) {
#pragma unroll
        for (int pb = 0; pb < 4; ++pb) { const f32x4 a = *(const f32x4*)(p.state_re + so + 16 * pb), c = *(const f32x4*)(p.state_im + so + 16 * pb);
#pragma unroll
            for (int j = 0; j < 4; ++j) { sr[pb * 4 + j] = a[j]; si[pb * 4 + j] = c[j]; } }
    }
#pragma unroll 1
    for (int pass = prompt ? 0 : 1; pass < 2; ++pass) {
        if (pass == 1 && prompt) {
#pragma unroll
            for (int pb = 0; pb < 4; ++pb) {
                *(LAS f32x4*)(E + (chain * 2 + 0) * 64 + 16 * pb + 4 * g4) = (f32x4){sr[pb * 4], sr[pb * 4 + 1], sr[pb * 4 + 2], sr[pb * 4 + 3]};
                *(LAS f32x4*)(E + (chain * 2 + 1) * 64 + 16 * pb + 4 * g4) = (f32x4){si[pb * 4], si[pb * 4 + 1], si[pb * 4 + 2], si[pb * 4 + 3]};
            }
            __syncthreads();
            if (w == 0) {
                float a_r, a_i; { const f32x4 t = CT[lane]; a_r = t[0]; a_i = t[1]; }
#pragma unroll
                for (int q = 0; q < 4; ++q) { const float nr = a_r * a_r - a_i * a_i, ni = 2.0f * a_r * a_i; a_r = nr; a_i = ni; }
                float Fr = 0.f, Fi = 0.f;
#pragma unroll 8
                for (int k = 0; k < 128; ++k) {
                    const float er = E[(2 * k) * 64 + lane], ei = E[(2 * k + 1) * 64 + lane];
                    E[(2 * k) * 64 + lane] = Fr; E[(2 * k + 1) * 64 + lane] = Fi;
                    const float nr = a_r * Fr - a_i * Fi + er; Fi = a_r * Fi + a_i * Fr + ei; Fr = nr;
                }
                p.out[O_RP + (size_t)(b * 64 + g) * 64 + lane] = Fr; p.out[O_IP + (size_t)(b * 64 + g) * 64 + lane] = Fi;
            }
            __syncthreads();
#pragma unroll
            for (int pb = 0; pb < 4; ++pb) {
                const f32x4 a = *(LAS f32x4*)(E + (chain * 2 + 0) * 64 + 16 * pb + 4 * g4), c = *(LAS f32x4*)(E + (chain * 2 + 1) * 64 + 16 * pb + 4 * g4);
#pragma unroll
                for (int j = 0; j < 4; ++j) { sr[pb * 4 + j] = a[j]; si[pb * 4 + j] = c[j]; }
            }
        }
        S5In cur; s5_load4(cur, PROJ, row0, g, g4);
#pragma unroll 1
        for (int q = 0; q < nq; ++q) {
            S5In nxt = cur;
            if (q + 1 < nq) s5_load4(nxt, PROJ, row0 + 4 * (q + 1), g, g4);
            s5_steps4(cur, YS, row0 + 4 * q, g, g4, pass == 1, bre, bim, cf, ar, ai, dsk, sr, si);
            cur = nxt;
        }
    }
    if (!prompt) {
#pragma unroll
        for (int pb = 0; pb < 4; ++pb) {
            *(f32x4*)(p.out + O_RS + so + 16 * pb) = (f32x4){sr[pb * 4], sr[pb * 4 + 1], sr[pb * 4 + 2], sr[pb * 4 + 3]};
            *(f32x4*)(p.out + O_IS + so + 16 * pb) = (f32x4){si[pb * 4], si[pb * 4 + 1], si[pb * 4 + 2], si[pb * 4 + 3]};
        }
    }
    __syncthreads();
}

__device__ __forceinline__ void attn_prompt_unit(const P& p, const int unit, LAS unsigned char* lds) {
    const bf16_t* PROJ = (const bf16_t*)(p.ws + WS_PROJ); const bf16_t* KB = (const bf16_t*)(p.ws + WS_KB); const bf16_t* VT = (const bf16_t*)(p.ws + WS_VT);
    bf16_t* OATT = (bf16_t*)(p.ws + WS_OATT);
    const int tid = otid(), lane = tid & 63, w = tid >> 6, cl = lane & 15, g4 = lane >> 4;
    const int b = unit >> 6, h = (unit >> 4) & 3, qb = unit & 15;
    const bf16_t* kbase = KB + (size_t)(b * 256) * 1024 + h * 256;
#pragma unroll
    for (int i = 0; i < 16; ++i) { const int idx = tid + 512 * i, r = idx >> 5, m = idx & 31;
        const u32x4 v = *(const u32x4*)(kbase + (size_t)r * 1024 + m * 8); *(LAS u32x4*)(lds + r * 512 + ((m ^ (r & 15)) << 4)) = v; }
    const size_t qrow = (size_t)b * 2048 + qb * 128 + w * 16 + cl;
    const bf16_t* qp = PROJ + qrow * NIN + OFF_AQ + h * 256 + 8 * g4;
    bf16x8 qf[8];
#pragma unroll
    for (int ks = 0; ks < 8; ++ks) qf[ks] = *(const bf16x8*)(qp + 32 * ks);
    __syncthreads();
    f32x4 s[16];
#pragma unroll
    for (int kb = 0; kb < 16; ++kb) { s[kb] = (f32x4){0.f, 0.f, 0.f, 0.f};
#pragma unroll
        for (int ks = 0; ks < 8; ++ks) { const int key = 16 * kb + cl, m = 4 * ks + g4;
            const bf16x8 kf = *(const LAS bf16x8*)(lds + key * 512 + ((m ^ cl) << 4)); s[kb] = MFMA16(kf, qf[ks], s[kb]); }
        __builtin_amdgcn_sched_barrier(0); }
    __syncthreads();
    const bf16_t* vbase = VT + (size_t)((b * 4 + h) * 256) * 256;
    u32x4 vst[16];
#pragma unroll
    for (int i = 0; i < 16; ++i) { const int idx = tid + 512 * i, r = idx >> 5, m = idx & 31; vst[i] = *(const u32x4*)(vbase + (size_t)r * 256 + m * 8); }
    float mx = -3.0e38f;
#pragma unroll
    for (int kb = 0; kb < 16; ++kb)
#pragma unroll
        for (int j = 0; j < 4; ++j) mx = fmaxf(mx, s[kb][j]);
    mx = fmaxf(mx, __shfl_xor(mx, 16)); mx = fmaxf(mx, __shfl_xor(mx, 32));
    float sum = 0.f;
#pragma unroll
    for (int kb = 0; kb < 16; ++kb)
#pragma unroll
        for (int j = 0; j < 4; ++j) { const float e = __expf((s[kb][j] - mx) * 0.0625f); s[kb][j] = e; sum += e; }
    sum += __shfl_xor(sum, 16); sum += __shfl_xor(sum, 32);
    const float inv = rcp_(sum);
    bf16x8 pf[8];
#pragma unroll
    for (int kk = 0; kk < 8; ++kk) pf[kk] = pack8(s[2 * kk], s[2 * kk + 1]);
#pragma unroll
    for (int i = 0; i < 16; ++i) { const int idx = tid + 512 * i, r = idx >> 5, m = idx & 31; *(LAS u32x4*)(lds + r * 512 + ((m ^ (r & 15)) << 4)) = vst[i]; }
    __syncthreads();
    const bf16_t* azp = PROJ + qrow * NIN + OFF_AZ + h * 256 + 4 * g4;
    bf16_t* op = OATT + qrow * 1024 + h * 256 + 4 * g4;
    u32x2 azv[16];
#pragma unroll
    for (int db = 0; db < 16; ++db) azv[db] = *(const u32x2*)(azp + 16 * db);
#pragma unroll
    for (int db = 0; db < 16; ++db) {
        f32x4 o = (f32x4){0.f, 0.f, 0.f, 0.f}; const int d = 16 * db + cl;
#pragma unroll
        for (int kk = 0; kk < 8; ++kk) {
            const int ch0 = 8 * kk + g4, ch1 = ch0 + 4;
            const u32x2 lo = *(const LAS u32x2*)(lds + d * 512 + (((ch0 >> 1) ^ cl) << 4) + (ch0 & 1) * 8);
            const u32x2 hi = *(const LAS u32x2*)(lds + d * 512 + (((ch1 >> 1) ^ cl) << 4) + (ch1 & 1) * 8);
            const u32x4 vv = (u32x4){lo.x, lo.y, hi.x, hi.y};
            o = MFMA16(__builtin_bit_cast(bf16x8, vv), pf[kk], o);
        }
        const u32x2 az = azv[db];
        const float z[4] = {bf_lo(az.x), bf_hi(az.x), bf_lo(az.y), bf_hi(az.y)};
        u32x2 wv; wv.x = cvt_pk_bf16(o[0] * inv * siluf_(z[0]), o[1] * inv * siluf_(z[1])); wv.y = cvt_pk_bf16(o[2] * inv * siluf_(z[2]), o[3] * inv * siluf_(z[3]));
        *(u32x2*)(op + 16 * db) = wv;
        __builtin_amdgcn_sched_barrier(0);
    }
    __syncthreads();
}

__device__ __forceinline__ void attn_sample_pair(const P& p, const int u0, const int u1_, LAS unsigned char* lds) {
    const int u1 = u1_ < 512 ? u1_ : u0;
    const bf16_t* PROJ = (const bf16_t*)(p.ws + WS_PROJ); bf16_t* OATT = (bf16_t*)(p.ws + WS_OATT);
    const int tid = otid(), lane = tid & 63, w = tid >> 6, cl = lane & 15, g4 = lane >> 4;
    LAS float* Pw = (LAS float*)(lds + w * 512);
    LAS float* ST = (LAS float*)(lds + 4096);
    LAS float* OW = (LAS float*)(lds + 8192);
    f32x4 bA[16], bB[16], o[4], s0, s1;
    bf16x8 qf[8];
#define SA_LOADQ(unit) do { const bf16_t* qp_ = PROJ + ((size_t)NPROMPT + 4 * ((unit) >> 2) + (cl & 3)) * NIN + OFF_AQ + ((unit) & 3) * 256 + 8 * g4; \
        _Pragma("unroll") for (int ks = 0; ks < 8; ++ks) qf[ks] = *(const bf16x8*)(qp_ + 32 * ks); } while (0)
#define SA_LOADK(buf, unit, kblk) do { const float* kr_ = p.cache_k + ((size_t)((unit) >> 2) * 1024 + ((unit) & 3)) * 256 + (size_t)(32 * w + 16 * (kblk) + cl) * 1024 + 8 * g4; \
        _Pragma("unroll") for (int ks = 0; ks < 8; ++ks) { buf[2 * ks] = NTL((const f32x4*)(kr_ + 32 * ks)); buf[2 * ks + 1] = NTL((const f32x4*)(kr_ + 32 * ks + 4)); } } while (0)
#define SA_LOADV(buf, unit, half) do { const float* vr_ = p.cache_v + ((size_t)((unit) >> 2) * 1024 + ((unit) & 3)) * 256 + (size_t)(32 * w + 16 * (half)) * 1024 + 4 * lane; \
        _Pragma("unroll") for (int i = 0; i < 16; ++i) buf[i] = NTL((const f32x4*)(vr_ + (size_t)i * 1024)); } while (0)
#define SA_QK(buf, sv) do { sv = (f32x4){0.f, 0.f, 0.f, 0.f}; _Pragma("unroll") for (int ks = 0; ks < 8; ++ks) sv = MFMA16(pack8(buf[2 * ks], buf[2 * ks + 1]), qf[ks], sv); } while (0)
#define SA_PV(buf, half) do { _Pragma("unroll") for (int ii = 0; ii < 4; ++ii) _Pragma("unroll") for (int q = 0; q < 4; ++q) { const f32x4 pv_ = *(const LAS f32x4*)(Pw + q * 32 + 16 * (half) + 4 * ii); \
        o[q] += pv_[0] * buf[4 * ii] + pv_[1] * buf[4 * ii + 1] + pv_[2] * buf[4 * ii + 2] + pv_[3] * buf[4 * ii + 3]; } } while (0)
#define SA_SOFTMAX(slot) do { float m_ = fmaxf(fmaxf(fmaxf(s0[0], s0[1]), fmaxf(s0[2], s0[3])), fmaxf(fmaxf(s1[0], s1[1]), fmaxf(s1[2], s1[3]))); \
        m_ = fmaxf(m_, __shfl_xor(m_, 16)); m_ = fmaxf(m_, __shfl_xor(m_, 32)); float l_ = 0.f; \
        _Pragma("unroll") for (int j = 0; j < 4; ++j) { s0[j] = __expf((s0[j] - m_) * 0.0625f); s1[j] = __expf((s1[j] - m_) * 0.0625f); l_ += s0[j] + s1[j]; } \
        l_ += __shfl_xor(l_, 16); l_ += __shfl_xor(l_, 32); \
        if (cl < 4) { *(LAS f32x4*)(Pw + cl * 32 + 4 * g4) = s0; *(LAS f32x4*)(Pw + cl * 32 + 16 + 4 * g4) = s1; \
            if (g4 == 0) { ST[(((slot) * 8 + w) * 4 + cl) * 2] = m_; ST[(((slot) * 8 + w) * 4 + cl) * 2 + 1] = l_; } } } while (0)
#define SA_OZERO() do { _Pragma("unroll") for (int q = 0; q < 4; ++q) o[q] = (f32x4){0.f, 0.f, 0.f, 0.f}; } while (0)
#define SA_OWRITE(slot) do { _Pragma("unroll") for (int q = 0; q < 4; ++q) *(LAS f32x4*)(OW + (size_t)((((slot) * 8 + w) * 4 + q) * 256) + 4 * lane) = o[q]; } while (0)
#define SA_SB() __builtin_amdgcn_sched_barrier(0)
    SA_LOADQ(u0);
    SA_LOADK(bA, u0, 0); SA_LOADK(bB, u0, 1); SA_SB();
    SA_QK(bA, s0); SA_LOADV(bA, u0, 0); SA_SB();
    SA_QK(bB, s1); SA_LOADV(bB, u0, 1); SA_SB();
    SA_SOFTMAX(0);
    SA_LOADQ(u1);
    SA_OZERO(); SA_SB();
    SA_PV(bA, 0); SA_LOADK(bA, u1, 0); SA_SB();
    SA_PV(bB, 1); SA_LOADK(bB, u1, 1); SA_SB();
    SA_OWRITE(0);
    {
        SA_QK(bA, s0); SA_LOADV(bA, u1, 0); SA_SB();
        SA_QK(bB, s1); SA_LOADV(bB, u1, 1); SA_SB();
        SA_SOFTMAX(1);
        SA_OZERO(); SA_SB();
        SA_PV(bA, 0); SA_SB();
        SA_PV(bB, 1);
        SA_OWRITE(1);
    }
    __syncthreads();
    {
        const int slot = tid >> 8, q = (tid >> 6) & 3, d = (tid & 63) * 4;
        const int unit = slot == 0 ? u0 : u1;
        {
            float M = -3.0e38f;
#pragma unroll
            for (int ww = 0; ww < 8; ++ww) M = fmaxf(M, ST[((slot * 8 + ww) * 4 + q) * 2]);
            float L = 0.f; f32x4 a = (f32x4){0.f, 0.f, 0.f, 0.f};
#pragma unroll
            for (int ww = 0; ww < 8; ++ww) { const float f = __expf((ST[((slot * 8 + ww) * 4 + q) * 2] - M) * 0.0625f); L += f * ST[((slot * 8 + ww) * 4 + q) * 2 + 1];
                a += f * *(const LAS f32x4*)(OW + (size_t)(((slot * 8 + ww) * 4 + q) * 256) + d); }
            const float inv = rcp_(L);
            const size_t row = (size_t)NPROMPT + 4 * (unit >> 2) + q; const int h = unit & 3;
            const u32x2 az = *(const u32x2*)(PROJ + row * NIN + OFF_AZ + h * 256 + d);
            u32x2 wv; wv.x = cvt_pk_bf16(a[0] * inv * siluf_(bf_lo(az.x)), a[1] * inv * siluf_(bf_hi(az.x))); wv.y = cvt_pk_bf16(a[2] * inv * siluf_(bf_lo(az.y)), a[3] * inv * siluf_(bf_hi(az.y)));
            *(u32x2*)(OATT + row * 1024 + h * 256 + d) = wv;
        }
    }
    __syncthreads();
#undef SA_LOADQ
#undef SA_LOADK
#undef SA_LOADV
#undef SA_QK
#undef SA_PV
#undef SA_SOFTMAX
#undef SA_OZERO
#undef SA_OWRITE
#undef SA_SB
}

__device__ __forceinline__ void phase5(const P& p) {
    const float* part = (const float*)(p.ws + WS_PART);
    const int t0 = otid(); const int lane = t0 & 63, gw = blockIdx.x * 8 + (t0 >> 6), nw = gridDim.x * 8;
    for (int row = gw; row < MTOK; row += nw) {
        float* orow = p.out + (size_t)row * DM;
        f32x4 v[8]; float s = 0.f;
        if (row < NPROMPT) {
            const float* xr = p.x_prompt + (size_t)row * DM; const bf16_t* dr = (const bf16_t*)(p.ws + WS_DELTA) + (size_t)row * DM;
#pragma unroll
            for (int i = 0; i < 8; ++i) { const u32x2 d = *(const u32x2*)(dr + 4 * (lane + 64 * i));
                v[i] = *(const f32x4*)(xr + 4 * (lane + 64 * i)) + (f32x4){bf_lo(d.x), bf_hi(d.x), bf_lo(d.y), bf_hi(d.y)}; }
        } else {
            const float* xr = p.x_sample + (size_t)(row - NPROMPT) * DM;
#pragma unroll
            for (int i = 0; i < 8; ++i) v[i] = *(const f32x4*)(xr + 4 * (lane + 64 * i));
#pragma unroll 2
            for (int ks = 0; ks < 8; ++ks) { const float* pr = part + ((size_t)ks * 512 + (row - NPROMPT)) * DM;
#pragma unroll
                for (int i = 0; i < 8; ++i) v[i] += *(const f32x4*)(pr + 4 * (lane + 64 * i)); }
        }
#pragma unroll
        for (int i = 0; i < 8; ++i) s += (v[i][0] * v[i][0] + v[i][1] * v[i][1]) + (v[i][2] * v[i][2] + v[i][3] * v[i][3]);
#pragma unroll
        for (int o = 32; o >= 1; o >>= 1) s += __shfl_xor(s, o);
        const float rstd = 1.0f / sqrtf(s * (1.0f / 2048.0f) + 1e-6f);
#pragma unroll
        for (int i = 0; i < 8; ++i) { const f32x4 gv = *(const f32x4*)(p.final_g + 4 * (lane + 64 * i)); *(f32x4*)(orow + 4 * (lane + 64 * i)) = v[i] * rstd * gv; }
    }
}

#define XB_TMO      128
#define XB_XCNT(j)  (256  + 64 * (j))
#define XB_XSUB(j)  (1280 + 64 * (j))
#define XB_XGEN(j)  (2304 + 64 * (j))
#define XB_TOP      3328
#define XB_TOPGEN   3392
#define XB_SPIN_CAP (1u << 20)
__device__ __forceinline__ unsigned xb_ld(unsigned* p)              { return __hip_atomic_load(p, __ATOMIC_RELAXED, __HIP_MEMORY_SCOPE_AGENT); }
__device__ __forceinline__ unsigned xb_add(unsigned* p, unsigned v) { return __hip_atomic_fetch_add(p, v, __ATOMIC_RELAXED, __HIP_MEMORY_SCOPE_AGENT); }
__device__ __forceinline__ unsigned xb_xcc_id() { return (unsigned)__builtin_amdgcn_s_getreg((3 << 11) | 20) & 0xFu; }
#define XB_SPIN(cond, bar) do { unsigned _sp = 0; while (cond) { __builtin_amdgcn_s_sleep(1); \
    if ((++_sp & 255u) == 0u) { if (xb_ld(&(bar)[XB_TMO])) break; if (_sp > XB_SPIN_CAP) { atomicAdd(&(bar)[XB_TMO], 1u); break; } } } } while (0)
struct XcdBarrier { unsigned* bar; unsigned x; volatile LAS unsigned* st; };
__device__ __forceinline__ XcdBarrier xcd_barrier_post(unsigned* bar, volatile LAS unsigned* st) {
    XcdBarrier b; b.bar = bar; b.x = xb_xcc_id(); b.st = st;
    if (threadIdx.x == 0) (void)xb_add(&bar[XB_XCNT(b.x)], 1u);
    return b;
}
__device__ __forceinline__ void xcd_barrier_complete(unsigned* bar, unsigned x, unsigned& nloc, unsigned& nx) {
    const unsigned G = gridDim.x * gridDim.y * gridDim.z;
    unsigned sum, cnt, mine, sp = 0u;
    for (;;) {
        sum = 0u; cnt = 0u; mine = 0u;
#pragma unroll
        for (unsigned j = 0; j < 16; ++j) { const unsigned c = xb_ld(&bar[XB_XCNT(j)]); sum += c; cnt += (c > 0u) ? 1u : 0u; mine = (j == x) ? c : mine; }
        if (sum == G) break;
        __builtin_amdgcn_s_sleep(1);
        if ((++sp & 255u) == 0u) { if (xb_ld(&bar[XB_TMO])) break; if (sp > XB_SPIN_CAP) { atomicAdd(&bar[XB_TMO], 1u); break; } }
    }
    nloc = mine > 0u ? mine : 1u; nx = cnt > 0u ? cnt : 1u;
}
__device__ __forceinline__ void xcd_barrier(const XcdBarrier& b) {
    asm volatile("s_waitcnt vmcnt(0)" ::: "memory");
    __syncthreads();
    if (threadIdx.x == 0) {
        unsigned* bar = b.bar;
        __builtin_amdgcn_s_waitcnt(0);
        unsigned nloc = b.st[0], nx = b.st[1];
        if (nloc == 0u) { xcd_barrier_complete(bar, b.x, nloc, nx); b.st[0] = nloc; b.st[1] = nx; }
        const unsigned old = xb_add(&bar[XB_XSUB(b.x)], 1u);
        const unsigned gen = old / nloc;
        if (old + 1u == (gen + 1u) * nloc) {
            __builtin_amdgcn_fence(__ATOMIC_RELEASE, "agent");
            asm volatile("s_waitcnt vmcnt(0)" ::: "memory");
            const unsigned og = xb_add(&bar[XB_TOP], 1u);
            const unsigned tg = og / nx;
            if (og + 1u == (tg + 1u) * nx) xb_add(&bar[XB_TOPGEN], 1u);
            else XB_SPIN(xb_ld(&bar[XB_TOPGEN]) == tg, bar);
            __builtin_amdgcn_fence(__ATOMIC_ACQUIRE, "agent");
            xb_add(&bar[XB_XGEN(b.x)], 1u);
            asm volatile("s_waitcnt vmcnt(0)" ::: "memory");
        } else {
            XB_SPIN(xb_ld(&bar[XB_XGEN(b.x)]) == gen, bar);
            __builtin_amdgcn_fence(__ATOMIC_ACQUIRE, "agent");
            asm volatile("s_waitcnt vmcnt(0)" ::: "memory");
        }
    }
    __syncthreads();
}

__global__ void __launch_bounds__(512, 2) mega_fwd(P p) {
    extern __shared__ __attribute__((aligned(16))) unsigned char shm[];
    LAS unsigned char* lds = (LAS unsigned char*)shm;
    cg::grid_group grid = cg::this_grid();
    unsigned char* ws = p.ws;
    const int G = gridDim.x, c = blockIdx.x;
    volatile LAS unsigned* bst = (volatile LAS unsigned*)(lds + 131072);
    if (threadIdx.x == 0) { bst[0] = 0u; bst[1] = 0u; }
    __syncthreads();
    const XcdBarrier xbar = xcd_barrier_post((unsigned*)(ws + WS_BAR), bst);
    if (p.out == nullptr) grid.sync();
#define GSYNC() xcd_barrier(xbar)

#ifndef PHMASK
#define PHMASK 0xffff
#endif
#ifndef REPMASK
#define REPMASK 0
#endif
#define NREP(bit) ((REPMASK & (bit)) ? 2 : 1)
#ifndef TPHASE
#define TPHASE -1
#endif
#ifndef TMULT
#define TMULT 4
#endif
    unsigned long long ts[8]; int nts = 0;
#define STAMP() do { if (TPHASE >= 0 && TPHASE < 10) { ts[nts] = wall_clock64(); } ++nts; } while (0)
    STAMP();
    for (int rep = 0; rep < NREP(1); ++rep) if (PHMASK & 1) phase0(p, lds);
    GSYNC(); STAMP();

    for (int rep = 0; rep < NREP(2); ++rep) if (PHMASK & 2) {
        Sched1 S{(const char*)(ws + WS_H), (const char*)(ws + WS_WIN), (const char*)(ws + WS_MEMN), (const char*)(ws + WS_WK), (const char*)(ws + WS_WV), G, c};
        Epi1 E{(bf16_t*)(ws + WS_PROJ), p.out + O_MK, (bf16_t*)(ws + WS_KB), p.out + O_MV, (bf16_t*)(ws + WS_VT)};
        pg8::gemm_phase(lds, 2048, 2048, S, E);
    }
    GSYNC(); STAMP();

    for (int rep = 0; rep < NREP(4); ++rep) {
        unsigned long long m0 = 0, m1 = 0, m2 = 0, m3 = 0, m4 = 0;
        if (TPHASE >= 10) m0 = wall_clock64();
        const int sg = (c >> 3) & 3;
        if (sg == 0) for (int u = c; u < 512; u += 2 * G) attn_sample_pair(p, u, u + G, lds);
        if (TPHASE >= 10) m1 = wall_clock64();
        for (int u = c; u < 256; u += G) s5_unit(p, u, lds);
        for (int u = 256 + (G - 1 - c); u < 320; u += G) s5_unit(p, u, lds);
        if (TPHASE >= 10) m2 = wall_clock64();
        if (sg == 1) for (int u = c; u < 512; u += 2 * G) attn_sample_pair(p, u, u + G, lds);
        for (int u = c; u < 256; u += G) attn_prompt_unit(p, u, lds);
        if (TPHASE >= 10) m3 = wall_clock64();
        if (sg == 2) for (int u = c; u < 512; u += 2 * G) attn_sample_pair(p, u, u + G, lds);
        conv_phase(p);
        if (sg == 3) for (int u = c; u < 512; u += 2 * G) attn_sample_pair(p, u, u + G, lds);
        late_transposes(p, lds, c, G, G == 256 ? 512 : 768);
        if (TPHASE >= 10) { m4 = wall_clock64(); ts[0] = 0; ts[1] = TPHASE == 10 ? m1 - m0 : (TPHASE == 11 ? m2 - m1 : (TPHASE == 12 ? m3 - m2 : m4 - m3)); }
    }
    GSYNC(); STAMP();

    for (int rep = 0; rep < NREP(8); ++rep) if (PHMASK & 64) {
        { Sched1g Sg{(const char*)(ws + WS_H), (const char*)(ws + WS_WIN), G, c}; Epi1 Eg{(bf16_t*)(ws + WS_PROJ), p.out + O_MK, (bf16_t*)(ws + WS_KB), p.out + O_MV, (bf16_t*)(ws + WS_VT)}; pg8::gemm_phase(lds, 2048, 2048, Sg, Eg); }
        if (G == 256 && c >= 144) late_transposes(p, lds, 512 + (c - 144), 112, 768);
        Sched2 S{(const char*)ws, G, c};
        Epi2 E{(bf16_t*)(ws + WS_GLU), (bf16_t*)(ws + WS_CONVO), (bf16_t*)(ws + WS_ATTO)};
        pg8::gemm_phase(lds, 1024, 1024, S, E);
    }
    GSYNC(); STAMP();

    for (int rep = 0; rep < NREP(32); ++rep) merge_phase(p);
    GSYNC(); STAMP();

    for (int rep = 0; rep < NREP(16); ++rep) if (PHMASK & 128) {
        { Sched3 S{(const char*)(ws + WS_MERGED), (const char*)(ws + WS_WO), G, c}; Epi3 E{(bf16_t*)(ws + WS_DELTA), (float*)(ws + WS_PART), false}; pg8::gemm_phase(lds, 2048, 2048, S, E); }
        { Sched3b S{(const char*)(ws + WS_MERGED), (const char*)(ws + WS_WO), G, c}; Epi3 E{(bf16_t*)(ws + WS_DELTA), (float*)(ws + WS_PART), true}; pg8::gemm_phase(lds, 256, 2048, S, E); }
    }
    GSYNC(); STAMP();

    if (PHMASK & 256) phase5(p);
    STAMP();
    if (TPHASE >= 0 && blockIdx.x == 0 && threadIdx.x == 0) {
        const unsigned long long d = (TPHASE >= 10 ? ts[1] - ts[0] : ts[TPHASE + 1] - ts[TPHASE]) * TMULT, t0 = wall_clock64();
        while (wall_clock64() - t0 < d) __builtin_amdgcn_s_sleep(16);
    }
}

extern "C" void kernel_launch(void* const* d_in, const int* in_sizes, int n_in, void* d_out, int out_size, void* d_ws, size_t ws_size, hipStream_t stream) {
    static int grid = 0;
    if (grid == 0) {
        int dev = 0, cus = 0, per_cu = 0;
        hipGetDevice(&dev);
        hipDeviceGetAttribute(&cus, hipDeviceAttributeMultiprocessorCount, dev);
        if (hipFuncSetAttribute((const void*)mega_fwd, hipFuncAttributeMaxDynamicSharedMemorySize, LDS_BYTES) != hipSuccess) fprintf(stderr, "kernel_launch: hipFuncSetAttribute failed\n");
        if (hipOccupancyMaxActiveBlocksPerMultiprocessor(&per_cu, (const void*)mega_fwd, 512, LDS_BYTES) != hipSuccess || per_cu < 1) per_cu = 1;
        (void)hipGetLastError();
        grid = cus * per_cu;
        if (ws_size < WS_END) fprintf(stderr, "kernel_launch: workspace too small (%zu < %zu)\n", ws_size, (size_t)WS_END);
    }
    P p{};
    const float** pp = (const float**)&p;
    for (int i = 0; i < 28; ++i) pp[i] = (const float*)d_in[i];
    p.out = (float*)d_out; p.ws = (unsigned char*)d_ws;
    void* args[] = {&p};
    (void)hipMemsetAsync((unsigned char*)d_ws + WS_BAR, 0, 16384, stream);
    hipError_t e = hipLaunchCooperativeKernel((const void*)mega_fwd, dim3(grid), dim3(512), args, LDS_BYTES, stream);
    if (e != hipSuccess) fprintf(stderr, "cooperative launch failed: %s (grid %d)\n", hipGetErrorString(e), grid);
}
```

```cpp
#include <hip/hip_runtime.h>
#include <hip/hip_cooperative_groups.h>
#include <cstdio>
namespace cg = cooperative_groups;

#define LAS __attribute__((address_space(3)))
typedef unsigned short bf16_t;
typedef short bf16x8 __attribute__((ext_vector_type(8)));
typedef float f32x4 __attribute__((ext_vector_type(4)));
typedef unsigned u32x4 __attribute__((ext_vector_type(4)));
typedef unsigned u32x2 __attribute__((ext_vector_type(2)));

constexpr int DM = 2048, NPROMPT = 8192, NSAMPLE = 512, MTOK = 8704, NIN = 14336;
constexpr int OFF_CB = 0, OFF_CC = 1024, OFF_CH = 2048, OFF_CZ = 3072, OFF_SU = 4096, OFF_SZ = 5120, OFF_AQ = 6144, OFF_AZ = 7168, OFF_G = 8192;
constexpr int LDS_BYTES = 131072 + 16;
constexpr size_t O_Y = 0, O_MK = 17825792, O_MV = 18874368, O_CP = 19922944, O_RP = 19931136, O_IP = 19947520, O_CS = 19963904, O_RS = 20226048, O_IS = 20750336;
constexpr size_t WS_WIN = 0;
constexpr size_t WS_WG = WS_WIN + (size_t)NIN * DM * 2;
constexpr size_t WS_WC = WS_WG + 8388608;
constexpr size_t WS_WA = WS_WC + 4194304;
constexpr size_t WS_WO = WS_WA + 4194304;
constexpr size_t WS_H = WS_WO + 8388608;
constexpr size_t WS_PROJ = WS_H + (size_t)MTOK * DM * 2;
constexpr size_t WS_YS = WS_PROJ + (size_t)MTOK * NIN * 2;
constexpr size_t WS_ACONV = WS_YS + (size_t)MTOK * 1024 * 2;
constexpr size_t WS_OATT = WS_ACONV + (size_t)MTOK * 1024 * 2;
constexpr size_t WS_SS = WS_OATT + (size_t)MTOK * 1024 * 2;
constexpr size_t WS_GLU = WS_SS + (size_t)MTOK * 32 * 4;
constexpr size_t WS_MERGED = WS_GLU + (size_t)MTOK * DM * 2;
constexpr size_t WS_BAR = WS_MERGED + (size_t)MTOK * DM * 2;
constexpr size_t WS_MEMN = WS_BAR + 16384;
constexpr size_t WS_WK = WS_MEMN + 4194304;
constexpr size_t WS_WV = WS_WK + 4194304;
constexpr size_t WS_KB = WS_WV + 4194304;
constexpr size_t WS_VT = WS_KB + 2097152;
constexpr size_t WS_ATTO = WS_MEMN;
constexpr size_t WS_END = WS_ATTO + (size_t)MTOK * DM * 2;
constexpr size_t WS_CONVO = WS_WIN, WS_PART = WS_PROJ, WS_DELTA = WS_PROJ + 67108864;
static_assert(WS_END <= 536870912, "workspace");
static_assert(WS_VT + 2097152 <= WS_END && (size_t)MTOK * DM * 2 <= 38u * 1048576u, "aliases");

struct P {
    const float *x_prompt, *x_sample, *mem_prompt, *cache_k, *cache_v, *state_conv, *state_re, *state_im, *norm_g, *mem_norm_g, *w_in, *conv_w, *w_conv_out,
        *lam_re, *lam_im, *log_dt, *b_re, *b_im, *c_re, *c_im, *ssm_d, *w_glu_a, *w_glu_b, *w_mem_k, *w_mem_v, *w_attn_out, *w_out, *final_g;
    float* out; unsigned char* ws;
};

__device__ __forceinline__ unsigned cvt_pk_bf16(float lo, float hi) { unsigned r; asm("v_cvt_pk_bf16_f32 %0, %1, %2" : "=v"(r) : "v"(lo), "v"(hi)); return r; }
__device__ __forceinline__ float bf_lo(unsigned w) { return __uint_as_float(w << 16); }
__device__ __forceinline__ float bf_hi(unsigned w) { return __uint_as_float(w & 0xffff0000u); }
__device__ __forceinline__ float rcp_(float x) { return __builtin_amdgcn_rcpf(x); }
__device__ __forceinline__ float sigmoidf_(float x) { return rcp_(1.0f + __expf(-x)); }
__device__ __forceinline__ float siluf_(float x) { return x * rcp_(1.0f + __expf(-x)); }
__device__ __forceinline__ float gelu_tanh(float x) { const float u = 1.5957691216057308f * (x + 0.044715f * x * x * x); return x * rcp_(1.0f + __expf(-u)); }
__device__ __forceinline__ bf16x8 pack8(const f32x4 a, const f32x4 b) {
    u32x4 w; w.x = cvt_pk_bf16(a[0], a[1]); w.y = cvt_pk_bf16(a[2], a[3]); w.z = cvt_pk_bf16(b[0], b[1]); w.w = cvt_pk_bf16(b[2], b[3]);
    return __builtin_bit_cast(bf16x8, w);
}
__device__ __forceinline__ u32x4 pack8u(const f32x4 a, const f32x4 b) {
    u32x4 w; w.x = cvt_pk_bf16(a[0], a[1]); w.y = cvt_pk_bf16(a[2], a[3]); w.z = cvt_pk_bf16(b[0], b[1]); w.w = cvt_pk_bf16(b[2], b[3]); return w;
}
__device__ __forceinline__ void unpack8(const u32x4 w, float (&f)[8]) {
    f[0] = bf_lo(w.x); f[1] = bf_hi(w.x); f[2] = bf_lo(w.y); f[3] = bf_hi(w.y); f[4] = bf_lo(w.z); f[5] = bf_hi(w.z); f[6] = bf_lo(w.w); f[7] = bf_hi(w.w);
}
__device__ __forceinline__ int otid() { int t = threadIdx.x; asm volatile("" : "+v"(t)); return t; }
#define NTL(p) __builtin_nontemporal_load(p)
#define NTS(v, p) __builtin_nontemporal_store((v), (p))
#define MFMA16(a, b, c) __builtin_amdgcn_mfma_f32_16x16x32_bf16((a), (b), (c), 0, 0, 0)

namespace pg8 {
constexpr int BM = 256, BK = 64, HALF = 128, HTB = HALF * BK * 2, STAGE_BYTES = 8 * HTB;
__device__ __forceinline__ int lds_byte(int r, int c) { const int st = (r >> 4) * 2 + (c >> 5), rr = r & 15, cc = c & 31, ob = rr * 64 + cc * 2; return st * 1024 + (ob ^ (((ob >> 9) & 1) << 5)); }
__device__ __forceinline__ void stage_rc(int b, int& R, int& C) { const int st = b / 1024, sb = b % 1024, swz = sb ^ (((sb >> 9) & 1) << 5); R = (st >> 1) * 16 + swz / 64; C = (st & 1) * 32 + (swz % 64) / 2; }
__device__ __forceinline__ int perm32(int rho) { const int n = rho >> 4, i = rho & 15; return 8 * (i >> 2) + 4 * n + (i & 3); }
struct Unit { const char* a; const char* b; int pm, pn, kind; };

template <class Sched, class Epi>
__device__ __forceinline__ void gemm_phase(LAS unsigned char* lds, const int K, const int ld, const Sched& S, const Epi& E) {
    const int tid = otid(), wid = __builtin_amdgcn_readfirstlane(tid >> 6), lane = tid & 63, wr = wid >> 2, wc = wid & 3, fr = lane & 15, fq = lane >> 4;
    const int nt = K / BK;
    unsigned voffA[2], voffB[2];
#pragma unroll
    for (int i = 0; i < 2; ++i) { int R, C; stage_rc(tid * 16 + i * 8192, R, C); const int Rb = (R & ~31) + perm32(R & 31);
        voffA[i] = (unsigned)(R * ld + C) * 2u; voffB[i] = (unsigned)(Rb * ld + C) * 2u; }
    const size_t kstep = (size_t)(BK * 2);
    const size_t hstep = (size_t)HALF * ld * 2;
    const unsigned ldsw = (unsigned)wid * 1024u;
    const int aoff = lds_byte(wr * 64 + fr, fq * 8), boff = lds_byte(wc * 32 + fr, fq * 8);
#define PG8_SA(b, h) (((b) * 2 + (h)) * HTB)
#define PG8_SB(b, h) ((4 + (b) * 2 + (h)) * HTB)
#define PG8_STAGE(bufoff, gbase, voff) do { _Pragma("unroll") for (int _i = 0; _i < 2; ++_i) \
        __builtin_amdgcn_global_load_lds((const unsigned*)((const char*)(gbase) + (voff)[_i]), (LAS unsigned*)(lds + (bufoff) + ldsw + _i * 8192), 16, 0, 0); } while (0)
#define PG8_LDA(dst, b, h) do { _Pragma("unroll") for (int m = 0; m < 4; ++m) _Pragma("unroll") for (int k = 0; k < 2; ++k) dst[m][k] = *(const LAS bf16x8*)(lds + PG8_SA(b, h) + aoff + m * 2048 + k * 1024); } while (0)
#define PG8_LDB(dst, b, h) do { _Pragma("unroll") for (int n = 0; n < 2; ++n) _Pragma("unroll") for (int k = 0; k < 2; ++k) dst[n][k] = *(const LAS bf16x8*)(lds + PG8_SB(b, h) + boff + n * 2048 + k * 1024); } while (0)
#define PG8_MMA(ai, bj, At, Bt) do { __builtin_amdgcn_s_setprio(1); _Pragma("unroll") for (int m = 0; m < 4; ++m) _Pragma("unroll") for (int n = 0; n < 2; ++n) _Pragma("unroll") for (int k = 0; k < 2; ++k) \
        acc[ai][bj][m][n] = __builtin_amdgcn_mfma_f32_16x16x32_bf16(Bt[n][k], At[m][k], acc[ai][bj][m][n], 0, 0, 0); __builtin_amdgcn_s_setprio(0); } while (0)
#define PG8_WAIT_V(n) asm volatile("s_waitcnt vmcnt(" #n ")" ::: "memory")
#define PG8_WAIT_L(n) asm volatile("s_waitcnt lgkmcnt(" #n ")" ::: "memory")
#define PG8_BAR __builtin_amdgcn_s_barrier()
#define PG8_SCHED __builtin_amdgcn_sched_barrier(0)
    Unit cur, nxt; int ui = 0;
    if (!S.next(0, cur)) return;
    f32x4 acc[2][2][4][2];
#pragma unroll
    for (int a = 0; a < 2; ++a)
#pragma unroll
        for (int b = 0; b < 2; ++b)
#pragma unroll
            for (int m = 0; m < 4; ++m)
#pragma unroll
                for (int n = 0; n < 2; ++n) acc[a][b][m][n] = (f32x4){0.f, 0.f, 0.f, 0.f};
    bf16x8 At[4][2], B0[2][2], B1[2][2];
    const char* cA = cur.a; const char* cB = cur.b;
    PG8_STAGE(PG8_SB(0, 0), cB, voffB); PG8_STAGE(PG8_SA(0, 0), cA, voffA); PG8_STAGE(PG8_SB(0, 1), cB + hstep, voffB); PG8_STAGE(PG8_SA(0, 1), cA + hstep, voffA);
    if (wr == 1) PG8_BAR;
    PG8_WAIT_V(4); PG8_BAR;
    PG8_STAGE(PG8_SB(1, 0), cB + kstep, voffB); PG8_STAGE(PG8_SA(1, 0), cA + kstep, voffA); PG8_STAGE(PG8_SB(1, 1), cB + hstep + kstep, voffB);
    PG8_WAIT_V(6); PG8_BAR;
    for (;;) {
        const bool has_next = S.next(ui + 1, nxt);
        const char* nA = has_next ? nxt.a : cA; const char* nB = has_next ? nxt.b : cB;
        for (int t = 0; t < nt; t += 2) {
            const bool last = (t == nt - 2);
            const char* a1 = cA + (size_t)(t + 1) * kstep;
            const char* a2 = last ? nA : cA + (size_t)(t + 2) * kstep; const char* b2 = last ? nB : cB + (size_t)(t + 2) * kstep;
            const char* a3 = a2 + kstep; const char* b3 = b2 + kstep;
            PG8_LDB(B0, 0, 0); PG8_SCHED; PG8_LDA(At, 0, 0); PG8_STAGE(PG8_SA(1, 1), a1 + hstep, voffA);
            PG8_WAIT_L(8); PG8_BAR; PG8_WAIT_L(0); PG8_MMA(0, 0, At, B0); PG8_BAR; PG8_SCHED;
            PG8_LDB(B1, 0, 1); PG8_STAGE(PG8_SB(0, 0), b2, voffB);
            PG8_BAR; PG8_WAIT_L(0); PG8_MMA(0, 1, At, B1); PG8_BAR;
            PG8_LDA(At, 0, 1); PG8_STAGE(PG8_SA(0, 0), a2, voffA);
            PG8_BAR; PG8_WAIT_L(0); PG8_MMA(1, 0, At, B0); PG8_BAR; PG8_SCHED;
            PG8_STAGE(PG8_SB(0, 1), b2 + hstep, voffB);
            PG8_WAIT_V(6); PG8_BAR; PG8_MMA(1, 1, At, B1); PG8_BAR;
            PG8_LDB(B0, 1, 0); PG8_SCHED; PG8_LDA(At, 1, 0); PG8_STAGE(PG8_SA(0, 1), a2 + hstep, voffA);
            PG8_WAIT_L(8); PG8_BAR; PG8_WAIT_L(0); PG8_MMA(0, 0, At, B0); PG8_BAR; PG8_SCHED;
            PG8_LDB(B1, 1, 1); PG8_STAGE(PG8_SB(1, 0), b3, voffB);
            PG8_BAR; PG8_WAIT_L(0); PG8_MMA(0, 1, At, B1); PG8_BAR;
            PG8_LDA(At, 1, 1); PG8_STAGE(PG8_SA(1, 0), a3, voffA);
            PG8_BAR; PG8_WAIT_L(0); PG8_MMA(1, 0, At, B0); PG8_BAR; PG8_SCHED;
            PG8_STAGE(PG8_SB(1, 1), b3 + hstep, voffB);
            PG8_WAIT_V(6); PG8_BAR; PG8_MMA(1, 1, At, B1); PG8_BAR;
        }
        const bool keep = E(acc, cur, wr, wc, fr, fq);
        if (!has_next) break;
        if (!keep) {
#pragma unroll
            for (int a = 0; a < 2; ++a)
#pragma unroll
                for (int b = 0; b < 2; ++b)
#pragma unroll
                    for (int m = 0; m < 4; ++m)
#pragma unroll
                        for (int n = 0; n < 2; ++n) acc[a][b][m][n] = (f32x4){0.f, 0.f, 0.f, 0.f};
        }
        cur = nxt; cA = nA; cB = nB; ++ui;
    }
    PG8_WAIT_V(0);
    if (wr == 0) PG8_BAR;
    PG8_BAR;
#undef PG8_SA
#undef PG8_SB
#undef PG8_STAGE
#undef PG8_LDA
#undef PG8_LDB
#undef PG8_MMA
#undef PG8_WAIT_V
#undef PG8_WAIT_L
#undef PG8_BAR
#undef PG8_SCHED
}
}
using pg8::Unit;

__device__ __forceinline__ void xcd_tile_order(int wgid, const int nM, const int nN, int& pm, int& pn) {
    const int nwg = nM * nN, NX = 8, WGM = 8;
    { const int q = nwg / NX, r = nwg % NX, xcd = wgid % NX, off = wgid / NX; wgid = (xcd < r ? xcd * (q + 1) : r * (q + 1) + (xcd - r) * q) + off; }
    const int nig = WGM * nN, gid = wgid / nig, fm = gid * WGM, gsz = (nM - fm) < WGM ? (nM - fm) : WGM;
    pm = fm + ((wgid % nig) % gsz); pn = (wgid % nig) / gsz;
}
struct Sched1 {
    const char *H, *WIN, *MEMN, *WK, *WV; int G, c;
    __device__ __forceinline__ bool next(int i, Unit& u) const {
        const int L = i * G + c; if (L >= 1792) return false;
        if (L < 1760) {
            int pm, pn;
            if (L < 1292) xcd_tile_order(L, 34, 38, pm, pn);
            else { xcd_tile_order(L - 1292, 26, 18, pm, pn); pn += 38; }
            u.pm = pm; u.pn = pn; u.kind = 0; u.a = H + (size_t)pm * 1048576; u.b = WIN + (size_t)pn * 1048576;
        } else if (L < 1776) { const int j = L - 1760; u.pm = j >> 2; u.pn = j & 3; u.kind = 1; u.a = MEMN + (size_t)u.pm * 1048576; u.b = WK + (size_t)u.pn * 1048576; }
        else { const int j = L - 1776; u.pm = j >> 2; u.pn = j & 3; u.kind = 2; u.a = WV + (size_t)u.pm * 1048576; u.b = MEMN + (size_t)u.pn * 1048576; }
        return true;
    }
};
struct Sched1g {
    const char *H, *WIN; int G, c;
    __device__ __forceinline__ bool next(int i, Unit& u) const {
        const int j = i * G + c; if (j >= 144) return false;
        u.pm = 26 + j / 18; u.pn = 38 + j % 18; u.kind = 0; u.a = H + (size_t)u.pm * 1048576; u.b = WIN + (size_t)u.pn * 1048576; return true;
    }
};
struct Epi1 {
    bf16_t* PROJ; float* outK; bf16_t* KB; float* outV; bf16_t* VT;
    __device__ __forceinline__ bool operator()(f32x4 (&acc)[2][2][4][2], const Unit& u, int wr, int wc, int fr, int fq) const {
        const int r0 = u.pm * 256 + wr * 64 + fr, c0 = u.pn * 256 + wc * 32 + 8 * fq;
        if (u.kind == 0) {
#pragma unroll
            for (int ai = 0; ai < 2; ++ai)
#pragma unroll
                for (int m = 0; m < 4; ++m) { bf16_t* rowp = PROJ + (size_t)(r0 + ai * 128 + m * 16) * NIN + c0;
#pragma unroll
                    for (int bj = 0; bj < 2; ++bj) *(u32x4*)(rowp + bj * 128) = pack8u(acc[ai][bj][m][0], acc[ai][bj][m][1]); }
        } else if (u.kind == 1) {
#pragma unroll
            for (int ai = 0; ai < 2; ++ai)
#pragma unroll
                for (int m = 0; m < 4; ++m) { const size_t off = (size_t)(r0 + ai * 128 + m * 16) * 1024 + c0;
#pragma unroll
                    for (int bj = 0; bj < 2; ++bj) { NTS(acc[ai][bj][m][0], (f32x4*)(outK + off + bj * 128)); NTS(acc[ai][bj][m][1], (f32x4*)(outK + off + bj * 128 + 4));
                        *(u32x4*)(KB + off + bj * 128) = pack8u(acc[ai][bj][m][0], acc[ai][bj][m][1]); } }
        } else {
            const int h = u.pm, b = u.pn;
#pragma unroll
            for (int ai = 0; ai < 2; ++ai)
#pragma unroll
                for (int m = 0; m < 4; ++m) { const int d = wr * 64 + fr + ai * 128 + m * 16;
#pragma unroll
                    for (int bj = 0; bj < 2; ++bj) { const int key0 = wc * 32 + 8 * fq + bj * 128;
                        *(u32x4*)(VT + ((size_t)((b * 4 + h) * 256 + d)) * 256 + key0) = pack8u(acc[ai][bj][m][0], acc[ai][bj][m][1]);
                        float* fp = outV + ((size_t)(b * 256 + key0)) * 1024 + h * 256 + d;
#pragma unroll
                        for (int e = 0; e < 4; ++e) { fp[(size_t)e * 1024] = acc[ai][bj][m][0][e]; fp[(size_t)(e + 4) * 1024] = acc[ai][bj][m][1][e]; } } }
        }
        return false;
    }
};

struct Sched2 {
    const char* ws; int G, c;
    __device__ __forceinline__ bool next(int i, Unit& u) const {
        int L;
        if (G == 256) { if (c < 144) { if (i >= 4) return false; L = c + 144 * i; } else { L = 576 + (c - 144) + 112 * i; } }
        else L = i * G + c;
        if (L >= 1088) return false;
        if (L < 544) { u.pm = L >> 4; u.pn = L & 15; u.kind = 0; u.a = ws + WS_YS + (size_t)u.pm * 524288; u.b = ws + WS_WG + (size_t)u.pn * 524288; }
        else { const int j = L - 544, k = j >= 272 ? 1 : 0, jj = j - 272 * k; u.pm = jj >> 3; u.pn = jj & 7; u.kind = 1 + k;
            u.a = ws + WS_ACONV + (size_t)k * ((size_t)MTOK * 1024 * 2) + (size_t)u.pm * 524288; u.b = ws + WS_WC + (size_t)k * 4194304 + (size_t)u.pn * 524288; }
        return true;
    }
};
struct Epi2 {
    bf16_t* GLU; bf16_t* CONVO; bf16_t* ATTO;
    __device__ __forceinline__ bool operator()(f32x4 (&acc)[2][2][4][2], const Unit& u, int wr, int wc, int fr, int fq) const {
        const int r0 = u.pm * 256 + wr * 64 + fr;
        if (u.kind == 0) {
            const int c0 = u.pn * 128 + wc * 32 + 8 * fq;
#pragma unroll
            for (int ai = 0; ai < 2; ++ai)
#pragma unroll
                for (int m = 0; m < 4; ++m) {
                    f32x4 t0, t1;
#pragma unroll
                    for (int e = 0; e < 4; ++e) { t0[e] = acc[ai][0][m][0][e] * sigmoidf_(acc[ai][1][m][0][e]); t1[e] = acc[ai][0][m][1][e] * sigmoidf_(acc[ai][1][m][1][e]); }
                    *(u32x4*)(GLU + (size_t)(r0 + ai * 128 + m * 16) * 2048 + c0) = pack8u(t0, t1);
                }
        } else {
            bf16_t* O = u.kind == 1 ? CONVO : ATTO; const int c0 = u.pn * 256 + wc * 32 + 8 * fq;
#pragma unroll
            for (int ai = 0; ai < 2; ++ai)
#pragma unroll
                for (int m = 0; m < 4; ++m) { bf16_t* rowp = O + (size_t)(r0 + ai * 128 + m * 16) * 2048 + c0;
#pragma unroll
                    for (int bj = 0; bj < 2; ++bj) *(u32x4*)(rowp + bj * 128) = pack8u(acc[ai][bj][m][0], acc[ai][bj][m][1]); }
        }
        return false;
    }
};
__device__ __forceinline__ void merge_phase(const P& p) {
    const bf16_t* PROJ = (const bf16_t*)(p.ws + WS_PROJ); const bf16_t* GLU = (const bf16_t*)(p.ws + WS_GLU); const bf16_t* CONVO = (const bf16_t*)(p.ws + WS_CONVO);
    const bf16_t* ATTO = (const bf16_t*)(p.ws + WS_ATTO); bf16_t* MERGED = (bf16_t*)(p.ws + WS_MERGED);
    const int NT = MTOK * 256, stride = gridDim.x * 512;
    for (int t = blockIdx.x * 512 + otid(); t < NT; t += 2 * stride) {
        u32x4 L[2][6]; const int t1 = t + stride; const bool has1 = t1 < NT;
#pragma unroll
        for (int k = 0; k < 2; ++k) { const int tt = k == 0 ? t : (has1 ? t1 : t);
            const size_t row = (size_t)(tt >> 8); const int c0 = (tt & 255) * 8; const bf16_t* pr = PROJ + row * NIN + OFF_G + c0; const size_t o = row * 2048 + c0;
            L[k][0] = NTL((const u32x4*)pr); L[k][1] = NTL((const u32x4*)(pr + 2048)); L[k][2] = NTL((const u32x4*)(pr + 4096));
            L[k][3] = NTL((const u32x4*)(CONVO + o)); L[k][4] = NTL((const u32x4*)(GLU + o)); L[k][5] = NTL((const u32x4*)(ATTO + o)); }
#pragma unroll
        for (int k = 0; k < 2; ++k) { if (k == 1 && !has1) break; const int tt = k == 0 ? t : t1;
            const size_t row = (size_t)(tt >> 8); const int c0 = (tt & 255) * 8; const size_t o = row * 2048 + c0;
            float g0[8], g1[8], g2[8], cv[8], gl[8], at[8];
            unpack8(L[k][0], g0); unpack8(L[k][1], g1); unpack8(L[k][2], g2); unpack8(L[k][3], cv); unpack8(L[k][4], gl); unpack8(L[k][5], at);
            f32x4 m0, m1;
#pragma unroll
            for (int e = 0; e < 8; ++e) { const float v = sigmoidf_(g0[e]) * cv[e] + sigmoidf_(g1[e]) * gl[e] + sigmoidf_(g2[e]) * at[e]; if (e < 4) m0[e] = v; else m1[e - 4] = v; }
            *(u32x4*)(MERGED + o) = pack8u(m0, m1); }
    }
}

struct Sched3 {
    const char *MERGED, *WO; int G, c;
    __device__ __forceinline__ bool next(int i, Unit& u) const {
        const int L = i * G + c; if (L >= 256) return false;
        u.pm = L >> 3; u.pn = L & 7; u.kind = 0; u.a = MERGED + (size_t)u.pm * 1048576; u.b = WO + (size_t)u.pn * 1048576; return true;
    }
};
struct Sched3b {
    const char *MERGED, *WO; int G, c;
    __device__ __forceinline__ bool next(int i, Unit& u) const {
        const int L = i * G + c; if (L >= 128) return false;
        const int tile = L >> 3, ks = L & 7; u.pm = 32 + (tile >> 3); u.pn = tile & 7; u.kind = ks;
        u.a = MERGED + (size_t)u.pm * 1048576 + (size_t)ks * 512; u.b = WO + (size_t)u.pn * 1048576 + (size_t)ks * 512; return true;
    }
};
struct Epi3 {
    bf16_t* delta; float* part;
    bool sample;
    __device__ __forceinline__ bool operator()(f32x4 (&acc)[2][2][4][2], const Unit& u, int wr, int wc, int fr, int fq) const {
        const int r0 = u.pm * 256 + wr * 64 + fr, c0 = u.pn * 256 + wc * 32 + 8 * fq;
        if (!sample) {
#pragma unroll
            for (int ai = 0; ai < 2; ++ai)
#pragma unroll
                for (int m = 0; m < 4; ++m) { bf16_t* o = delta + (size_t)(r0 + ai * 128 + m * 16) * DM + c0;
#pragma unroll
                    for (int bj = 0; bj < 2; ++bj) *(u32x4*)(o + bj * 128) = pack8u(acc[ai][bj][m][0], acc[ai][bj][m][1]); }
        } else {
            float* base = part + ((size_t)u.kind * 512 - NPROMPT) * DM;
#pragma unroll
            for (int ai = 0; ai < 2; ++ai)
#pragma unroll
                for (int m = 0; m < 4; ++m) {
                    float* o = base + (size_t)(r0 + ai * 128 + m * 16) * DM + c0;
#pragma unroll
                    for (int bj = 0; bj < 2; ++bj)
#pragma unroll
                        for (int n = 0; n < 2; ++n) *(f32x4*)(o + bj * 128 + 4 * n) = acc[ai][bj][m][n];
                }
        }
        return false;
    }
};

__device__ __forceinline__ void transpose_tile(const float* __restrict__ src, const int K, const int N, bf16_t* __restrict__ dst, const int mode, const int t, LAS float* tile) {
    const int tid = otid(); const int tn = N / 256;
    const int r = tid >> 3, c8 = (tid & 7) * 8;
    const int k0 = (t / tn) * 64, n0 = (t % tn) * 256;
    const float* s = src + (size_t)(k0 + r) * N + n0 + c8;
    f32x4 v[8];
#pragma unroll
    for (int j = 0; j < 4; ++j) { v[2 * j] = NTL((const f32x4*)(s + j * 64)); v[2 * j + 1] = NTL((const f32x4*)(s + j * 64 + 4)); }
#pragma unroll
    for (int j = 0; j < 4; ++j)
#pragma unroll
        for (int e = 0; e < 4; ++e) { tile[j * 4160 + r * 65 + c8 + e] = v[2 * j][e]; tile[j * 4160 + r * 65 + c8 + 4 + e] = v[2 * j + 1][e]; }
    __syncthreads();
#pragma unroll
    for (int j = 0; j < 4; ++j) {
        f32x4 a, b;
#pragma unroll
        for (int e = 0; e < 4; ++e) { a[e] = tile[j * 4160 + (c8 + e) * 65 + r]; b[e] = tile[j * 4160 + (c8 + 4 + e) * 65 + r]; }
        const int n = n0 + j * 64 + r;
        const int row = mode == 0 ? n : ((n >> 7) * 256 + (mode - 1) * 128 + (n & 127));
        *(u32x4*)(dst + (size_t)row * K + k0 + c8) = pack8u(a, b);
    }
    __syncthreads();
}
__device__ __forceinline__ void tload_win(const float* w_in, int t, int r, int c8, f32x4 (&v)[8]) {
    const int k0 = (t / 56) * 64, n0 = (t % 56) * 256;
    const float* s = w_in + (size_t)(k0 + r) * NIN + n0 + c8;
#pragma unroll
    for (int j = 0; j < 4; ++j) { v[2 * j] = NTL((const f32x4*)(s + j * 64)); v[2 * j + 1] = NTL((const f32x4*)(s + j * 64 + 4)); }
}
__device__ __forceinline__ void phase0(const P& p, LAS unsigned char* lds) {
    unsigned char* ws = p.ws; LAS float* tile = (LAS float*)lds;
    {
        const int tid = otid(); const int r = tid >> 3, c8 = (tid & 7) * 8;
        bf16_t* dst = (bf16_t*)(ws + WS_WIN);
        int j = blockIdx.x; f32x4 v[8];
        if (j < 1792) tload_win(p.w_in, j, r, c8, v);
        while (j < 1792) {
#pragma unroll
            for (int q = 0; q < 4; ++q)
#pragma unroll
                for (int e = 0; e < 4; ++e) { tile[q * 4160 + r * 65 + c8 + e] = v[2 * q][e]; tile[q * 4160 + r * 65 + c8 + 4 + e] = v[2 * q + 1][e]; }
            const int jn = j + gridDim.x;
            if (jn < 1792) tload_win(p.w_in, jn, r, c8, v);
            __syncthreads();
            const int k0 = (j / 56) * 64, n0 = (j % 56) * 256;
#pragma unroll
            for (int q = 0; q < 4; ++q) {
                f32x4 a, b;
#pragma unroll
                for (int e = 0; e < 4; ++e) { a[e] = tile[q * 4160 + (c8 + e) * 65 + r]; b[e] = tile[q * 4160 + (c8 + 4 + e) * 65 + r]; }
                *(u32x4*)(dst + (size_t)(n0 + q * 64 + r) * 2048 + k0 + c8) = pack8u(a, b);
            }
            __syncthreads();
            j = jn;
        }
    }
    for (int t = blockIdx.x; t < 256; t += gridDim.x) {
        if (t < 128) transpose_tile(p.w_mem_k, 2048, 1024, (bf16_t*)(ws + WS_WK), 0, t, tile);
        else transpose_tile(p.w_mem_v, 2048, 1024, (bf16_t*)(ws + WS_WV), 0, t - 128, tile);
    }
    const int t0 = otid(); const int lane = t0 & 63, gw = blockIdx.x * 8 + (t0 >> 6), nw = gridDim.x * 8;
    auto rowsrc = [&](int row) -> const float* { return row < NPROMPT ? p.x_prompt + (size_t)row * DM : (row < MTOK ? p.x_sample + (size_t)(row - NPROMPT) * DM : p.mem_prompt + (size_t)(row - MTOK) * DM); };
    f32x4 v[8], vn[8];
    if (gw < MTOK + 1024) { const float* src = rowsrc(gw);
#pragma unroll
        for (int i = 0; i < 8; ++i) v[i] = NTL((const f32x4*)(src + 4 * (lane + 64 * i))); }
    for (int row = gw; row < MTOK + 1024; row += nw) {
        const float* g = row < MTOK ? p.norm_g : p.mem_norm_g;
        bf16_t* dst = row < MTOK ? (bf16_t*)(ws + WS_H) + (size_t)row * DM : (bf16_t*)(ws + WS_MEMN) + (size_t)(row - MTOK) * DM;
        if (row + nw < MTOK + 1024) { const float* src = rowsrc(row + nw);
#pragma unroll
            for (int i = 0; i < 8; ++i) vn[i] = NTL((const f32x4*)(src + 4 * (lane + 64 * i))); }
        float s = 0.f;
#pragma unroll
        for (int i = 0; i < 8; ++i) s += (v[i][0] * v[i][0] + v[i][1] * v[i][1]) + (v[i][2] * v[i][2] + v[i][3] * v[i][3]);
#pragma unroll
        for (int o = 32; o >= 1; o >>= 1) s += __shfl_xor(s, o);
        const float rstd = 1.0f / sqrtf(s * (1.0f / 2048.0f) + 1e-6f);
#pragma unroll
        for (int i = 0; i < 8; ++i) { const f32x4 gv = *(const f32x4*)(g + 4 * (lane + 64 * i));
            u32x2 w; w.x = cvt_pk_bf16(v[i][0] * rstd * gv[0], v[i][1] * rstd * gv[1]); w.y = cvt_pk_bf16(v[i][2] * rstd * gv[2], v[i][3] * rstd * gv[3]);
            *(u32x2*)(dst + 4 * (lane + 64 * i)) = w; }
#pragma unroll
        for (int i = 0; i < 8; ++i) v[i] = vn[i];
    }
}

__device__ __forceinline__ void late_transposes(const P& p, LAS unsigned char* lds, const int first, const int stride, const int end) {
    unsigned char* ws = p.ws; LAS float* tile = (LAS float*)lds;
    for (int t = first; t < end; t += stride) {
        if (t < 128) transpose_tile(p.w_conv_out, 1024, 2048, (bf16_t*)(ws + WS_WC), 0, t, tile);
        else if (t < 256) transpose_tile(p.w_attn_out, 1024, 2048, (bf16_t*)(ws + WS_WA), 0, t - 128, tile);
        else if (t < 384) transpose_tile(p.w_glu_a, 1024, 2048, (bf16_t*)(ws + WS_WG), 1, t - 256, tile);
        else if (t < 512) transpose_tile(p.w_glu_b, 1024, 2048, (bf16_t*)(ws + WS_WG), 2, t - 384, tile);
        else transpose_tile(p.w_out, 2048, 2048, (bf16_t*)(ws + WS_WO), 0, t - 512, tile);
    }
}

template <int LEN, bool PROMPT>
__device__ __forceinline__ void conv_task(const P& p, const int r0, const int cgp, const int bs) {
    const bf16_t* PROJ = (const bf16_t*)(p.ws + WS_PROJ); bf16_t* ACONV = (bf16_t*)(p.ws + WS_ACONV);
    const int c0 = cgp * 8;
    const bf16_t* pr = PROJ + (size_t)r0 * NIN + c0;
    u32x4 lcb[LEN], lcz[LEN], lcc[LEN + 2], lch[LEN + 2];
    const bool has_halo = PROMPT && (r0 & 2047) != 0;
#pragma unroll
    for (int i = 0; i < LEN; ++i) { lcb[i] = *(const u32x4*)(pr + (size_t)i * NIN + OFF_CB); lcz[i] = *(const u32x4*)(pr + (size_t)i * NIN + OFF_CZ);
        lcc[i + 2] = *(const u32x4*)(pr + (size_t)i * NIN + OFF_CC); lch[i + 2] = *(const u32x4*)(pr + (size_t)i * NIN + OFF_CH); }
#pragma unroll
    for (int i = 0; i < 2; ++i) { lcc[i] = (u32x4){0u, 0u, 0u, 0u}; lch[i] = lcc[i];
        if (has_halo) { lcc[i] = *(const u32x4*)(pr - (size_t)(2 - i) * NIN + OFF_CC); lch[i] = *(const u32x4*)(pr - (size_t)(2 - i) * NIN + OFF_CH); } }
    float w0[8], w1[8], w2[8], vm2[8], vm1[8];
    { const f32x4 a0 = *(const f32x4*)(p.conv_w + c0), a1 = *(const f32x4*)(p.conv_w + c0 + 4), b0 = *(const f32x4*)(p.conv_w + 1024 + c0), b1 = *(const f32x4*)(p.conv_w + 1024 + c0 + 4),
          d0 = *(const f32x4*)(p.conv_w + 2048 + c0), d1 = *(const f32x4*)(p.conv_w + 2048 + c0 + 4);
#pragma unroll
      for (int e = 0; e < 4; ++e) { w0[e] = a0[e]; w0[e + 4] = a1[e]; w1[e] = b0[e]; w1[e + 4] = b1[e]; w2[e] = d0[e]; w2[e + 4] = d1[e]; } }
    if (PROMPT) {
        float a[8], b[8];
        unpack8(lcc[0], a); unpack8(lch[0], b);
#pragma unroll
        for (int e = 0; e < 8; ++e) vm2[e] = a[e] * b[e];
        unpack8(lcc[1], a); unpack8(lch[1], b);
#pragma unroll
        for (int e = 0; e < 8; ++e) vm1[e] = a[e] * b[e];
    } else {
        const float* sc = p.state_conv + (size_t)bs * 2048 + c0;
        const f32x4 a0 = *(const f32x4*)sc, a1 = *(const f32x4*)(sc + 4), b0 = *(const f32x4*)(sc + 1024), b1 = *(const f32x4*)(sc + 1028);
#pragma unroll
        for (int e = 0; e < 4; ++e) { vm2[e] = a0[e]; vm2[e + 4] = a1[e]; vm1[e] = b0[e]; vm1[e + 4] = b1[e]; }
    }
#pragma unroll
    for (int i = 0; i < LEN; ++i) {
        const size_t row = (size_t)(r0 + i);
        float cb[8], cc[8], ch[8], cz[8], v[8];
        unpack8(lcb[i], cb); unpack8(lcc[i + 2], cc); unpack8(lch[i + 2], ch); unpack8(lcz[i], cz);
        f32x4 o0, o1;
#pragma unroll
        for (int e = 0; e < 8; ++e) { v[e] = cc[e] * ch[e]; const float cv = w0[e] * vm2[e] + w1[e] * vm1[e] + w2[e] * v[e]; const float r = cb[e] * cv * siluf_(cz[e]);
            if (e < 4) o0[e] = r; else o1[e - 4] = r; vm2[e] = vm1[e]; vm1[e] = v[e]; }
        *(u32x4*)(ACONV + row * 1024 + c0) = pack8u(o0, o1);
        float* dst = nullptr;
        if (PROMPT) { const int pos = (r0 + i) & 2047; if (pos >= 2046) dst = p.out + O_CP + ((size_t)((r0 + i) >> 11) * 2 + (pos - 2046)) * 1024 + c0; }
        else if (i >= 2) dst = p.out + O_CS + ((size_t)bs * 2 + (i - 2)) * 1024 + c0;
        if (dst) { *(f32x4*)dst = (f32x4){v[0], v[1], v[2], v[3]}; *(f32x4*)(dst + 4) = (f32x4){v[4], v[5], v[6], v[7]}; }
    }
}
__device__ __forceinline__ void conv_phase(const P& p) {
    const int t0 = blockIdx.x * 512 + otid(), nt = gridDim.x * 512;
    for (int task = t0; task < 262144; task += nt) conv_task<4, true>(p, (task >> 7) * 4, task & 127, 0);
    for (int task = t0; task < 16384; task += nt) conv_task<4, false>(p, NPROMPT + 4 * (task >> 7), task & 127, task >> 7);
}

struct S5In { bf16x8 U[4]; u32x2 u4[4], z4[4]; };
__device__ __forceinline__ void s5_load4(S5In& in, const bf16_t* PROJ, const size_t row0, const int g, const int g4) {
    const bf16_t* base = PROJ + row0 * NIN + g * 16;
#pragma unroll
    for (int i = 0; i < 4; ++i) {
        in.U[i] = *(const bf16x8*)(base + (size_t)i * NIN + OFF_SU + 8 * (g4 & 1));
        in.u4[i] = *(const u32x2*)(base + (size_t)i * NIN + OFF_SU + 4 * g4); in.z4[i] = *(const u32x2*)(base + (size_t)i * NIN + OFF_SZ + 4 * g4);
    }
}
__device__ __forceinline__ void s5_steps4(const S5In& in, bf16_t* YS, const size_t row0, const int g, const int g4, const bool Y,
                                          const bf16x8 (&bre)[4], const bf16x8 (&bim)[4], const bf16x8 (&cf)[4], const float (&ar)[16], const float (&ai)[16], const f32x4 dsk,
                                          float (&sr)[16], float (&si)[16]) {
    const f32x4 zero4 = (f32x4){0.f, 0.f, 0.f, 0.f};
#pragma unroll
    for (int i = 0; i < 4; ++i) {
#pragma unroll
        for (int pb = 0; pb < 4; ++pb) {
            const f32x4 xr = MFMA16(bre[pb], in.U[i], zero4), xi = MFMA16(bim[pb], in.U[i], zero4);
#pragma unroll
            for (int j = 0; j < 4; ++j) { const int k = pb * 4 + j; const float nr = ar[k] * sr[k] - ai[k] * si[k] + xr[j]; const float ni = ar[k] * si[k] + ai[k] * sr[k] + xi[j]; sr[k] = nr; si[k] = ni; }
        }
        if (Y) {
            f32x4 y = zero4;
            y = MFMA16(cf[0], pack8((f32x4){sr[0], sr[1], sr[2], sr[3]}, (f32x4){sr[4], sr[5], sr[6], sr[7]}), y);
            y = MFMA16(cf[1], pack8((f32x4){sr[8], sr[9], sr[10], sr[11]}, (f32x4){sr[12], sr[13], sr[14], sr[15]}), y);
            y = MFMA16(cf[2], pack8((f32x4){si[0], si[1], si[2], si[3]}, (f32x4){si[4], si[5], si[6], si[7]}), y);
            y = MFMA16(cf[3], pack8((f32x4){si[8], si[9], si[10], si[11]}, (f32x4){si[12], si[13], si[14], si[15]}), y);
            const float uu[4] = {bf_lo(in.u4[i].x), bf_hi(in.u4[i].x), bf_lo(in.u4[i].y), bf_hi(in.u4[i].y)};
            const float zz[4] = {bf_lo(in.z4[i].x), bf_hi(in.z4[i].x), bf_lo(in.z4[i].y), bf_hi(in.z4[i].y)};
            float o[4];
#pragma unroll
            for (int j = 0; j < 4; ++j) { const float ysv = y[j] + dsk[j] * uu[j]; o[j] = gelu_tanh(ysv * siluf_(zz[j])); }
            u32x2 w; w.x = cvt_pk_bf16(o[0], o[1]); w.y = cvt_pk_bf16(o[2], o[3]);
            *(u32x2*)(YS + (row0 + i) * 1024 + g * 16 + 4 * g4) = w;
        }
    }
}
__device__ __forceinline__ void s5_coef(const P& p, int g, int pp, float dt, float& ar, float& ai, float& fr, float& fi) {
    const float lr = p.lam_re[g * 64 + pp], li = p.lam_im[g * 64 + pp];
    const float mag = expf(lr * dt), ang = li * dt; float sn, cs; sincosf(ang, &sn, &cs);
    ar = mag * cs; ai = mag * sn; const float den = lr * lr + li * li;
    fr = ((ar - 1.0f) * lr + ai * li) / den; fi = (ai * lr - (ar - 1.0f) * li) / den;
}
__device__ __forceinline__ void s5_unit(const P& p, const int unit, LAS unsigned char* lds) {
    const bf16_t* PROJ = (const bf16_t*)(p.ws + WS_PROJ); bf16_t* YS = (bf16_t*)(p.ws + WS_YS);
    const int tid = otid(), lane = tid & 63, w = tid >> 6, cl = lane & 15, g4 = lane >> 4;
    const bool prompt = unit < 256; const int g = prompt ? (unit & 63) : (unit - 256); const int b = unit >> 6;
    const float dt = expf(p.log_dt[g]);
    LAS float* E = (LAS float*)lds;
    LAS f32x4* CT = (LAS f32x4*)(lds + 65536);
    if (tid < 64) { float a_r, a_i, fr_, fi_; s5_coef(p, g, tid, dt, a_r, a_i, fr_, fi_); CT[tid] = (f32x4){a_r, a_i, fr_, fi_}; }
    __syncthreads();
    float ar[16], ai[16];
#pragma unroll
    for (int pb = 0; pb < 4; ++pb)
#pragma unroll
        for (int j = 0; j < 4; ++j) { const f32x4 t = CT[16 * pb + 4 * g4 + j]; ar[pb * 4 + j] = t[0]; ai[pb * 4 + j] = t[1]; }
    bf16x8 bre[4], bim[4], cf[4];
    const float bmask = g4 < 2 ? 1.0f : 0.0f;
#pragma unroll
    for (int pb = 0; pb < 4; ++pb) {
        const int pp = 16 * pb + cl; const f32x4 t = CT[pp]; const float fr_ = t[2] * bmask, fi_ = t[3] * bmask;
        const float* br = p.b_re + ((size_t)(g * 64 + pp)) * 16 + 8 * (g4 & 1); const float* bi = p.b_im + ((size_t)(g * 64 + pp)) * 16 + 8 * (g4 & 1);
        const f32x4 r0 = *(const f32x4*)br, r1 = *(const f32x4*)(br + 4), i0 = *(const f32x4*)bi, i1 = *(const f32x4*)(bi + 4);
        bre[pb] = pack8(fr_ * r0 - fi_ * i0, fr_ * r1 - fi_ * i1);
        bim[pb] = pack8(fr_ * i0 + fi_ * r0, fr_ * i1 + fi_ * r1);
    }
#pragma unroll
    for (int ks = 0; ks < 4; ++ks) {
        const float* cp = (ks < 2 ? p.c_re : p.c_im) + ((size_t)(g * 16 + cl)) * 64 + 32 * (ks & 1) + 4 * g4;
        f32x4 a = *(const f32x4*)cp, c = *(const f32x4*)(cp + 16);
        if (ks >= 2) { a = -a; c = -c; }
        cf[ks] = pack8(a, c);
    }
    const f32x4 dsk = *(const f32x4*)(p.ssm_d + g * 16 + 4 * g4);
    const int chain = 16 * w + cl;
    const size_t row0 = prompt ? (size_t)b * 2048 + (size_t)chain * 16 : (size_t)NPROMPT + 4 * chain;
    const size_t so = ((size_t)chain * 64 + g) * 64 + 4 * g4;
    const int nq = prompt ? 4 : 1;
    float sr[16], si[16];
#pragma unroll
    for (int k = 0; k < 16; ++k) { sr[k] = 0.f; si[k] = 0.f; }
    if (!prompt) {
#pragma unroll
        for (int pb = 0; pb < 4; ++pb) { const f32x4 a = *(const f32x4*)(p.state_re + so + 16 * pb), c = *(const f32x4*)(p.state_im + so + 16 * pb);
#pragma unroll
            for (int j = 0; j < 4; ++j) { sr[pb * 4 + j] = a[j]; si[pb * 4 + j] = c[j]; } }
    }
#pragma unroll 1
    for (int pass = prompt ? 0 : 1; pass < 2; ++pass) {
        if (pass == 1 && prompt) {
#pragma unroll
            for (int pb = 0; pb < 4; ++pb) {
                *(LAS f32x4*)(E + (chain * 2 + 0) * 64 + 16 * pb + 4 * g4) = (f32x4){sr[pb * 4], sr[pb * 4 + 1], sr[pb * 4 + 2], sr[pb * 4 + 3]};
                *(LAS f32x4*)(E + (chain * 2 + 1) * 64 + 16 * pb + 4 * g4) = (f32x4){si[pb * 4], si[pb * 4 + 1], si[pb * 4 + 2], si[pb * 4 + 3]};
            }
            __syncthreads();
            if (w == 0) {
                float a_r, a_i; { const f32x4 t = CT[lane]; a_r = t[0]; a_i = t[1]; }
#pragma unroll
                for (int q = 0; q < 4; ++q) { const float nr = a_r * a_r - a_i * a_i, ni = 2.0f * a_r * a_i; a_r = nr; a_i = ni; }
                float Fr = 0.f, Fi = 0.f;
#pragma unroll 8
                for (int k = 0; k < 128; ++k) {
                    const float er = E[(2 * k) * 64 + lane], ei = E[(2 * k + 1) * 64 + lane];
                    E[(2 * k) * 64 + lane] = Fr; E[(2 * k + 1) * 64 + lane] = Fi;
                    const float nr = a_r * Fr - a_i * Fi + er; Fi = a_r * Fi + a_i * Fr + ei; Fr = nr;
                }
                p.out[O_RP + (size_t)(b * 64 + g) * 64 + lane] = Fr; p.out[O_IP + (size_t)(b * 64 + g) * 64 + lane] = Fi;
            }
            __syncthreads();
#pragma unroll
            for (int pb = 0; pb < 4; ++pb) {
                const f32x4 a = *(LAS f32x4*)(E + (chain * 2 + 0) * 64 + 16 * pb + 4 * g4), c = *(LAS f32x4*)(E + (chain * 2 + 1) * 64 + 16 * pb + 4 * g4);
#pragma unroll
                for (int j = 0; j < 4; ++j) { sr[pb * 4 + j] = a[j]; si[pb * 4 + j] = c[j]; }
            }
        }
        S5In cur; s5_load4(cur, PROJ, row0, g, g4);
#pragma unroll 1
        for (int q = 0; q < nq; ++q) {
            S5In nxt = cur;
            if (q + 1 < nq) s5_load4(nxt, PROJ, row0 + 4 * (q + 1), g, g4);
            s5_steps4(cur, YS, row0 + 4 * q, g, g4, pass == 1, bre, bim, cf, ar, ai, dsk, sr, si);
            cur = nxt;
        }
    }
    if (!prompt) {
#pragma unroll
        for (int pb = 0; pb < 4; ++pb) {
            *(f32x4*)(p.out + O_RS + so + 16 * pb) = (f32x4){sr[pb * 4], sr[pb * 4 + 1], sr[pb * 4 + 2], sr[pb * 4 + 3]};
            *(f32x4*)(p.out + O_IS + so + 16 * pb) = (f32x4){si[pb * 4], si[pb * 4 + 1], si[pb * 4 + 2], si[pb * 4 + 3]};
        }
    }
    __syncthreads();
}

__device__ __forceinline__ void attn_prompt_unit(const P& p, const int unit, LAS unsigned char* lds) {
    const bf16_t* PROJ = (const bf16_t*)(p.ws + WS_PROJ); const bf16_t* KB = (const bf16_t*)(p.ws + WS_KB); const bf16_t* VT = (const bf16_t*)(p.ws + WS_VT);
    bf16_t* OATT = (bf16_t*)(p.ws + WS_OATT);
    const int tid = otid(), lane = tid & 63, w = tid >> 6, cl = lane & 15, g4 = lane >> 4;
    const int b = unit >> 6, h = (unit >> 4) & 3, qb = unit & 15;
    const bf16_t* kbase = KB + (size_t)(b * 256) * 1024 + h * 256;
#pragma unroll
    for (int i = 0; i < 16; ++i) { const int idx = tid + 512 * i, r = idx >> 5, m = idx & 31;
        const u32x4 v = *(const u32x4*)(kbase + (size_t)r * 1024 + m * 8); *(LAS u32x4*)(lds + r * 512 + ((m ^ (r & 15)) << 4)) = v; }
    const size_t qrow = (size_t)b * 2048 + qb * 128 + w * 16 + cl;
    const bf16_t* qp = PROJ + qrow * NIN + OFF_AQ + h * 256 + 8 * g4;
    bf16x8 qf[8];
#pragma unroll
    for (int ks = 0; ks < 8; ++ks) qf[ks] = *(const bf16x8*)(qp + 32 * ks);
    __syncthreads();
    f32x4 s[16];
#pragma unroll
    for (int kb = 0; kb < 16; ++kb) { s[kb] = (f32x4){0.f, 0.f, 0.f, 0.f};
#pragma unroll
        for (int ks = 0; ks < 8; ++ks) { const int key = 16 * kb + cl, m = 4 * ks + g4;
            const bf16x8 kf = *(const LAS bf16x8*)(lds + key * 512 + ((m ^ cl) << 4)); s[kb] = MFMA16(kf, qf[ks], s[kb]); }
        __builtin_amdgcn_sched_barrier(0); }
    __syncthreads();
    const bf16_t* vbase = VT + (size_t)((b * 4 + h) * 256) * 256;
    u32x4 vst[16];
#pragma unroll
    for (int i = 0; i < 16; ++i) { const int idx = tid + 512 * i, r = idx >> 5, m = idx & 31; vst[i] = *(const u32x4*)(vbase + (size_t)r * 256 + m * 8); }
    float mx = -3.0e38f;
#pragma unroll
    for (int kb = 0; kb < 16; ++kb)
#pragma unroll
        for (int j = 0; j < 4; ++j) mx = fmaxf(mx, s[kb][j]);
    mx = fmaxf(mx, __shfl_xor(mx, 16)); mx = fmaxf(mx, __shfl_xor(mx, 32));
    float sum = 0.f;
#pragma unroll
    for (int kb = 0; kb < 16; ++kb)
#pragma unroll
        for (int j = 0; j < 4; ++j) { const float e = __expf((s[kb][j] - mx) * 0.0625f); s[kb][j] = e; sum += e; }
    sum += __shfl_xor(sum, 16); sum += __shfl_xor(sum, 32);
    const float inv = rcp_(sum);
    bf16x8 pf[8];
#pragma unroll
    for (int kk = 0; kk < 8; ++kk) pf[kk] = pack8(s[2 * kk], s[2 * kk + 1]);
#pragma unroll
    for (int i = 0; i < 16; ++i) { const int idx = tid + 512 * i, r = idx >> 5, m = idx & 31; *(LAS u32x4*)(lds + r * 512 + ((m ^ (r & 15)) << 4)) = vst[i]; }
    __syncthreads();
    const bf16_t* azp = PROJ + qrow * NIN + OFF_AZ + h * 256 + 4 * g4;
    bf16_t* op = OATT + qrow * 1024 + h * 256 + 4 * g4;
    u32x2 azv[16];
#pragma unroll
    for (int db = 0; db < 16; ++db) azv[db] = *(const u32x2*)(azp + 16 * db);
#pragma unroll
    for (int db = 0; db < 16; ++db) {
        f32x4 o = (f32x4){0.f, 0.f, 0.f, 0.f}; const int d = 16 * db + cl;
#pragma unroll
        for (int kk = 0; kk < 8; ++kk) {
            const int ch0 = 8 * kk + g4, ch1 = ch0 + 4;
            const u32x2 lo = *(const LAS u32x2*)(lds + d * 512 + (((ch0 >> 1) ^ cl) << 4) + (ch0 & 1) * 8);
            const u32x2 hi = *(const LAS u32x2*)(lds + d * 512 + (((ch1 >> 1) ^ cl) << 4) + (ch1 & 1) * 8);
            const u32x4 vv = (u32x4){lo.x, lo.y, hi.x, hi.y};
            o = MFMA16(__builtin_bit_cast(bf16x8, vv), pf[kk], o);
        }
        const u32x2 az = azv[db];
        const float z[4] = {bf_lo(az.x), bf_hi(az.x), bf_lo(az.y), bf_hi(az.y)};
        u32x2 wv; wv.x = cvt_pk_bf16(o[0] * inv * siluf_(z[0]), o[1] * inv * siluf_(z[1])); wv.y = cvt_pk_bf16(o[2] * inv * siluf_(z[2]), o[3] * inv * siluf_(z[3]));
        *(u32x2*)(op + 16 * db) = wv;
        __builtin_amdgcn_sched_barrier(0);
    }
    __syncthreads();
}

__device__ __forceinline__ void attn_sample_pair(const P& p, const int u0, const int u1_, LAS unsigned char* lds) {
    const int u1 = u1_ < 512 ? u1_ : u0;
    const bf16_t* PROJ = (const bf16_t*)(p.ws + WS_PROJ); bf16_t* OATT = (bf16_t*)(p.ws + WS_OATT);
    const int tid = otid(), lane = tid & 63, w = tid >> 6, cl = lane & 15, g4 = lane >> 4;
    LAS float* Pw = (LAS float*)(lds + w * 512);
    LAS float* ST = (LAS float*)(lds + 4096);
    LAS float* OW = (LAS float*)(lds + 8192);
    f32x4 bA[16], bB[16], o[4], s0, s1;
    bf16x8 qf[8];
#define SA_LOADQ(unit) do { const bf16_t* qp_ = PROJ + ((size_t)NPROMPT + 4 * ((unit) >> 2) + (cl & 3)) * NIN + OFF_AQ + ((unit) & 3) * 256 + 8 * g4; \
        _Pragma("unroll") for (int ks = 0; ks < 8; ++ks) qf[ks] = *(const bf16x8*)(qp_ + 32 * ks); } while (0)
#define SA_LOADK(buf, unit, kblk) do { const float* kr_ = p.cache_k + ((size_t)((unit) >> 2) * 1024 + ((unit) & 3)) * 256 + (size_t)(32 * w + 16 * (kblk) + cl) * 1024 + 8 * g4; \
        _Pragma("unroll") for (int ks = 0; ks < 8; ++ks) { buf[2 * ks] = NTL((const f32x4*)(kr_ + 32 * ks)); buf[2 * ks + 1] = NTL((const f32x4*)(kr_ + 32 * ks + 4)); } } while (0)
#define SA_LOADV(buf, unit, half) do { const float* vr_ = p.cache_v + ((size_t)((unit) >> 2) * 1024 + ((unit) & 3)) * 256 + (size_t)(32 * w + 16 * (half)) * 1024 + 4 * lane; \
        _Pragma("unroll") for (int i = 0; i < 16; ++i) buf[i] = NTL((const f32x4*)(vr_ + (size_t)i * 1024)); } while (0)
#define SA_QK(buf, sv) do { sv = (f32x4){0.f, 0.f, 0.f, 0.f}; _Pragma("unroll") for (int ks = 0; ks < 8; ++ks) sv = MFMA16(pack8(buf[2 * ks], buf[2 * ks + 1]), qf[ks], sv); } while (0)
#define SA_PV(buf, half) do { _Pragma("unroll") for (int ii = 0; ii < 4; ++ii) _Pragma("unroll") for (int q = 0; q < 4; ++q) { const f32x4 pv_ = *(const LAS f32x4*)(Pw + q * 32 + 16 * (half) + 4 * ii); \
        o[q] += pv_[0] * buf[4 * ii] + pv_[1] * buf[4 * ii + 1] + pv_[2] * buf[4 * ii + 2] + pv_[3] * buf[4 * ii + 3]; } } while (0)
#define SA_SOFTMAX(slot) do { float m_ = fmaxf(fmaxf(fmaxf(s0[0], s0[1]), fmaxf(s0[2], s0[3])), fmaxf(fmaxf(s1[0], s1[1]), fmaxf(s1[2], s1[3]))); \
        m_ = fmaxf(m_, __shfl_xor(m_, 16)); m_ = fmaxf(m_, __shfl_xor(m_, 32)); float l_ = 0.f; \
        _Pragma("unroll") for (int j = 0; j < 4; ++j) { s0[j] = __expf((s0[j] - m_) * 0.0625f); s1[j] = __expf((s1[j] - m_) * 0.0625f); l_ += s0[j] + s1[j]; } \
        l_ += __shfl_xor(l_, 16); l_ += __shfl_xor(l_, 32); \
        if (cl < 4) { *(LAS f32x4*)(Pw + cl * 32 + 4 * g4) = s0; *(LAS f32x4*)(Pw + cl * 32 + 16 + 4 * g4) = s1; \
            if (g4 == 0) { ST[(((slot) * 8 + w) * 4 + cl) * 2] = m_; ST[(((slot) * 8 + w) * 4 + cl) * 2 + 1] = l_; } } } while (0)
#define SA_OZERO() do { _Pragma("unroll") for (int q = 0; q < 4; ++q) o[q] = (f32x4){0.f, 0.f, 0.f, 0.f}; } while (0)
#define SA_OWRITE(slot) do { _Pragma("unroll") for (int q = 0; q < 4; ++q) *(LAS f32x4*)(OW + (size_t)((((slot) * 8 + w) * 4 + q) * 256) + 4 * lane) = o[q]; } while (0)
#define SA_SB() __builtin_amdgcn_sched_barrier(0)
    SA_LOADQ(u0);
    SA_LOADK(bA, u0, 0); SA_LOADK(bB, u0, 1); SA_SB();
    SA_QK(bA, s0); SA_LOADV(bA, u0, 0); SA_SB();
    SA_QK(bB, s1); SA_LOADV(bB, u0, 1); SA_SB();
    SA_SOFTMAX(0);
    SA_LOADQ(u1);
    SA_OZERO(); SA_SB();
    SA_PV(bA, 0); SA_LOADK(bA, u1, 0); SA_SB();
    SA_PV(bB, 1); SA_LOADK(bB, u1, 1); SA_SB();
    SA_OWRITE(0);
    {
        SA_QK(bA, s0); SA_LOADV(bA, u1, 0); SA_SB();
        SA_QK(bB, s1); SA_LOADV(bB, u1, 1); SA_SB();
        SA_SOFTMAX(1);
        SA_OZERO(); SA_SB();
        SA_PV(bA, 0); SA_SB();
        SA_PV(bB, 1);
        SA_OWRITE(1);
    }
    __syncthreads();
    {
        const int slot = tid >> 8, q = (tid >> 6) & 3, d = (tid & 63) * 4;
        const int unit = slot == 0 ? u0 : u1;
        {
            float M = -3.0e38f;
#pragma unroll
            for (int ww = 0; ww < 8; ++ww) M = fmaxf(M, ST[((slot * 8 + ww) * 4 + q) * 2]);
            float L = 0.f; f32x4 a = (f32x4){0.f, 0.f, 0.f, 0.f};
#pragma unroll
            for (int ww = 0; ww < 8; ++ww) { const float f = __expf((ST[((slot * 8 + ww) * 4 + q) * 2] - M) * 0.0625f); L += f * ST[((slot * 8 + ww) * 4 + q) * 2 + 1];
                a += f * *(const LAS f32x4*)(OW + (size_t)(((slot * 8 + ww) * 4 + q) * 256) + d); }
            const float inv = rcp_(L);
            const size_t row = (size_t)NPROMPT + 4 * (unit >> 2) + q; const int h = unit & 3;
            const u32x2 az = *(const u32x2*)(PROJ + row * NIN + OFF_AZ + h * 256 + d);
            u32x2 wv; wv.x = cvt_pk_bf16(a[0] * inv * siluf_(bf_lo(az.x)), a[1] * inv * siluf_(bf_hi(az.x))); wv.y = cvt_pk_bf16(a[2] * inv * siluf_(bf_lo(az.y)), a[3] * inv * siluf_(bf_hi(az.y)));
            *(u32x2*)(OATT + row * 1024 + h * 256 + d) = wv;
        }
    }
    __syncthreads();
#undef SA_LOADQ
#undef SA_LOADK
#undef SA_LOADV
#undef SA_QK
#undef SA_PV
#undef SA_SOFTMAX
#undef SA_OZERO
#undef SA_OWRITE
#undef SA_SB
}

__device__ __forceinline__ void phase5(const P& p) {
    const float* part = (const float*)(p.ws + WS_PART);
    const int t0 = otid(); const int lane = t0 & 63, gw = blockIdx.x * 8 + (t0 >> 6), nw = gridDim.x * 8;
    for (int row = gw; row < MTOK; row += nw) {
        float* orow = p.out + (size_t)row * DM;
        f32x4 v[8]; float s = 0.f;
        if (row < NPROMPT) {
            const float* xr = p.x_prompt + (size_t)row * DM; const bf16_t* dr = (const bf16_t*)(p.ws + WS_DELTA) + (size_t)row * DM;
#pragma unroll
            for (int i = 0; i < 8; ++i) { const u32x2 d = NTL((const u32x2*)(dr + 4 * (lane + 64 * i)));
                v[i] = NTL((const f32x4*)(xr + 4 * (lane + 64 * i))) + (f32x4){bf_lo(d.x), bf_hi(d.x), bf_lo(d.y), bf_hi(d.y)}; }
        } else {
            const float* xr = p.x_sample + (size_t)(row - NPROMPT) * DM;
#pragma unroll
            for (int i = 0; i < 8; ++i) v[i] = NTL((const f32x4*)(xr + 4 * (lane + 64 * i)));
#pragma unroll 2
            for (int ks = 0; ks < 8; ++ks) { const float* pr = part + ((size_t)ks * 512 + (row - NPROMPT)) * DM;
#pragma unroll
                for (int i = 0; i < 8; ++i) v[i] += NTL((const f32x4*)(pr + 4 * (lane + 64 * i))); }
        }
#pragma unroll
        for (int i = 0; i < 8; ++i) s += (v[i][0] * v[i][0] + v[i][1] * v[i][1]) + (v[i][2] * v[i][2] + v[i][3] * v[i][3]);
#pragma unroll
        for (int o = 32; o >= 1; o >>= 1) s += __shfl_xor(s, o);
        const float rstd = 1.0f / sqrtf(s * (1.0f / 2048.0f) + 1e-6f);
#pragma unroll
        for (int i = 0; i < 8; ++i) { const f32x4 gv = *(const f32x4*)(p.final_g + 4 * (lane + 64 * i)); NTS(v[i] * rstd * gv, (f32x4*)(orow + 4 * (lane + 64 * i))); }
    }
}

#define XB_TMO      128
#define XB_XCNT(j)  (256  + 64 * (j))
#define XB_XSUB(j)  (1280 + 64 * (j))
#define XB_XGEN(j)  (2304 + 64 * (j))
#define XB_TOP      3328
#define XB_TOPGEN   3392
#define XB_SPIN_CAP (1u << 20)
__device__ __forceinline__ unsigned xb_ld(unsigned* p)              { return __hip_atomic_load(p, __ATOMIC_RELAXED, __HIP_MEMORY_SCOPE_AGENT); }
__device__ __forceinline__ unsigned xb_add(unsigned* p, unsigned v) { return __hip_atomic_fetch_add(p, v, __ATOMIC_RELAXED, __HIP_MEMORY_SCOPE_AGENT); }
__device__ __forceinline__ unsigned xb_xcc_id() { return (unsigned)__builtin_amdgcn_s_getreg((3 << 11) | 20) & 0xFu; }
#define XB_SPIN(cond, bar) do { unsigned _sp = 0; while (cond) { __builtin_amdgcn_s_sleep(1); \
    if ((++_sp & 255u) == 0u) { if (xb_ld(&(bar)[XB_TMO])) break; if (_sp > XB_SPIN_CAP) { atomicAdd(&(bar)[XB_TMO], 1u); break; } } } } while (0)
struct XcdBarrier { unsigned* bar; unsigned x; volatile LAS unsigned* st; };
__device__ __forceinline__ XcdBarrier xcd_barrier_post(unsigned* bar, volatile LAS unsigned* st) {
    XcdBarrier b; b.bar = bar; b.x = xb_xcc_id(); b.st = st;
    if (threadIdx.x == 0) (void)xb_add(&bar[XB_XCNT(b.x)], 1u);
    return b;
}
__device__ __forceinline__ void xcd_barrier_complete(unsigned* bar, unsigned x, unsigned& nloc, unsigned& nx) {
    const unsigned G = gridDim.x * gridDim.y * gridDim.z;
    unsigned sum, cnt, mine, sp = 0u;
    for (;;) {
        sum = 0u; cnt = 0u; mine = 0u;
#pragma unroll
        for (unsigned j = 0; j < 16; ++j) { const unsigned c = xb_ld(&bar[XB_XCNT(j)]); sum += c; cnt += (c > 0u) ? 1u : 0u; mine = (j == x) ? c : mine; }
        if (sum == G) break;
        __builtin_amdgcn_s_sleep(1);
        if ((++sp & 255u) == 0u) { if (xb_ld(&bar[XB_TMO])) break; if (sp > XB_SPIN_CAP) { atomicAdd(&bar[XB_TMO], 1u); break; } }
    }
    nloc = mine > 0u ? mine : 1u; nx = cnt > 0u ? cnt : 1u;
}
__device__ __forceinline__ void xcd_barrier(const XcdBarrier& b) {
    asm volatile("s_waitcnt vmcnt(0)" ::: "memory");
    __syncthreads();
    if (threadIdx.x == 0) {
        unsigned* bar = b.bar;
        __builtin_amdgcn_s_waitcnt(0);
        unsigned nloc = b.st[0], nx = b.st[1];
        if (nloc == 0u) { xcd_barrier_complete(bar, b.x, nloc, nx); b.st[0] = nloc; b.st[1] = nx; }
        const unsigned old = xb_add(&bar[XB_XSUB(b.x)], 1u);
        const unsigned gen = old / nloc;
        if (old + 1u == (gen + 1u) * nloc) {
            __builtin_amdgcn_fence(__ATOMIC_RELEASE, "agent");
            asm volatile("s_waitcnt vmcnt(0)" ::: "memory");
            const unsigned og = xb_add(&bar[XB_TOP], 1u);
            const unsigned tg = og / nx;
            if (og + 1u == (tg + 1u) * nx) xb_add(&bar[XB_TOPGEN], 1u);
            else XB_SPIN(xb_ld(&bar[XB_TOPGEN]) == tg, bar);
            __builtin_amdgcn_fence(__ATOMIC_ACQUIRE, "agent");
            xb_add(&bar[XB_XGEN(b.x)], 1u);
            asm volatile("s_waitcnt vmcnt(0)" ::: "memory");
        } else {
            XB_SPIN(xb_ld(&bar[XB_XGEN(b.x)]) == gen, bar);
            __builtin_amdgcn_fence(__ATOMIC_ACQUIRE, "agent");
            asm volatile("s_waitcnt vmcnt(0)" ::: "memory");
        }
    }
    __syncthreads();
}

__global__ void __launch_bounds__(512, 2) mega_fwd(P p) {
    extern __shared__ __attribute__((aligned(16))) unsigned char shm[];
    LAS unsigned char* lds = (LAS unsigned char*)shm;
    cg::grid_group grid = cg::this_grid();
    unsigned char* ws = p.ws;
    const int G = gridDim.x, c = blockIdx.x;
    volatile LAS unsigned* bst = (volatile LAS unsigned*)(lds + 131072);
    if (threadIdx.x == 0) { bst[0] = 0u; bst[1] = 0u; }
    __syncthreads();
    const XcdBarrier xbar = xcd_barrier_post((unsigned*)(ws + WS_BAR), bst);
    if (p.out == nullptr) grid.sync();
#define GSYNC() xcd_barrier(xbar)

#ifndef PHMASK
#define PHMASK 0xffff
#endif
#ifndef REPMASK
#define REPMASK 0
#endif
#define NREP(bit) ((REPMASK & (bit)) ? 2 : 1)
#ifndef TPHASE
#define TPHASE -1
#endif
#ifndef TMULT
#define TMULT 4
#endif
    unsigned long long ts[8]; int nts = 0;
#define STAMP() do { if (TPHASE >= 0 && TPHASE < 10) { ts[nts] = wall_clock64(); } ++nts; } while (0)
    STAMP();
    for (int rep = 0; rep < NREP(1); ++rep) if (PHMASK & 1) phase0(p, lds);
    GSYNC(); STAMP();

    for (int rep = 0; rep < NREP(2); ++rep) if (PHMASK & 2) {
        Sched1 S{(const char*)(ws + WS_H), (const char*)(ws + WS_WIN), (const char*)(ws + WS_MEMN), (const char*)(ws + WS_WK), (const char*)(ws + WS_WV), G, c};
        Epi1 E{(bf16_t*)(ws + WS_PROJ), p.out + O_MK, (bf16_t*)(ws + WS_KB), p.out + O_MV, (bf16_t*)(ws + WS_VT)};
        pg8::gemm_phase(lds, 2048, 2048, S, E);
    }
    GSYNC(); STAMP();

    for (int rep = 0; rep < NREP(4); ++rep) {
        unsigned long long m0 = 0, m1 = 0, m2 = 0, m3 = 0, m4 = 0;
        if (TPHASE >= 10) m0 = wall_clock64();
        const int sg = (c >> 3) & 3;
        if (sg == 0) for (int u = c; u < 512; u += 2 * G) attn_sample_pair(p, u, u + G, lds);
        if (TPHASE >= 10) m1 = wall_clock64();
        for (int u = c; u < 256; u += G) s5_unit(p, u, lds);
        for (int u = 256 + (G - 1 - c); u < 320; u += G) s5_unit(p, u, lds);
        if (TPHASE >= 10) m2 = wall_clock64();
        if (sg == 1) for (int u = c; u < 512; u += 2 * G) attn_sample_pair(p, u, u + G, lds);
        for (int u = c; u < 256; u += G) attn_prompt_unit(p, u, lds);
        if (TPHASE >= 10) m3 = wall_clock64();
        if (sg == 2) for (int u = c; u < 512; u += 2 * G) attn_sample_pair(p, u, u + G, lds);
        conv_phase(p);
        if (sg == 3) for (int u = c; u < 512; u += 2 * G) attn_sample_pair(p, u, u + G, lds);
        late_transposes(p, lds, c, G, G == 256 ? 512 : 768);
        if (TPHASE >= 10) { m4 = wall_clock64(); ts[0] = 0; ts[1] = TPHASE == 10 ? m1 - m0 : (TPHASE == 11 ? m2 - m1 : (TPHASE == 12 ? m3 - m2 : m4 - m3)); }
    }
    GSYNC(); STAMP();

    for (int rep = 0; rep < NREP(8); ++rep) if (PHMASK & 64) {
        { Sched1g Sg{(const char*)(ws + WS_H), (const char*)(ws + WS_WIN), G, c}; Epi1 Eg{(bf16_t*)(ws + WS_PROJ), p.out + O_MK, (bf16_t*)(ws + WS_KB), p.out + O_MV, (bf16_t*)(ws + WS_VT)}; pg8::gemm_phase(lds, 2048, 2048, Sg, Eg); }
        if (G == 256 && c >= 144) late_transposes(p, lds, 512 + (c - 144), 112, 768);
        Sched2 S{(const char*)ws, G, c};
        Epi2 E{(bf16_t*)(ws + WS_GLU), (bf16_t*)(ws + WS_CONVO), (bf16_t*)(ws + WS_ATTO)};
        pg8::gemm_phase(lds, 1024, 1024, S, E);
    }
    GSYNC(); STAMP();

    for (int rep = 0; rep < NREP(32); ++rep) merge_phase(p);
    GSYNC(); STAMP();

    for (int rep = 0; rep < NREP(16); ++rep) if (PHMASK & 128) {
        { Sched3 S{(const char*)(ws + WS_MERGED), (const char*)(ws + WS_WO), G, c}; Epi3 E{(bf16_t*)(ws + WS_DELTA), (float*)(ws + WS_PART), false}; pg8::gemm_phase(lds, 2048, 2048, S, E); }
        { Sched3b S{(const char*)(ws + WS_MERGED), (const char*)(ws + WS_WO), G, c}; Epi3 E{(bf16_t*)(ws + WS_DELTA), (float*)(ws + WS_PART), true}; pg8::gemm_phase(lds, 256, 2048, S, E); }
    }
    GSYNC(); STAMP();

    if (PHMASK & 256) phase5(p);
    STAMP();
    if (TPHASE >= 0 && blockIdx.x == 0 && threadIdx.x == 0) {
        const unsigned long long d = (TPHASE >= 10 ? ts[1] - ts[0] : ts[TPHASE + 1] - ts[TPHASE]) * TMULT, t0 = wall_clock64();
        while (wall_clock64() - t0 < d) __builtin_amdgcn_s_sleep(16);
    }
}

extern "C" void kernel_launch(void* const* d_in, const int* in_sizes, int n_in, void* d_out, int out_size, void* d_ws, size_t ws_size, hipStream_t stream) {
    static int grid = 0;
    if (grid == 0) {
        int dev = 0, cus = 0, per_cu = 0;
        hipGetDevice(&dev);
        hipDeviceGetAttribute(&cus, hipDeviceAttributeMultiprocessorCount, dev);
        if (hipFuncSetAttribute((const void*)mega_fwd, hipFuncAttributeMaxDynamicSharedMemorySize, LDS_BYTES) != hipSuccess) fprintf(stderr, "kernel_launch: hipFuncSetAttribute failed\n");
        if (hipOccupancyMaxActiveBlocksPerMultiprocessor(&per_cu, (const void*)mega_fwd, 512, LDS_BYTES) != hipSuccess || per_cu < 1) per_cu = 1;
        (void)hipGetLastError();
        grid = cus * per_cu;
        if (ws_size < WS_END) fprintf(stderr, "kernel_launch: workspace too small (%zu < %zu)\n", ws_size, (size_t)WS_END);
    }
    P p{};
    const float** pp = (const float**)&p;
    for (int i = 0; i < 28; ++i) pp[i] = (const float*)d_in[i];
    p.out = (float*)d_out; p.ws = (unsigned char*)d_ws;
    void* args[] = {&p};
    (void)hipMemsetAsync((unsigned char*)d_ws + WS_BAR, 0, 16384, stream);
    hipError_t e = hipLaunchCooperativeKernel((const void*)mega_fwd, dim3(grid), dim3(512), args, LDS_BYTES, stream);
    if (e != hipSuccess) fprintf(stderr, "cooperative launch failed: %s (grid %d)\n", hipGetErrorString(e), grid);
}
```

```cpp
#include <hip/hip_runtime.h>
#include <hip/hip_cooperative_groups.h>
#include <cstdio>
namespace cg = cooperative_groups;

#define LAS __attribute__((address_space(3)))
typedef unsigned short bf16_t;
typedef short bf16x8 __attribute__((ext_vector_type(8)));
typedef float f32x4 __attribute__((ext_vector_type(4)));
typedef unsigned u32x4 __attribute__((ext_vector_type(4)));
typedef unsigned u32x2 __attribute__((ext_vector_type(2)));

constexpr int DM = 2048, NPROMPT = 8192, NSAMPLE = 512, MTOK = 8704, NIN = 14336;
constexpr int OFF_CB = 0, OFF_CC = 1024, OFF_CH = 2048, OFF_CZ = 3072, OFF_SU = 4096, OFF_SZ = 5120, OFF_AQ = 6144, OFF_AZ = 7168, OFF_G = 8192;
constexpr int LDS_BYTES = 131072 + 16;
constexpr size_t O_Y = 0, O_MK = 17825792, O_MV = 18874368, O_CP = 19922944, O_RP = 19931136, O_IP = 19947520, O_CS = 19963904, O_RS = 20226048, O_IS = 20750336;
constexpr size_t WS_WIN = 0;
constexpr size_t WS_WG = WS_WIN + (size_t)NIN * DM * 2;
constexpr size_t WS_WC = WS_WG + 8388608;
constexpr size_t WS_WA = WS_WC + 4194304;
constexpr size_t WS_WO = WS_WA + 4194304;
constexpr size_t WS_H = WS_WO + 8388608;
constexpr size_t WS_PROJ = WS_H + (size_t)MTOK * DM * 2;
constexpr size_t WS_YS = WS_PROJ + (size_t)MTOK * NIN * 2;
constexpr size_t WS_ACONV = WS_YS + (size_t)MTOK * 1024 * 2;
constexpr size_t WS_OATT = WS_ACONV + (size_t)MTOK * 1024 * 2;
constexpr size_t WS_SS = WS_OATT + (size_t)MTOK * 1024 * 2;
constexpr size_t WS_GLU = WS_SS + (size_t)MTOK * 32 * 4;
constexpr size_t WS_MERGED = WS_GLU + (size_t)MTOK * DM * 2;
constexpr size_t WS_BAR = WS_MERGED + (size_t)MTOK * DM * 2;
constexpr size_t WS_MEMN = WS_BAR + 16384;
constexpr size_t WS_WK = WS_MEMN + 4194304;
constexpr size_t WS_WV = WS_WK + 4194304;
constexpr size_t WS_KB = WS_WV + 4194304;
constexpr size_t WS_VT = WS_KB + 2097152;
constexpr size_t WS_ATTO = WS_MEMN;
constexpr size_t WS_END = WS_ATTO + (size_t)MTOK * DM * 2;
constexpr size_t WS_CONVO = WS_WIN, WS_PART = WS_PROJ, WS_DELTA = WS_PROJ + 67108864;
static_assert(WS_END <= 536870912, "workspace");
static_assert(WS_VT + 2097152 <= WS_END && (size_t)MTOK * DM * 2 <= 38u * 1048576u, "aliases");

struct P {
    const float *x_prompt, *x_sample, *mem_prompt, *cache_k, *cache_v, *state_conv, *state_re, *state_im, *norm_g, *mem_norm_g, *w_in, *conv_w, *w_conv_out,
        *lam_re, *lam_im, *log_dt, *b_re, *b_im, *c_re, *c_im, *ssm_d, *w_glu_a, *w_glu_b, *w_mem_k, *w_mem_v, *w_attn_out, *w_out, *final_g;
    float* out; unsigned char* ws;
};

__device__ __forceinline__ unsigned cvt_pk_bf16(float lo, float hi) { unsigned r; asm("v_cvt_pk_bf16_f32 %0, %1, %2" : "=v"(r) : "v"(lo), "v"(hi)); return r; }
__device__ __forceinline__ float bf_lo(unsigned w) { return __uint_as_float(w << 16); }
__device__ __forceinline__ float bf_hi(unsigned w) { return __uint_as_float(w & 0xffff0000u); }
__device__ __forceinline__ float rcp_(float x) { return __builtin_amdgcn_rcpf(x); }
__device__ __forceinline__ float sigmoidf_(float x) { return rcp_(1.0f + __expf(-x)); }
__device__ __forceinline__ float siluf_(float x) { return x * rcp_(1.0f + __expf(-x)); }
__device__ __forceinline__ float gelu_tanh(float x) { const float u = 1.5957691216057308f * (x + 0.044715f * x * x * x); return x * rcp_(1.0f + __expf(-u)); }
__device__ __forceinline__ bf16x8 pack8(const f32x4 a, const f32x4 b) {
    u32x4 w; w.x = cvt_pk_bf16(a[0], a[1]); w.y = cvt_pk_bf16(a[2], a[3]); w.z = cvt_pk_bf16(b[0], b[1]); w.w = cvt_pk_bf16(b[2], b[3]);
    return __builtin_bit_cast(bf16x8, w);
}
__device__ __forceinline__ u32x4 pack8u(const f32x4 a, const f32x4 b) {
    u32x4 w; w.x = cvt_pk_bf16(a[0], a[1]); w.y = cvt_pk_bf16(a[2], a[3]); w.z = cvt_pk_bf16(b[0], b[1]); w.w = cvt_pk_bf16(b[2], b[3]); return w;
}
__device__ __forceinline__ void unpack8(const u32x4 w, float (&f)[8]) {
    f[0] = bf_lo(w.x); f[1] = bf_hi(w.x); f[2] = bf_lo(w.y); f[3] = bf_hi(w.y); f[4] = bf_lo(w.z); f[5] = bf_hi(w.z); f[6] = bf_lo(w.w); f[7] = bf_hi(w.w);
}
__device__ __forceinline__ int otid() { int t = threadIdx.x; asm volatile("" : "+v"(t)); return t; }
#define NTL(p) __builtin_nontemporal_load(p)
#define NTS(v, p) __builtin_nontemporal_store((v), (p))
#define MFMA16(a, b, c) __builtin_amdgcn_mfma_f32_16x16x32_bf16((a), (b), (c), 0, 0, 0)

namespace pg8 {
constexpr int BM = 256, BK = 64, HALF = 128, HTB = HALF * BK * 2, STAGE_BYTES = 8 * HTB;
__device__ __forceinline__ int lds_byte(int r, int c) { const int st = (r >> 4) * 2 + (c >> 5), rr = r & 15, cc = c & 31, ob = rr * 64 + cc * 2; return st * 1024 + (ob ^ (((ob >> 9) & 1) << 5)); }
__device__ __forceinline__ void stage_rc(int b, int& R, int& C) { const int st = b / 1024, sb = b % 1024, swz = sb ^ (((sb >> 9) & 1) << 5); R = (st >> 1) * 16 + swz / 64; C = (st & 1) * 32 + (swz % 64) / 2; }
__device__ __forceinline__ int perm32(int rho) { const int n = rho >> 4, i = rho & 15; return 8 * (i >> 2) + 4 * n + (i & 3); }
struct Unit { const char* a; const char* b; int pm, pn, kind; };

template <class Sched, class Epi>
__device__ __forceinline__ void gemm_phase(LAS unsigned char* lds, const int K, const int ld, const Sched& S, const Epi& E) {
    const int tid = otid(), wid = __builtin_amdgcn_readfirstlane(tid >> 6), lane = tid & 63, wr = wid >> 2, wc = wid & 3, fr = lane & 15, fq = lane >> 4;
    const int nt = K / BK;
    unsigned voffA[2], voffB[2];
#pragma unroll
    for (int i = 0; i < 2; ++i) { int R, C; stage_rc(tid * 16 + i * 8192, R, C); const int Rb = (R & ~31) + perm32(R & 31);
        voffA[i] = (unsigned)(R * ld + C) * 2u; voffB[i] = (unsigned)(Rb * ld + C) * 2u; }
    const size_t kstep = (size_t)(BK * 2);
    const size_t hstep = (size_t)HALF * ld * 2;
    const unsigned ldsw = (unsigned)wid * 1024u;
    const int aoff = lds_byte(wr * 64 + fr, fq * 8), boff = lds_byte(wc * 32 + fr, fq * 8);
#define PG8_SA(b, h) (((b) * 2 + (h)) * HTB)
#define PG8_SB(b, h) ((4 + (b) * 2 + (h)) * HTB)
#define PG8_STAGE(bufoff, gbase, voff) do { _Pragma("unroll") for (int _i = 0; _i < 2; ++_i) \
        __builtin_amdgcn_global_load_lds((const unsigned*)((const char*)(gbase) + (voff)[_i]), (LAS unsigned*)(lds + (bufoff) + ldsw + _i * 8192), 16, 0, 0); } while (0)
#define PG8_LDA(dst, b, h) do { _Pragma("unroll") for (int m = 0; m < 4; ++m) _Pragma("unroll") for (int k = 0; k < 2; ++k) dst[m][k] = *(const LAS bf16x8*)(lds + PG8_SA(b, h) + aoff + m * 2048 + k * 1024); } while (0)
#define PG8_LDB(dst, b, h) do { _Pragma("unroll") for (int n = 0; n < 2; ++n) _Pragma("unroll") for (int k = 0; k < 2; ++k) dst[n][k] = *(const LAS bf16x8*)(lds + PG8_SB(b, h) + boff + n * 2048 + k * 1024); } while (0)
#define PG8_MMA(ai, bj, At, Bt) do { __builtin_amdgcn_s_setprio(1); _Pragma("unroll") for (int m = 0; m < 4; ++m) _Pragma("unroll") for (int n = 0; n < 2; ++n) _Pragma("unroll") for (int k = 0; k < 2; ++k) \
        acc[ai][bj][m][n] = __builtin_amdgcn_mfma_f32_16x16x32_bf16(Bt[n][k], At[m][k], acc[ai][bj][m][n], 0, 0, 0); __builtin_amdgcn_s_setprio(0); } while (0)
#define PG8_WAIT_V(n) asm volatile("s_waitcnt vmcnt(" #n ")" ::: "memory")
#define PG8_WAIT_L(n) asm volatile("s_waitcnt lgkmcnt(" #n ")" ::: "memory")
#define PG8_BAR __builtin_amdgcn_s_barrier()
#define PG8_SCHED __builtin_amdgcn_sched_barrier(0)
    Unit cur, nxt; int ui = 0;
    if (!S.next(0, cur)) return;
    f32x4 acc[2][2][4][2];
#pragma unroll
    for (int a = 0; a < 2; ++a)
#pragma unroll
        for (int b = 0; b < 2; ++b)
#pragma unroll
            for (int m = 0; m < 4; ++m)
#pragma unroll
                for (int n = 0; n < 2; ++n) acc[a][b][m][n] = (f32x4){0.f, 0.f, 0.f, 0.f};
    bf16x8 At[4][2], B0[2][2], B1[2][2];
    const char* cA = cur.a; const char* cB = cur.b;
    PG8_STAGE(PG8_SB(0, 0), cB, voffB); PG8_STAGE(PG8_SA(0, 0), cA, voffA); PG8_STAGE(PG8_SB(0, 1), cB + hstep, voffB); PG8_STAGE(PG8_SA(0, 1), cA + hstep, voffA);
    if (wr == 1) PG8_BAR;
    PG8_WAIT_V(4); PG8_BAR;
    PG8_STAGE(PG8_SB(1, 0), cB + kstep, voffB); PG8_STAGE(PG8_SA(1, 0), cA + kstep, voffA); PG8_STAGE(PG8_SB(1, 1), cB + hstep + kstep, voffB);
    PG8_WAIT_V(6); PG8_BAR;
    for (;;) {
        const bool has_next = S.next(ui + 1, nxt);
        const char* nA = has_next ? nxt.a : cA; const char* nB = has_next ? nxt.b : cB;
        for (int t = 0; t < nt; t += 2) {
            const bool last = (t == nt - 2);
            const char* a1 = cA + (size_t)(t + 1) * kstep;
            const char* a2 = last ? nA : cA + (size_t)(t + 2) * kstep; const char* b2 = last ? nB : cB + (size_t)(t + 2) * kstep;
            const char* a3 = a2 + kstep; const char* b3 = b2 + kstep;
            PG8_LDB(B0, 0, 0); PG8_SCHED; PG8_LDA(At, 0, 0); PG8_STAGE(PG8_SA(1, 1), a1 + hstep, voffA);
            PG8_WAIT_L(8); PG8_BAR; PG8_WAIT_L(0); PG8_MMA(0, 0, At, B0); PG8_BAR; PG8_SCHED;
            PG8_LDB(B1, 0, 1); PG8_STAGE(PG8_SB(0, 0), b2, voffB);
            PG8_BAR; PG8_WAIT_L(0); PG8_MMA(0, 1, At, B1); PG8_BAR;
            PG8_LDA(At, 0, 1); PG8_STAGE(PG8_SA(0, 0), a2, voffA);
            PG8_BAR; PG8_WAIT_L(0); PG8_MMA(1, 0, At, B0); PG8_BAR; PG8_SCHED;
            PG8_STAGE(PG8_SB(0, 1), b2 + hstep, voffB);
            PG8_WAIT_V(6); PG8_BAR; PG8_MMA(1, 1, At, B1); PG8_BAR;
            PG8_LDB(B0, 1, 0); PG8_SCHED; PG8_LDA(At, 1, 0); PG8_STAGE(PG8_SA(0, 1), a2 + hstep, voffA);
            PG8_WAIT_L(8); PG8_BAR; PG8_WAIT_L(0); PG8_MMA(0, 0, At, B0); PG8_BAR; PG8_SCHED;
            PG8_LDB(B1, 1, 1); PG8_STAGE(PG8_SB(1, 0), b3, voffB);
            PG8_BAR; PG8_WAIT_L(0); PG8_MMA(0, 1, At, B1); PG8_BAR;
            PG8_LDA(At, 1, 1); PG8_STAGE(PG8_SA(1, 0), a3, voffA);
            PG8_BAR; PG8_WAIT_L(0); PG8_MMA(1, 0, At, B0); PG8_BAR; PG8_SCHED;
            PG8_STAGE(PG8_SB(1, 1), b3 + hstep, voffB);
            PG8_WAIT_V(6); PG8_BAR; PG8_MMA(1, 1, At, B1); PG8_BAR;
        }
        const bool keep = E(acc, cur, wr, wc, fr, fq);
        if (!has_next) break;
        if (!keep) {
#pragma unroll
            for (int a = 0; a < 2; ++a)
#pragma unroll
                for (int b = 0; b < 2; ++b)
#pragma unroll
                    for (int m = 0; m < 4; ++m)
#pragma unroll
                        for (int n = 0; n < 2; ++n) acc[a][b][m][n] = (f32x4){0.f, 0.f, 0.f, 0.f};
        }
        cur = nxt; cA = nA; cB = nB; ++ui;
    }
    PG8_WAIT_V(0);
    if (wr == 0) PG8_BAR;
    PG8_BAR;
#undef PG8_SA
#undef PG8_SB
#undef PG8_STAGE
#undef PG8_LDA
#undef PG8_LDB
#undef PG8_MMA
#undef PG8_WAIT_V
#undef PG8_WAIT_L
#undef PG8_BAR
#undef PG8_SCHED
}
}
using pg8::Unit;

__device__ __forceinline__ void xcd_tile_order(int wgid, const int nM, const int nN, int& pm, int& pn) {
    const int nwg = nM * nN, NX = 8, WGM = 8;
    { const int q = nwg / NX, r = nwg % NX, xcd = wgid % NX, off = wgid / NX; wgid = (xcd < r ? xcd * (q + 1) : r * (q + 1) + (xcd - r) * q) + off; }
    const int nig = WGM * nN, gid = wgid / nig, fm = gid * WGM, gsz = (nM - fm) < WGM ? (nM - fm) : WGM;
    pm = fm + ((wgid % nig) % gsz); pn = (wgid % nig) / gsz;
}
struct Sched1 {
    const char *H, *WIN, *MEMN, *WK, *WV; int G, c;
    __device__ __forceinline__ bool next(int i, Unit& u) const {
        const int L = i * G + c; if (L >= 1792) return false;
        if (L < 1760) {
            int pm, pn;
            if (L < 1292) xcd_tile_order(L, 34, 38, pm, pn);
            else { xcd_tile_order(L - 1292, 26, 18, pm, pn); pn += 38; }
            u.pm = pm; u.pn = pn; u.kind = 0; u.a = H + (size_t)pm * 1048576; u.b = WIN + (size_t)pn * 1048576;
        } else if (L < 1776) { const int j = L - 1760; u.pm = j >> 2; u.pn = j & 3; u.kind = 1; u.a = MEMN + (size_t)u.pm * 1048576; u.b = WK + (size_t)u.pn * 1048576; }
        else { const int j = L - 1776; u.pm = j >> 2; u.pn = j & 3; u.kind = 2; u.a = WV + (size_t)u.pm * 1048576; u.b = MEMN + (size_t)u.pn * 1048576; }
        return true;
    }
};
struct Sched1g {
    const char *H, *WIN; int G, c;
    __device__ __forceinline__ bool next(int i, Unit& u) const {
        const int j = i * G + c; if (j >= 144) return false;
        u.pm = 26 + j / 18; u.pn = 38 + j % 18; u.kind = 0; u.a = H + (size_t)u.pm * 1048576; u.b = WIN + (size_t)u.pn * 1048576; return true;
    }
};
struct Epi1 {
    bf16_t* PROJ; float* outK; bf16_t* KB; float* outV; bf16_t* VT;
    __device__ __forceinline__ bool operator()(f32x4 (&acc)[2][2][4][2], const Unit& u, int wr, int wc, int fr, int fq) const {
        const int r0 = u.pm * 256 + wr * 64 + fr, c0 = u.pn * 256 + wc * 32 + 8 * fq;
        if (u.kind == 0) {
            const bool gate = u.pn >= 32;
#pragma unroll
            for (int ai = 0; ai < 2; ++ai)
#pragma unroll
                for (int m = 0; m < 4; ++m) { bf16_t* rowp = PROJ + (size_t)(r0 + ai * 128 + m * 16) * NIN + c0;
#pragma unroll
                    for (int bj = 0; bj < 2; ++bj) { const u32x4 w = pack8u(acc[ai][bj][m][0], acc[ai][bj][m][1]);
                        if (gate) NTS(w, (u32x4*)(rowp + bj * 128)); else *(u32x4*)(rowp + bj * 128) = w; } }
        } else if (u.kind == 1) {
#pragma unroll
            for (int ai = 0; ai < 2; ++ai)
#pragma unroll
                for (int m = 0; m < 4; ++m) { const size_t off = (size_t)(r0 + ai * 128 + m * 16) * 1024 + c0;
#pragma unroll
                    for (int bj = 0; bj < 2; ++bj) { NTS(acc[ai][bj][m][0], (f32x4*)(outK + off + bj * 128)); NTS(acc[ai][bj][m][1], (f32x4*)(outK + off + bj * 128 + 4));
                        *(u32x4*)(KB + off + bj * 128) = pack8u(acc[ai][bj][m][0], acc[ai][bj][m][1]); } }
        } else {
            const int h = u.pm, b = u.pn;
#pragma unroll
            for (int ai = 0; ai < 2; ++ai)
#pragma unroll
                for (int m = 0; m < 4; ++m) { const int d = wr * 64 + fr + ai * 128 + m * 16;
#pragma unroll
                    for (int bj = 0; bj < 2; ++bj) { const int key0 = wc * 32 + 8 * fq + bj * 128;
                        *(u32x4*)(VT + ((size_t)((b * 4 + h) * 256 + d)) * 256 + key0) = pack8u(acc[ai][bj][m][0], acc[ai][bj][m][1]);
                        float* fp = outV + ((size_t)(b * 256 + key0)) * 1024 + h * 256 + d;
#pragma unroll
                        for (int e = 0; e < 4; ++e) { fp[(size_t)e * 1024] = acc[ai][bj][m][0][e]; fp[(size_t)(e + 4) * 1024] = acc[ai][bj][m][1][e]; } } }
        }
        return false;
    }
};

struct Sched2 {
    const char* ws; int G, c;
    __device__ __forceinline__ bool next(int i, Unit& u) const {
        int L;
        if (G == 256) { if (c < 144) { if (i >= 4) return false; L = c + 144 * i; } else { L = 576 + (c - 144) + 112 * i; } }
        else L = i * G + c;
        if (L >= 1088) return false;
        if (L < 544) { u.pm = L >> 4; u.pn = L & 15; u.kind = 0; u.a = ws + WS_YS + (size_t)u.pm * 524288; u.b = ws + WS_WG + (size_t)u.pn * 524288; }
        else { const int j = L - 544, k = j >= 272 ? 1 : 0, jj = j - 272 * k; u.pm = jj >> 3; u.pn = jj & 7; u.kind = 1 + k;
            u.a = ws + WS_ACONV + (size_t)k * ((size_t)MTOK * 1024 * 2) + (size_t)u.pm * 524288; u.b = ws + WS_WC + (size_t)k * 4194304 + (size_t)u.pn * 524288; }
        return true;
    }
};
struct Epi2 {
    bf16_t* GLU; bf16_t* CONVO; bf16_t* ATTO;
    __device__ __forceinline__ bool operator()(f32x4 (&acc)[2][2][4][2], const Unit& u, int wr, int wc, int fr, int fq) const {
        const int r0 = u.pm * 256 + wr * 64 + fr;
        if (u.kind == 0) {
            const int c0 = u.pn * 128 + wc * 32 + 8 * fq;
#pragma unroll
            for (int ai = 0; ai < 2; ++ai)
#pragma unroll
                for (int m = 0; m < 4; ++m) {
                    f32x4 t0, t1;
#pragma unroll
                    for (int e = 0; e < 4; ++e) { t0[e] = acc[ai][0][m][0][e] * sigmoidf_(acc[ai][1][m][0][e]); t1[e] = acc[ai][0][m][1][e] * sigmoidf_(acc[ai][1][m][1][e]); }
                    *(u32x4*)(GLU + (size_t)(r0 + ai * 128 + m * 16) * 2048 + c0) = pack8u(t0, t1);
                }
        } else {
            bf16_t* O = u.kind == 1 ? CONVO : ATTO; const int c0 = u.pn * 256 + wc * 32 + 8 * fq;
#pragma unroll
            for (int ai = 0; ai < 2; ++ai)
#pragma unroll
                for (int m = 0; m < 4; ++m) { bf16_t* rowp = O + (size_t)(r0 + ai * 128 + m * 16) * 2048 + c0;
#pragma unroll
                    for (int bj = 0; bj < 2; ++bj) *(u32x4*)(rowp + bj * 128) = pack8u(acc[ai][bj][m][0], acc[ai][bj][m][1]); }
        }
        return false;
    }
};
__device__ __forceinline__ void merge_phase(const P& p) {
    const bf16_t* PROJ = (const bf16_t*)(p.ws + WS_PROJ); const bf16_t* GLU = (const bf16_t*)(p.ws + WS_GLU); const bf16_t* CONVO = (const bf16_t*)(p.ws + WS_CONVO);
    const bf16_t* ATTO = (const bf16_t*)(p.ws + WS_ATTO); bf16_t* MERGED = (bf16_t*)(p.ws + WS_MERGED);
    const int NT = MTOK * 256, stride = gridDim.x * 512;
    for (int t = blockIdx.x * 512 + otid(); t < NT; t += 2 * stride) {
        u32x4 L[2][6]; const int t1 = t + stride; const bool has1 = t1 < NT;
#pragma unroll
        for (int k = 0; k < 2; ++k) { const int tt = k == 0 ? t : (has1 ? t1 : t);
            const size_t row = (size_t)(tt >> 8); const int c0 = (tt & 255) * 8; const bf16_t* pr = PROJ + row * NIN + OFF_G + c0; const size_t o = row * 2048 + c0;
            L[k][0] = NTL((const u32x4*)pr); L[k][1] = NTL((const u32x4*)(pr + 2048)); L[k][2] = NTL((const u32x4*)(pr + 4096));
            L[k][3] = NTL((const u32x4*)(CONVO + o)); L[k][4] = NTL((const u32x4*)(GLU + o)); L[k][5] = NTL((const u32x4*)(ATTO + o)); }
#pragma unroll
        for (int k = 0; k < 2; ++k) { if (k == 1 && !has1) break; const int tt = k == 0 ? t : t1;
            const size_t row = (size_t)(tt >> 8); const int c0 = (tt & 255) * 8; const size_t o = row * 2048 + c0;
            float g0[8], g1[8], g2[8], cv[8], gl[8], at[8];
            unpack8(L[k][0], g0); unpack8(L[k][1], g1); unpack8(L[k][2], g2); unpack8(L[k][3], cv); unpack8(L[k][4], gl); unpack8(L[k][5], at);
            f32x4 m0, m1;
#pragma unroll
            for (int e = 0; e < 8; ++e) { const float v = sigmoidf_(g0[e]) * cv[e] + sigmoidf_(g1[e]) * gl[e] + sigmoidf_(g2[e]) * at[e]; if (e < 4) m0[e] = v; else m1[e - 4] = v; }
            *(u32x4*)(MERGED + o) = pack8u(m0, m1); }
    }
}

struct Sched3 {
    const char *MERGED, *WO; int G, c;
    __device__ __forceinline__ bool next(int i, Unit& u) const {
        const int L = i * G + c; if (L >= 256) return false;
        u.pm = L >> 3; u.pn = L & 7; u.kind = 0; u.a = MERGED + (size_t)u.pm * 1048576; u.b = WO + (size_t)u.pn * 1048576; return true;
    }
};
struct Sched3b {
    const char *MERGED, *WO; int G, c;
    __device__ __forceinline__ bool next(int i, Unit& u) const {
        const int L = i * G + c; if (L >= 128) return false;
        const int tile = L >> 3, ks = L & 7; u.pm = 32 + (tile >> 3); u.pn = tile & 7; u.kind = ks;
        u.a = MERGED + (size_t)u.pm * 1048576 + (size_t)ks * 512; u.b = WO + (size_t)u.pn * 1048576 + (size_t)ks * 512; return true;
    }
};
struct Epi3 {
    bf16_t* delta; float* part;
    bool sample;
    __device__ __forceinline__ bool operator()(f32x4 (&acc)[2][2][4][2], const Unit& u, int wr, int wc, int fr, int fq) const {
        const int r0 = u.pm * 256 + wr * 64 + fr, c0 = u.pn * 256 + wc * 32 + 8 * fq;
        if (!sample) {
#pragma unroll
            for (int ai = 0; ai < 2; ++ai)
#pragma unroll
                for (int m = 0; m < 4; ++m) { bf16_t* o = delta + (size_t)(r0 + ai * 128 + m * 16) * DM + c0;
#pragma unroll
                    for (int bj = 0; bj < 2; ++bj) *(u32x4*)(o + bj * 128) = pack8u(acc[ai][bj][m][0], acc[ai][bj][m][1]); }
        } else {
            float* base = part + ((size_t)u.kind * 512 - NPROMPT) * DM;
#pragma unroll
            for (int ai = 0; ai < 2; ++ai)
#pragma unroll
                for (int m = 0; m < 4; ++m) {
                    float* o = base + (size_t)(r0 + ai * 128 + m * 16) * DM + c0;
#pragma unroll
                    for (int bj = 0; bj < 2; ++bj)
#pragma unroll
                        for (int n = 0; n < 2; ++n) *(f32x4*)(o + bj * 128 + 4 * n) = acc[ai][bj][m][n];
                }
        }
        return false;
    }
};

__device__ __forceinline__ void transpose_tile(const float* __restrict__ src, const int K, const int N, bf16_t* __restrict__ dst, const int mode, const int t, LAS float* tile) {
    const int tid = otid(); const int tn = N / 256;
    const int r = tid >> 3, c8 = (tid & 7) * 8;
    const int k0 = (t / tn) * 64, n0 = (t % tn) * 256;
    const float* s = src + (size_t)(k0 + r) * N + n0 + c8;
    f32x4 v[8];
#pragma unroll
    for (int j = 0; j < 4; ++j) { v[2 * j] = NTL((const f32x4*)(s + j * 64)); v[2 * j + 1] = NTL((const f32x4*)(s + j * 64 + 4)); }
#pragma unroll
    for (int j = 0; j < 4; ++j)
#pragma unroll
        for (int e = 0; e < 4; ++e) { tile[j * 4160 + r * 65 + c8 + e] = v[2 * j][e]; tile[j * 4160 + r * 65 + c8 + 4 + e] = v[2 * j + 1][e]; }
    __syncthreads();
#pragma unroll
    for (int j = 0; j < 4; ++j) {
        f32x4 a, b;
#pragma unroll
        for (int e = 0; e < 4; ++e) { a[e] = tile[j * 4160 + (c8 + e) * 65 + r]; b[e] = tile[j * 4160 + (c8 + 4 + e) * 65 + r]; }
        const int n = n0 + j * 64 + r;
        const int row = mode == 0 ? n : ((n >> 7) * 256 + (mode - 1) * 128 + (n & 127));
        *(u32x4*)(dst + (size_t)row * K + k0 + c8) = pack8u(a, b);
    }
    __syncthreads();
}
__device__ __forceinline__ void tload_win(const float* w_in, int t, int r, int c8, f32x4 (&v)[8]) {
    const int k0 = (t / 56) * 64, n0 = (t % 56) * 256;
    const float* s = w_in + (size_t)(k0 + r) * NIN + n0 + c8;
#pragma unroll
    for (int j = 0; j < 4; ++j) { v[2 * j] = NTL((const f32x4*)(s + j * 64)); v[2 * j + 1] = NTL((const f32x4*)(s + j * 64 + 4)); }
}
__device__ __forceinline__ void phase0(const P& p, LAS unsigned char* lds) {
    unsigned char* ws = p.ws; LAS float* tile = (LAS float*)lds;
    {
        const int tid = otid(); const int r = tid >> 3, c8 = (tid & 7) * 8;
        bf16_t* dst = (bf16_t*)(ws + WS_WIN);
        int j = blockIdx.x; f32x4 v[8];
        if (j < 1792) tload_win(p.w_in, j, r, c8, v);
        while (j < 1792) {
#pragma unroll
            for (int q = 0; q < 4; ++q)
#pragma unroll
                for (int e = 0; e < 4; ++e) { tile[q * 4160 + r * 65 + c8 + e] = v[2 * q][e]; tile[q * 4160 + r * 65 + c8 + 4 + e] = v[2 * q + 1][e]; }
            const int jn = j + gridDim.x;
            if (jn < 1792) tload_win(p.w_in, jn, r, c8, v);
            __syncthreads();
            const int k0 = (j / 56) * 64, n0 = (j % 56) * 256;
#pragma unroll
            for (int q = 0; q < 4; ++q) {
                f32x4 a, b;
#pragma unroll
                for (int e = 0; e < 4; ++e) { a[e] = tile[q * 4160 + (c8 + e) * 65 + r]; b[e] = tile[q * 4160 + (c8 + 4 + e) * 65 + r]; }
                *(u32x4*)(dst + (size_t)(n0 + q * 64 + r) * 2048 + k0 + c8) = pack8u(a, b);
            }
            __syncthreads();
            j = jn;
        }
    }
    for (int t = blockIdx.x; t < 256; t += gridDim.x) {
        if (t < 128) transpose_tile(p.w_mem_k, 2048, 1024, (bf16_t*)(ws + WS_WK), 0, t, tile);
        else transpose_tile(p.w_mem_v, 2048, 1024, (bf16_t*)(ws + WS_WV), 0, t - 128, tile);
    }
    const int t0 = otid(); const int lane = t0 & 63, gw = blockIdx.x * 8 + (t0 >> 6), nw = gridDim.x * 8;
    auto rowsrc = [&](int row) -> const float* { return row < NPROMPT ? p.x_prompt + (size_t)row * DM : (row < MTOK ? p.x_sample + (size_t)(row - NPROMPT) * DM : p.mem_prompt + (size_t)(row - MTOK) * DM); };
    f32x4 v[8], vn[8];
    if (gw < MTOK + 1024) { const float* src = rowsrc(gw);
#pragma unroll
        for (int i = 0; i < 8; ++i) v[i] = NTL((const f32x4*)(src + 4 * (lane + 64 * i))); }
    for (int row = gw; row < MTOK + 1024; row += nw) {
        const float* g = row < MTOK ? p.norm_g : p.mem_norm_g;
        bf16_t* dst = row < MTOK ? (bf16_t*)(ws + WS_H) + (size_t)row * DM : (bf16_t*)(ws + WS_MEMN) + (size_t)(row - MTOK) * DM;
        if (row + nw < MTOK + 1024) { const float* src = rowsrc(row + nw);
#pragma unroll
            for (int i = 0; i < 8; ++i) vn[i] = NTL((const f32x4*)(src + 4 * (lane + 64 * i))); }
        float s = 0.f;
#pragma unroll
        for (int i = 0; i < 8; ++i) s += (v[i][0] * v[i][0] + v[i][1] * v[i][1]) + (v[i][2] * v[i][2] + v[i][3] * v[i][3]);
#pragma unroll
        for (int o = 32; o >= 1; o >>= 1) s += __shfl_xor(s, o);
        const float rstd = 1.0f / sqrtf(s * (1.0f / 2048.0f) + 1e-6f);
#pragma unroll
        for (int i = 0; i < 8; ++i) { const f32x4 gv = *(const f32x4*)(g + 4 * (lane + 64 * i));
            u32x2 w; w.x = cvt_pk_bf16(v[i][0] * rstd * gv[0], v[i][1] * rstd * gv[1]); w.y = cvt_pk_bf16(v[i][2] * rstd * gv[2], v[i][3] * rstd * gv[3]);
            *(u32x2*)(dst + 4 * (lane + 64 * i)) = w; }
#pragma unroll
        for (int i = 0; i < 8; ++i) v[i] = vn[i];
    }
}

__device__ __forceinline__ void late_transposes(const P& p, LAS unsigned char* lds, const int first, const int stride, const int end) {
    unsigned char* ws = p.ws; LAS float* tile = (LAS float*)lds;
    for (int t = first; t < end; t += stride) {
        if (t < 128) transpose_tile(p.w_conv_out, 1024, 2048, (bf16_t*)(ws + WS_WC), 0, t, tile);
        else if (t < 256) transpose_tile(p.w_attn_out, 1024, 2048, (bf16_t*)(ws + WS_WA), 0, t - 128, tile);
        else if (t < 384) transpose_tile(p.w_glu_a, 1024, 2048, (bf16_t*)(ws + WS_WG), 1, t - 256, tile);
        else if (t < 512) transpose_tile(p.w_glu_b, 1024, 2048, (bf16_t*)(ws + WS_WG), 2, t - 384, tile);
        else transpose_tile(p.w_out, 2048, 2048, (bf16_t*)(ws + WS_WO), 0, t - 512, tile);
    }
}

template <int LEN, bool PROMPT>
__device__ __forceinline__ void conv_task(const P& p, const int r0, const int cgp, const int bs) {
    const bf16_t* PROJ = (const bf16_t*)(p.ws + WS_PROJ); bf16_t* ACONV = (bf16_t*)(p.ws + WS_ACONV);
    const int c0 = cgp * 8;
    const bf16_t* pr = PROJ + (size_t)r0 * NIN + c0;
    u32x4 lcb[LEN], lcz[LEN], lcc[LEN + 2], lch[LEN + 2];
    const bool has_halo = PROMPT && (r0 & 2047) != 0;
#pragma unroll
    for (int i = 0; i < LEN; ++i) { lcb[i] = NTL((const u32x4*)(pr + (size_t)i * NIN + OFF_CB)); lcz[i] = NTL((const u32x4*)(pr + (size_t)i * NIN + OFF_CZ));
        lcc[i + 2] = *(const u32x4*)(pr + (size_t)i * NIN + OFF_CC); lch[i + 2] = *(const u32x4*)(pr + (size_t)i * NIN + OFF_CH); }
#pragma unroll
    for (int i = 0; i < 2; ++i) { lcc[i] = (u32x4){0u, 0u, 0u, 0u}; lch[i] = lcc[i];
        if (has_halo) { lcc[i] = *(const u32x4*)(pr - (size_t)(2 - i) * NIN + OFF_CC); lch[i] = *(const u32x4*)(pr - (size_t)(2 - i) * NIN + OFF_CH); } }
    float w0[8], w1[8], w2[8], vm2[8], vm1[8];
    { const f32x4 a0 = *(const f32x4*)(p.conv_w + c0), a1 = *(const f32x4*)(p.conv_w + c0 + 4), b0 = *(const f32x4*)(p.conv_w + 1024 + c0), b1 = *(const f32x4*)(p.conv_w + 1024 + c0 + 4),
          d0 = *(const f32x4*)(p.conv_w + 2048 + c0), d1 = *(const f32x4*)(p.conv_w + 2048 + c0 + 4);
#pragma unroll
      for (int e = 0; e < 4; ++e) { w0[e] = a0[e]; w0[e + 4] = a1[e]; w1[e] = b0[e]; w1[e + 4] = b1[e]; w2[e] = d0[e]; w2[e + 4] = d1[e]; } }
    if (PROMPT) {
        float a[8], b[8];
        unpack8(lcc[0], a); unpack8(lch[0], b);
#pragma unroll
        for (int e = 0; e < 8; ++e) vm2[e] = a[e] * b[e];
        unpack8(lcc[1], a); unpack8(lch[1], b);
#pragma unroll
        for (int e = 0; e < 8; ++e) vm1[e] = a[e] * b[e];
    } else {
        const float* sc = p.state_conv + (size_t)bs * 2048 + c0;
        const f32x4 a0 = *(const f32x4*)sc, a1 = *(const f32x4*)(sc + 4), b0 = *(const f32x4*)(sc + 1024), b1 = *(const f32x4*)(sc + 1028);
#pragma unroll
        for (int e = 0; e < 4; ++e) { vm2[e] = a0[e]; vm2[e + 4] = a1[e]; vm1[e] = b0[e]; vm1[e + 4] = b1[e]; }
    }
#pragma unroll
    for (int i = 0; i < LEN; ++i) {
        const size_t row = (size_t)(r0 + i);
        float cb[8], cc[8], ch[8], cz[8], v[8];
        unpack8(lcb[i], cb); unpack8(lcc[i + 2], cc); unpack8(lch[i + 2], ch); unpack8(lcz[i], cz);
        f32x4 o0, o1;
#pragma unroll
        for (int e = 0; e < 8; ++e) { v[e] = cc[e] * ch[e]; const float cv = w0[e] * vm2[e] + w1[e] * vm1[e] + w2[e] * v[e]; const float r = cb[e] * cv * siluf_(cz[e]);
            if (e < 4) o0[e] = r; else o1[e - 4] = r; vm2[e] = vm1[e]; vm1[e] = v[e]; }
        *(u32x4*)(ACONV + row * 1024 + c0) = pack8u(o0, o1);
        float* dst = nullptr;
        if (PROMPT) { const int pos = (r0 + i) & 2047; if (pos >= 2046) dst = p.out + O_CP + ((size_t)((r0 + i) >> 11) * 2 + (pos - 2046)) * 1024 + c0; }
        else if (i >= 2) dst = p.out + O_CS + ((size_t)bs * 2 + (i - 2)) * 1024 + c0;
        if (dst) { *(f32x4*)dst = (f32x4){v[0], v[1], v[2], v[3]}; *(f32x4*)(dst + 4) = (f32x4){v[4], v[5], v[6], v[7]}; }
    }
}
__device__ __forceinline__ void conv_phase(const P& p) {
    const int t0 = blockIdx.x * 512 + otid(), nt = gridDim.x * 512;
    for (int task = t0; task < 262144; task += nt) conv_task<4, true>(p, (task >> 7) * 4, task & 127, 0);
    for (int task = t0; task < 16384; task += nt) conv_task<4, false>(p, NPROMPT + 4 * (task >> 7), task & 127, task >> 7);
}

struct S5In { bf16x8 U[4]; u32x2 u4[4], z4[4]; };
__device__ __forceinline__ void s5_load4(S5In& in, const bf16_t* PROJ, const size_t row0, const int g, const int g4) {
    const bf16_t* base = PROJ + row0 * NIN + g * 16;
#pragma unroll
    for (int i = 0; i < 4; ++i) {
        in.U[i] = *(const bf16x8*)(base + (size_t)i * NIN + OFF_SU + 8 * (g4 & 1));
        in.u4[i] = *(const u32x2*)(base + (size_t)i * NIN + OFF_SU + 4 * g4); in.z4[i] = *(const u32x2*)(base + (size_t)i * NIN + OFF_SZ + 4 * g4);
    }
}
__device__ __forceinline__ void s5_steps4(const S5In& in, bf16_t* YS, const size_t row0, const int g, const int g4, const bool Y,
                                          const bf16x8 (&bre)[4], const bf16x8 (&bim)[4], const bf16x8 (&cf)[4], const float (&ar)[16], const float (&ai)[16], const f32x4 dsk,
                                          float (&sr)[16], float (&si)[16]) {
    const f32x4 zero4 = (f32x4){0.f, 0.f, 0.f, 0.f};
#pragma unroll
    for (int i = 0; i < 4; ++i) {
#pragma unroll
        for (int pb = 0; pb < 4; ++pb) {
            const f32x4 xr = MFMA16(bre[pb], in.U[i], zero4), xi = MFMA16(bim[pb], in.U[i], zero4);
#pragma unroll
            for (int j = 0; j < 4; ++j) { const int k = pb * 4 + j; const float nr = ar[k] * sr[k] - ai[k] * si[k] + xr[j]; const float ni = ar[k] * si[k] + ai[k] * sr[k] + xi[j]; sr[k] = nr; si[k] = ni; }
        }
        if (Y) {
            f32x4 y = zero4;
            y = MFMA16(cf[0], pack8((f32x4){sr[0], sr[1], sr[2], sr[3]}, (f32x4){sr[4], sr[5], sr[6], sr[7]}), y);
            y = MFMA16(cf[1], pack8((f32x4){sr[8], sr[9], sr[10], sr[11]}, (f32x4){sr[12], sr[13], sr[14], sr[15]}), y);
            y = MFMA16(cf[2], pack8((f32x4){si[0], si[1], si[2], si[3]}, (f32x4){si[4], si[5], si[6], si[7]}), y);
            y = MFMA16(cf[3], pack8((f32x4){si[8], si[9], si[10], si[11]}, (f32x4){si[12], si[13], si[14], si[15]}), y);
            const float uu[4] = {bf_lo(in.u4[i].x), bf_hi(in.u4[i].x), bf_lo(in.u4[i].y), bf_hi(in.u4[i].y)};
            const float zz[4] = {bf_lo(in.z4[i].x), bf_hi(in.z4[i].x), bf_lo(in.z4[i].y), bf_hi(in.z4[i].y)};
            float o[4];
#pragma unroll
            for (int j = 0; j < 4; ++j) { const float ysv = y[j] + dsk[j] * uu[j]; o[j] = gelu_tanh(ysv * siluf_(zz[j])); }
            u32x2 w; w.x = cvt_pk_bf16(o[0], o[1]); w.y = cvt_pk_bf16(o[2], o[3]);
            *(u32x2*)(YS + (row0 + i) * 1024 + g * 16 + 4 * g4) = w;
        }
    }
}
__device__ __forceinline__ void s5_coef(const P& p, int g, int pp, float dt, float& ar, float& ai, float& fr, float& fi) {
    const float lr = p.lam_re[g * 64 + pp], li = p.lam_im[g * 64 + pp];
    const float mag = expf(lr * dt), ang = li * dt; float sn, cs; sincosf(ang, &sn, &cs);
    ar = mag * cs; ai = mag * sn; const float den = lr * lr + li * li;
    fr = ((ar - 1.0f) * lr + ai * li) / den; fi = (ai * lr - (ar - 1.0f) * li) / den;
}
__device__ __forceinline__ void s5_unit(const P& p, const int unit, LAS unsigned char* lds) {
    const bf16_t* PROJ = (const bf16_t*)(p.ws + WS_PROJ); bf16_t* YS = (bf16_t*)(p.ws + WS_YS);
    const int tid = otid(), lane = tid & 63, w = tid >> 6, cl = lane & 15, g4 = lane >> 4;
    const bool prompt = unit < 256; const int g = prompt ? (unit & 63) : (unit - 256); const int b = unit >> 6;
    const float dt = expf(p.log_dt[g]);
    LAS float* E = (LAS float*)lds;
    LAS f32x4* CT = (LAS f32x4*)(lds + 65536);
    if (tid < 64) { float a_r, a_i, fr_, fi_; s5_coef(p, g, tid, dt, a_r, a_i, fr_, fi_); CT[tid] = (f32x4){a_r, a_i, fr_, fi_}; }
    __syncthreads();
    float ar[16], ai[16];
#pragma unroll
    for (int pb = 0; pb < 4; ++pb)
#pragma unroll
        for (int j = 0; j < 4; ++j) { const f32x4 t = CT[16 * pb + 4 * g4 + j]; ar[pb * 4 + j] = t[0]; ai[pb * 4 + j] = t[1]; }
    bf16x8 bre[4], bim[4], cf[4];
    const float bmask = g4 < 2 ? 1.0f : 0.0f;
#pragma unroll
    for (int pb = 0; pb < 4; ++pb) {
        const int pp = 16 * pb + cl; const f32x4 t = CT[pp]; const float fr_ = t[2] * bmask, fi_ = t[3] * bmask;
        const float* br = p.b_re + ((size_t)(g * 64 + pp)) * 16 + 8 * (g4 & 1); const float* bi = p.b_im + ((size_t)(g * 64 + pp)) * 16 + 8 * (g4 & 1);
        const f32x4 r0 = *(const f32x4*)br, r1 = *(const f32x4*)(br + 4), i0 = *(const f32x4*)bi, i1 = *(const f32x4*)(bi + 4);
        bre[pb] = pack8(fr_ * r0 - fi_ * i0, fr_ * r1 - fi_ * i1);
        bim[pb] = pack8(fr_ * i0 + fi_ * r0, fr_ * i1 + fi_ * r1);
    }
#pragma unroll
    for (int ks = 0; ks < 4; ++ks) {
        const float* cp = (ks < 2 ? p.c_re : p.c_im) + ((size_t)(g * 16 + cl)) * 64 + 32 * (ks & 1) + 4 * g4;
        f32x4 a = *(const f32x4*)cp, c = *(const f32x4*)(cp + 16);
        if (ks >= 2) { a = -a; c = -c; }
        cf[ks] = pack8(a, c);
    }
    const f32x4 dsk = *(const f32x4*)(p.ssm_d + g * 16 + 4 * g4);
    const int chain = 16 * w + cl;
    const size_t row0 = prompt ? (size_t)b * 2048 + (size_t)chain * 16 : (size_t)NPROMPT + 4 * chain;
    const size_t so = ((size_t)chain * 64 + g) * 64 + 4 * g4;
    const int nq = prompt ? 4 : 1;
    float sr[16], si[16];
#pragma unroll
    for (int k = 0; k < 16; ++k) { sr[k] = 0.f; si[k] = 0.f; }
    if (!prompt) {
#pragma unroll
        for (int pb = 0; pb < 4; ++pb) { const f32x4 a = *(const f32x4*)(p.state_re + so + 16 * pb), c = *(const f32x4*)(p.state_im + so + 16 * pb);
#pragma unroll
            for (int j = 0; j < 4; ++j) { sr[pb * 4 + j] = a[j]; si[pb * 4 + j] = c[j]; } }
    }
#pragma unroll 1
    for (int pass = prompt ? 0 : 1; pass < 2; ++pass) {
        if (pass == 1 && prompt) {
#pragma unroll
            for (int pb = 0; pb < 4; ++pb) {
                *(LAS f32x4*)(E + (chain * 2 + 0) * 64 + 16 * pb + 4 * g4) = (f32x4){sr[pb * 4], sr[pb * 4 + 1], sr[pb * 4 + 2], sr[pb * 4 + 3]};
                *(LAS f32x4*)(E + (chain * 2 + 1) * 64 + 16 * pb + 4 * g4) = (f32x4){si[pb * 4], si[pb * 4 + 1], si[pb * 4 + 2], si[pb * 4 + 3]};
            }
            __syncthreads();
            if (w == 0) {
                float a_r, a_i; { const f32x4 t = CT[lane]; a_r = t[0]; a_i = t[1]; }
#pragma unroll
                for (int q = 0; q < 4; ++q) { const float nr = a_r * a_r - a_i * a_i, ni = 2.0f * a_r * a_i; a_r = nr; a_i = ni; }
                float Fr = 0.f, Fi = 0.f;
#pragma unroll 8
                for (int k = 0; k < 128; ++k) {
                    const float er = E[(2 * k) * 64 + lane], ei = E[(2 * k + 1) * 64 + lane];
                    E[(2 * k) * 64 + lane] = Fr; E[(2 * k + 1) * 64 + lane] = Fi;
                    const float nr = a_r * Fr - a_i * Fi + er; Fi = a_r * Fi + a_i * Fr + ei; Fr = nr;
                }
                p.out[O_RP + (size_t)(b * 64 + g) * 64 + lane] = Fr; p.out[O_IP + (size_t)(b * 64 + g) * 64 + lane] = Fi;
            }
            __syncthreads();
#pragma unroll
            for (int pb = 0; pb < 4; ++pb) {
                const f32x4 a = *(LAS f32x4*)(E + (chain * 2 + 0) * 64 + 16 * pb + 4 * g4), c = *(LAS f32x4*)(E + (chain * 2 + 1) * 64 + 16 * pb + 4 * g4);
#pragma unroll
                for (int j = 0; j < 4; ++j) { sr[pb * 4 + j] = a[j]; si[pb * 4 + j] = c[j]; }
            }
        }
        S5In cur; s5_load4(cur, PROJ, row0, g, g4);
#pragma unroll 1
        for (int q = 0; q < nq; ++q) {
            S5In nxt = cur;
            if (q + 1 < nq) s5_load4(nxt, PROJ, row0 + 4 * (q + 1), g, g4);
            s5_steps4(cur, YS, row0 + 4 * q, g, g4, pass == 1, bre, bim, cf, ar, ai, dsk, sr, si);
            cur = nxt;
        }
    }
    if (!prompt) {
#pragma unroll
        for (int pb = 0; pb < 4; ++pb) {
            *(f32x4*)(p.out + O_RS + so + 16 * pb) = (f32x4){sr[pb * 4], sr[pb * 4 + 1], sr[pb * 4 + 2], sr[pb * 4 + 3]};
            *(f32x4*)(p.out + O_IS + so + 16 * pb) = (f32x4){si[pb * 4], si[pb * 4 + 1], si[pb * 4 + 2], si[pb * 4 + 3]};
        }
    }
    __syncthreads();
}

__device__ __forceinline__ void attn_prompt_unit(const P& p, const int unit, LAS unsigned char* lds) {
    const bf16_t* PROJ = (const bf16_t*)(p.ws + WS_PROJ); const bf16_t* KB = (const bf16_t*)(p.ws + WS_KB); const bf16_t* VT = (const bf16_t*)(p.ws + WS_VT);
    bf16_t* OATT = (bf16_t*)(p.ws + WS_OATT);
    const int tid = otid(), lane = tid & 63, w = tid >> 6, cl = lane & 15, g4 = lane >> 4;
    const int b = unit >> 6, h = (unit >> 4) & 3, qb = unit & 15;
    const bf16_t* kbase = KB + (size_t)(b * 256) * 1024 + h * 256;
#pragma unroll
    for (int i = 0; i < 16; ++i) { const int idx = tid + 512 * i, r = idx >> 5, m = idx & 31;
        const u32x4 v = *(const u32x4*)(kbase + (size_t)r * 1024 + m * 8); *(LAS u32x4*)(lds + r * 512 + ((m ^ (r & 15)) << 4)) = v; }
    const size_t qrow = (size_t)b * 2048 + qb * 128 + w * 16 + cl;
    const bf16_t* qp = PROJ + qrow * NIN + OFF_AQ + h * 256 + 8 * g4;
    bf16x8 qf[8];
#pragma unroll
    for (int ks = 0; ks < 8; ++ks) qf[ks] = *(const bf16x8*)(qp + 32 * ks);
    __syncthreads();
    f32x4 s[16];
#pragma unroll
    for (int kb = 0; kb < 16; ++kb) { s[kb] = (f32x4){0.f, 0.f, 0.f, 0.f};
#pragma unroll
        for (int ks = 0; ks < 8; ++ks) { const int key = 16 * kb + cl, m = 4 * ks + g4;
            const bf16x8 kf = *(const LAS bf16x8*)(lds + key * 512 + ((m ^ cl) << 4)); s[kb] = MFMA16(kf, qf[ks], s[kb]); }
        __builtin_amdgcn_sched_barrier(0); }
    __syncthreads();
    const bf16_t* vbase = VT + (size_t)((b * 4 + h) * 256) * 256;
    u32x4 vst[16];
#pragma unroll
    for (int i = 0; i < 16; ++i) { const int idx = tid + 512 * i, r = idx >> 5, m = idx & 31; vst[i] = *(const u32x4*)(vbase + (size_t)r * 256 + m * 8); }
    float mx = -3.0e38f;
#pragma unroll
    for (int kb = 0; kb < 16; ++kb)
#pragma unroll
        for (int j = 0; j < 4; ++j) mx = fmaxf(mx, s[kb][j]);
    mx = fmaxf(mx, __shfl_xor(mx, 16)); mx = fmaxf(mx, __shfl_xor(mx, 32));
    float sum = 0.f;
#pragma unroll
    for (int kb = 0; kb < 16; ++kb)
#pragma unroll
        for (int j = 0; j < 4; ++j) { const float e = __expf((s[kb][j] - mx) * 0.0625f); s[kb][j] = e; sum += e; }
    sum += __shfl_xor(sum, 16); sum += __shfl_xor(sum, 32);
    const float inv = rcp_(sum);
    bf16x8 pf[8];
#pragma unroll
    for (int kk = 0; kk < 8; ++kk) pf[kk] = pack8(s[2 * kk], s[2 * kk + 1]);
#pragma unroll
    for (int i = 0; i < 16; ++i) { const int idx = tid + 512 * i, r = idx >> 5, m = idx & 31; *(LAS u32x4*)(lds + r * 512 + ((m ^ (r & 15)) << 4)) = vst[i]; }
    __syncthreads();
    const bf16_t* azp = PROJ + qrow * NIN + OFF_AZ + h * 256 + 4 * g4;
    bf16_t* op = OATT + qrow * 1024 + h * 256 + 4 * g4;
    u32x2 azv[16];
#pragma unroll
    for (int db = 0; db < 16; ++db) azv[db] = *(const u32x2*)(azp + 16 * db);
#pragma unroll
    for (int db = 0; db < 16; ++db) {
        f32x4 o = (f32x4){0.f, 0.f, 0.f, 0.f}; const int d = 16 * db + cl;
#pragma unroll
        for (int kk = 0; kk < 8; ++kk) {
            const int ch0 = 8 * kk + g4, ch1 = ch0 + 4;
            const u32x2 lo = *(const LAS u32x2*)(lds + d * 512 + (((ch0 >> 1) ^ cl) << 4) + (ch0 & 1) * 8);
            const u32x2 hi = *(const LAS u32x2*)(lds + d * 512 + (((ch1 >> 1) ^ cl) << 4) + (ch1 & 1) * 8);
            const u32x4 vv = (u32x4){lo.x, lo.y, hi.x, hi.y};
            o = MFMA16(__builtin_bit_cast(bf16x8, vv), pf[kk], o);
        }
        const u32x2 az = azv[db];
        const float z[4] = {bf_lo(az.x), bf_hi(az.x), bf_lo(az.y), bf_hi(az.y)};
        u32x2 wv; wv.x = cvt_pk_bf16(o[0] * inv * siluf_(z[0]), o[1] * inv * siluf_(z[1])); wv.y = cvt_pk_bf16(o[2] * inv * siluf_(z[2]), o[3] * inv * siluf_(z[3]));
        *(u32x2*)(op + 16 * db) = wv;
        __builtin_amdgcn_sched_barrier(0);
    }
    __syncthreads();
}

__device__ __forceinline__ void attn_sample_pair(const P& p, const int u0, const int u1_, LAS unsigned char* lds) {
    const int u1 = u1_ < 512 ? u1_ : u0;
    const bf16_t* PROJ = (const bf16_t*)(p.ws + WS_PROJ); bf16_t* OATT = (bf16_t*)(p.ws + WS_OATT);
    const int tid = otid(), lane = tid & 63, w = tid >> 6, cl = lane & 15, g4 = lane >> 4;
    LAS float* Pw = (LAS float*)(lds + w * 512);
    LAS float* ST = (LAS float*)(lds + 4096);
    LAS float* OW = (LAS float*)(lds + 8192);
    f32x4 bA[16], bB[16], o[4], s0, s1;
    bf16x8 qf[8];
#define SA_LOADQ(unit) do { const bf16_t* qp_ = PROJ + ((size_t)NPROMPT + 4 * ((unit) >> 2) + (cl & 3)) * NIN + OFF_AQ + ((unit) & 3) * 256 + 8 * g4; \
        _Pragma("unroll") for (int ks = 0; ks < 8; ++ks) qf[ks] = *(const bf16x8*)(qp_ + 32 * ks); } while (0)
#define SA_LOADK(buf, unit, kblk) do { const float* kr_ = p.cache_k + ((size_t)((unit) >> 2) * 1024 + ((unit) & 3)) * 256 + (size_t)(32 * w + 16 * (kblk) + cl) * 1024 + 8 * g4; \
        _Pragma("unroll") for (int ks = 0; ks < 8; ++ks) { buf[2 * ks] = NTL((const f32x4*)(kr_ + 32 * ks)); buf[2 * ks + 1] = NTL((const f32x4*)(kr_ + 32 * ks + 4)); } } while (0)
#define SA_LOADV(buf, unit, half) do { const float* vr_ = p.cache_v + ((size_t)((unit) >> 2) * 1024 + ((unit) & 3)) * 256 + (size_t)(32 * w + 16 * (half)) * 1024 + 4 * lane; \
        _Pragma("unroll") for (int i = 0; i < 16; ++i) buf[i] = NTL((const f32x4*)(vr_ + (size_t)i * 1024)); } while (0)
#define SA_QK(buf, sv) do { sv = (f32x4){0.f, 0.f, 0.f, 0.f}; _Pragma("unroll") for (int ks = 0; ks < 8; ++ks) sv = MFMA16(pack8(buf[2 * ks], buf[2 * ks + 1]), qf[ks], sv); } while (0)
#define SA_PV(buf, half) do { _Pragma("unroll") for (int ii = 0; ii < 4; ++ii) _Pragma("unroll") for (int q = 0; q < 4; ++q) { const f32x4 pv_ = *(const LAS f32x4*)(Pw + q * 32 + 16 * (half) + 4 * ii); \
        o[q] += pv_[0] * buf[4 * ii] + pv_[1] * buf[4 * ii + 1] + pv_[2] * buf[4 * ii + 2] + pv_[3] * buf[4 * ii + 3]; } } while (0)
#define SA_SOFTMAX(slot) do { float m_ = fmaxf(fmaxf(fmaxf(s0[0], s0[1]), fmaxf(s0[2], s0[3])), fmaxf(fmaxf(s1[0], s1[1]), fmaxf(s1[2], s1[3]))); \
        m_ = fmaxf(m_, __shfl_xor(m_, 16)); m_ = fmaxf(m_, __shfl_xor(m_, 32)); float l_ = 0.f; \
        _Pragma("unroll") for (int j = 0; j < 4; ++j) { s0[j] = __expf((s0[j] - m_) * 0.0625f); s1[j] = __expf((s1[j] - m_) * 0.0625f); l_ += s0[j] + s1[j]; } \
        l_ += __shfl_xor(l_, 16); l_ += __shfl_xor(l_, 32); \
        if (cl < 4) { *(LAS f32x4*)(Pw + cl * 32 + 4 * g4) = s0; *(LAS f32x4*)(Pw + cl * 32 + 16 + 4 * g4) = s1; \
            if (g4 == 0) { ST[(((slot) * 8 + w) * 4 + cl) * 2] = m_; ST[(((slot) * 8 + w) * 4 + cl) * 2 + 1] = l_; } } } while (0)
#define SA_OZERO() do { _Pragma("unroll") for (int q = 0; q < 4; ++q) o[q] = (f32x4){0.f, 0.f, 0.f, 0.f}; } while (0)
#define SA_OWRITE(slot) do { _Pragma("unroll") for (int q = 0; q < 4; ++q) *(LAS f32x4*)(OW + (size_t)((((slot) * 8 + w) * 4 + q) * 256) + 4 * lane) = o[q]; } while (0)
#define SA_SB() __builtin_amdgcn_sched_barrier(0)
    SA_LOADQ(u0);
    SA_LOADK(bA, u0, 0); SA_LOADK(bB, u0, 1); SA_SB();
    SA_QK(bA, s0); SA_LOADV(bA, u0, 0); SA_SB();
    SA_QK(bB, s1); SA_LOADV(bB, u0, 1); SA_SB();
    SA_SOFTMAX(0);
    SA_LOADQ(u1);
    SA_OZERO(); SA_SB();
    SA_PV(bA, 0); SA_LOADK(bA, u1, 0); SA_SB();
    SA_PV(bB, 1); SA_LOADK(bB, u1, 1); SA_SB();
    SA_OWRITE(0);
    {
        SA_QK(bA, s0); SA_LOADV(bA, u1, 0); SA_SB();
        SA_QK(bB, s1); SA_LOADV(bB, u1, 1); SA_SB();
        SA_SOFTMAX(1);
        SA_OZERO(); SA_SB();
        SA_PV(bA, 0); SA_SB();
        SA_PV(bB, 1);
        SA_OWRITE(1);
    }
    __syncthreads();
    {
        const int slot = tid >> 8, q = (tid >> 6) & 3, d = (tid & 63) * 4;
        const int unit = slot == 0 ? u0 : u1;
        {
            float M = -3.0e38f;
#pragma unroll
            for (int ww = 0; ww < 8; ++ww) M = fmaxf(M, ST[((slot * 8 + ww) * 4 + q) * 2]);
            float L = 0.f; f32x4 a = (f32x4){0.f, 0.f, 0.f, 0.f};
#pragma unroll
            for (int ww = 0; ww < 8; ++ww) { const float f = __expf((ST[((slot * 8 + ww) * 4 + q) * 2] - M) * 0.0625f); L += f * ST[((slot * 8 + ww) * 4 + q) * 2 + 1];
                a += f * *(const LAS f32x4*)(OW + (size_t)(((slot * 8 + ww) * 4 + q) * 256) + d); }
            const float inv = rcp_(L);
            const size_t row = (size_t)NPROMPT + 4 * (unit >> 2) + q; const int h = unit & 3;
            const u32x2 az = *(const u32x2*)(PROJ + row * NIN + OFF_AZ + h * 256 + d);
            u32x2 wv; wv.x = cvt_pk_bf16(a[0] * inv * siluf_(bf_lo(az.x)), a[1] * inv * siluf_(bf_hi(az.x))); wv.y = cvt_pk_bf16(a[2] * inv * siluf_(bf_lo(az.y)), a[3] * inv * siluf_(bf_hi(az.y)));
            *(u32x2*)(OATT + row * 1024 + h * 256 + d) = wv;
        }
    }
    __syncthreads();
#undef SA_LOADQ
#undef SA_LOADK
#undef SA_LOADV
#undef SA_QK
#undef SA_PV
#undef SA_SOFTMAX
#undef SA_OZERO
#undef SA_OWRITE
#undef SA_SB
}

__device__ __forceinline__ void phase5(const P& p) {
    const float* part = (const float*)(p.ws + WS_PART);
    const int t0 = otid(); const int lane = t0 & 63, gw = blockIdx.x * 8 + (t0 >> 6), nw = gridDim.x * 8;
    for (int row = gw; row < MTOK; row += nw) {
        float* orow = p.out + (size_t)row * DM;
        f32x4 v[8]; float s = 0.f;
        if (row < NPROMPT) {
            const float* xr = p.x_prompt + (size_t)row * DM; const bf16_t* dr = (const bf16_t*)(p.ws + WS_DELTA) + (size_t)row * DM;
#pragma unroll
            for (int i = 0; i < 8; ++i) { const u32x2 d = NTL((const u32x2*)(dr + 4 * (lane + 64 * i)));
                v[i] = NTL((const f32x4*)(xr + 4 * (lane + 64 * i))) + (f32x4){bf_lo(d.x), bf_hi(d.x), bf_lo(d.y), bf_hi(d.y)}; }
        } else {
            const float* xr = p.x_sample + (size_t)(row - NPROMPT) * DM;
#pragma unroll
            for (int i = 0; i < 8; ++i) v[i] = NTL((const f32x4*)(xr + 4 * (lane + 64 * i)));
#pragma unroll 2
            for (int ks = 0; ks < 8; ++ks) { const float* pr = part + ((size_t)ks * 512 + (row - NPROMPT)) * DM;
#pragma unroll
                for (int i = 0; i < 8; ++i) v[i] += NTL((const f32x4*)(pr + 4 * (lane + 64 * i))); }
        }
#pragma unroll
        for (int i = 0; i < 8; ++i) s += (v[i][0] * v[i][0] + v[i][1] * v[i][1]) + (v[i][2] * v[i][2] + v[i][3] * v[i][3]);
#pragma unroll
        for (int o = 32; o >= 1; o >>= 1) s += __shfl_xor(s, o);
        const float rstd = 1.0f / sqrtf(s * (1.0f / 2048.0f) + 1e-6f);
#pragma unroll
        for (int i = 0; i < 8; ++i) { const f32x4 gv = *(const f32x4*)(p.final_g + 4 * (lane + 64 * i)); NTS(v[i] * rstd * gv, (f32x4*)(orow + 4 * (lane + 64 * i))); }
    }
}

#define XB_TMO      128
#define XB_XCNT(j)  (256  + 64 * (j))
#define XB_XSUB(j)  (1280 + 64 * (j))
#define XB_XGEN(j)  (2304 + 64 * (j))
#define XB_TOP      3328
#define XB_TOPGEN   3392
#define XB_SPIN_CAP (1u << 20)
__device__ __forceinline__ unsigned xb_ld(unsigned* p)              { return __hip_atomic_load(p, __ATOMIC_RELAXED, __HIP_MEMORY_SCOPE_AGENT); }
__device__ __forceinline__ unsigned xb_add(unsigned* p, unsigned v) { return __hip_atomic_fetch_add(p, v, __ATOMIC_RELAXED, __HIP_MEMORY_SCOPE_AGENT); }
__device__ __forceinline__ unsigned xb_xcc_id() { return (unsigned)__builtin_amdgcn_s_getreg((3 << 11) | 20) & 0xFu; }
#define XB_SPIN(cond, bar) do { unsigned _sp = 0; while (cond) { __builtin_amdgcn_s_sleep(1); \
    if ((++_sp & 255u) == 0u) { if (xb_ld(&(bar)[XB_TMO])) break; if (_sp > XB_SPIN_CAP) { atomicAdd(&(bar)[XB_TMO], 1u); break; } } } } while (0)
struct XcdBarrier { unsigned* bar; unsigned x; volatile LAS unsigned* st; };
__device__ __forceinline__ XcdBarrier xcd_barrier_post(unsigned* bar, volatile LAS unsigned* st) {
    XcdBarrier b; b.bar = bar; b.x = xb_xcc_id(); b.st = st;
    if (threadIdx.x == 0) (void)xb_add(&bar[XB_XCNT(b.x)], 1u);
    return b;
}
__device__ __forceinline__ void xcd_barrier_complete(unsigned* bar, unsigned x, unsigned& nloc, unsigned& nx) {
    const unsigned G = gridDim.x * gridDim.y * gridDim.z;
    unsigned sum, cnt, mine, sp = 0u;
    for (;;) {
        sum = 0u; cnt = 0u; mine = 0u;
#pragma unroll
        for (unsigned j = 0; j < 16; ++j) { const unsigned c = xb_ld(&bar[XB_XCNT(j)]); sum += c; cnt += (c > 0u) ? 1u : 0u; mine = (j == x) ? c : mine; }
        if (sum == G) break;
        __builtin_amdgcn_s_sleep(1);
        if ((++sp & 255u) == 0u) { if (xb_ld(&bar[XB_TMO])) break; if (sp > XB_SPIN_CAP) { atomicAdd(&bar[XB_TMO], 1u); break; } }
    }
    nloc = mine > 0u ? mine : 1u; nx = cnt > 0u ? cnt : 1u;
}
__device__ __forceinline__ void xcd_barrier(const XcdBarrier& b) {
    asm volatile("s_waitcnt vmcnt(0)" ::: "memory");
    __syncthreads();
    if (threadIdx.x == 0) {
        unsigned* bar = b.bar;
        __builtin_amdgcn_s_waitcnt(0);
        unsigned nloc = b.st[0], nx = b.st[1];
        if (nloc == 0u) { xcd_barrier_complete(bar, b.x, nloc, nx); b.st[0] = nloc; b.st[1] = nx; }
        const unsigned old = xb_add(&bar[XB_XSUB(b.x)], 1u);
        const unsigned gen = old / nloc;
        if (old + 1u == (gen + 1u) * nloc) {
            __builtin_amdgcn_fence(__ATOMIC_RELEASE, "agent");
            asm volatile("s_waitcnt vmcnt(0)" ::: "memory");
            const unsigned og = xb_add(&bar[XB_TOP], 1u);
            const unsigned tg = og / nx;
            if (og + 1u == (tg + 1u) * nx) xb_add(&bar[XB_TOPGEN], 1u);
            else XB_SPIN(xb_ld(&bar[XB_TOPGEN]) == tg, bar);
            __builtin_amdgcn_fence(__ATOMIC_ACQUIRE, "agent");
            xb_add(&bar[XB_XGEN(b.x)], 1u);
            asm volatile("s_waitcnt vmcnt(0)" ::: "memory");
        } else {
            XB_SPIN(xb_ld(&bar[XB_XGEN(b.x)]) == gen, bar);
            __builtin_amdgcn_fence(__ATOMIC_ACQUIRE, "agent");
            asm volatile("s_waitcnt vmcnt(0)" ::: "memory");
        }
    }
    __syncthreads();
}

__global__ void __launch_bounds__(512, 2) mega_fwd(P p) {
    extern __shared__ __attribute__((aligned(16))) unsigned char shm[];
    LAS unsigned char* lds = (LAS unsigned char*)shm;
    cg::grid_group grid = cg::this_grid();
    unsigned char* ws = p.ws;
    const int G = gridDim.x, c = blockIdx.x;
    volatile LAS unsigned* bst = (volatile LAS unsigned*)(lds + 131072);
    if (threadIdx.x == 0) { bst[0] = 0u; bst[1] = 0u; }
    __syncthreads();
    const XcdBarrier xbar = xcd_barrier_post((unsigned*)(ws + WS_BAR), bst);
    if (p.out == nullptr) grid.sync();
#define GSYNC() xcd_barrier(xbar)

#ifndef PHMASK
#define PHMASK 0xffff
#endif
#ifndef REPMASK
#define REPMASK 0
#endif
#define NREP(bit) ((REPMASK & (bit)) ? 2 : 1)
#ifndef TPHASE
#define TPHASE -1
#endif
#ifndef TMULT
#define TMULT 4
#endif
    unsigned long long ts[8]; int nts = 0;
#define STAMP() do { if (TPHASE >= 0 && TPHASE < 10) { ts[nts] = wall_clock64(); } ++nts; } while (0)
    STAMP();
    for (int rep = 0; rep < NREP(1); ++rep) if (PHMASK & 1) phase0(p, lds);
    GSYNC(); STAMP();

    for (int rep = 0; rep < NREP(2); ++rep) if (PHMASK & 2) {
        Sched1 S{(const char*)(ws + WS_H), (const char*)(ws + WS_WIN), (const char*)(ws + WS_MEMN), (const char*)(ws + WS_WK), (const char*)(ws + WS_WV), G, c};
        Epi1 E{(bf16_t*)(ws + WS_PROJ), p.out + O_MK, (bf16_t*)(ws + WS_KB), p.out + O_MV, (bf16_t*)(ws + WS_VT)};
        pg8::gemm_phase(lds, 2048, 2048, S, E);
    }
    GSYNC(); STAMP();

    for (int rep = 0; rep < NREP(4); ++rep) {
        unsigned long long m0 = 0, m1 = 0, m2 = 0, m3 = 0, m4 = 0;
        if (TPHASE >= 10) m0 = wall_clock64();
        const int sg = (c >> 3) & 3;
        if (sg == 0) for (int u = c; u < 512; u += 2 * G) attn_sample_pair(p, u, u + G, lds);
        if (TPHASE >= 10) m1 = wall_clock64();
        for (int u = c; u < 256; u += G) s5_unit(p, u, lds);
        for (int u = 256 + (G - 1 - c); u < 320; u += G) s5_unit(p, u, lds);
        if (TPHASE >= 10) m2 = wall_clock64();
        if (sg == 1) for (int u = c; u < 512; u += 2 * G) attn_sample_pair(p, u, u + G, lds);
        for (int u = c; u < 256; u += G) attn_prompt_unit(p, u, lds);
        if (TPHASE >= 10) m3 = wall_clock64();
        if (sg == 2) for (int u = c; u < 512; u += 2 * G) attn_sample_pair(p, u, u + G, lds);
        conv_phase(p);
        if (sg == 3) for (int u = c; u < 512; u += 2 * G) attn_sample_pair(p, u, u + G, lds);
        late_transposes(p, lds, c, G, G == 256 ? 512 : 768);
        if (TPHASE >= 10) { m4 = wall_clock64(); ts[0] = 0; ts[1] = TPHASE == 10 ? m1 - m0 : (TPHASE == 11 ? m2 - m1 : (TPHASE == 12 ? m3 - m2 : m4 - m3)); }
    }
    GSYNC(); STAMP();

    for (int rep = 0; rep < NREP(8); ++rep) if (PHMASK & 64) {
        { Sched1g Sg{(const char*)(ws + WS_H), (const char*)(ws + WS_WIN), G, c}; Epi1 Eg{(bf16_t*)(ws + WS_PROJ), p.out + O_MK, (bf16_t*)(ws + WS_KB), p.out + O_MV, (bf16_t*)(ws + WS_VT)}; pg8::gemm_phase(lds, 2048, 2048, Sg, Eg); }
        if (G == 256 && c >= 144) late_transposes(p, lds, 512 + (c - 144), 112, 768);
        Sched2 S{(const char*)ws, G, c};
        Epi2 E{(bf16_t*)(ws + WS_GLU), (bf16_t*)(ws + WS_CONVO), (bf16_t*)(ws + WS_ATTO)};
        pg8::gemm_phase(lds, 1024, 1024, S, E);
    }
    GSYNC(); STAMP();

    for (int rep = 0; rep < NREP(32); ++rep) merge_phase(p);
    GSYNC(); STAMP();

    for (int rep = 0; rep < NREP(16); ++rep) if (PHMASK & 128) {
        { Sched3 S{(const char*)(ws + WS_MERGED), (const char*)(ws + WS_WO), G, c}; Epi3 E{(bf16_t*)(ws + WS_DELTA), (float*)(ws + WS_PART), false}; pg8::gemm_phase(lds, 2048, 2048, S, E); }
        { Sched3b S{(const char*)(ws + WS_MERGED), (const char*)(ws + WS_WO), G, c}; Epi3 E{(bf16_t*)(ws + WS_DELTA), (float*)(ws + WS_PART), true}; pg8::gemm_phase(lds, 256, 2048, S, E); }
    }
    GSYNC(); STAMP();

    if (PHMASK & 256) phase5(p);
    STAMP();
    if (TPHASE >= 0 && blockIdx.x == 0 && threadIdx.x == 0) {
        const unsigned long long d = (TPHASE >= 10 ? ts[1] - ts[0] : ts[TPHASE + 1] - ts[TPHASE]) * TMULT, t0 = wall_clock64();
        while (wall_clock64() - t0 < d) __builtin_amdgcn_s_sleep(16);
    }
}

extern "C" void kernel_launch(void* const* d_in, const int* in_sizes, int n_in, void* d_out, int out_size, void* d_ws, size_t ws_size, hipStream_t stream) {
    static int grid = 0;
    if (grid == 0) {
        int dev = 0, cus = 0, per_cu = 0;
        hipGetDevice(&dev);
        hipDeviceGetAttribute(&cus, hipDeviceAttributeMultiprocessorCount, dev);
        if (hipFuncSetAttribute((const void*)mega_fwd, hipFuncAttributeMaxDynamicSharedMemorySize, LDS_BYTES) != hipSuccess) fprintf(stderr, "kernel_launch: hipFuncSetAttribute failed\n");
        if (hipOccupancyMaxActiveBlocksPerMultiprocessor(&per_cu, (const void*)mega_fwd, 512, LDS_BYTES) != hipSuccess || per_cu < 1) per_cu = 1;
        (void)hipGetLastError();
        grid = cus * per_cu;
        if (ws_size < WS_END) fprintf(stderr, "kernel_launch: workspace too small (%zu < %zu)\n", ws_size, (size_t)WS_END);
    }
    P p{};
    const float** pp = (const float**)&p;
    for (int i = 0; i < 28; ++i) pp[i] = (const float*)d_in[i];
    p.out = (float*)d_out; p.ws = (unsigned char*)d_ws;
    void* args[] = {&p};
    (void)hipMemsetAsync((unsigned char*)d_ws + WS_BAR, 0, 16384, stream);
    hipError_t e = hipLaunchCooperativeKernel((const void*)mega_fwd, dim3(grid), dim3(512), args, LDS_BYTES, stream);
    if (e != hipSuccess) fprintf(stderr, "cooperative launch failed: %s (grid %d)\n", hipGetErrorString(e), grid);
}
```

```cpp
#include <hip/hip_runtime.h>
#include <hip/hip_cooperative_groups.h>
#include <cstdio>
namespace cg = cooperative_groups;

#define LAS __attribute__((address_space(3)))
typedef unsigned short bf16_t;
typedef short bf16x8 __attribute__((ext_vector_type(8)));
typedef float f32x4 __attribute__((ext_vector_type(4)));
typedef unsigned u32x4 __attribute__((ext_vector_type(4)));
typedef unsigned u32x2 __attribute__((ext_vector_type(2)));

constexpr int DM = 2048, NPROMPT = 8192, NSAMPLE = 512, MTOK = 8704, NIN = 14336;
constexpr int OFF_CB = 0, OFF_CC = 1024, OFF_CH = 2048, OFF_CZ = 3072, OFF_SU = 4096, OFF_SZ = 5120, OFF_AQ = 6144, OFF_AZ = 7168, OFF_G = 8192;
constexpr int LDS_BYTES = 131072 + 16;
constexpr size_t O_Y = 0, O_MK = 17825792, O_MV = 18874368, O_CP = 19922944, O_RP = 19931136, O_IP = 19947520, O_CS = 19963904, O_RS = 20226048, O_IS = 20750336;
constexpr size_t WS_WIN = 0;
constexpr size_t WS_WG = WS_WIN + (size_t)NIN * DM * 2;
constexpr size_t WS_WC = WS_WG + 8388608;
constexpr size_t WS_WA = WS_WC + 4194304;
constexpr size_t WS_WO = WS_WA + 4194304;
constexpr size_t WS_H = WS_WO + 8388608;
constexpr size_t WS_PROJ = WS_H + (size_t)MTOK * DM * 2;
constexpr size_t WS_YS = WS_PROJ + (size_t)MTOK * NIN * 2;
constexpr size_t WS_ACONV = WS_YS + (size_t)MTOK * 1024 * 2;
constexpr size_t WS_OATT = WS_ACONV + (size_t)MTOK * 1024 * 2;
constexpr size_t WS_SS = WS_OATT + (size_t)MTOK * 1024 * 2;
constexpr size_t WS_GLU = WS_SS + (size_t)MTOK * 32 * 4;
constexpr size_t WS_MERGED = WS_GLU + (size_t)MTOK * DM * 2;
constexpr size_t WS_BAR = WS_MERGED + (size_t)MTOK * DM * 2;
constexpr size_t WS_MEMN = WS_BAR + 16384;
constexpr size_t WS_WK = WS_MEMN + 4194304;
constexpr size_t WS_WV = WS_WK + 4194304;
constexpr size_t WS_KB = WS_WV + 4194304;
constexpr size_t WS_VT = WS_KB + 2097152;
constexpr size_t WS_ATTO = WS_MEMN;
constexpr size_t WS_END = WS_ATTO + (size_t)MTOK * DM * 2;
constexpr size_t WS_CONVO = WS_WIN, WS_PART = WS_PROJ, WS_DELTA = WS_PROJ + 67108864;
static_assert(WS_END <= 536870912, "workspace");
static_assert(WS_VT + 2097152 <= WS_END && (size_t)MTOK * DM * 2 <= 38u * 1048576u, "aliases");

struct P {
    const float *x_prompt, *x_sample, *mem_prompt, *cache_k, *cache_v, *state_conv, *state_re, *state_im, *norm_g, *mem_norm_g, *w_in, *conv_w, *w_conv_out,
        *lam_re, *lam_im, *log_dt, *b_re, *b_im, *c_re, *c_im, *ssm_d, *w_glu_a, *w_glu_b, *w_mem_k, *w_mem_v, *w_attn_out, *w_out, *final_g;
    float* out; unsigned char* ws;
};

__device__ __forceinline__ unsigned cvt_pk_bf16(float lo, float hi) { unsigned r; asm("v_cvt_pk_bf16_f32 %0, %1, %2" : "=v"(r) : "v"(lo), "v"(hi)); return r; }
__device__ __forceinline__ float bf_lo(unsigned w) { return __uint_as_float(w << 16); }
__device__ __forceinline__ float bf_hi(unsigned w) { return __uint_as_float(w & 0xffff0000u); }
__device__ __forceinline__ float rcp_(float x) { return __builtin_amdgcn_rcpf(x); }
__device__ __forceinline__ float sigmoidf_(float x) { return rcp_(1.0f + __expf(-x)); }
__device__ __forceinline__ float siluf_(float x) { return x * rcp_(1.0f + __expf(-x)); }
__device__ __forceinline__ float gelu_tanh(float x) { const float u = 1.5957691216057308f * (x + 0.044715f * x * x * x); return x * rcp_(1.0f + __expf(-u)); }
__device__ __forceinline__ bf16x8 pack8(const f32x4 a, const f32x4 b) {
    u32x4 w; w.x = cvt_pk_bf16(a[0], a[1]); w.y = cvt_pk_bf16(a[2], a[3]); w.z = cvt_pk_bf16(b[0], b[1]); w.w = cvt_pk_bf16(b[2], b[3]);
    return __builtin_bit_cast(bf16x8, w);
}
__device__ __forceinline__ u32x4 pack8u(const f32x4 a, const f32x4 b) {
    u32x4 w; w.x = cvt_pk_bf16(a[0], a[1]); w.y = cvt_pk_bf16(a[2], a[3]); w.z = cvt_pk_bf16(b[0], b[1]); w.w = cvt_pk_bf16(b[2], b[3]); return w;
}
__device__ __forceinline__ void unpack8(const u32x4 w, float (&f)[8]) {
    f[0] = bf_lo(w.x); f[1] = bf_hi(w.x); f[2] = bf_lo(w.y); f[3] = bf_hi(w.y); f[4] = bf_lo(w.z); f[5] = bf_hi(w.z); f[6] = bf_lo(w.w); f[7] = bf_hi(w.w);
}
__device__ __forceinline__ int otid() { int t = threadIdx.x; asm volatile("" : "+v"(t)); return t; }
#define NTL(p) __builtin_nontemporal_load(p)
#define NTS(v, p) __builtin_nontemporal_store((v), (p))
#define MFMA16(a, b, c) __builtin_amdgcn_mfma_f32_16x16x32_bf16((a), (b), (c), 0, 0, 0)

namespace pg8 {
constexpr int BM = 256, BK = 64, HALF = 128, HTB = HALF * BK * 2, STAGE_BYTES = 8 * HTB;
__device__ __forceinline__ int lds_byte(int r, int c) { const int st = (r >> 4) * 2 + (c >> 5), rr = r & 15, cc = c & 31, ob = rr * 64 + cc * 2; return st * 1024 + (ob ^ (((ob >> 9) & 1) << 5)); }
__device__ __forceinline__ void stage_rc(int b, int& R, int& C) { const int st = b / 1024, sb = b % 1024, swz = sb ^ (((sb >> 9) & 1) << 5); R = (st >> 1) * 16 + swz / 64; C = (st & 1) * 32 + (swz % 64) / 2; }
__device__ __forceinline__ int perm32(int rho) { const int n = rho >> 4, i = rho & 15; return 8 * (i >> 2) + 4 * n + (i & 3); }
struct Unit { const char* a; const char* b; int pm, pn, kind; };

template <class Sched, class Epi>
__device__ __forceinline__ void gemm_phase(LAS unsigned char* lds, const int K, const int ld, const Sched& S, const Epi& E) {
    const int tid = otid(), wid = __builtin_amdgcn_readfirstlane(tid >> 6), lane = tid & 63, wr = wid >> 2, wc = wid & 3, fr = lane & 15, fq = lane >> 4;
    const int nt = K / BK;
    unsigned voffA[2], voffB[2];
#pragma unroll
    for (int i = 0; i < 2; ++i) { int R, C; stage_rc(tid * 16 + i * 8192, R, C); const int Rb = (R & ~31) + perm32(R & 31);
        voffA[i] = (unsigned)(R * ld + C) * 2u; voffB[i] = (unsigned)(Rb * ld + C) * 2u; }
    const size_t kstep = (size_t)(BK * 2);
    const size_t hstep = (size_t)HALF * ld * 2;
    const unsigned ldsw = (unsigned)wid * 1024u;
    const int aoff = lds_byte(wr * 64 + fr, fq * 8), boff = lds_byte(wc * 32 + fr, fq * 8);
#define PG8_SA(b, h) (((b) * 2 + (h)) * HTB)
#define PG8_SB(b, h) ((4 + (b) * 2 + (h)) * HTB)
#define PG8_STAGE(bufoff, gbase, voff) do { _Pragma("unroll") for (int _i = 0; _i < 2; ++_i) \
        __builtin_amdgcn_global_load_lds((const unsigned*)((const char*)(gbase) + (voff)[_i]), (LAS unsigned*)(lds + (bufoff) + ldsw + _i * 8192), 16, 0, 0); } while (0)
#define PG8_LDA(dst, b, h) do { _Pragma("unroll") for (int m = 0; m < 4; ++m) _Pragma("unroll") for (int k = 0; k < 2; ++k) dst[m][k] = *(const LAS bf16x8*)(lds + PG8_SA(b, h) + aoff + m * 2048 + k * 1024); } while (0)
#define PG8_LDB(dst, b, h) do { _Pragma("unroll") for (int n = 0; n < 2; ++n) _Pragma("unroll") for (int k = 0; k < 2; ++k) dst[n][k] = *(const LAS bf16x8*)(lds + PG8_SB(b, h) + boff + n * 2048 + k * 1024); } while (0)
#define PG8_MMA(ai, bj, At, Bt) do { __builtin_amdgcn_s_setprio(1); _Pragma("unroll") for (int m = 0; m < 4; ++m) _Pragma("unroll") for (int n = 0; n < 2; ++n) _Pragma("unroll") for (int k = 0; k < 2; ++k) \
        acc[ai][bj][m][n] = __builtin_amdgcn_mfma_f32_16x16x32_bf16(Bt[n][k], At[m][k], acc[ai][bj][m][n], 0, 0, 0); __builtin_amdgcn_s_setprio(0); } while (0)
#define PG8_WAIT_V(n) asm volatile("s_waitcnt vmcnt(" #n ")" ::: "memory")
#define PG8_WAIT_L(n) asm volatile("s_waitcnt lgkmcnt(" #n ")" ::: "memory")
#define PG8_BAR __builtin_amdgcn_s_barrier()
#define PG8_SCHED __builtin_amdgcn_sched_barrier(0)
    Unit cur, nxt; int ui = 0;
    if (!S.next(0, cur)) return;
    f32x4 acc[2][2][4][2];
#pragma unroll
    for (int a = 0; a < 2; ++a)
#pragma unroll
        for (int b = 0; b < 2; ++b)
#pragma unroll
            for (int m = 0; m < 4; ++m)
#pragma unroll
                for (int n = 0; n < 2; ++n) acc[a][b][m][n] = (f32x4){0.f, 0.f, 0.f, 0.f};
    bf16x8 At[4][2], B0[2][2], B1[2][2];
    const char* cA = cur.a; const char* cB = cur.b;
    PG8_STAGE(PG8_SB(0, 0), cB, voffB); PG8_STAGE(PG8_SA(0, 0), cA, voffA); PG8_STAGE(PG8_SB(0, 1), cB + hstep, voffB); PG8_STAGE(PG8_SA(0, 1), cA + hstep, voffA);
    if (wr == 1) PG8_BAR;
    PG8_WAIT_V(4); PG8_BAR;
    PG8_STAGE(PG8_SB(1, 0), cB + kstep, voffB); PG8_STAGE(PG8_SA(1, 0), cA + kstep, voffA); PG8_STAGE(PG8_SB(1, 1), cB + hstep + kstep, voffB);
    PG8_WAIT_V(6); PG8_BAR;
    for (;;) {
        const bool has_next = S.next(ui + 1, nxt);
        const char* nA = has_next ? nxt.a : cA; const char* nB = has_next ? nxt.b : cB;
        for (int t = 0; t < nt; t += 2) {
            const bool last = (t == nt - 2);
            const char* a1 = cA + (size_t)(t + 1) * kstep;
            const char* a2 = last ? nA : cA + (size_t)(t + 2) * kstep; const char* b2 = last ? nB : cB + (size_t)(t + 2) * kstep;
            const char* a3 = a2 + kstep; const char* b3 = b2 + kstep;
            PG8_LDB(B0, 0, 0); PG8_SCHED; PG8_LDA(At, 0, 0); PG8_STAGE(PG8_SA(1, 1), a1 + hstep, voffA);
            PG8_WAIT_L(8); PG8_BAR; PG8_WAIT_L(0); PG8_MMA(0, 0, At, B0); PG8_BAR; PG8_SCHED;
            PG8_LDB(B1, 0, 1); PG8_STAGE(PG8_SB(0, 0), b2, voffB);
            PG8_BAR; PG8_WAIT_L(0); PG8_MMA(0, 1, At, B1); PG8_BAR;
            PG8_LDA(At, 0, 1); PG8_STAGE(PG8_SA(0, 0), a2, voffA);
            PG8_BAR; PG8_WAIT_L(0); PG8_MMA(1, 0, At, B0); PG8_BAR; PG8_SCHED;
            PG8_STAGE(PG8_SB(0, 1), b2 + hstep, voffB);
            PG8_WAIT_V(6); PG8_BAR; PG8_MMA(1, 1, At, B1); PG8_BAR;
            PG8_LDB(B0, 1, 0); PG8_SCHED; PG8_LDA(At, 1, 0); PG8_STAGE(PG8_SA(0, 1), a2 + hstep, voffA);
            PG8_WAIT_L(8); PG8_BAR; PG8_WAIT_L(0); PG8_MMA(0, 0, At, B0); PG8_BAR; PG8_SCHED;
            PG8_LDB(B1, 1, 1); PG8_STAGE(PG8_SB(1, 0), b3, voffB);
            PG8_BAR; PG8_WAIT_L(0); PG8_MMA(0, 1, At, B1); PG8_BAR;
            PG8_LDA(At, 1, 1); PG8_STAGE(PG8_SA(1, 0), a3, voffA);
            PG8_BAR; PG8_WAIT_L(0); PG8_MMA(1, 0, At, B0); PG8_BAR; PG8_SCHED;
            PG8_STAGE(PG8_SB(1, 1), b3 + hstep, voffB);
            PG8_WAIT_V(6); PG8_BAR; PG8_MMA(1, 1, At, B1); PG8_BAR;
        }
        const bool keep = E(acc, cur, wr, wc, fr, fq);
        if (!has_next) break;
        if (!keep) {
#pragma unroll
            for (int a = 0; a < 2; ++a)
#pragma unroll
                for (int b = 0; b < 2; ++b)
#pragma unroll
                    for (int m = 0; m < 4; ++m)
#pragma unroll
                        for (int n = 0; n < 2; ++n) acc[a][b][m][n] = (f32x4){0.f, 0.f, 0.f, 0.f};
        }
        cur = nxt; cA = nA; cB = nB; ++ui;
    }
    PG8_WAIT_V(0);
    if (wr == 0) PG8_BAR;
    PG8_BAR;
#undef PG8_SA
#undef PG8_SB
#undef PG8_STAGE
#undef PG8_LDA
#undef PG8_LDB
#undef PG8_MMA
#undef PG8_WAIT_V
#undef PG8_WAIT_L
#undef PG8_BAR
#undef PG8_SCHED
}
}
using pg8::Unit;

__device__ __forceinline__ void xcd_tile_order(int wgid, const int nM, const int nN, int& pm, int& pn) {
    const int nwg = nM * nN, NX = 8, WGM = 8;
    { const int q = nwg / NX, r = nwg % NX, xcd = wgid % NX, off = wgid / NX; wgid = (xcd < r ? xcd * (q + 1) : r * (q + 1) + (xcd - r) * q) + off; }
    const int nig = WGM * nN, gid = wgid / nig, fm = gid * WGM, gsz = (nM - fm) < WGM ? (nM - fm) : WGM;
    pm = fm + ((wgid % nig) % gsz); pn = (wgid % nig) / gsz;
}
struct Sched1 {
    const char *H, *WIN, *MEMN, *WK, *WV; int G, c;
    __device__ __forceinline__ bool next(int i, Unit& u) const {
        const int L = i * G + c; if (L >= 1792) return false;
        if (L < 1760) {
            int pm, pn;
            if (L < 1292) xcd_tile_order(L, 34, 38, pm, pn);
            else { xcd_tile_order(L - 1292, 26, 18, pm, pn); pn += 38; }
            u.pm = pm; u.pn = pn; u.kind = 0; u.a = H + (size_t)pm * 1048576; u.b = WIN + (size_t)pn * 1048576;
        } else if (L < 1776) { const int j = L - 1760; u.pm = j >> 2; u.pn = j & 3; u.kind = 1; u.a = MEMN + (size_t)u.pm * 1048576; u.b = WK + (size_t)u.pn * 1048576; }
        else { const int j = L - 1776; u.pm = j >> 2; u.pn = j & 3; u.kind = 2; u.a = WV + (size_t)u.pm * 1048576; u.b = MEMN + (size_t)u.pn * 1048576; }
        return true;
    }
};
struct Sched1g {
    const char *H, *WIN; int G, c;
    __device__ __forceinline__ bool next(int i, Unit& u) const {
        const int j = i * G + c; if (j >= 144) return false;
        u.pm = 26 + j / 18; u.pn = 38 + j % 18; u.kind = 0; u.a = H + (size_t)u.pm * 1048576; u.b = WIN + (size_t)u.pn * 1048576; return true;
    }
};
struct Epi1 {
    bf16_t* PROJ; float* outK; bf16_t* KB; float* outV; bf16_t* VT;
    __device__ __forceinline__ bool operator()(f32x4 (&acc)[2][2][4][2], const Unit& u, int wr, int wc, int fr, int fq) const {
        const int r0 = u.pm * 256 + wr * 64 + fr, c0 = u.pn * 256 + wc * 32 + 8 * fq;
        if (u.kind == 0) {
            const bool gate = u.pn >= 32;
#pragma unroll
            for (int ai = 0; ai < 2; ++ai)
#pragma unroll
                for (int m = 0; m < 4; ++m) { bf16_t* rowp = PROJ + (size_t)(r0 + ai * 128 + m * 16) * NIN + c0;
#pragma unroll
                    for (int bj = 0; bj < 2; ++bj) { const u32x4 w = pack8u(acc[ai][bj][m][0], acc[ai][bj][m][1]);
                        if (gate) NTS(w, (u32x4*)(rowp + bj * 128)); else *(u32x4*)(rowp + bj * 128) = w; } }
        } else if (u.kind == 1) {
#pragma unroll
            for (int ai = 0; ai < 2; ++ai)
#pragma unroll
                for (int m = 0; m < 4; ++m) { const size_t off = (size_t)(r0 + ai * 128 + m * 16) * 1024 + c0;
#pragma unroll
                    for (int bj = 0; bj < 2; ++bj) { NTS(acc[ai][bj][m][0], (f32x4*)(outK + off + bj * 128)); NTS(acc[ai][bj][m][1], (f32x4*)(outK + off + bj * 128 + 4));
                        *(u32x4*)(KB + off + bj * 128) = pack8u(acc[ai][bj][m][0], acc[ai][bj][m][1]); } }
        } else {
            const int h = u.pm, b = u.pn;
#pragma unroll
            for (int ai = 0; ai < 2; ++ai)
#pragma unroll
                for (int m = 0; m < 4; ++m) { const int d = wr * 64 + fr + ai * 128 + m * 16;
#pragma unroll
                    for (int bj = 0; bj < 2; ++bj) { const int key0 = wc * 32 + 8 * fq + bj * 128;
                        *(u32x4*)(VT + ((size_t)((b * 4 + h) * 256 + d)) * 256 + key0) = pack8u(acc[ai][bj][m][0], acc[ai][bj][m][1]);
                        float* fp = outV + ((size_t)(b * 256 + key0)) * 1024 + h * 256 + d;
#pragma unroll
                        for (int e = 0; e < 4; ++e) { fp[(size_t)e * 1024] = acc[ai][bj][m][0][e]; fp[(size_t)(e + 4) * 1024] = acc[ai][bj][m][1][e]; } } }
        }
        return false;
    }
};

struct Sched2 {
    const char* ws; int G, c;
    __device__ __forceinline__ bool next(int i, Unit& u) const {
        int L;
        if (G == 256) { if (c < 144) { if (i >= 4) return false; L = c + 144 * i; } else { L = 576 + (c - 144) + 112 * i; } }
        else L = i * G + c;
        if (L >= 1088) return false;
        if (L < 544) { u.pm = L >> 4; u.pn = L & 15; u.kind = 0; u.a = ws + WS_YS + (size_t)u.pm * 524288; u.b = ws + WS_WG + (size_t)u.pn * 524288; }
        else { const int j = L - 544, k = j >= 272 ? 1 : 0, jj = j - 272 * k; u.pm = jj >> 3; u.pn = jj & 7; u.kind = 1 + k;
            u.a = ws + WS_ACONV + (size_t)k * ((size_t)MTOK * 1024 * 2) + (size_t)u.pm * 524288; u.b = ws + WS_WC + (size_t)k * 4194304 + (size_t)u.pn * 524288; }
        return true;
    }
};
struct Epi2 {
    bf16_t* GLU; bf16_t* CONVO; bf16_t* ATTO;
    __device__ __forceinline__ bool operator()(f32x4 (&acc)[2][2][4][2], const Unit& u, int wr, int wc, int fr, int fq) const {
        const int r0 = u.pm * 256 + wr * 64 + fr;
        if (u.kind == 0) {
            const int c0 = u.pn * 128 + wc * 32 + 8 * fq;
#pragma unroll
            for (int ai = 0; ai < 2; ++ai)
#pragma unroll
                for (int m = 0; m < 4; ++m) {
                    f32x4 t0, t1;
#pragma unroll
                    for (int e = 0; e < 4; ++e) { t0[e] = acc[ai][0][m][0][e] * sigmoidf_(acc[ai][1][m][0][e]); t1[e] = acc[ai][0][m][1][e] * sigmoidf_(acc[ai][1][m][1][e]); }
                    *(u32x4*)(GLU + (size_t)(r0 + ai * 128 + m * 16) * 2048 + c0) = pack8u(t0, t1);
                }
        } else {
            bf16_t* O = u.kind == 1 ? CONVO : ATTO; const int c0 = u.pn * 256 + wc * 32 + 8 * fq;
#pragma unroll
            for (int ai = 0; ai < 2; ++ai)
#pragma unroll
                for (int m = 0; m < 4; ++m) { bf16_t* rowp = O + (size_t)(r0 + ai * 128 + m * 16) * 2048 + c0;
#pragma unroll
                    for (int bj = 0; bj < 2; ++bj) *(u32x4*)(rowp + bj * 128) = pack8u(acc[ai][bj][m][0], acc[ai][bj][m][1]); }
        }
        return false;
    }
};
__device__ __forceinline__ void merge_phase(const P& p) {
    const bf16_t* PROJ = (const bf16_t*)(p.ws + WS_PROJ); const bf16_t* GLU = (const bf16_t*)(p.ws + WS_GLU); const bf16_t* CONVO = (const bf16_t*)(p.ws + WS_CONVO);
    const bf16_t* ATTO = (const bf16_t*)(p.ws + WS_ATTO); bf16_t* MERGED = (bf16_t*)(p.ws + WS_MERGED);
    const int NT = MTOK * 256, stride = gridDim.x * 512;
    for (int t = blockIdx.x * 512 + otid(); t < NT; t += 2 * stride) {
        u32x4 L[2][6]; const int t1 = t + stride; const bool has1 = t1 < NT;
#pragma unroll
        for (int k = 0; k < 2; ++k) { const int tt = k == 0 ? t : (has1 ? t1 : t);
            const size_t row = (size_t)(tt >> 8); const int c0 = (tt & 255) * 8; const bf16_t* pr = PROJ + row * NIN + OFF_G + c0; const size_t o = row * 2048 + c0;
            L[k][0] = NTL((const u32x4*)pr); L[k][1] = NTL((const u32x4*)(pr + 2048)); L[k][2] = NTL((const u32x4*)(pr + 4096));
            L[k][3] = NTL((const u32x4*)(CONVO + o)); L[k][4] = NTL((const u32x4*)(GLU + o)); L[k][5] = NTL((const u32x4*)(ATTO + o)); }
#pragma unroll
        for (int k = 0; k < 2; ++k) { if (k == 1 && !has1) break; const int tt = k == 0 ? t : t1;
            const size_t row = (size_t)(tt >> 8); const int c0 = (tt & 255) * 8; const size_t o = row * 2048 + c0;
            float g0[8], g1[8], g2[8], cv[8], gl[8], at[8];
            unpack8(L[k][0], g0); unpack8(L[k][1], g1); unpack8(L[k][2], g2); unpack8(L[k][3], cv); unpack8(L[k][4], gl); unpack8(L[k][5], at);
            f32x4 m0, m1;
#pragma unroll
            for (int e = 0; e < 8; ++e) { const float v = sigmoidf_(g0[e]) * cv[e] + sigmoidf_(g1[e]) * gl[e] + sigmoidf_(g2[e]) * at[e]; if (e < 4) m0[e] = v; else m1[e - 4] = v; }
            *(u32x4*)(MERGED + o) = pack8u(m0, m1); }
    }
}

struct Sched3 {
    const char *MERGED, *WO; int G, c;
    __device__ __forceinline__ bool next(int i, Unit& u) const {
        const int L = i * G + c; if (L >= 256) return false;
        u.pm = L >> 3; u.pn = L & 7; u.kind = 0; u.a = MERGED + (size_t)u.pm * 1048576; u.b = WO + (size_t)u.pn * 1048576; return true;
    }
};
struct Sched3b {
    const char *MERGED, *WO; int G, c;
    __device__ __forceinline__ bool next(int i, Unit& u) const {
        const int L = i * G + c; if (L >= 128) return false;
        const int tile = L >> 3, ks = L & 7; u.pm = 32 + (tile >> 3); u.pn = tile & 7; u.kind = ks;
        u.a = MERGED + (size_t)u.pm * 1048576 + (size_t)ks * 512; u.b = WO + (size_t)u.pn * 1048576 + (size_t)ks * 512; return true;
    }
};
struct Epi3 {
    bf16_t* delta; float* part;
    bool sample;
    __device__ __forceinline__ bool operator()(f32x4 (&acc)[2][2][4][2], const Unit& u, int wr, int wc, int fr, int fq) const {
        const int r0 = u.pm * 256 + wr * 64 + fr, c0 = u.pn * 256 + wc * 32 + 8 * fq;
        if (!sample) {
#pragma unroll
            for (int ai = 0; ai < 2; ++ai)
#pragma unroll
                for (int m = 0; m < 4; ++m) { bf16_t* o = delta + (size_t)(r0 + ai * 128 + m * 16) * DM + c0;
#pragma unroll
                    for (int bj = 0; bj < 2; ++bj) *(u32x4*)(o + bj * 128) = pack8u(acc[ai][bj][m][0], acc[ai][bj][m][1]); }
        } else {
            float* base = part + ((size_t)u.kind * 512 - NPROMPT) * DM;
#pragma unroll
            for (int ai = 0; ai < 2; ++ai)
#pragma unroll
                for (int m = 0; m < 4; ++m) {
                    float* o = base + (size_t)(r0 + ai * 128 + m * 16) * DM + c0;
#pragma unroll
                    for (int bj = 0; bj < 2; ++bj)
#pragma unroll
                        for (int n = 0; n < 2; ++n) *(f32x4*)(o + bj * 128 + 4 * n) = acc[ai][bj][m][n];
                }
        }
        return false;
    }
};

__device__ __forceinline__ void transpose_tile(const float* __restrict__ src, const int K, const int N, bf16_t* __restrict__ dst, const int mode, const int t, LAS float* tile) {
    const int tid = otid(); const int tn = N / 256;
    const int r = tid >> 3, c8 = (tid & 7) * 8;
    const int k0 = (t / tn) * 64, n0 = (t % tn) * 256;
    const float* s = src + (size_t)(k0 + r) * N + n0 + c8;
    f32x4 v[8];
#pragma unroll
    for (int j = 0; j < 4; ++j) { v[2 * j] = NTL((const f32x4*)(s + j * 64)); v[2 * j + 1] = NTL((const f32x4*)(s + j * 64 + 4)); }
#pragma unroll
    for (int j = 0; j < 4; ++j)
#pragma unroll
        for (int e = 0; e < 4; ++e) { tile[j * 4160 + r * 65 + c8 + e] = v[2 * j][e]; tile[j * 4160 + r * 65 + c8 + 4 + e] = v[2 * j + 1][e]; }
    __syncthreads();
#pragma unroll
    for (int j = 0; j < 4; ++j) {
        f32x4 a, b;
#pragma unroll
        for (int e = 0; e < 4; ++e) { a[e] = tile[j * 4160 + (c8 + e) * 65 + r]; b[e] = tile[j * 4160 + (c8 + 4 + e) * 65 + r]; }
        const int n = n0 + j * 64 + r;
        const int row = mode == 0 ? n : ((n >> 7) * 256 + (mode - 1) * 128 + (n & 127));
        *(u32x4*)(dst + (size_t)row * K + k0 + c8) = pack8u(a, b);
    }
    __syncthreads();
}
__device__ __forceinline__ void tload_win(const float* w_in, int t, int r, int c8, f32x4 (&v)[8]) {
    const int k0 = (t / 56) * 64, n0 = (t % 56) * 256;
    const float* s = w_in + (size_t)(k0 + r) * NIN + n0 + c8;
#pragma unroll
    for (int j = 0; j < 4; ++j) { v[2 * j] = NTL((const f32x4*)(s + j * 64)); v[2 * j + 1] = NTL((const f32x4*)(s + j * 64 + 4)); }
}
__device__ __forceinline__ void phase0(const P& p, LAS unsigned char* lds) {
    unsigned char* ws = p.ws; LAS float* tile = (LAS float*)lds;
    {
        const int tid = otid(); const int r = tid >> 3, c8 = (tid & 7) * 8;
        bf16_t* dst = (bf16_t*)(ws + WS_WIN);
        int j = blockIdx.x; f32x4 v[8];
        if (j < 1792) tload_win(p.w_in, j, r, c8, v);
        while (j < 1792) {
#pragma unroll
            for (int q = 0; q < 4; ++q)
#pragma unroll
                for (int e = 0; e < 4; ++e) { tile[q * 4160 + r * 65 + c8 + e] = v[2 * q][e]; tile[q * 4160 + r * 65 + c8 + 4 + e] = v[2 * q + 1][e]; }
            const int jn = j + gridDim.x;
            if (jn < 1792) tload_win(p.w_in, jn, r, c8, v);
            __syncthreads();
            const int k0 = (j / 56) * 64, n0 = (j % 56) * 256;
#pragma unroll
            for (int q = 0; q < 4; ++q) {
                f32x4 a, b;
#pragma unroll
                for (int e = 0; e < 4; ++e) { a[e] = tile[q * 4160 + (c8 + e) * 65 + r]; b[e] = tile[q * 4160 + (c8 + 4 + e) * 65 + r]; }
                *(u32x4*)(dst + (size_t)(n0 + q * 64 + r) * 2048 + k0 + c8) = pack8u(a, b);
            }
            __syncthreads();
            j = jn;
        }
    }
    for (int t = blockIdx.x; t < 256; t += gridDim.x) {
        if (t < 128) transpose_tile(p.w_mem_k, 2048, 1024, (bf16_t*)(ws + WS_WK), 0, t, tile);
        else transpose_tile(p.w_mem_v, 2048, 1024, (bf16_t*)(ws + WS_WV), 0, t - 128, tile);
    }
    const int t0 = otid(); const int lane = t0 & 63, gw = blockIdx.x * 8 + (t0 >> 6), nw = gridDim.x * 8;
    auto rowsrc = [&](int row) -> const float* { return row < NPROMPT ? p.x_prompt + (size_t)row * DM : (row < MTOK ? p.x_sample + (size_t)(row - NPROMPT) * DM : p.mem_prompt + (size_t)(row - MTOK) * DM); };
    f32x4 v[8], vn[8];
    if (gw < MTOK + 1024) { const float* src = rowsrc(gw);
#pragma unroll
        for (int i = 0; i < 8; ++i) v[i] = NTL((const f32x4*)(src + 4 * (lane + 64 * i))); }
    for (int row = gw; row < MTOK + 1024; row += nw) {
        const float* g = row < MTOK ? p.norm_g : p.mem_norm_g;
        bf16_t* dst = row < MTOK ? (bf16_t*)(ws + WS_H) + (size_t)row * DM : (bf16_t*)(ws + WS_MEMN) + (size_t)(row - MTOK) * DM;
        if (row + nw < MTOK + 1024) { const float* src = rowsrc(row + nw);
#pragma unroll
            for (int i = 0; i < 8; ++i) vn[i] = NTL((const f32x4*)(src + 4 * (lane + 64 * i))); }
        float s = 0.f;
#pragma unroll
        for (int i = 0; i < 8; ++i) s += (v[i][0] * v[i][0] + v[i][1] * v[i][1]) + (v[i][2] * v[i][2] + v[i][3] * v[i][3]);
#pragma unroll
        for (int o = 32; o >= 1; o >>= 1) s += __shfl_xor(s, o);
        const float rstd = 1.0f / sqrtf(s * (1.0f / 2048.0f) + 1e-6f);
#pragma unroll
        for (int i = 0; i < 8; ++i) { const f32x4 gv = *(const f32x4*)(g + 4 * (lane + 64 * i));
            u32x2 w; w.x = cvt_pk_bf16(v[i][0] * rstd * gv[0], v[i][1] * rstd * gv[1]); w.y = cvt_pk_bf16(v[i][2] * rstd * gv[2], v[i][3] * rstd * gv[3]);
            *(u32x2*)(dst + 4 * (lane + 64 * i)) = w; }
#pragma unroll
        for (int i = 0; i < 8; ++i) v[i] = vn[i];
    }
}

__device__ __forceinline__ void late_transposes(const P& p, LAS unsigned char* lds, const int first, const int stride, const int end) {
    unsigned char* ws = p.ws; LAS float* tile = (LAS float*)lds;
    for (int t = first; t < end; t += stride) {
        if (t < 128) transpose_tile(p.w_conv_out, 1024, 2048, (bf16_t*)(ws + WS_WC), 0, t, tile);
        else if (t < 256) transpose_tile(p.w_attn_out, 1024, 2048, (bf16_t*)(ws + WS_WA), 0, t - 128, tile);
        else if (t < 384) transpose_tile(p.w_glu_a, 1024, 2048, (bf16_t*)(ws + WS_WG), 1, t - 256, tile);
        else if (t < 512) transpose_tile(p.w_glu_b, 1024, 2048, (bf16_t*)(ws + WS_WG), 2, t - 384, tile);
        else transpose_tile(p.w_out, 2048, 2048, (bf16_t*)(ws + WS_WO), 0, t - 512, tile);
    }
}

template <int LEN, bool PROMPT>
__device__ __forceinline__ void conv_task(const P& p, const int r0, const int cgp, const int bs) {
    const bf16_t* PROJ = (const bf16_t*)(p.ws + WS_PROJ); bf16_t* ACONV = (bf16_t*)(p.ws + WS_ACONV);
    const int c0 = cgp * 8;
    const bf16_t* pr = PROJ + (size_t)r0 * NIN + c0;
    u32x4 lcb[LEN], lcz[LEN], lcc[LEN + 2], lch[LEN + 2];
    const bool has_halo = PROMPT && (r0 & 2047) != 0;
#pragma unroll
    for (int i = 0; i < LEN; ++i) { lcb[i] = NTL((const u32x4*)(pr + (size_t)i * NIN + OFF_CB)); lcz[i] = NTL((const u32x4*)(pr + (size_t)i * NIN + OFF_CZ));
        lcc[i + 2] = NTL((const u32x4*)(pr + (size_t)i * NIN + OFF_CC)); lch[i + 2] = NTL((const u32x4*)(pr + (size_t)i * NIN + OFF_CH)); }
#pragma unroll
    for (int i = 0; i < 2; ++i) { lcc[i] = (u32x4){0u, 0u, 0u, 0u}; lch[i] = lcc[i];
        if (has_halo) { lcc[i] = *(const u32x4*)(pr - (size_t)(2 - i) * NIN + OFF_CC); lch[i] = *(const u32x4*)(pr - (size_t)(2 - i) * NIN + OFF_CH); } }
    float w0[8], w1[8], w2[8], vm2[8], vm1[8];
    { const f32x4 a0 = *(const f32x4*)(p.conv_w + c0), a1 = *(const f32x4*)(p.conv_w + c0 + 4), b0 = *(const f32x4*)(p.conv_w + 1024 + c0), b1 = *(const f32x4*)(p.conv_w + 1024 + c0 + 4),
          d0 = *(const f32x4*)(p.conv_w + 2048 + c0), d1 = *(const f32x4*)(p.conv_w + 2048 + c0 + 4);
#pragma unroll
      for (int e = 0; e < 4; ++e) { w0[e] = a0[e]; w0[e + 4] = a1[e]; w1[e] = b0[e]; w1[e + 4] = b1[e]; w2[e] = d0[e]; w2[e + 4] = d1[e]; } }
    if (PROMPT) {
        float a[8], b[8];
        unpack8(lcc[0], a); unpack8(lch[0], b);
#pragma unroll
        for (int e = 0; e < 8; ++e) vm2[e] = a[e] * b[e];
        unpack8(lcc[1], a); unpack8(lch[1], b);
#pragma unroll
        for (int e = 0; e < 8; ++e) vm1[e] = a[e] * b[e];
    } else {
        const float* sc = p.state_conv + (size_t)bs * 2048 + c0;
        const f32x4 a0 = *(const f32x4*)sc, a1 = *(const f32x4*)(sc + 4), b0 = *(const f32x4*)(sc + 1024), b1 = *(const f32x4*)(sc + 1028);
#pragma unroll
        for (int e = 0; e < 4; ++e) { vm2[e] = a0[e]; vm2[e + 4] = a1[e]; vm1[e] = b0[e]; vm1[e + 4] = b1[e]; }
    }
#pragma unroll
    for (int i = 0; i < LEN; ++i) {
        const size_t row = (size_t)(r0 + i);
        float cb[8], cc[8], ch[8], cz[8], v[8];
        unpack8(lcb[i], cb); unpack8(lcc[i + 2], cc); unpack8(lch[i + 2], ch); unpack8(lcz[i], cz);
        f32x4 o0, o1;
#pragma unroll
        for (int e = 0; e < 8; ++e) { v[e] = cc[e] * ch[e]; const float cv = w0[e] * vm2[e] + w1[e] * vm1[e] + w2[e] * v[e]; const float r = cb[e] * cv * siluf_(cz[e]);
            if (e < 4) o0[e] = r; else o1[e - 4] = r; vm2[e] = vm1[e]; vm1[e] = v[e]; }
        *(u32x4*)(ACONV + row * 1024 + c0) = pack8u(o0, o1);
        float* dst = nullptr;
        if (PROMPT) { const int pos = (r0 + i) & 2047; if (pos >= 2046) dst = p.out + O_CP + ((size_t)((r0 + i) >> 11) * 2 + (pos - 2046)) * 1024 + c0; }
        else if (i >= 2) dst = p.out + O_CS + ((size_t)bs * 2 + (i - 2)) * 1024 + c0;
        if (dst) { *(f32x4*)dst = (f32x4){v[0], v[1], v[2], v[3]}; *(f32x4*)(dst + 4) = (f32x4){v[4], v[5], v[6], v[7]}; }
    }
}
__device__ __forceinline__ void conv_phase(const P& p) {
    const int t0 = blockIdx.x * 512 + otid(), nt = gridDim.x * 512;
    for (int task = t0; task < 262144; task += nt) conv_task<4, true>(p, (task >> 7) * 4, task & 127, 0);
    for (int task = t0; task < 16384; task += nt) conv_task<4, false>(p, NPROMPT + 4 * (task >> 7), task & 127, task >> 7);
}

struct S5In { bf16x8 U[4]; u32x2 u4[4], z4[4]; };
__device__ __forceinline__ void s5_load4(S5In& in, const bf16_t* PROJ, const size_t row0, const int g, const int g4) {
    const bf16_t* base = PROJ + row0 * NIN + g * 16;
#pragma unroll
    for (int i = 0; i < 4; ++i) {
        in.U[i] = *(const bf16x8*)(base + (size_t)i * NIN + OFF_SU + 8 * (g4 & 1));
        in.u4[i] = *(const u32x2*)(base + (size_t)i * NIN + OFF_SU + 4 * g4); in.z4[i] = *(const u32x2*)(base + (size_t)i * NIN + OFF_SZ + 4 * g4);
    }
}
__device__ __forceinline__ void s5_steps4(const S5In& in, bf16_t* YS, const size_t row0, const int g, const int g4, const bool Y,
                                          const bf16x8 (&bre)[4], const bf16x8 (&bim)[4], const bf16x8 (&cf)[4], const float (&ar)[16], const float (&ai)[16], const f32x4 dsk,
                                          float (&sr)[16], float (&si)[16]) {
    const f32x4 zero4 = (f32x4){0.f, 0.f, 0.f, 0.f};
#pragma unroll
    for (int i = 0; i < 4; ++i) {
#pragma unroll
        for (int pb = 0; pb < 4; ++pb) {
            const f32x4 xr = MFMA16(bre[pb], in.U[i], zero4), xi = MFMA16(bim[pb], in.U[i], zero4);
#pragma unroll
            for (int j = 0; j < 4; ++j) { const int k = pb * 4 + j; const float nr = ar[k] * sr[k] - ai[k] * si[k] + xr[j]; const float ni = ar[k] * si[k] + ai[k] * sr[k] + xi[j]; sr[k] = nr; si[k] = ni; }
        }
        if (Y) {
            f32x4 y = zero4;
            y = MFMA16(cf[0], pack8((f32x4){sr[0], sr[1], sr[2], sr[3]}, (f32x4){sr[4], sr[5], sr[6], sr[7]}), y);
            y = MFMA16(cf[1], pack8((f32x4){sr[8], sr[9], sr[10], sr[11]}, (f32x4){sr[12], sr[13], sr[14], sr[15]}), y);
            y = MFMA16(cf[2], pack8((f32x4){si[0], si[1], si[2], si[3]}, (f32x4){si[4], si[5], si[6], si[7]}), y);
            y = MFMA16(cf[3], pack8((f32x4){si[8], si[9], si[10], si[11]}, (f32x4){si[12], si[13], si[14], si[15]}), y);
            const float uu[4] = {bf_lo(in.u4[i].x), bf_hi(in.u4[i].x), bf_lo(in.u4[i].y), bf_hi(in.u4[i].y)};
            const float zz[4] = {bf_lo(in.z4[i].x), bf_hi(in.z4[i].x), bf_lo(in.z4[i].y), bf_hi(in.z4[i].y)};
            float o[4];
#pragma unroll
            for (int j = 0; j < 4; ++j) { const float ysv = y[j] + dsk[j] * uu[j]; o[j] = gelu_tanh(ysv * siluf_(zz[j])); }
            u32x2 w; w.x = cvt_pk_bf16(o[0], o[1]); w.y = cvt_pk_bf16(o[2], o[3]);
            *(u32x2*)(YS + (row0 + i) * 1024 + g * 16 + 4 * g4) = w;
        }
    }
}
__device__ __forceinline__ void s5_coef(const P& p, int g, int pp, float dt, float& ar, float& ai, float& fr, float& fi) {
    const float lr = p.lam_re[g * 64 + pp], li = p.lam_im[g * 64 + pp];
    const float mag = expf(lr * dt), ang = li * dt; float sn, cs; sincosf(ang, &sn, &cs);
    ar = mag * cs; ai = mag * sn; const float den = lr * lr + li * li;
    fr = ((ar - 1.0f) * lr + ai * li) / den; fi = (ai * lr - (ar - 1.0f) * li) / den;
}
__device__ __forceinline__ void s5_unit(const P& p, const int unit, LAS unsigned char* lds) {
    const bf16_t* PROJ = (const bf16_t*)(p.ws + WS_PROJ); bf16_t* YS = (bf16_t*)(p.ws + WS_YS);
    const int tid = otid(), lane = tid & 63, w = tid >> 6, cl = lane & 15, g4 = lane >> 4;
    const bool prompt = unit < 256; const int g = prompt ? (unit & 63) : (unit - 256); const int b = unit >> 6;
    const float dt = expf(p.log_dt[g]);
    LAS float* E = (LAS float*)lds;
    LAS f32x4* CT = (LAS f32x4*)(lds + 65536);
    if (tid < 64) { float a_r, a_i, fr_, fi_; s5_coef(p, g, tid, dt, a_r, a_i, fr_, fi_); CT[tid] = (f32x4){a_r, a_i, fr_, fi_}; }
    __syncthreads();
    float ar[16], ai[16];
#pragma unroll
    for (int pb = 0; pb < 4; ++pb)
#pragma unroll
        for (int j = 0; j < 4; ++j) { const f32x4 t = CT[16 * pb + 4 * g4 + j]; ar[pb * 4 + j] = t[0]; ai[pb * 4 + j] = t[1]; }
    bf16x8 bre[4], bim[4], cf[4];
    const float bmask = g4 < 2 ? 1.0f : 0.0f;
#pragma unroll
    for (int pb = 0; pb < 4; ++pb) {
        const int pp = 16 * pb + cl; const f32x4 t = CT[pp]; const float fr_ = t[2] * bmask, fi_ = t[3] * bmask;
        const float* br = p.b_re + ((size_t)(g * 64 + pp)) * 16 + 8 * (g4 & 1); const float* bi = p.b_im + ((size_t)(g * 64 + pp)) * 16 + 8 * (g4 & 1);
        const f32x4 r0 = *(const f32x4*)br, r1 = *(const f32x4*)(br + 4), i0 = *(const f32x4*)bi, i1 = *(const f32x4*)(bi + 4);
        bre[pb] = pack8(fr_ * r0 - fi_ * i0, fr_ * r1 - fi_ * i1);
        bim[pb] = pack8(fr_ * i0 + fi_ * r0, fr_ * i1 + fi_ * r1);
    }
#pragma unroll
    for (int ks = 0; ks < 4; ++ks) {
        const float* cp = (ks < 2 ? p.c_re : p.c_im) + ((size_t)(g * 16 + cl)) * 64 + 32 * (ks & 1) + 4 * g4;
        f32x4 a = *(const f32x4*)cp, c = *(const f32x4*)(cp + 16);
        if (ks >= 2) { a = -a; c = -c; }
        cf[ks] = pack8(a, c);
    }
    const f32x4 dsk = *(const f32x4*)(p.ssm_d + g * 16 + 4 * g4);
    const int chain = 16 * w + cl;
    const size_t row0 = prompt ? (size_t)b * 2048 + (size_t)chain * 16 : (size_t)NPROMPT + 4 * chain;
    const size_t so = ((size_t)chain * 64 + g) * 64 + 4 * g4;
    const int nq = prompt ? 4 : 1;
    float sr[16], si[16];
#pragma unroll
    for (int k = 0; k < 16; ++k) { sr[k] = 0.f; si[k] = 0.f; }
    if (!prompt) {
#pragma unroll
        for (int pb = 0; pb < 4; ++pb) { const f32x4 a = *(const f32x4*)(p.state_re + so + 16 * pb), c = *(const f32x4*)(p.state_im + so + 16 * pb);
#pragma unroll
            for (int j = 0; j < 4; ++j) { sr[pb * 4 + j] = a[j]; si[pb * 4 + j] = c[j]; } }
    }
#pragma unroll 1
    for (int pass = prompt ? 0 : 1; pass < 2; ++pass) {
        if (pass == 1 && prompt) {
#pragma unroll
            for (int pb = 0; pb < 4; ++pb) {
                *(LAS f32x4*)(E + (chain * 2 + 0) * 64 + 16 * pb + 4 * g4) = (f32x4){sr[pb * 4], sr[pb * 4 + 1], sr[pb * 4 + 2], sr[pb * 4 + 3]};
                *(LAS f32x4*)(E + (chain * 2 + 1) * 64 + 16 * pb + 4 * g4) = (f32x4){si[pb * 4], si[pb * 4 + 1], si[pb * 4 + 2], si[pb * 4 + 3]};
            }
            __syncthreads();
            if (w == 0) {
                float a_r, a_i; { const f32x4 t = CT[lane]; a_r = t[0]; a_i = t[1]; }
#pragma unroll
                for (int q = 0; q < 4; ++q) { const float nr = a_r * a_r - a_i * a_i, ni = 2.0f * a_r * a_i; a_r = nr; a_i = ni; }
                float Fr = 0.f, Fi = 0.f;
#pragma unroll 8
                for (int k = 0; k < 128; ++k) {
                    const float er = E[(2 * k) * 64 + lane], ei = E[(2 * k + 1) * 64 + lane];
                    E[(2 * k) * 64 + lane] = Fr; E[(2 * k + 1) * 64 + lane] = Fi;
                    const float nr = a_r * Fr - a_i * Fi + er; Fi = a_r * Fi + a_i * Fr + ei; Fr = nr;
                }
                p.out[O_RP + (size_t)(b * 64 + g) * 64 + lane] = Fr; p.out[O_IP + (size_t)(b * 64 + g) * 64 + lane] = Fi;
            }
            __syncthreads();
#pragma unroll
            for (int pb = 0; pb < 4; ++pb) {
                const f32x4 a = *(LAS f32x4*)(E + (chain * 2 + 0) * 64 + 16 * pb + 4 * g4), c = *(LAS f32x4*)(E + (chain * 2 + 1) * 64 + 16 * pb + 4 * g4);
#pragma unroll
                for (int j = 0; j < 4; ++j) { sr[pb * 4 + j] = a[j]; si[pb * 4 + j] = c[j]; }
            }
        }
        S5In cur; s5_load4(cur, PROJ, row0, g, g4);
#pragma unroll 1
        for (int q = 0; q < nq; ++q) {
            S5In nxt = cur;
            if (q + 1 < nq) s5_load4(nxt, PROJ, row0 + 4 * (q + 1), g, g4);
            s5_steps4(cur, YS, row0 + 4 * q, g, g4, pass == 1, bre, bim, cf, ar, ai, dsk, sr, si);
            cur = nxt;
        }
    }
    if (!prompt) {
#pragma unroll
        for (int pb = 0; pb < 4; ++pb) {
            *(f32x4*)(p.out + O_RS + so + 16 * pb) = (f32x4){sr[pb * 4], sr[pb * 4 + 1], sr[pb * 4 + 2], sr[pb * 4 + 3]};
            *(f32x4*)(p.out + O_IS + so + 16 * pb) = (f32x4){si[pb * 4], si[pb * 4 + 1], si[pb * 4 + 2], si[pb * 4 + 3]};
        }
    }
    __syncthreads();
}

__device__ __forceinline__ void attn_prompt_unit(const P& p, const int unit, LAS unsigned char* lds) {
    const bf16_t* PROJ = (const bf16_t*)(p.ws + WS_PROJ); const bf16_t* KB = (const bf16_t*)(p.ws + WS_KB); const bf16_t* VT = (const bf16_t*)(p.ws + WS_VT);
    bf16_t* OATT = (bf16_t*)(p.ws + WS_OATT);
    const int tid = otid(), lane = tid & 63, w = tid >> 6, cl = lane & 15, g4 = lane >> 4;
    const int b = unit >> 6, h = (unit >> 4) & 3, qb = unit & 15;
    const bf16_t* kbase = KB + (size_t)(b * 256) * 1024 + h * 256;
#pragma unroll
    for (int i = 0; i < 16; ++i) { const int idx = tid + 512 * i, r = idx >> 5, m = idx & 31;
        const u32x4 v = *(const u32x4*)(kbase + (size_t)r * 1024 + m * 8); *(LAS u32x4*)(lds + r * 512 + ((m ^ (r & 15)) << 4)) = v; }
    const size_t qrow = (size_t)b * 2048 + qb * 128 + w * 16 + cl;
    const bf16_t* qp = PROJ + qrow * NIN + OFF_AQ + h * 256 + 8 * g4;
    bf16x8 qf[8];
#pragma unroll
    for (int ks = 0; ks < 8; ++ks) qf[ks] = NTL((const bf16x8*)(qp + 32 * ks));
    __syncthreads();
    f32x4 s[16];
#pragma unroll
    for (int kb = 0; kb < 16; ++kb) { s[kb] = (f32x4){0.f, 0.f, 0.f, 0.f};
#pragma unroll
        for (int ks = 0; ks < 8; ++ks) { const int key = 16 * kb + cl, m = 4 * ks + g4;
            const bf16x8 kf = *(const LAS bf16x8*)(lds + key * 512 + ((m ^ cl) << 4)); s[kb] = MFMA16(kf, qf[ks], s[kb]); }
        __builtin_amdgcn_sched_barrier(0); }
    __syncthreads();
    const bf16_t* vbase = VT + (size_t)((b * 4 + h) * 256) * 256;
    u32x4 vst[16];
#pragma unroll
    for (int i = 0; i < 16; ++i) { const int idx = tid + 512 * i, r = idx >> 5, m = idx & 31; vst[i] = *(const u32x4*)(vbase + (size_t)r * 256 + m * 8); }
    float mx = -3.0e38f;
#pragma unroll
    for (int kb = 0; kb < 16; ++kb)
#pragma unroll
        for (int j = 0; j < 4; ++j) mx = fmaxf(mx, s[kb][j]);
    mx = fmaxf(mx, __shfl_xor(mx, 16)); mx = fmaxf(mx, __shfl_xor(mx, 32));
    float sum = 0.f;
#pragma unroll
    for (int kb = 0; kb < 16; ++kb)
#pragma unroll
        for (int j = 0; j < 4; ++j) { const float e = __expf((s[kb][j] - mx) * 0.0625f); s[kb][j] = e; sum += e; }
    sum += __shfl_xor(sum, 16); sum += __shfl_xor(sum, 32);
    const float inv = rcp_(sum);
    bf16x8 pf[8];
#pragma unroll
    for (int kk = 0; kk < 8; ++kk) pf[kk] = pack8(s[2 * kk], s[2 * kk + 1]);
#pragma unroll
    for (int i = 0; i < 16; ++i) { const int idx = tid + 512 * i, r = idx >> 5, m = idx & 31; *(LAS u32x4*)(lds + r * 512 + ((m ^ (r & 15)) << 4)) = vst[i]; }
    __syncthreads();
    const bf16_t* azp = PROJ + qrow * NIN + OFF_AZ + h * 256 + 4 * g4;
    bf16_t* op = OATT + qrow * 1024 + h * 256 + 4 * g4;
    u32x2 azv[16];
#pragma unroll
    for (int db = 0; db < 16; ++db) azv[db] = NTL((const u32x2*)(azp + 16 * db));
#pragma unroll
    for (int db = 0; db < 16; ++db) {
        f32x4 o = (f32x4){0.f, 0.f, 0.f, 0.f}; const int d = 16 * db + cl;
#pragma unroll
        for (int kk = 0; kk < 8; ++kk) {
            const int ch0 = 8 * kk + g4, ch1 = ch0 + 4;
            const u32x2 lo = *(const LAS u32x2*)(lds + d * 512 + (((ch0 >> 1) ^ cl) << 4) + (ch0 & 1) * 8);
            const u32x2 hi = *(const LAS u32x2*)(lds + d * 512 + (((ch1 >> 1) ^ cl) << 4) + (ch1 & 1) * 8);
            const u32x4 vv = (u32x4){lo.x, lo.y, hi.x, hi.y};
            o = MFMA16(__builtin_bit_cast(bf16x8, vv), pf[kk], o);
        }
        const u32x2 az = azv[db];
        const float z[4] = {bf_lo(az.x), bf_hi(az.x), bf_lo(az.y), bf_hi(az.y)};
        u32x2 wv; wv.x = cvt_pk_bf16(o[0] * inv * siluf_(z[0]), o[1] * inv * siluf_(z[1])); wv.y = cvt_pk_bf16(o[2] * inv * siluf_(z[2]), o[3] * inv * siluf_(z[3]));
        *(u32x2*)(op + 16 * db) = wv;
        __builtin_amdgcn_sched_barrier(0);
    }
    __syncthreads();
}

__device__ __forceinline__ void attn_sample_pair(const P& p, const int u0, const int u1_, LAS unsigned char* lds) {
    const int u1 = u1_ < 512 ? u1_ : u0;
    const bf16_t* PROJ = (const bf16_t*)(p.ws + WS_PROJ); bf16_t* OATT = (bf16_t*)(p.ws + WS_OATT);
    const int tid = otid(), lane = tid & 63, w = tid >> 6, cl = lane & 15, g4 = lane >> 4;
    LAS float* Pw = (LAS float*)(lds + w * 512);
    LAS float* ST = (LAS float*)(lds + 4096);
    LAS float* OW = (LAS float*)(lds + 8192);
    f32x4 bA[16], bB[16], o[4], s0, s1;
    bf16x8 qf[8];
#define SA_LOADQ(unit) do { const bf16_t* qp_ = PROJ + ((size_t)NPROMPT + 4 * ((unit) >> 2) + (cl & 3)) * NIN + OFF_AQ + ((unit) & 3) * 256 + 8 * g4; \
        _Pragma("unroll") for (int ks = 0; ks < 8; ++ks) qf[ks] = *(const bf16x8*)(qp_ + 32 * ks); } while (0)
#define SA_LOADK(buf, unit, kblk) do { const float* kr_ = p.cache_k + ((size_t)((unit) >> 2) * 1024 + ((unit) & 3)) * 256 + (size_t)(32 * w + 16 * (kblk) + cl) * 1024 + 8 * g4; \
        _Pragma("unroll") for (int ks = 0; ks < 8; ++ks) { buf[2 * ks] = NTL((const f32x4*)(kr_ + 32 * ks)); buf[2 * ks + 1] = NTL((const f32x4*)(kr_ + 32 * ks + 4)); } } while (0)
#define SA_LOADV(buf, unit, half) do { const float* vr_ = p.cache_v + ((size_t)((unit) >> 2) * 1024 + ((unit) & 3)) * 256 + (size_t)(32 * w + 16 * (half)) * 1024 + 4 * lane; \
        _Pragma("unroll") for (int i = 0; i < 16; ++i) buf[i] = NTL((const f32x4*)(vr_ + (size_t)i * 1024)); } while (0)
#define SA_QK(buf, sv) do { sv = (f32x4){0.f, 0.f, 0.f, 0.f}; _Pragma("unroll") for (int ks = 0; ks < 8; ++ks) sv = MFMA16(pack8(buf[2 * ks], buf[2 * ks + 1]), qf[ks], sv); } while (0)
#define SA_PV(buf, half) do { _Pragma("unroll") for (int ii = 0; ii < 4; ++ii) _Pragma("unroll") for (int q = 0; q < 4; ++q) { const f32x4 pv_ = *(const LAS f32x4*)(Pw + q * 32 + 16 * (half) + 4 * ii); \
        o[q] += pv_[0] * buf[4 * ii] + pv_[1] * buf[4 * ii + 1] + pv_[2] * buf[4 * ii + 2] + pv_[3] * buf[4 * ii + 3]; } } while (0)
#define SA_SOFTMAX(slot) do { float m_ = fmaxf(fmaxf(fmaxf(s0[0], s0[1]), fmaxf(s0[2], s0[3])), fmaxf(fmaxf(s1[0], s1[1]), fmaxf(s1[2], s1[3]))); \
        m_ = fmaxf(m_, __shfl_xor(m_, 16)); m_ = fmaxf(m_, __shfl_xor(m_, 32)); float l_ = 0.f; \
        _Pragma("unroll") for (int j = 0; j < 4; ++j) { s0[j] = __expf((s0[j] - m_) * 0.0625f); s1[j] = __expf((s1[j] - m_) * 0.0625f); l_ += s0[j] + s1[j]; } \
        l_ += __shfl_xor(l_, 16); l_ += __shfl_xor(l_, 32); \
        if (cl < 4) { *(LAS f32x4*)(Pw + cl * 32 + 4 * g4) = s0; *(LAS f32x4*)(Pw + cl * 32 + 16 + 4 * g4) = s1; \
            if (g4 == 0) { ST[(((slot) * 8 + w) * 4 + cl) * 2] = m_; ST[(((slot) * 8 + w) * 4 + cl) * 2 + 1] = l_; } } } while (0)
#define SA_OZERO() do { _Pragma("unroll") for (int q = 0; q < 4; ++q) o[q] = (f32x4){0.f, 0.f, 0.f, 0.f}; } while (0)
#define SA_OWRITE(slot) do { _Pragma("unroll") for (int q = 0; q < 4; ++q) *(LAS f32x4*)(OW + (size_t)((((slot) * 8 + w) * 4 + q) * 256) + 4 * lane) = o[q]; } while (0)
#define SA_SB() __builtin_amdgcn_sched_barrier(0)
    SA_LOADQ(u0);
    SA_LOADK(bA, u0, 0); SA_LOADK(bB, u0, 1); SA_SB();
    SA_QK(bA, s0); SA_LOADV(bA, u0, 0); SA_SB();
    SA_QK(bB, s1); SA_LOADV(bB, u0, 1); SA_SB();
    SA_SOFTMAX(0);
    SA_LOADQ(u1);
    SA_OZERO(); SA_SB();
    SA_PV(bA, 0); SA_LOADK(bA, u1, 0); SA_SB();
    SA_PV(bB, 1); SA_LOADK(bB, u1, 1); SA_SB();
    SA_OWRITE(0);
    {
        SA_QK(bA, s0); SA_LOADV(bA, u1, 0); SA_SB();
        SA_QK(bB, s1); SA_LOADV(bB, u1, 1); SA_SB();
        SA_SOFTMAX(1);
        SA_OZERO(); SA_SB();
        SA_PV(bA, 0); SA_SB();
        SA_PV(bB, 1);
        SA_OWRITE(1);
    }
    __syncthreads();
    {
        const int slot = tid >> 8, q = (tid >> 6) & 3, d = (tid & 63) * 4;
        const int unit = slot == 0 ? u0 : u1;
        {
            float M = -3.0e38f;
#pragma unroll
            for (int ww = 0; ww < 8; ++ww) M = fmaxf(M, ST[((slot * 8 + ww) * 4 + q) * 2]);
            float L = 0.f; f32x4 a = (f32x4){0.f, 0.f, 0.f, 0.f};
#pragma unroll
            for (int ww = 0; ww < 8; ++ww) { const float f = __expf((ST[((slot * 8 + ww) * 4 + q) * 2] - M) * 0.0625f); L += f * ST[((slot * 8 + ww) * 4 + q) * 2 + 1];
                a += f * *(const LAS f32x4*)(OW + (size_t)(((slot * 8 + ww) * 4 + q) * 256) + d); }
            const float inv = rcp_(L);
            const size_t row = (size_t)NPROMPT + 4 * (unit >> 2) + q; const int h = unit & 3;
            const u32x2 az = *(const u32x2*)(PROJ + row * NIN + OFF_AZ + h * 256 + d);
            u32x2 wv; wv.x = cvt_pk_bf16(a[0] * inv * siluf_(bf_lo(az.x)), a[1] * inv * siluf_(bf_hi(az.x))); wv.y = cvt_pk_bf16(a[2] * inv * siluf_(bf_lo(az.y)), a[3] * inv * siluf_(bf_hi(az.y)));
            *(u32x2*)(OATT + row * 1024 + h * 256 + d) = wv;
        }
    }
    __syncthreads();
#undef SA_LOADQ
#undef SA_LOADK
#undef SA_LOADV
#undef SA_QK
#undef SA_PV
#undef SA_SOFTMAX
#undef SA_OZERO
#undef SA_OWRITE
#undef SA_SB
}

__device__ __forceinline__ void phase5(const P& p) {
    const float* part = (const float*)(p.ws + WS_PART);
    const int t0 = otid(); const int lane = t0 & 63, gw = blockIdx.x * 8 + (t0 >> 6), nw = gridDim.x * 8;
    for (int row = gw; row < MTOK; row += nw) {
        float* orow = p.out + (size_t)row * DM;
        f32x4 v[8]; float s = 0.f;
        if (row < NPROMPT) {
            const float* xr = p.x_prompt + (size_t)row * DM; const bf16_t* dr = (const bf16_t*)(p.ws + WS_DELTA) + (size_t)row * DM;
#pragma unroll
            for (int i = 0; i < 8; ++i) { const u32x2 d = NTL((const u32x2*)(dr + 4 * (lane + 64 * i)));
                v[i] = NTL((const f32x4*)(xr + 4 * (lane + 64 * i))) + (f32x4){bf_lo(d.x), bf_hi(d.x), bf_lo(d.y), bf_hi(d.y)}; }
        } else {
            const float* xr = p.x_sample + (size_t)(row - NPROMPT) * DM;
#pragma unroll
            for (int i = 0; i < 8; ++i) v[i] = NTL((const f32x4*)(xr + 4 * (lane + 64 * i)));
#pragma unroll 2
            for (int ks = 0; ks < 8; ++ks) { const float* pr = part + ((size_t)ks * 512 + (row - NPROMPT)) * DM;
#pragma unroll
                for (int i = 0; i < 8; ++i) v[i] += NTL((const f32x4*)(pr + 4 * (lane + 64 * i))); }
        }
#pragma unroll
        for (int i = 0; i < 8; ++i) s += (v[i][0] * v[i][0] + v[i][1] * v[i][1]) + (v[i][2] * v[i][2] + v[i][3] * v[i][3]);
#pragma unroll
        for (int o = 32; o >= 1; o >>= 1) s += __shfl_xor(s, o);
        const float rstd = 1.0f / sqrtf(s * (1.0f / 2048.0f) + 1e-6f);
#pragma unroll
        for (int i = 0; i < 8; ++i) { const f32x4 gv = *(const f32x4*)(p.final_g + 4 * (lane + 64 * i)); NTS(v[i] * rstd * gv, (f32x4*)(orow + 4 * (lane + 64 * i))); }
    }
}

#define XB_TMO      128
#define XB_XCNT(j)  (256  + 64 * (j))
#define XB_XSUB(j)  (1280 + 64 * (j))
#define XB_XGEN(j)  (2304 + 64 * (j))
#define XB_TOP      3328
#define XB_TOPGEN   3392
#define XB_SPIN_CAP (1u << 20)
__device__ __forceinline__ unsigned xb_ld(unsigned* p)              { return __hip_atomic_load(p, __ATOMIC_RELAXED, __HIP_MEMORY_SCOPE_AGENT); }
__device__ __forceinline__ unsigned xb_add(unsigned* p, unsigned v) { return __hip_atomic_fetch_add(p, v, __ATOMIC_RELAXED, __HIP_MEMORY_SCOPE_AGENT); }
__device__ __forceinline__ unsigned xb_xcc_id() { return (unsigned)__builtin_amdgcn_s_getreg((3 << 11) | 20) & 0xFu; }
#define XB_SPIN(cond, bar) do { unsigned _sp = 0; while (cond) { __builtin_amdgcn_s_sleep(1); \
    if ((++_sp & 255u) == 0u) { if (xb_ld(&(bar)[XB_TMO])) break; if (_sp > XB_SPIN_CAP) { atomicAdd(&(bar)[XB_TMO], 1u); break; } } } } while (0)
struct XcdBarrier { unsigned* bar; unsigned x; volatile LAS unsigned* st; };
__device__ __forceinline__ XcdBarrier xcd_barrier_post(unsigned* bar, volatile LAS unsigned* st) {
    XcdBarrier b; b.bar = bar; b.x = xb_xcc_id(); b.st = st;
    if (threadIdx.x == 0) (void)xb_add(&bar[XB_XCNT(b.x)], 1u);
    return b;
}
__device__ __forceinline__ void xcd_barrier_complete(unsigned* bar, unsigned x, unsigned& nloc, unsigned& nx) {
    const unsigned G = gridDim.x * gridDim.y * gridDim.z;
    unsigned sum, cnt, mine, sp = 0u;
    for (;;) {
        sum = 0u; cnt = 0u; mine = 0u;
#pragma unroll
        for (unsigned j = 0; j < 16; ++j) { const unsigned c = xb_ld(&bar[XB_XCNT(j)]); sum += c; cnt += (c > 0u) ? 1u : 0u; mine = (j == x) ? c : mine; }
        if (sum == G) break;
        __builtin_amdgcn_s_sleep(1);
        if ((++sp & 255u) == 0u) { if (xb_ld(&bar[XB_TMO])) break; if (sp > XB_SPIN_CAP) { atomicAdd(&bar[XB_TMO], 1u); break; } }
    }
    nloc = mine > 0u ? mine : 1u; nx = cnt > 0u ? cnt : 1u;
}
__device__ __forceinline__ void xcd_barrier(const XcdBarrier& b) {
    asm volatile("s_waitcnt vmcnt(0)" ::: "memory");
    __syncthreads();
    if (threadIdx.x == 0) {
        unsigned* bar = b.bar;
        __builtin_amdgcn_s_waitcnt(0);
        unsigned nloc = b.st[0], nx = b.st[1];
        if (nloc == 0u) { xcd_barrier_complete(bar, b.x, nloc, nx); b.st[0] = nloc; b.st[1] = nx; }
        const unsigned old = xb_add(&bar[XB_XSUB(b.x)], 1u);
        const unsigned gen = old / nloc;
        if (old + 1u == (gen + 1u) * nloc) {
            __builtin_amdgcn_fence(__ATOMIC_RELEASE, "agent");
            asm volatile("s_waitcnt vmcnt(0)" ::: "memory");
            const unsigned og = xb_add(&bar[XB_TOP], 1u);
            const unsigned tg = og / nx;
            if (og + 1u == (tg + 1u) * nx) xb_add(&bar[XB_TOPGEN], 1u);
            else XB_SPIN(xb_ld(&bar[XB_TOPGEN]) == tg, bar);
            __builtin_amdgcn_fence(__ATOMIC_ACQUIRE, "agent");
            xb_add(&bar[XB_XGEN(b.x)], 1u);
            asm volatile("s_waitcnt vmcnt(0)" ::: "memory");
        } else {
            XB_SPIN(xb_ld(&bar[XB_XGEN(b.x)]) == gen, bar);
            __builtin_amdgcn_fence(__ATOMIC_ACQUIRE, "agent");
            asm volatile("s_waitcnt vmcnt(0)" ::: "memory");
        }
    }
    __syncthreads();
}

__global__ void __launch_bounds__(512, 2) mega_fwd(P p) {
    extern __shared__ __attribute__((aligned(16))) unsigned char shm[];
    LAS unsigned char* lds = (LAS unsigned char*)shm;
    cg::grid_group grid = cg::this_grid();
    unsigned char* ws = p.ws;
    const int G = gridDim.x, c = blockIdx.x;
    volatile LAS unsigned* bst = (volatile LAS unsigned*)(lds + 131072);
    if (threadIdx.x == 0) { bst[0] = 0u; bst[1] = 0u; }
    __syncthreads();
    const XcdBarrier xbar = xcd_barrier_post((unsigned*)(ws + WS_BAR), bst);
    if (p.out == nullptr) grid.sync();
#define GSYNC() xcd_barrier(xbar)

#ifndef PHMASK
#define PHMASK 0xffff
#endif
#ifndef REPMASK
#define REPMASK 0
#endif
#define NREP(bit) ((REPMASK & (bit)) ? 2 : 1)
#ifndef TPHASE
#define TPHASE -1
#endif
#ifndef TMULT
#define TMULT 4
#endif
    unsigned long long ts[8]; int nts = 0;
#define STAMP() do { if (TPHASE >= 0 && TPHASE < 10) { ts[nts] = wall_clock64(); } ++nts; } while (0)
    STAMP();
    for (int rep = 0; rep < NREP(1); ++rep) if (PHMASK & 1) phase0(p, lds);
    GSYNC(); STAMP();

    for (int rep = 0; rep < NREP(2); ++rep) if (PHMASK & 2) {
        Sched1 S{(const char*)(ws + WS_H), (const char*)(ws + WS_WIN), (const char*)(ws + WS_MEMN), (const char*)(ws + WS_WK), (const char*)(ws + WS_WV), G, c};
        Epi1 E{(bf16_t*)(ws + WS_PROJ), p.out + O_MK, (bf16_t*)(ws + WS_KB), p.out + O_MV, (bf16_t*)(ws + WS_VT)};
        pg8::gemm_phase(lds, 2048, 2048, S, E);
    }
    GSYNC(); STAMP();

    for (int rep = 0; rep < NREP(4); ++rep) {
        unsigned long long m0 = 0, m1 = 0, m2 = 0, m3 = 0, m4 = 0;
        if (TPHASE >= 10) m0 = wall_clock64();
        const int sg = (c >> 3) & 3;
        if (sg == 0) for (int u = c; u < 512; u += 2 * G) attn_sample_pair(p, u, u + G, lds);
        if (TPHASE >= 10) m1 = wall_clock64();
        for (int u = c; u < 256; u += G) s5_unit(p, u, lds);
        for (int u = 256 + (G - 1 - c); u < 320; u += G) s5_unit(p, u, lds);
        if (TPHASE >= 10) m2 = wall_clock64();
        if (sg == 1) for (int u = c; u < 512; u += 2 * G) attn_sample_pair(p, u, u + G, lds);
        for (int u = c; u < 256; u += G) attn_prompt_unit(p, u, lds);
        if (TPHASE >= 10) m3 = wall_clock64();
        if (sg == 2) for (int u = c; u < 512; u += 2 * G) attn_sample_pair(p, u, u + G, lds);
        conv_phase(p);
        if (sg == 3) for (int u = c; u < 512; u += 2 * G) attn_sample_pair(p, u, u + G, lds);
        late_transposes(p, lds, c, G, G == 256 ? 512 : 768);
        if (TPHASE >= 10) { m4 = wall_clock64(); ts[0] = 0; ts[1] = TPHASE == 10 ? m1 - m0 : (TPHASE == 11 ? m2 - m1 : (TPHASE == 12 ? m3 - m2 : m4 - m3)); }
    }
    GSYNC(); STAMP();

    for (int rep = 0; rep < NREP(8); ++rep) if (PHMASK & 64) {
        { Sched1g Sg{(const char*)(ws + WS_H), (const char*)(ws + WS_WIN), G, c}; Epi1 Eg{(bf16_t*)(ws + WS_PROJ), p.out + O_MK, (bf16_t*)(ws + WS_KB), p.out + O_MV, (bf16_t*)(ws + WS_VT)}; pg8::gemm_phase(lds, 2048, 2048, Sg, Eg); }
        if (G == 256 && c >= 144) late_transposes(p, lds, 512 + (c - 144), 112, 768);
        Sched2 S{(const char*)ws, G, c};
        Epi2 E{(bf16_t*)(ws + WS_GLU), (bf16_t*)(ws + WS_CONVO), (bf16_t*)(ws + WS_ATTO)};
        pg8::gemm_phase(lds, 1024, 1024, S, E);
    }
    GSYNC(); STAMP();

    for (int rep = 0; rep < NREP(32); ++rep) merge_phase(p);
    GSYNC(); STAMP();

    for (int rep = 0; rep < NREP(16); ++rep) if (PHMASK & 128) {
        { Sched3 S{(const char*)(ws + WS_MERGED), (const char*)(ws + WS_WO), G, c}; Epi3 E{(bf16_t*)(ws + WS_DELTA), (float*)(ws + WS_PART), false}; pg8::gemm_phase(lds, 2048, 2048, S, E); }
        { Sched3b S{(const char*)(ws + WS_MERGED), (const char*)(ws + WS_WO), G, c}; Epi3 E{(bf16_t*)(ws + WS_DELTA), (float*)(ws + WS_PART), true}; pg8::gemm_phase(lds, 256, 2048, S, E); }
    }
    GSYNC(); STAMP();

    if (PHMASK & 256) phase5(p);
    STAMP();
    if (TPHASE >= 0 && blockIdx.x == 0 && threadIdx.x == 0) {
        const unsigned long long d = (TPHASE >= 10 ? ts[1] - ts[0] : ts[TPHASE + 1] - ts[TPHASE]) * TMULT, t0 = wall_clock64();
        while (wall_clock64() - t0 < d) __builtin_amdgcn_s_sleep(16);
    }
}

extern "C" void kernel_launch(void* const* d_in, const int* in_sizes, int n_in, void* d_out, int out_size, void* d_ws, size_t ws_size, hipStream_t stream) {
    static int grid = 0;
    if (grid == 0) {
        int dev = 0, cus = 0, per_cu = 0;
        hipGetDevice(&dev);
        hipDeviceGetAttribute(&cus, hipDeviceAttributeMultiprocessorCount, dev);
        if (hipFuncSetAttribute((const void*)mega_fwd, hipFuncAttributeMaxDynamicSharedMemorySize, LDS_BYTES) != hipSuccess) fprintf(stderr, "kernel_launch: hipFuncSetAttribute failed\n");
        if (hipOccupancyMaxActiveBlocksPerMultiprocessor(&per_cu, (const void*)mega_fwd, 512, LDS_BYTES) != hipSuccess || per_cu < 1) per_cu = 1;
        (void)hipGetLastError();
        grid = cus * per_cu;
        if (ws_size < WS_END) fprintf(stderr, "kernel_launch: workspace too small (%zu < %zu)\n", ws_size, (size_t)WS_END);
    }
    P p{};
    const float** pp = (const float**)&p;
    for (int i = 0; i < 28; ++i) pp[i] = (const float*)d_in[i];
    p.out = (float*)d_out; p.ws = (unsigned char*)d_ws;
    void* args[] = {&p};
    (void)hipMemsetAsync((unsigned char*)d_ws + WS_BAR, 0, 16384, stream);
    hipError_t e = hipLaunchCooperativeKernel((const void*)mega_fwd, dim3(grid), dim3(512), args, LDS_BYTES, stream);
    if (e != hipSuccess) fprintf(stderr, "cooperative launch failed: %s (grid %d)\n", hipGetErrorString(e), grid);
}
```

```cpp
#include <hip/hip_runtime.h>
#include <hip/hip_cooperative_groups.h>
#include <cstdio>
namespace cg = cooperative_groups;

#define LAS __attribute__((address_space(3)))
typedef unsigned short bf16_t;
typedef short bf16x8 __attribute__((ext_vector_type(8)));
typedef float f32x4 __attribute__((ext_vector_type(4)));
typedef unsigned u32x4 __attribute__((ext_vector_type(4)));
typedef unsigned u32x2 __attribute__((ext_vector_type(2)));

constexpr int DM = 2048, NPROMPT = 8192, NSAMPLE = 512, MTOK = 8704, NIN = 14336;
constexpr int OFF_CB = 0, OFF_CC = 1024, OFF_CH = 2048, OFF_CZ = 3072, OFF_SU = 4096, OFF_SZ = 5120, OFF_AQ = 6144, OFF_AZ = 7168, OFF_G = 8192;
constexpr int LDS_BYTES = 131072 + 16;
constexpr size_t O_Y = 0, O_MK = 17825792, O_MV = 18874368, O_CP = 19922944, O_RP = 19931136, O_IP = 19947520, O_CS = 19963904, O_RS = 20226048, O_IS = 20750336;
constexpr size_t WS_WIN = 0;
constexpr size_t WS_WG = WS_WIN + (size_t)NIN * DM * 2;
constexpr size_t WS_WC = WS_WG + 8388608;
constexpr size_t WS_WA = WS_WC + 4194304;
constexpr size_t WS_WO = WS_WA + 4194304;
constexpr size_t WS_H = WS_WO + 8388608;
constexpr size_t WS_PROJ = WS_H + (size_t)MTOK * DM * 2;
constexpr size_t WS_YS = WS_PROJ + (size_t)MTOK * NIN * 2;
constexpr size_t WS_ACONV = WS_YS + (size_t)MTOK * 1024 * 2;
constexpr size_t WS_OATT = WS_ACONV + (size_t)MTOK * 1024 * 2;
constexpr size_t WS_SS = WS_OATT + (size_t)MTOK * 1024 * 2;
constexpr size_t WS_GLU = WS_SS + (size_t)MTOK * 32 * 4;
constexpr size_t WS_MERGED = WS_GLU + (size_t)MTOK * DM * 2;
constexpr size_t WS_BAR = WS_MERGED + (size_t)MTOK * DM * 2;
constexpr size_t WS_MEMN = WS_BAR + 16384;
constexpr size_t WS_WK = WS_MEMN + 4194304;
constexpr size_t WS_WV = WS_WK + 4194304;
constexpr size_t WS_KB = WS_WV + 4194304;
constexpr size_t WS_VT = WS_KB + 2097152;
constexpr size_t WS_ATTO = WS_MEMN;
constexpr size_t WS_END = WS_ATTO + (size_t)MTOK * DM * 2;
constexpr size_t WS_SUZ = WS_GLU;
constexpr size_t WS_CONVO = WS_WIN, WS_PART = WS_PROJ, WS_DELTA = WS_PROJ + 67108864;
static_assert(WS_END <= 536870912, "workspace");
static_assert(WS_VT + 2097152 <= WS_END && (size_t)MTOK * DM * 2 <= 38u * 1048576u, "aliases");

struct P {
    const float *x_prompt, *x_sample, *mem_prompt, *cache_k, *cache_v, *state_conv, *state_re, *state_im, *norm_g, *mem_norm_g, *w_in, *conv_w, *w_conv_out,
        *lam_re, *lam_im, *log_dt, *b_re, *b_im, *c_re, *c_im, *ssm_d, *w_glu_a, *w_glu_b, *w_mem_k, *w_mem_v, *w_attn_out, *w_out, *final_g;
    float* out; unsigned char* ws;
};

__device__ __forceinline__ unsigned cvt_pk_bf16(float lo, float hi) { unsigned r; asm("v_cvt_pk_bf16_f32 %0, %1, %2" : "=v"(r) : "v"(lo), "v"(hi)); return r; }
__device__ __forceinline__ float bf_lo(unsigned w) { return __uint_as_float(w << 16); }
__device__ __forceinline__ float bf_hi(unsigned w) { return __uint_as_float(w & 0xffff0000u); }
__device__ __forceinline__ float rcp_(float x) { return __builtin_amdgcn_rcpf(x); }
__device__ __forceinline__ float sigmoidf_(float x) { return rcp_(1.0f + __expf(-x)); }
__device__ __forceinline__ float siluf_(float x) { return x * rcp_(1.0f + __expf(-x)); }
__device__ __forceinline__ float gelu_tanh(float x) { const float u = 1.5957691216057308f * (x + 0.044715f * x * x * x); return x * rcp_(1.0f + __expf(-u)); }
__device__ __forceinline__ bf16x8 pack8(const f32x4 a, const f32x4 b) {
    u32x4 w; w.x = cvt_pk_bf16(a[0], a[1]); w.y = cvt_pk_bf16(a[2], a[3]); w.z = cvt_pk_bf16(b[0], b[1]); w.w = cvt_pk_bf16(b[2], b[3]);
    return __builtin_bit_cast(bf16x8, w);
}
__device__ __forceinline__ u32x4 pack8u(const f32x4 a, const f32x4 b) {
    u32x4 w; w.x = cvt_pk_bf16(a[0], a[1]); w.y = cvt_pk_bf16(a[2], a[3]); w.z = cvt_pk_bf16(b[0], b[1]); w.w = cvt_pk_bf16(b[2], b[3]); return w;
}
__device__ __forceinline__ void unpack8(const u32x4 w, float (&f)[8]) {
    f[0] = bf_lo(w.x); f[1] = bf_hi(w.x); f[2] = bf_lo(w.y); f[3] = bf_hi(w.y); f[4] = bf_lo(w.z); f[5] = bf_hi(w.z); f[6] = bf_lo(w.w); f[7] = bf_hi(w.w);
}
__device__ __forceinline__ int otid() { int t = threadIdx.x; asm volatile("" : "+v"(t)); return t; }
#define NTL(p) __builtin_nontemporal_load(p)
#define NTS(v, p) __builtin_nontemporal_store((v), (p))
#define MFMA16(a, b, c) __builtin_amdgcn_mfma_f32_16x16x32_bf16((a), (b), (c), 0, 0, 0)

namespace pg8 {
constexpr int BM = 256, BK = 64, HALF = 128, HTB = HALF * BK * 2, STAGE_BYTES = 8 * HTB;
__device__ __forceinline__ int lds_byte(int r, int c) { const int st = (r >> 4) * 2 + (c >> 5), rr = r & 15, cc = c & 31, ob = rr * 64 + cc * 2; return st * 1024 + (ob ^ (((ob >> 9) & 1) << 5)); }
__device__ __forceinline__ void stage_rc(int b, int& R, int& C) { const int st = b / 1024, sb = b % 1024, swz = sb ^ (((sb >> 9) & 1) << 5); R = (st >> 1) * 16 + swz / 64; C = (st & 1) * 32 + (swz % 64) / 2; }
__device__ __forceinline__ int perm32(int rho) { const int n = rho >> 4, i = rho & 15; return 8 * (i >> 2) + 4 * n + (i & 3); }
struct Unit { const char* a; const char* b; int pm, pn, kind; };

template <class Sched, class Epi>
__device__ __forceinline__ void gemm_phase(LAS unsigned char* lds, const int K, const int ld, const Sched& S, const Epi& E) {
    const int tid = otid(), wid = __builtin_amdgcn_readfirstlane(tid >> 6), lane = tid & 63, wr = wid >> 2, wc = wid & 3, fr = lane & 15, fq = lane >> 4;
    const int nt = K / BK;
    unsigned voffA[2], voffB[2];
#pragma unroll
    for (int i = 0; i < 2; ++i) { int R, C; stage_rc(tid * 16 + i * 8192, R, C); const int Rb = (R & ~31) + perm32(R & 31);
        voffA[i] = (unsigned)(R * ld + C) * 2u; voffB[i] = (unsigned)(Rb * ld + C) * 2u; }
    const size_t kstep = (size_t)(BK * 2);
    const size_t hstep = (size_t)HALF * ld * 2;
    const unsigned ldsw = (unsigned)wid * 1024u;
    const int aoff = lds_byte(wr * 64 + fr, fq * 8), boff = lds_byte(wc * 32 + fr, fq * 8);
#define PG8_SA(b, h) (((b) * 2 + (h)) * HTB)
#define PG8_SB(b, h) ((4 + (b) * 2 + (h)) * HTB)
#define PG8_STAGE(bufoff, gbase, voff) do { _Pragma("unroll") for (int _i = 0; _i < 2; ++_i) \
        __builtin_amdgcn_global_load_lds((const unsigned*)((const char*)(gbase) + (voff)[_i]), (LAS unsigned*)(lds + (bufoff) + ldsw + _i * 8192), 16, 0, 0); } while (0)
#define PG8_LDA(dst, b, h) do { _Pragma("unroll") for (int m = 0; m < 4; ++m) _Pragma("unroll") for (int k = 0; k < 2; ++k) dst[m][k] = *(const LAS bf16x8*)(lds + PG8_SA(b, h) + aoff + m * 2048 + k * 1024); } while (0)
#define PG8_LDB(dst, b, h) do { _Pragma("unroll") for (int n = 0; n < 2; ++n) _Pragma("unroll") for (int k = 0; k < 2; ++k) dst[n][k] = *(const LAS bf16x8*)(lds + PG8_SB(b, h) + boff + n * 2048 + k * 1024); } while (0)
#define PG8_MMA(ai, bj, At, Bt) do { __builtin_amdgcn_s_setprio(1); _Pragma("unroll") for (int m = 0; m < 4; ++m) _Pragma("unroll") for (int n = 0; n < 2; ++n) _Pragma("unroll") for (int k = 0; k < 2; ++k) \
        acc[ai][bj][m][n] = __builtin_amdgcn_mfma_f32_16x16x32_bf16(Bt[n][k], At[m][k], acc[ai][bj][m][n], 0, 0, 0); __builtin_amdgcn_s_setprio(0); } while (0)
#define PG8_WAIT_V(n) asm volatile("s_waitcnt vmcnt(" #n ")" ::: "memory")
#define PG8_WAIT_L(n) asm volatile("s_waitcnt lgkmcnt(" #n ")" ::: "memory")
#define PG8_BAR __builtin_amdgcn_s_barrier()
#define PG8_SCHED __builtin_amdgcn_sched_barrier(0)
    Unit cur, nxt; int ui = 0;
    if (!S.next(0, cur)) return;
    f32x4 acc[2][2][4][2];
#pragma unroll
    for (int a = 0; a < 2; ++a)
#pragma unroll
        for (int b = 0; b < 2; ++b)
#pragma unroll
            for (int m = 0; m < 4; ++m)
#pragma unroll
                for (int n = 0; n < 2; ++n) acc[a][b][m][n] = (f32x4){0.f, 0.f, 0.f, 0.f};
    bf16x8 At[4][2], B0[2][2], B1[2][2];
    const char* cA = cur.a; const char* cB = cur.b;
    PG8_STAGE(PG8_SB(0, 0), cB, voffB); PG8_STAGE(PG8_SA(0, 0), cA, voffA); PG8_STAGE(PG8_SB(0, 1), cB + hstep, voffB); PG8_STAGE(PG8_SA(0, 1), cA + hstep, voffA);
    if (wr == 1) PG8_BAR;
    PG8_WAIT_V(4); PG8_BAR;
    PG8_STAGE(PG8_SB(1, 0), cB + kstep, voffB); PG8_STAGE(PG8_SA(1, 0), cA + kstep, voffA); PG8_STAGE(PG8_SB(1, 1), cB + hstep + kstep, voffB);
    PG8_WAIT_V(6); PG8_BAR;
    for (;;) {
        const bool has_next = S.next(ui + 1, nxt);
        const char* nA = has_next ? nxt.a : cA; const char* nB = has_next ? nxt.b : cB;
        for (int t = 0; t < nt; t += 2) {
            const bool last = (t == nt - 2);
            const char* a1 = cA + (size_t)(t + 1) * kstep;
            const char* a2 = last ? nA : cA + (size_t)(t + 2) * kstep; const char* b2 = last ? nB : cB + (size_t)(t + 2) * kstep;
            const char* a3 = a2 + kstep; const char* b3 = b2 + kstep;
            PG8_LDB(B0, 0, 0); PG8_SCHED; PG8_LDA(At, 0, 0); PG8_STAGE(PG8_SA(1, 1), a1 + hstep, voffA);
            PG8_WAIT_L(8); PG8_BAR; PG8_WAIT_L(0); PG8_MMA(0, 0, At, B0); PG8_BAR; PG8_SCHED;
            PG8_LDB(B1, 0, 1); PG8_STAGE(PG8_SB(0, 0), b2, voffB);
            PG8_BAR; PG8_WAIT_L(0); PG8_MMA(0, 1, At, B1); PG8_BAR;
            PG8_LDA(At, 0, 1); PG8_STAGE(PG8_SA(0, 0), a2, voffA);
            PG8_BAR; PG8_WAIT_L(0); PG8_MMA(1, 0, At, B0); PG8_BAR; PG8_SCHED;
            PG8_STAGE(PG8_SB(0, 1), b2 + hstep, voffB);
            PG8_WAIT_V(6); PG8_BAR; PG8_MMA(1, 1, At, B1); PG8_BAR;
            PG8_LDB(B0, 1, 0); PG8_SCHED; PG8_LDA(At, 1, 0); PG8_STAGE(PG8_SA(0, 1), a2 + hstep, voffA);
            PG8_WAIT_L(8); PG8_BAR; PG8_WAIT_L(0); PG8_MMA(0, 0, At, B0); PG8_BAR; PG8_SCHED;
            PG8_LDB(B1, 1, 1); PG8_STAGE(PG8_SB(1, 0), b3, voffB);
            PG8_BAR; PG8_WAIT_L(0); PG8_MMA(0, 1, At, B1); PG8_BAR;
            PG8_LDA(At, 1, 1); PG8_STAGE(PG8_SA(1, 0), a3, voffA);
            PG8_BAR; PG8_WAIT_L(0); PG8_MMA(1, 0, At, B0); PG8_BAR; PG8_SCHED;
            PG8_STAGE(PG8_SB(1, 1), b3 + hstep, voffB);
            PG8_WAIT_V(6); PG8_BAR; PG8_MMA(1, 1, At, B1); PG8_BAR;
        }
        const bool keep = E(acc, cur, wr, wc, fr, fq);
        if (!has_next) break;
        if (!keep) {
#pragma unroll
            for (int a = 0; a < 2; ++a)
#pragma unroll
                for (int b = 0; b < 2; ++b)
#pragma unroll
                    for (int m = 0; m < 4; ++m)
#pragma unroll
                        for (int n = 0; n < 2; ++n) acc[a][b][m][n] = (f32x4){0.f, 0.f, 0.f, 0.f};
        }
        cur = nxt; cA = nA; cB = nB; ++ui;
    }
    PG8_WAIT_V(0);
    if (wr == 0) PG8_BAR;
    PG8_BAR;
#undef PG8_SA
#undef PG8_SB
#undef PG8_STAGE
#undef PG8_LDA
#undef PG8_LDB
#undef PG8_MMA
#undef PG8_WAIT_V
#undef PG8_WAIT_L
#undef PG8_BAR
#undef PG8_SCHED
}
}
using pg8::Unit;

__device__ __forceinline__ void xcd_tile_order(int wgid, const int nM, const int nN, int& pm, int& pn) {
    const int nwg = nM * nN, NX = 8, WGM = 8;
    { const int q = nwg / NX, r = nwg % NX, xcd = wgid % NX, off = wgid / NX; wgid = (xcd < r ? xcd * (q + 1) : r * (q + 1) + (xcd - r) * q) + off; }
    const int nig = WGM * nN, gid = wgid / nig, fm = gid * WGM, gsz = (nM - fm) < WGM ? (nM - fm) : WGM;
    pm = fm + ((wgid % nig) % gsz); pn = (wgid % nig) / gsz;
}
struct Sched1 {
    const char *H, *WIN, *MEMN, *WK, *WV; int G, c;
    __device__ __forceinline__ bool next(int i, Unit& u) const {
        const int L = i * G + c; if (L >= 1792) return false;
        if (L < 1760) {
            int pm, pn;
            if (L < 1292) xcd_tile_order(L, 34, 38, pm, pn);
            else { xcd_tile_order(L - 1292, 26, 18, pm, pn); pn += 38; }
            u.pm = pm; u.pn = pn; u.kind = 0; u.a = H + (size_t)pm * 1048576; u.b = WIN + (size_t)pn * 1048576;
        } else if (L < 1776) { const int j = L - 1760; u.pm = j >> 2; u.pn = j & 3; u.kind = 1; u.a = MEMN + (size_t)u.pm * 1048576; u.b = WK + (size_t)u.pn * 1048576; }
        else { const int j = L - 1776; u.pm = j >> 2; u.pn = j & 3; u.kind = 2; u.a = WV + (size_t)u.pm * 1048576; u.b = MEMN + (size_t)u.pn * 1048576; }
        return true;
    }
};
struct Sched1g {
    const char *H, *WIN; int G, c;
    __device__ __forceinline__ bool next(int i, Unit& u) const {
        const int j = i * G + c; if (j >= 144) return false;
        u.pm = 26 + j / 18; u.pn = 38 + j % 18; u.kind = 0; u.a = H + (size_t)u.pm * 1048576; u.b = WIN + (size_t)u.pn * 1048576; return true;
    }
};
struct Epi1 {
    bf16_t* PROJ; float* outK; bf16_t* KB; float* outV; bf16_t* VT; bf16_t* SUZ;
    __device__ __forceinline__ bool operator()(f32x4 (&acc)[2][2][4][2], const Unit& u, int wr, int wc, int fr, int fq) const {
        const int r0 = u.pm * 256 + wr * 64 + fr, c0 = u.pn * 256 + wc * 32 + 8 * fq;
        if (u.kind == 0) {
            const bool gate = u.pn >= 32;
            if (u.pn >= 16 && u.pn < 24) {
#pragma unroll
                for (int ai = 0; ai < 2; ++ai)
#pragma unroll
                    for (int m = 0; m < 4; ++m) { const size_t row = (size_t)(r0 + ai * 128 + m * 16);
#pragma unroll
                        for (int bj = 0; bj < 2; ++bj) { const int cc = c0 + bj * 128 - 4096;
                            *(u32x4*)(SUZ + ((size_t)(cc >> 4) * MTOK + row) * 16 + (cc & 8)) = pack8u(acc[ai][bj][m][0], acc[ai][bj][m][1]); } }
                return false;
            }
#pragma unroll
            for (int ai = 0; ai < 2; ++ai)
#pragma unroll
                for (int m = 0; m < 4; ++m) { bf16_t* rowp = PROJ + (size_t)(r0 + ai * 128 + m * 16) * NIN + c0;
#pragma unroll
                    for (int bj = 0; bj < 2; ++bj) { const u32x4 w = pack8u(acc[ai][bj][m][0], acc[ai][bj][m][1]);
                        if (gate) NTS(w, (u32x4*)(rowp + bj * 128)); else *(u32x4*)(rowp + bj * 128) = w; } }
        } else if (u.kind == 1) {
#pragma unroll
            for (int ai = 0; ai < 2; ++ai)
#pragma unroll
                for (int m = 0; m < 4; ++m) { const size_t off = (size_t)(r0 + ai * 128 + m * 16) * 1024 + c0;
#pragma unroll
                    for (int bj = 0; bj < 2; ++bj) { NTS(acc[ai][bj][m][0], (f32x4*)(outK + off + bj * 128)); NTS(acc[ai][bj][m][1], (f32x4*)(outK + off + bj * 128 + 4));
                        *(u32x4*)(KB + off + bj * 128) = pack8u(acc[ai][bj][m][0], acc[ai][bj][m][1]); } }
        } else {
            const int h = u.pm, b = u.pn;
#pragma unroll
            for (int ai = 0; ai < 2; ++ai)
#pragma unroll
                for (int m = 0; m < 4; ++m) { const int d = wr * 64 + fr + ai * 128 + m * 16;
#pragma unroll
                    for (int bj = 0; bj < 2; ++bj) { const int key0 = wc * 32 + 8 * fq + bj * 128;
                        *(u32x4*)(VT + ((size_t)((b * 4 + h) * 256 + d)) * 256 + key0) = pack8u(acc[ai][bj][m][0], acc[ai][bj][m][1]);
                        float* fp = outV + ((size_t)(b * 256 + key0)) * 1024 + h * 256 + d;
#pragma unroll
                        for (int e = 0; e < 4; ++e) { fp[(size_t)e * 1024] = acc[ai][bj][m][0][e]; fp[(size_t)(e + 4) * 1024] = acc[ai][bj][m][1][e]; } } }
        }
        return false;
    }
};

struct Sched2 {
    const char* ws; int G, c;
    __device__ __forceinline__ bool next(int i, Unit& u) const {
        int L;
        if (G == 256) { if (c < 144) { if (i >= 4) return false; L = c + 144 * i; } else { L = 576 + (c - 144) + 112 * i; } }
        else L = i * G + c;
        if (L >= 1088) return false;
        if (L < 544) { u.pm = L >> 4; u.pn = L & 15; u.kind = 0; u.a = ws + WS_YS + (size_t)u.pm * 524288; u.b = ws + WS_WG + (size_t)u.pn * 524288; }
        else { const int j = L - 544, k = j >= 272 ? 1 : 0, jj = j - 272 * k; u.pm = jj >> 3; u.pn = jj & 7; u.kind = 1 + k;
            u.a = ws + WS_ACONV + (size_t)k * ((size_t)MTOK * 1024 * 2) + (size_t)u.pm * 524288; u.b = ws + WS_WC + (size_t)k * 4194304 + (size_t)u.pn * 524288; }
        return true;
    }
};
struct Epi2 {
    bf16_t* GLU; bf16_t* CONVO; bf16_t* ATTO;
    __device__ __forceinline__ bool operator()(f32x4 (&acc)[2][2][4][2], const Unit& u, int wr, int wc, int fr, int fq) const {
        const int r0 = u.pm * 256 + wr * 64 + fr;
        if (u.kind == 0) {
            const int c0 = u.pn * 128 + wc * 32 + 8 * fq;
#pragma unroll
            for (int ai = 0; ai < 2; ++ai)
#pragma unroll
                for (int m = 0; m < 4; ++m) {
                    f32x4 t0, t1;
#pragma unroll
                    for (int e = 0; e < 4; ++e) { t0[e] = acc[ai][0][m][0][e] * sigmoidf_(acc[ai][1][m][0][e]); t1[e] = acc[ai][0][m][1][e] * sigmoidf_(acc[ai][1][m][1][e]); }
                    *(u32x4*)(GLU + (size_t)(r0 + ai * 128 + m * 16) * 2048 + c0) = pack8u(t0, t1);
                }
        } else {
            bf16_t* O = u.kind == 1 ? CONVO : ATTO; const int c0 = u.pn * 256 + wc * 32 + 8 * fq;
#pragma unroll
            for (int ai = 0; ai < 2; ++ai)
#pragma unroll
                for (int m = 0; m < 4; ++m) { bf16_t* rowp = O + (size_t)(r0 + ai * 128 + m * 16) * 2048 + c0;
#pragma unroll
                    for (int bj = 0; bj < 2; ++bj) *(u32x4*)(rowp + bj * 128) = pack8u(acc[ai][bj][m][0], acc[ai][bj][m][1]); }
        }
        return false;
    }
};
__device__ __forceinline__ void merge_phase(const P& p) {
    const bf16_t* PROJ = (const bf16_t*)(p.ws + WS_PROJ); const bf16_t* GLU = (const bf16_t*)(p.ws + WS_GLU); const bf16_t* CONVO = (const bf16_t*)(p.ws + WS_CONVO);
    const bf16_t* ATTO = (const bf16_t*)(p.ws + WS_ATTO); bf16_t* MERGED = (bf16_t*)(p.ws + WS_MERGED);
    const int NT = MTOK * 256, stride = gridDim.x * 512;
    for (int t = blockIdx.x * 512 + otid(); t < NT; t += 2 * stride) {
        u32x4 L[2][6]; const int t1 = t + stride; const bool has1 = t1 < NT;
#pragma unroll
        for (int k = 0; k < 2; ++k) { const int tt = k == 0 ? t : (has1 ? t1 : t);
            const size_t row = (size_t)(tt >> 8); const int c0 = (tt & 255) * 8; const bf16_t* pr = PROJ + row * NIN + OFF_G + c0; const size_t o = row * 2048 + c0;
            L[k][0] = NTL((const u32x4*)pr); L[k][1] = NTL((const u32x4*)(pr + 2048)); L[k][2] = NTL((const u32x4*)(pr + 4096));
            L[k][3] = NTL((const u32x4*)(CONVO + o)); L[k][4] = NTL((const u32x4*)(GLU + o)); L[k][5] = NTL((const u32x4*)(ATTO + o)); }
#pragma unroll
        for (int k = 0; k < 2; ++k) { if (k == 1 && !has1) break; const int tt = k == 0 ? t : t1;
            const size_t row = (size_t)(tt >> 8); const int c0 = (tt & 255) * 8; const size_t o = row * 2048 + c0;
            float g0[8], g1[8], g2[8], cv[8], gl[8], at[8];
            unpack8(L[k][0], g0); unpack8(L[k][1], g1); unpack8(L[k][2], g2); unpack8(L[k][3], cv); unpack8(L[k][4], gl); unpack8(L[k][5], at);
            f32x4 m0, m1;
#pragma unroll
            for (int e = 0; e < 8; ++e) { const float v = sigmoidf_(g0[e]) * cv[e] + sigmoidf_(g1[e]) * gl[e] + sigmoidf_(g2[e]) * at[e]; if (e < 4) m0[e] = v; else m1[e - 4] = v; }
            *(u32x4*)(MERGED + o) = pack8u(m0, m1); }
    }
}

struct Sched3 {
    const char *MERGED, *WO; int G, c;
    __device__ __forceinline__ bool next(int i, Unit& u) const {
        const int L = i * G + c; if (L >= 256) return false;
        u.pm = L >> 3; u.pn = L & 7; u.kind = 0; u.a = MERGED + (size_t)u.pm * 1048576; u.b = WO + (size_t)u.pn * 1048576; return true;
    }
};
struct Sched3b {
    const char *MERGED, *WO; int G, c;
    __device__ __forceinline__ bool next(int i, Unit& u) const {
        const int L = i * G + c; if (L >= 128) return false;
        const int tile = L >> 3, ks = L & 7; u.pm = 32 + (tile >> 3); u.pn = tile & 7; u.kind = ks;
        u.a = MERGED + (size_t)u.pm * 1048576 + (size_t)ks * 512; u.b = WO + (size_t)u.pn * 1048576 + (size_t)ks * 512; return true;
    }
};
struct Epi3 {
    bf16_t* delta; float* part;
    bool sample;
    __device__ __forceinline__ bool operator()(f32x4 (&acc)[2][2][4][2], const Unit& u, int wr, int wc, int fr, int fq) const {
        const int r0 = u.pm * 256 + wr * 64 + fr, c0 = u.pn * 256 + wc * 32 + 8 * fq;
        if (!sample) {
#pragma unroll
            for (int ai = 0; ai < 2; ++ai)
#pragma unroll
                for (int m = 0; m < 4; ++m) { bf16_t* o = delta + (size_t)(r0 + ai * 128 + m * 16) * DM + c0;
#pragma unroll
                    for (int bj = 0; bj < 2; ++bj) *(u32x4*)(o + bj * 128) = pack8u(acc[ai][bj][m][0], acc[ai][bj][m][1]); }
        } else {
            float* base = part + ((size_t)u.kind * 512 - NPROMPT) * DM;
#pragma unroll
            for (int ai = 0; ai < 2; ++ai)
#pragma unroll
                for (int m = 0; m < 4; ++m) {
                    float* o = base + (size_t)(r0 + ai * 128 + m * 16) * DM + c0;
#pragma unroll
                    for (int bj = 0; bj < 2; ++bj)
#pragma unroll
                        for (int n = 0; n < 2; ++n) *(f32x4*)(o + bj * 128 + 4 * n) = acc[ai][bj][m][n];
                }
        }
        return false;
    }
};

__device__ __forceinline__ void transpose_tile(const float* __restrict__ src, const int K, const int N, bf16_t* __restrict__ dst, const int mode, const int t, LAS float* tile) {
    const int tid = otid(); const int tn = N / 256;
    const int r = tid >> 3, c8 = (tid & 7) * 8;
    const int k0 = (t / tn) * 64, n0 = (t % tn) * 256;
    const float* s = src + (size_t)(k0 + r) * N + n0 + c8;
    f32x4 v[8];
#pragma unroll
    for (int j = 0; j < 4; ++j) { v[2 * j] = NTL((const f32x4*)(s + j * 64)); v[2 * j + 1] = NTL((const f32x4*)(s + j * 64 + 4)); }
#pragma unroll
    for (int j = 0; j < 4; ++j)
#pragma unroll
        for (int e = 0; e < 4; ++e) { tile[j * 4160 + r * 65 + c8 + e] = v[2 * j][e]; tile[j * 4160 + r * 65 + c8 + 4 + e] = v[2 * j + 1][e]; }
    __syncthreads();
#pragma unroll
    for (int j = 0; j < 4; ++j) {
        f32x4 a, b;
#pragma unroll
        for (int e = 0; e < 4; ++e) { a[e] = tile[j * 4160 + (c8 + e) * 65 + r]; b[e] = tile[j * 4160 + (c8 + 4 + e) * 65 + r]; }
        const int n = n0 + j * 64 + r;
        const int row = mode == 0 ? n : ((n >> 7) * 256 + (mode - 1) * 128 + (n & 127));
        *(u32x4*)(dst + (size_t)row * K + k0 + c8) = pack8u(a, b);
    }
    __syncthreads();
}
__device__ __forceinline__ void tload_win(const float* w_in, int t, int r, int c8, f32x4 (&v)[8]) {
    const int k0 = (t / 56) * 64, n0 = (t % 56) * 256;
    const float* s = w_in + (size_t)(k0 + r) * NIN + n0 + c8;
#pragma unroll
    for (int j = 0; j < 4; ++j) { v[2 * j] = NTL((const f32x4*)(s + j * 64)); v[2 * j + 1] = NTL((const f32x4*)(s + j * 64 + 4)); }
}
__device__ __forceinline__ void phase0(const P& p, LAS unsigned char* lds) {
    unsigned char* ws = p.ws; LAS float* tile = (LAS float*)lds;
    {
        const int tid = otid(); const int r = tid >> 3, c8 = (tid & 7) * 8;
        bf16_t* dst = (bf16_t*)(ws + WS_WIN);
        int j = blockIdx.x; f32x4 v[8];
        if (j < 1792) tload_win(p.w_in, j, r, c8, v);
        while (j < 1792) {
#pragma unroll
            for (int q = 0; q < 4; ++q)
#pragma unroll
                for (int e = 0; e < 4; ++e) { tile[q * 4160 + r * 65 + c8 + e] = v[2 * q][e]; tile[q * 4160 + r * 65 + c8 + 4 + e] = v[2 * q + 1][e]; }
            const int jn = j + gridDim.x;
            if (jn < 1792) tload_win(p.w_in, jn, r, c8, v);
            __syncthreads();
            const int k0 = (j / 56) * 64, n0 = (j % 56) * 256;
#pragma unroll
            for (int q = 0; q < 4; ++q) {
                f32x4 a, b;
#pragma unroll
                for (int e = 0; e < 4; ++e) { a[e] = tile[q * 4160 + (c8 + e) * 65 + r]; b[e] = tile[q * 4160 + (c8 + 4 + e) * 65 + r]; }
                *(u32x4*)(dst + (size_t)(n0 + q * 64 + r) * 2048 + k0 + c8) = pack8u(a, b);
            }
            __syncthreads();
            j = jn;
        }
    }
    for (int t = blockIdx.x; t < 256; t += gridDim.x) {
        if (t < 128) transpose_tile(p.w_mem_k, 2048, 1024, (bf16_t*)(ws + WS_WK), 0, t, tile);
        else transpose_tile(p.w_mem_v, 2048, 1024, (bf16_t*)(ws + WS_WV), 0, t - 128, tile);
    }
    const int t0 = otid(); const int lane = t0 & 63, gw = blockIdx.x * 8 + (t0 >> 6), nw = gridDim.x * 8;
    auto rowsrc = [&](int row) -> const float* { return row < NPROMPT ? p.x_prompt + (size_t)row * DM : (row < MTOK ? p.x_sample + (size_t)(row - NPROMPT) * DM : p.mem_prompt + (size_t)(row - MTOK) * DM); };
    f32x4 v[8], vn[8];
    if (gw < MTOK + 1024) { const float* src = rowsrc(gw);
#pragma unroll
        for (int i = 0; i < 8; ++i) v[i] = NTL((const f32x4*)(src + 4 * (lane + 64 * i))); }
    for (int row = gw; row < MTOK + 1024; row += nw) {
        const float* g = row < MTOK ? p.norm_g : p.mem_norm_g;
        bf16_t* dst = row < MTOK ? (bf16_t*)(ws + WS_H) + (size_t)row * DM : (bf16_t*)(ws + WS_MEMN) + (size_t)(row - MTOK) * DM;
        if (row + nw < MTOK + 1024) { const float* src = rowsrc(row + nw);
#pragma unroll
            for (int i = 0; i < 8; ++i) vn[i] = NTL((const f32x4*)(src + 4 * (lane + 64 * i))); }
        float s = 0.f;
#pragma unroll
        for (int i = 0; i < 8; ++i) s += (v[i][0] * v[i][0] + v[i][1] * v[i][1]) + (v[i][2] * v[i][2] + v[i][3] * v[i][3]);
#pragma unroll
        for (int o = 32; o >= 1; o >>= 1) s += __shfl_xor(s, o);
        const float rstd = 1.0f / sqrtf(s * (1.0f / 2048.0f) + 1e-6f);
#pragma unroll
        for (int i = 0; i < 8; ++i) { const f32x4 gv = *(const f32x4*)(g + 4 * (lane + 64 * i));
            u32x2 w; w.x = cvt_pk_bf16(v[i][0] * rstd * gv[0], v[i][1] * rstd * gv[1]); w.y = cvt_pk_bf16(v[i][2] * rstd * gv[2], v[i][3] * rstd * gv[3]);
            *(u32x2*)(dst + 4 * (lane + 64 * i)) = w; }
#pragma unroll
        for (int i = 0; i < 8; ++i) v[i] = vn[i];
    }
}

__device__ __forceinline__ void late_transposes(const P& p, LAS unsigned char* lds, const int first, const int stride, const int end) {
    unsigned char* ws = p.ws; LAS float* tile = (LAS float*)lds;
    for (int t = first; t < end; t += stride) {
        if (t < 128) transpose_tile(p.w_conv_out, 1024, 2048, (bf16_t*)(ws + WS_WC), 0, t, tile);
        else if (t < 256) transpose_tile(p.w_attn_out, 1024, 2048, (bf16_t*)(ws + WS_WA), 0, t - 128, tile);
        else if (t < 384) transpose_tile(p.w_glu_a, 1024, 2048, (bf16_t*)(ws + WS_WG), 1, t - 256, tile);
        else if (t < 512) transpose_tile(p.w_glu_b, 1024, 2048, (bf16_t*)(ws + WS_WG), 2, t - 384, tile);
        else transpose_tile(p.w_out, 2048, 2048, (bf16_t*)(ws + WS_WO), 0, t - 512, tile);
    }
}

template <int LEN, bool PROMPT>
__device__ __forceinline__ void conv_task(const P& p, const int r0, const int cgp, const int bs) {
    const bf16_t* PROJ = (const bf16_t*)(p.ws + WS_PROJ); bf16_t* ACONV = (bf16_t*)(p.ws + WS_ACONV);
    const int c0 = cgp * 8;
    const bf16_t* pr = PROJ + (size_t)r0 * NIN + c0;
    u32x4 lcb[LEN], lcz[LEN], lcc[LEN + 2], lch[LEN + 2];
    const bool has_halo = PROMPT && (r0 & 2047) != 0;
#pragma unroll
    for (int i = 0; i < LEN; ++i) { lcb[i] = NTL((const u32x4*)(pr + (size_t)i * NIN + OFF_CB)); lcz[i] = NTL((const u32x4*)(pr + (size_t)i * NIN + OFF_CZ));
        lcc[i + 2] = NTL((const u32x4*)(pr + (size_t)i * NIN + OFF_CC)); lch[i + 2] = NTL((const u32x4*)(pr + (size_t)i * NIN + OFF_CH)); }
#pragma unroll
    for (int i = 0; i < 2; ++i) { lcc[i] = (u32x4){0u, 0u, 0u, 0u}; lch[i] = lcc[i];
        if (has_halo) { lcc[i] = *(const u32x4*)(pr - (size_t)(2 - i) * NIN + OFF_CC); lch[i] = *(const u32x4*)(pr - (size_t)(2 - i) * NIN + OFF_CH); } }
    float w0[8], w1[8], w2[8], vm2[8], vm1[8];
    { const f32x4 a0 = *(const f32x4*)(p.conv_w + c0), a1 = *(const f32x4*)(p.conv_w + c0 + 4), b0 = *(const f32x4*)(p.conv_w + 1024 + c0), b1 = *(const f32x4*)(p.conv_w + 1024 + c0 + 4),
          d0 = *(const f32x4*)(p.conv_w + 2048 + c0), d1 = *(const f32x4*)(p.conv_w + 2048 + c0 + 4);
#pragma unroll
      for (int e = 0; e < 4; ++e) { w0[e] = a0[e]; w0[e + 4] = a1[e]; w1[e] = b0[e]; w1[e + 4] = b1[e]; w2[e] = d0[e]; w2[e + 4] = d1[e]; } }
    if (PROMPT) {
        float a[8], b[8];
        unpack8(lcc[0], a); unpack8(lch[0], b);
#pragma unroll
        for (int e = 0; e < 8; ++e) vm2[e] = a[e] * b[e];
        unpack8(lcc[1], a); unpack8(lch[1], b);
#pragma unroll
        for (int e = 0; e < 8; ++e) vm1[e] = a[e] * b[e];
    } else {
        const float* sc = p.state_conv + (size_t)bs * 2048 + c0;
        const f32x4 a0 = *(const f32x4*)sc, a1 = *(const f32x4*)(sc + 4), b0 = *(const f32x4*)(sc + 1024), b1 = *(const f32x4*)(sc + 1028);
#pragma unroll
        for (int e = 0; e < 4; ++e) { vm2[e] = a0[e]; vm2[e + 4] = a1[e]; vm1[e] = b0[e]; vm1[e + 4] = b1[e]; }
    }
#pragma unroll
    for (int i = 0; i < LEN; ++i) {
        const size_t row = (size_t)(r0 + i);
        float cb[8], cc[8], ch[8], cz[8], v[8];
        unpack8(lcb[i], cb); unpack8(lcc[i + 2], cc); unpack8(lch[i + 2], ch); unpack8(lcz[i], cz);
        f32x4 o0, o1;
#pragma unroll
        for (int e = 0; e < 8; ++e) { v[e] = cc[e] * ch[e]; const float cv = w0[e] * vm2[e] + w1[e] * vm1[e] + w2[e] * v[e]; const float r = cb[e] * cv * siluf_(cz[e]);
            if (e < 4) o0[e] = r; else o1[e - 4] = r; vm2[e] = vm1[e]; vm1[e] = v[e]; }
        *(u32x4*)(ACONV + row * 1024 + c0) = pack8u(o0, o1);
        float* dst = nullptr;
        if (PROMPT) { const int pos = (r0 + i) & 2047; if (pos >= 2046) dst = p.out + O_CP + ((size_t)((r0 + i) >> 11) * 2 + (pos - 2046)) * 1024 + c0; }
        else if (i >= 2) dst = p.out + O_CS + ((size_t)bs * 2 + (i - 2)) * 1024 + c0;
        if (dst) { *(f32x4*)dst = (f32x4){v[0], v[1], v[2], v[3]}; *(f32x4*)(dst + 4) = (f32x4){v[4], v[5], v[6], v[7]}; }
    }
}
__device__ __forceinline__ void conv_phase(const P& p) {
    const int t0 = blockIdx.x * 512 + otid(), nt = gridDim.x * 512;
    for (int task = t0; task < 262144; task += nt) conv_task<4, true>(p, (task >> 7) * 4, task & 127, 0);
    for (int task = t0; task < 16384; task += nt) conv_task<4, false>(p, NPROMPT + 4 * (task >> 7), task & 127, task >> 7);
}

struct S5In { bf16x8 U[4]; u32x2 u4[4], z4[4]; };
__device__ __forceinline__ void s5_load4(S5In& in, const bf16_t* SUZ, const size_t row0, const int g, const int g4) {
    const bf16_t* su = SUZ + ((size_t)g * MTOK + row0) * 16; const bf16_t* sz = SUZ + ((size_t)(64 + g) * MTOK + row0) * 16;
#pragma unroll
    for (int i = 0; i < 4; ++i) {
        in.U[i] = *(const bf16x8*)(su + i * 16 + 8 * (g4 & 1));
        in.u4[i] = *(const u32x2*)(su + i * 16 + 4 * g4); in.z4[i] = *(const u32x2*)(sz + i * 16 + 4 * g4);
    }
}
__device__ __forceinline__ void s5_steps4(const S5In& in, bf16_t* YS, const size_t row0, const int g, const int g4, const bool Y,
                                          const bf16x8 (&bre)[4], const bf16x8 (&bim)[4], const bf16x8 (&cf)[4], const float (&ar)[16], const float (&ai)[16], const f32x4 dsk,
                                          float (&sr)[16], float (&si)[16]) {
    const f32x4 zero4 = (f32x4){0.f, 0.f, 0.f, 0.f};
#pragma unroll
    for (int i = 0; i < 4; ++i) {
#pragma unroll
        for (int pb = 0; pb < 4; ++pb) {
            const f32x4 xr = MFMA16(bre[pb], in.U[i], zero4), xi = MFMA16(bim[pb], in.U[i], zero4);
#pragma unroll
            for (int j = 0; j < 4; ++j) { const int k = pb * 4 + j; const float nr = ar[k] * sr[k] - ai[k] * si[k] + xr[j]; const float ni = ar[k] * si[k] + ai[k] * sr[k] + xi[j]; sr[k] = nr; si[k] = ni; }
        }
        if (Y) {
            f32x4 y = zero4;
            y = MFMA16(cf[0], pack8((f32x4){sr[0], sr[1], sr[2], sr[3]}, (f32x4){sr[4], sr[5], sr[6], sr[7]}), y);
            y = MFMA16(cf[1], pack8((f32x4){sr[8], sr[9], sr[10], sr[11]}, (f32x4){sr[12], sr[13], sr[14], sr[15]}), y);
            y = MFMA16(cf[2], pack8((f32x4){si[0], si[1], si[2], si[3]}, (f32x4){si[4], si[5], si[6], si[7]}), y);
            y = MFMA16(cf[3], pack8((f32x4){si[8], si[9], si[10], si[11]}, (f32x4){si[12], si[13], si[14], si[15]}), y);
            const float uu[4] = {bf_lo(in.u4[i].x), bf_hi(in.u4[i].x), bf_lo(in.u4[i].y), bf_hi(in.u4[i].y)};
            const float zz[4] = {bf_lo(in.z4[i].x), bf_hi(in.z4[i].x), bf_lo(in.z4[i].y), bf_hi(in.z4[i].y)};
            float o[4];
#pragma unroll
            for (int j = 0; j < 4; ++j) { const float ysv = y[j] + dsk[j] * uu[j]; o[j] = gelu_tanh(ysv * siluf_(zz[j])); }
            u32x2 w; w.x = cvt_pk_bf16(o[0], o[1]); w.y = cvt_pk_bf16(o[2], o[3]);
            *(u32x2*)(YS + (row0 + i) * 1024 + g * 16 + 4 * g4) = w;
        }
    }
}
__device__ __forceinline__ void s5_coef(const P& p, int g, int pp, float dt, float& ar, float& ai, float& fr, float& fi) {
    const float lr = p.lam_re[g * 64 + pp], li = p.lam_im[g * 64 + pp];
    const float mag = expf(lr * dt), ang = li * dt; float sn, cs; sincosf(ang, &sn, &cs);
    ar = mag * cs; ai = mag * sn; const float den = lr * lr + li * li;
    fr = ((ar - 1.0f) * lr + ai * li) / den; fi = (ai * lr - (ar - 1.0f) * li) / den;
}
__device__ __forceinline__ void s5_unit(const P& p, const int unit, LAS unsigned char* lds) {
    const bf16_t* PROJ = (const bf16_t*)(p.ws + WS_SUZ); bf16_t* YS = (bf16_t*)(p.ws + WS_YS);
    const int tid = otid(), lane = tid & 63, w = tid >> 6, cl = lane & 15, g4 = lane >> 4;
    const bool prompt = unit < 256; const int g = prompt ? (unit & 63) : (unit - 256); const int b = unit >> 6;
    const float dt = expf(p.log_dt[g]);
    LAS float* E = (LAS float*)lds;
    LAS f32x4* CT = (LAS f32x4*)(lds + 65536);
    if (tid < 64) { float a_r, a_i, fr_, fi_; s5_coef(p, g, tid, dt, a_r, a_i, fr_, fi_); CT[tid] = (f32x4){a_r, a_i, fr_, fi_}; }
    __syncthreads();
    float ar[16], ai[16];
#pragma unroll
    for (int pb = 0; pb < 4; ++pb)
#pragma unroll
        for (int j = 0; j < 4; ++j) { const f32x4 t = CT[16 * pb + 4 * g4 + j]; ar[pb * 4 + j] = t[0]; ai[pb * 4 + j] = t[1]; }
    bf16x8 bre[4], bim[4], cf[4];
    const float bmask = g4 < 2 ? 1.0f : 0.0f;
#pragma unroll
    for (int pb = 0; pb < 4; ++pb) {
        const int pp = 16 * pb + cl; const f32x4 t = CT[pp]; const float fr_ = t[2] * bmask, fi_ = t[3] * bmask;
        const float* br = p.b_re + ((size_t)(g * 64 + pp)) * 16 + 8 * (g4 & 1); const float* bi = p.b_im + ((size_t)(g * 64 + pp)) * 16 + 8 * (g4 & 1);
        const f32x4 r0 = *(const f32x4*)br, r1 = *(const f32x4*)(br + 4), i0 = *(const f32x4*)bi, i1 = *(const f32x4*)(bi + 4);
        bre[pb] = pack8(fr_ * r0 - fi_ * i0, fr_ * r1 - fi_ * i1);
        bim[pb] = pack8(fr_ * i0 + fi_ * r0, fr_ * i1 + fi_ * r1);
    }
#pragma unroll
    for (int ks = 0; ks < 4; ++ks) {
        const float* cp = (ks < 2 ? p.c_re : p.c_im) + ((size_t)(g * 16 + cl)) * 64 + 32 * (ks & 1) + 4 * g4;
        f32x4 a = *(const f32x4*)cp, c = *(const f32x4*)(cp + 16);
        if (ks >= 2) { a = -a; c = -c; }
        cf[ks] = pack8(a, c);
    }
    const f32x4 dsk = *(const f32x4*)(p.ssm_d + g * 16 + 4 * g4);
    const int chain = 16 * w + cl;
    const size_t row0 = prompt ? (size_t)b * 2048 + (size_t)chain * 16 : (size_t)NPROMPT + 4 * chain;
    const size_t so = ((size_t)chain * 64 + g) * 64 + 4 * g4;
    const int nq = prompt ? 4 : 1;
    float sr[16], si[16];
#pragma unroll
    for (int k = 0; k < 16; ++k) { sr[k] = 0.f; si[k] = 0.f; }
    if (!prompt) {
#pragma unroll
        for (int pb = 0; pb < 4; ++pb) { const f32x4 a = *(const f32x4*)(p.state_re + so + 16 * pb), c = *(const f32x4*)(p.state_im + so + 16 * pb);
#pragma unroll
            for (int j = 0; j < 4; ++j) { sr[pb * 4 + j] = a[j]; si[pb * 4 + j] = c[j]; } }
    }
#pragma unroll 1
    for (int pass = prompt ? 0 : 1; pass < 2; ++pass) {
        if (pass == 1 && prompt) {
#pragma unroll
            for (int pb = 0; pb < 4; ++pb) {
                *(LAS f32x4*)(E + (chain * 2 + 0) * 64 + 16 * pb + 4 * g4) = (f32x4){sr[pb * 4], sr[pb * 4 + 1], sr[pb * 4 + 2], sr[pb * 4 + 3]};
                *(LAS f32x4*)(E + (chain * 2 + 1) * 64 + 16 * pb + 4 * g4) = (f32x4){si[pb * 4], si[pb * 4 + 1], si[pb * 4 + 2], si[pb * 4 + 3]};
            }
            __syncthreads();
            if (w == 0) {
                float a_r, a_i; { const f32x4 t = CT[lane]; a_r = t[0]; a_i = t[1]; }
#pragma unroll
                for (int q = 0; q < 4; ++q) { const float nr = a_r * a_r - a_i * a_i, ni = 2.0f * a_r * a_i; a_r = nr; a_i = ni; }
                float Fr = 0.f, Fi = 0.f;
#pragma unroll 8
                for (int k = 0; k < 128; ++k) {
                    const float er = E[(2 * k) * 64 + lane], ei = E[(2 * k + 1) * 64 + lane];
                    E[(2 * k) * 64 + lane] = Fr; E[(2 * k + 1) * 64 + lane] = Fi;
                    const float nr = a_r * Fr - a_i * Fi + er; Fi = a_r * Fi + a_i * Fr + ei; Fr = nr;
                }
                p.out[O_RP + (size_t)(b * 64 + g) * 64 + lane] = Fr; p.out[O_IP + (size_t)(b * 64 + g) * 64 + lane] = Fi;
            }
            __syncthreads();
#pragma unroll
            for (int pb = 0; pb < 4; ++pb) {
                const f32x4 a = *(LAS f32x4*)(E + (chain * 2 + 0) * 64 + 16 * pb + 4 * g4), c = *(LAS f32x4*)(E + (chain * 2 + 1) * 64 + 16 * pb + 4 * g4);
#pragma unroll
                for (int j = 0; j < 4; ++j) { sr[pb * 4 + j] = a[j]; si[pb * 4 + j] = c[j]; }
            }
        }
        S5In cur; s5_load4(cur, PROJ, row0, g, g4);
#pragma unroll 1
        for (int q = 0; q < nq; ++q) {
            S5In nxt = cur;
            if (q + 1 < nq) s5_load4(nxt, PROJ, row0 + 4 * (q + 1), g, g4);
            s5_steps4(cur, YS, row0 + 4 * q, g, g4, pass == 1, bre, bim, cf, ar, ai, dsk, sr, si);
            cur = nxt;
        }
    }
    if (!prompt) {
#pragma unroll
        for (int pb = 0; pb < 4; ++pb) {
            *(f32x4*)(p.out + O_RS + so + 16 * pb) = (f32x4){sr[pb * 4], sr[pb * 4 + 1], sr[pb * 4 + 2], sr[pb * 4 + 3]};
            *(f32x4*)(p.out + O_IS + so + 16 * pb) = (f32x4){si[pb * 4], si[pb * 4 + 1], si[pb * 4 + 2], si[pb * 4 + 3]};
        }
    }
    __syncthreads();
}

__device__ __forceinline__ void attn_prompt_unit(const P& p, const int unit, LAS unsigned char* lds) {
    const bf16_t* PROJ = (const bf16_t*)(p.ws + WS_PROJ); const bf16_t* KB = (const bf16_t*)(p.ws + WS_KB); const bf16_t* VT = (const bf16_t*)(p.ws + WS_VT);
    bf16_t* OATT = (bf16_t*)(p.ws + WS_OATT);
    const int tid = otid(), lane = tid & 63, w = tid >> 6, cl = lane & 15, g4 = lane >> 4;
    const int b = unit >> 6, h = (unit >> 4) & 3, qb = unit & 15;
    const bf16_t* kbase = KB + (size_t)(b * 256) * 1024 + h * 256;
#pragma unroll
    for (int i = 0; i < 16; ++i) { const int idx = tid + 512 * i, r = idx >> 5, m = idx & 31;
        const u32x4 v = *(const u32x4*)(kbase + (size_t)r * 1024 + m * 8); *(LAS u32x4*)(lds + r * 512 + ((m ^ (r & 15)) << 4)) = v; }
    const size_t qrow = (size_t)b * 2048 + qb * 128 + w * 16 + cl;
    const bf16_t* qp = PROJ + qrow * NIN + OFF_AQ + h * 256 + 8 * g4;
    bf16x8 qf[8];
#pragma unroll
    for (int ks = 0; ks < 8; ++ks) qf[ks] = NTL((const bf16x8*)(qp + 32 * ks));
    __syncthreads();
    f32x4 s[16];
#pragma unroll
    for (int kb = 0; kb < 16; ++kb) { s[kb] = (f32x4){0.f, 0.f, 0.f, 0.f};
#pragma unroll
        for (int ks = 0; ks < 8; ++ks) { const int key = 16 * kb + cl, m = 4 * ks + g4;
            const bf16x8 kf = *(const LAS bf16x8*)(lds + key * 512 + ((m ^ cl) << 4)); s[kb] = MFMA16(kf, qf[ks], s[kb]); }
        __builtin_amdgcn_sched_barrier(0); }
    __syncthreads();
    const bf16_t* vbase = VT + (size_t)((b * 4 + h) * 256) * 256;
    u32x4 vst[16];
#pragma unroll
    for (int i = 0; i < 16; ++i) { const int idx = tid + 512 * i, r = idx >> 5, m = idx & 31; vst[i] = *(const u32x4*)(vbase + (size_t)r * 256 + m * 8); }
    float mx = -3.0e38f;
#pragma unroll
    for (int kb = 0; kb < 16; ++kb)
#pragma unroll
        for (int j = 0; j < 4; ++j) mx = fmaxf(mx, s[kb][j]);
    mx = fmaxf(mx, __shfl_xor(mx, 16)); mx = fmaxf(mx, __shfl_xor(mx, 32));
    float sum = 0.f;
#pragma unroll
    for (int kb = 0; kb < 16; ++kb)
#pragma unroll
        for (int j = 0; j < 4; ++j) { const float e = __expf((s[kb][j] - mx) * 0.0625f); s[kb][j] = e; sum += e; }
    sum += __shfl_xor(sum, 16); sum += __shfl_xor(sum, 32);
    const float inv = rcp_(sum);
    bf16x8 pf[8];
#pragma unroll
    for (int kk = 0; kk < 8; ++kk) pf[kk] = pack8(s[2 * kk], s[2 * kk + 1]);
#pragma unroll
    for (int i = 0; i < 16; ++i) { const int idx = tid + 512 * i, r = idx >> 5, m = idx & 31; *(LAS u32x4*)(lds + r * 512 + ((m ^ (r & 15)) << 4)) = vst[i]; }
    __syncthreads();
    const bf16_t* azp = PROJ + qrow * NIN + OFF_AZ + h * 256 + 4 * g4;
    bf16_t* op = OATT + qrow * 1024 + h * 256 + 4 * g4;
    u32x2 azv[16];
#pragma unroll
    for (int db = 0; db < 16; ++db) azv[db] = NTL((const u32x2*)(azp + 16 * db));
#pragma unroll
    for (int db = 0; db < 16; ++db) {
        f32x4 o = (f32x4){0.f, 0.f, 0.f, 0.f}; const int d = 16 * db + cl;
#pragma unroll
        for (int kk = 0; kk < 8; ++kk) {
            const int ch0 = 8 * kk + g4, ch1 = ch0 + 4;
            const u32x2 lo = *(const LAS u32x2*)(lds + d * 512 + (((ch0 >> 1) ^ cl) << 4) + (ch0 & 1) * 8);
            const u32x2 hi = *(const LAS u32x2*)(lds + d * 512 + (((ch1 >> 1) ^ cl) << 4) + (ch1 & 1) * 8);
            const u32x4 vv = (u32x4){lo.x, lo.y, hi.x, hi.y};
            o = MFMA16(__builtin_bit_cast(bf16x8, vv), pf[kk], o);
        }
        const u32x2 az = azv[db];
        const float z[4] = {bf_lo(az.x), bf_hi(az.x), bf_lo(az.y), bf_hi(az.y)};
        u32x2 wv; wv.x = cvt_pk_bf16(o[0] * inv * siluf_(z[0]), o[1] * inv * siluf_(z[1])); wv.y = cvt_pk_bf16(o[2] * inv * siluf_(z[2]), o[3] * inv * siluf_(z[3]));
        *(u32x2*)(op + 16 * db) = wv;
        __builtin_amdgcn_sched_barrier(0);
    }
    __syncthreads();
}

__device__ __forceinline__ void attn_sample_pair(const P& p, const int u0, const int u1_, LAS unsigned char* lds) {
    const int u1 = u1_ < 512 ? u1_ : u0;
    const bf16_t* PROJ = (const bf16_t*)(p.ws + WS_PROJ); bf16_t* OATT = (bf16_t*)(p.ws + WS_OATT);
    const int tid = otid(), lane = tid & 63, w = tid >> 6, cl = lane & 15, g4 = lane >> 4;
    LAS float* Pw = (LAS float*)(lds + w * 512);
    LAS float* ST = (LAS float*)(lds + 4096);
    LAS float* OW = (LAS float*)(lds + 8192);
    f32x4 bA[16], bB[16], o[4], s0, s1;
    bf16x8 qf[8];
#define SA_LOADQ(unit) do { const bf16_t* qp_ = PROJ + ((size_t)NPROMPT + 4 * ((unit) >> 2) + (cl & 3)) * NIN + OFF_AQ + ((unit) & 3) * 256 + 8 * g4; \
        _Pragma("unroll") for (int ks = 0; ks < 8; ++ks) qf[ks] = *(const bf16x8*)(qp_ + 32 * ks); } while (0)
#define SA_LOADK(buf, unit, kblk) do { const float* kr_ = p.cache_k + ((size_t)((unit) >> 2) * 1024 + ((unit) & 3)) * 256 + (size_t)(32 * w + 16 * (kblk) + cl) * 1024 + 8 * g4; \
        _Pragma("unroll") for (int ks = 0; ks < 8; ++ks) { buf[2 * ks] = NTL((const f32x4*)(kr_ + 32 * ks)); buf[2 * ks + 1] = NTL((const f32x4*)(kr_ + 32 * ks + 4)); } } while (0)
#define SA_LOADV(buf, unit, half) do { const float* vr_ = p.cache_v + ((size_t)((unit) >> 2) * 1024 + ((unit) & 3)) * 256 + (size_t)(32 * w + 16 * (half)) * 1024 + 4 * lane; \
        _Pragma("unroll") for (int i = 0; i < 16; ++i) buf[i] = NTL((const f32x4*)(vr_ + (size_t)i * 1024)); } while (0)
#define SA_QK(buf, sv) do { sv = (f32x4){0.f, 0.f, 0.f, 0.f}; _Pragma("unroll") for (int ks = 0; ks < 8; ++ks) sv = MFMA16(pack8(buf[2 * ks], buf[2 * ks + 1]), qf[ks], sv); } while (0)
#define SA_PV(buf, half) do { _Pragma("unroll") for (int ii = 0; ii < 4; ++ii) _Pragma("unroll") for (int q = 0; q < 4; ++q) { const f32x4 pv_ = *(const LAS f32x4*)(Pw + q * 32 + 16 * (half) + 4 * ii); \
        o[q] += pv_[0] * buf[4 * ii] + pv_[1] * buf[4 * ii + 1] + pv_[2] * buf[4 * ii + 2] + pv_[3] * buf[4 * ii + 3]; } } while (0)
#define SA_SOFTMAX(slot) do { float m_ = fmaxf(fmaxf(fmaxf(s0[0], s0[1]), fmaxf(s0[2], s0[3])), fmaxf(fmaxf(s1[0], s1[1]), fmaxf(s1[2], s1[3]))); \
        m_ = fmaxf(m_, __shfl_xor(m_, 16)); m_ = fmaxf(m_, __shfl_xor(m_, 32)); float l_ = 0.f; \
        _Pragma("unroll") for (int j = 0; j < 4; ++j) { s0[j] = __expf((s0[j] - m_) * 0.0625f); s1[j] = __expf((s1[j] - m_) * 0.0625f); l_ += s0[j] + s1[j]; } \
        l_ += __shfl_xor(l_, 16); l_ += __shfl_xor(l_, 32); \
        if (cl < 4) { *(LAS f32x4*)(Pw + cl * 32 + 4 * g4) = s0; *(LAS f32x4*)(Pw + cl * 32 + 16 + 4 * g4) = s1; \
            if (g4 == 0) { ST[(((slot) * 8 + w) * 4 + cl) * 2] = m_; ST[(((slot) * 8 + w) * 4 + cl) * 2 + 1] = l_; } } } while (0)
#define SA_OZERO() do { _Pragma("unroll") for (int q = 0; q < 4; ++q) o[q] = (f32x4){0.f, 0.f, 0.f, 0.f}; } while (0)
#define SA_OWRITE(slot) do { _Pragma("unroll") for (int q = 0; q < 4; ++q) *(LAS f32x4*)(OW + (size_t)((((slot) * 8 + w) * 4 + q) * 256) + 4 * lane) = o[q]; } while (0)
#define SA_SB() __builtin_amdgcn_sched_barrier(0)
    SA_LOADQ(u0);
    SA_LOADK(bA, u0, 0); SA_LOADK(bB, u0, 1); SA_SB();
    SA_QK(bA, s0); SA_LOADV(bA, u0, 0); SA_SB();
    SA_QK(bB, s1); SA_LOADV(bB, u0, 1); SA_SB();
    SA_SOFTMAX(0);
    SA_LOADQ(u1);
    SA_OZERO(); SA_SB();
    SA_PV(bA, 0); SA_LOADK(bA, u1, 0); SA_SB();
    SA_PV(bB, 1); SA_LOADK(bB, u1, 1); SA_SB();
    SA_OWRITE(0);
    {
        SA_QK(bA, s0); SA_LOADV(bA, u1, 0); SA_SB();
        SA_QK(bB, s1); SA_LOADV(bB, u1, 1); SA_SB();
        SA_SOFTMAX(1);
        SA_OZERO(); SA_SB();
        SA_PV(bA, 0); SA_SB();
        SA_PV(bB, 1);
        SA_OWRITE(1);
    }
    __syncthreads();
    {
        const int slot = tid >> 8, q = (tid >> 6) & 3, d = (tid & 63) * 4;
        const int unit = slot == 0 ? u0 : u1;
        {
            float M = -3.0e38f;
#pragma unroll
            for (int ww = 0; ww < 8; ++ww) M = fmaxf(M, ST[((slot * 8 + ww) * 4 + q) * 2]);
            float L = 0.f; f32x4 a = (f32x4){0.f, 0.f, 0.f, 0.f};
#pragma unroll
            for (int ww = 0; ww < 8; ++ww) { const float f = __expf((ST[((slot * 8 + ww) * 4 + q) * 2] - M) * 0.0625f); L += f * ST[((slot * 8 + ww) * 4 + q) * 2 + 1];
                a += f * *(const LAS f32x4*)(OW + (size_t)(((slot * 8 + ww) * 4 + q) * 256) + d); }
            const float inv = rcp_(L);
            const size_t row = (size_t)NPROMPT + 4 * (unit >> 2) + q; const int h = unit & 3;
            const u32x2 az = *(const u32x2*)(PROJ + row * NIN + OFF_AZ + h * 256 + d);
            u32x2 wv; wv.x = cvt_pk_bf16(a[0] * inv * siluf_(bf_lo(az.x)), a[1] * inv * siluf_(bf_hi(az.x))); wv.y = cvt_pk_bf16(a[2] * inv * siluf_(bf_lo(az.y)), a[3] * inv * siluf_(bf_hi(az.y)));
            *(u32x2*)(OATT + row * 1024 + h * 256 + d) = wv;
        }
    }
    __syncthreads();
#undef SA_LOADQ
#undef SA_LOADK
#undef SA_LOADV
#undef SA_QK
#undef SA_PV
#undef SA_SOFTMAX
#undef SA_OZERO
#undef SA_OWRITE
#undef SA_SB
}

__device__ __forceinline__ void phase5(const P& p) {
    const float* part = (const float*)(p.ws + WS_PART);
    const int t0 = otid(); const int lane = t0 & 63, gw = blockIdx.x * 8 + (t0 >> 6), nw = gridDim.x * 8;
    for (int row = gw; row < MTOK; row += nw) {
        float* orow = p.out + (size_t)row * DM;
        f32x4 v[8]; float s = 0.f;
        if (row < NPROMPT) {
            const float* xr = p.x_prompt + (size_t)row * DM; const bf16_t* dr = (const bf16_t*)(p.ws + WS_DELTA) + (size_t)row * DM;
#pragma unroll
            for (int i = 0; i < 8; ++i) { const u32x2 d = NTL((const u32x2*)(dr + 4 * (lane + 64 * i)));
                v[i] = NTL((const f32x4*)(xr + 4 * (lane + 64 * i))) + (f32x4){bf_lo(d.x), bf_hi(d.x), bf_lo(d.y), bf_hi(d.y)}; }
        } else {
            const float* xr = p.x_sample + (size_t)(row - NPROMPT) * DM;
#pragma unroll
            for (int i = 0; i < 8; ++i) v[i] = NTL((const f32x4*)(xr + 4 * (lane + 64 * i)));
#pragma unroll 2
            for (int ks = 0; ks < 8; ++ks) { const float* pr = part + ((size_t)ks * 512 + (row - NPROMPT)) * DM;
#pragma unroll
                for (int i = 0; i < 8; ++i) v[i] += NTL((const f32x4*)(pr + 4 * (lane + 64 * i))); }
        }
#pragma unroll
        for (int i = 0; i < 8; ++i) s += (v[i][0] * v[i][0] + v[i][1] * v[i][1]) + (v[i][2] * v[i][2] + v[i][3] * v[i][3]);
#pragma unroll
        for (int o = 32; o >= 1; o >>= 1) s += __shfl_xor(s, o);
        const float rstd = 1.0f / sqrtf(s * (1.0f / 2048.0f) + 1e-6f);
#pragma unroll
        for (int i = 0; i < 8; ++i) { const f32x4 gv = *(const f32x4*)(p.final_g + 4 * (lane + 64 * i)); NTS(v[i] * rstd * gv, (f32x4*)(orow + 4 * (lane + 64 * i))); }
    }
}

#define XB_TMO      128
#define XB_XCNT(j)  (256  + 64 * (j))
#define XB_XSUB(j)  (1280 + 64 * (j))
#define XB_XGEN(j)  (2304 + 64 * (j))
#define XB_TOP      3328
#define XB_TOPGEN   3392
#define XB_SPIN_CAP (1u << 20)
__device__ __forceinline__ unsigned xb_ld(unsigned* p)              { return __hip_atomic_load(p, __ATOMIC_RELAXED, __HIP_MEMORY_SCOPE_AGENT); }
__device__ __forceinline__ unsigned xb_add(unsigned* p, unsigned v) { return __hip_atomic_fetch_add(p, v, __ATOMIC_RELAXED, __HIP_MEMORY_SCOPE_AGENT); }
__device__ __forceinline__ unsigned xb_xcc_id() { return (unsigned)__builtin_amdgcn_s_getreg((3 << 11) | 20) & 0xFu; }
#define XB_SPIN(cond, bar) do { unsigned _sp = 0; while (cond) { __builtin_amdgcn_s_sleep(1); \
    if ((++_sp & 255u) == 0u) { if (xb_ld(&(bar)[XB_TMO])) break; if (_sp > XB_SPIN_CAP) { atomicAdd(&(bar)[XB_TMO], 1u); break; } } } } while (0)
struct XcdBarrier { unsigned* bar; unsigned x; volatile LAS unsigned* st; };
__device__ __forceinline__ XcdBarrier xcd_barrier_post(unsigned* bar, volatile LAS unsigned* st) {
    XcdBarrier b; b.bar = bar; b.x = xb_xcc_id(); b.st = st;
    if (threadIdx.x == 0) (void)xb_add(&bar[XB_XCNT(b.x)], 1u);
    return b;
}
__device__ __forceinline__ void xcd_barrier_complete(unsigned* bar, unsigned x, unsigned& nloc, unsigned& nx) {
    const unsigned G = gridDim.x * gridDim.y * gridDim.z;
    unsigned sum, cnt, mine, sp = 0u;
    for (;;) {
        sum = 0u; cnt = 0u; mine = 0u;
#pragma unroll
        for (unsigned j = 0; j < 16; ++j) { const unsigned c = xb_ld(&bar[XB_XCNT(j)]); sum += c; cnt += (c > 0u) ? 1u : 0u; mine = (j == x) ? c : mine; }
        if (sum == G) break;
        __builtin_amdgcn_s_sleep(1);
        if ((++sp & 255u) == 0u) { if (xb_ld(&bar[XB_TMO])) break; if (sp > XB_SPIN_CAP) { atomicAdd(&bar[XB_TMO], 1u); break; } }
    }
    nloc = mine > 0u ? mine : 1u; nx = cnt > 0u ? cnt : 1u;
}
__device__ __forceinline__ void xcd_barrier(const XcdBarrier& b) {
    asm volatile("s_waitcnt vmcnt(0)" ::: "memory");
    __syncthreads();
    if (threadIdx.x == 0) {
        unsigned* bar = b.bar;
        __builtin_amdgcn_s_waitcnt(0);
        unsigned nloc = b.st[0], nx = b.st[1];
        if (nloc == 0u) { xcd_barrier_complete(bar, b.x, nloc, nx); b.st[0] = nloc; b.st[1] = nx; }
        const unsigned old = xb_add(&bar[XB_XSUB(b.x)], 1u);
        const unsigned gen = old / nloc;
        if (old + 1u == (gen + 1u) * nloc) {
            __builtin_amdgcn_fence(__ATOMIC_RELEASE, "agent");
            asm volatile("s_waitcnt vmcnt(0)" ::: "memory");
            const unsigned og = xb_add(&bar[XB_TOP], 1u);
            const unsigned tg = og / nx;
            if (og + 1u == (tg + 1u) * nx) xb_add(&bar[XB_TOPGEN], 1u);
            else XB_SPIN(xb_ld(&bar[XB_TOPGEN]) == tg, bar);
            __builtin_amdgcn_fence(__ATOMIC_ACQUIRE, "agent");
            xb_add(&bar[XB_XGEN(b.x)], 1u);
            asm volatile("s_waitcnt vmcnt(0)" ::: "memory");
        } else {
            XB_SPIN(xb_ld(&bar[XB_XGEN(b.x)]) == gen, bar);
            __builtin_amdgcn_fence(__ATOMIC_ACQUIRE, "agent");
            asm volatile("s_waitcnt vmcnt(0)" ::: "memory");
        }
    }
    __syncthreads();
}

__global__ void __launch_bounds__(512, 2) mega_fwd(P p) {
    extern __shared__ __attribute__((aligned(16))) unsigned char shm[];
    LAS unsigned char* lds = (LAS unsigned char*)shm;
    cg::grid_group grid = cg::this_grid();
    unsigned char* ws = p.ws;
    const int G = gridDim.x, c = blockIdx.x;
    volatile LAS unsigned* bst = (volatile LAS unsigned*)(lds + 131072);
    if (threadIdx.x == 0) { bst[0] = 0u; bst[1] = 0u; }
    __syncthreads();
    const XcdBarrier xbar = xcd_barrier_post((unsigned*)(ws + WS_BAR), bst);
    if (p.out == nullptr) grid.sync();
#define GSYNC() xcd_barrier(xbar)

#ifndef PHMASK
#define PHMASK 0xffff
#endif
#ifndef REPMASK
#define REPMASK 0
#endif
#define NREP(bit) ((REPMASK & (bit)) ? 2 : 1)
#ifndef TPHASE
#define TPHASE -1
#endif
#ifndef TMULT
#define TMULT 4
#endif
    unsigned long long ts[8]; int nts = 0;
#define STAMP() do { if (TPHASE >= 0 && TPHASE < 10) { ts[nts] = wall_clock64(); } ++nts; } while (0)
    STAMP();
    for (int rep = 0; rep < NREP(1); ++rep) if (PHMASK & 1) phase0(p, lds);
    GSYNC(); STAMP();

    for (int rep = 0; rep < NREP(2); ++rep) if (PHMASK & 2) {
        Sched1 S{(const char*)(ws + WS_H), (const char*)(ws + WS_WIN), (const char*)(ws + WS_MEMN), (const char*)(ws + WS_WK), (const char*)(ws + WS_WV), G, c};
        Epi1 E{(bf16_t*)(ws + WS_PROJ), p.out + O_MK, (bf16_t*)(ws + WS_KB), p.out + O_MV, (bf16_t*)(ws + WS_VT), (bf16_t*)(ws + WS_SUZ)};
        pg8::gemm_phase(lds, 2048, 2048, S, E);
    }
    GSYNC(); STAMP();

    for (int rep = 0; rep < NREP(4); ++rep) {
        unsigned long long m0 = 0, m1 = 0, m2 = 0, m3 = 0, m4 = 0;
        if (TPHASE >= 10) m0 = wall_clock64();
        const int sg = (c >> 3) & 3;
        if (sg == 0) for (int u = c; u < 512; u += 2 * G) attn_sample_pair(p, u, u + G, lds);
        if (TPHASE >= 10) m1 = wall_clock64();
        for (int u = c; u < 256; u += G) s5_unit(p, u, lds);
        for (int u = 256 + (G - 1 - c); u < 320; u += G) s5_unit(p, u, lds);
        if (TPHASE >= 10) m2 = wall_clock64();
        if (sg == 1) for (int u = c; u < 512; u += 2 * G) attn_sample_pair(p, u, u + G, lds);
        for (int u = c; u < 256; u += G) attn_prompt_unit(p, u, lds);
        if (TPHASE >= 10) m3 = wall_clock64();
        if (sg == 2) for (int u = c; u < 512; u += 2 * G) attn_sample_pair(p, u, u + G, lds);
        conv_phase(p);
        if (sg == 3) for (int u = c; u < 512; u += 2 * G) attn_sample_pair(p, u, u + G, lds);
        late_transposes(p, lds, c, G, G == 256 ? 512 : 768);
        if (TPHASE >= 10) { m4 = wall_clock64(); ts[0] = 0; ts[1] = TPHASE == 10 ? m1 - m0 : (TPHASE == 11 ? m2 - m1 : (TPHASE == 12 ? m3 - m2 : m4 - m3)); }
    }
    GSYNC(); STAMP();

    for (int rep = 0; rep < NREP(8); ++rep) if (PHMASK & 64) {
        { Sched1g Sg{(const char*)(ws + WS_H), (const char*)(ws + WS_WIN), G, c}; Epi1 Eg{(bf16_t*)(ws + WS_PROJ), p.out + O_MK, (bf16_t*)(ws + WS_KB), p.out + O_MV, (bf16_t*)(ws + WS_VT), (bf16_t*)(ws + WS_SUZ)}; pg8::gemm_phase(lds, 2048, 2048, Sg, Eg); }
        if (G == 256 && c >= 144) late_transposes(p, lds, 512 + (c - 144), 112, 768);
        Sched2 S{(const char*)ws, G, c};
        Epi2 E{(bf16_t*)(ws + WS_GLU), (bf16_t*)(ws + WS_CONVO), (bf16_t*)(ws + WS_ATTO)};
        pg8::gemm_phase(lds, 1024, 1024, S, E);
    }
    GSYNC(); STAMP();

    for (int rep = 0; rep < NREP(32); ++rep) merge_phase(p);
    GSYNC(); STAMP();

    for (int rep = 0; rep < NREP(16); ++rep) if (PHMASK & 128) {
        { Sched3 S{(const char*)(ws + WS_MERGED), (const char*)(ws + WS_WO), G, c}; Epi3 E{(bf16_t*)(ws + WS_DELTA), (float*)(ws + WS_PART), false}; pg8::gemm_phase(lds, 2048, 2048, S, E); }
        { Sched3b S{(const char*)(ws + WS_MERGED), (const char*)(ws + WS_WO), G, c}; Epi3 E{(bf16_t*)(ws + WS_DELTA), (float*)(ws + WS_PART), true}; pg8::gemm_phase(lds, 256, 2048, S, E); }
    }
    GSYNC(); STAMP();

    if (PHMASK & 256) phase5(p);
    STAMP();
    if (TPHASE >= 0 && blockIdx.x == 0 && threadIdx.x == 0) {
        const unsigned long long d = (TPHASE >= 10 ? ts[1] - ts[0] : ts[TPHASE + 1] - ts[TPHASE]) * TMULT, t0 = wall_clock64();
        while (wall_clock64() - t0 < d) __builtin_amdgcn_s_sleep(16);
    }
}

extern "C" void kernel_launch(void* const* d_in, const int* in_sizes, int n_in, void* d_out, int out_size, void* d_ws, size_t ws_size, hipStream_t stream) {
    static int grid = 0;
    if (grid == 0) {
        int dev = 0, cus = 0, per_cu = 0;
        hipGetDevice(&dev);
        hipDeviceGetAttribute(&cus, hipDeviceAttributeMultiprocessorCount, dev);
        if (hipFuncSetAttribute((const void*)mega_fwd, hipFuncAttributeMaxDynamicSharedMemorySize, LDS_BYTES) != hipSuccess) fprintf(stderr, "kernel_launch: hipFuncSetAttribute failed\n");
        if (hipOccupancyMaxActiveBlocksPerMultiprocessor(&per_cu, (const void*)mega_fwd, 512, LDS_BYTES) != hipSuccess || per_cu < 1) per_cu = 1;
        (void)hipGetLastError();
        grid = cus * per_cu;
        if (ws_size < WS_END) fprintf(stderr, "kernel_launch: workspace too small (%zu < %zu)\n", ws_size, (size_t)WS_END);
    }
    P p{};
    const float** pp = (const float**)&p;
    for (int i = 0; i < 28; ++i) pp[i] = (const float*)d_in[i];
    p.out = (float*)d_out; p.ws = (unsigned char*)d_ws;
    void* args[] = {&p};
    (void)hipMemsetAsync((unsigned char*)d_ws + WS_BAR, 0, 16384, stream);
    hipError_t e = hipLaunchCooperativeKernel((const void*)mega_fwd, dim3(grid), dim3(512), args, LDS_BYTES, stream);
    if (e != hipSuccess) fprintf(stderr, "cooperative launch failed: %s (grid %d)\n", hipGetErrorString(e), grid);
}
```

```cpp
#include <hip/hip_runtime.h>
#include <hip/hip_cooperative_groups.h>
#include <cstdio>
namespace cg = cooperative_groups;

#define LAS __attribute__((address_space(3)))
typedef unsigned short bf16_t;
typedef short bf16x8 __attribute__((ext_vector_type(8)));
typedef float f32x4 __attribute__((ext_vector_type(4)));
typedef unsigned u32x4 __attribute__((ext_vector_type(4)));
typedef unsigned u32x2 __attribute__((ext_vector_type(2)));

constexpr int DM = 2048, NPROMPT = 8192, NSAMPLE = 512, MTOK = 8704, NIN = 14336;
constexpr int OFF_CB = 0, OFF_CC = 1024, OFF_CH = 2048, OFF_CZ = 3072, OFF_SU = 4096, OFF_SZ = 5120, OFF_AQ = 6144, OFF_AZ = 7168, OFF_G = 8192;
constexpr int LDS_BYTES = 131072 + 16;
constexpr size_t O_Y = 0, O_MK = 17825792, O_MV = 18874368, O_CP = 19922944, O_RP = 19931136, O_IP = 19947520, O_CS = 19963904, O_RS = 20226048, O_IS = 20750336;
constexpr size_t WS_WIN = 0;
constexpr size_t WS_WG = WS_WIN + (size_t)NIN * DM * 2;
constexpr size_t WS_WC = WS_WG + 8388608;
constexpr size_t WS_WA = WS_WC + 4194304;
constexpr size_t WS_WO = WS_WA + 4194304;
constexpr size_t WS_H = WS_WO + 8388608;
constexpr size_t WS_PROJ = WS_H + (size_t)MTOK * DM * 2;
constexpr size_t WS_YS = WS_PROJ + (size_t)MTOK * NIN * 2;
constexpr size_t WS_ACONV = WS_YS + (size_t)MTOK * 1024 * 2;
constexpr size_t WS_OATT = WS_ACONV + (size_t)MTOK * 1024 * 2;
constexpr size_t WS_SS = WS_OATT + (size_t)MTOK * 1024 * 2;
constexpr size_t WS_GLU = WS_SS + (size_t)MTOK * 32 * 4;
constexpr size_t WS_MERGED = WS_GLU + (size_t)MTOK * DM * 2;
constexpr size_t WS_BAR = WS_MERGED + (size_t)MTOK * DM * 2;
constexpr size_t WS_MEMN = WS_BAR + 16384;
constexpr size_t WS_WK = WS_MEMN + 4194304;
constexpr size_t WS_WV = WS_WK + 4194304;
constexpr size_t WS_KB = WS_WV + 4194304;
constexpr size_t WS_VT = WS_KB + 2097152;
constexpr size_t WS_ATTO = WS_MEMN;
constexpr size_t WS_END = WS_ATTO + (size_t)MTOK * DM * 2;
constexpr size_t WS_SUZ = WS_GLU;
constexpr size_t WS_CONVO = WS_WIN, WS_PART = WS_PROJ, WS_DELTA = WS_PROJ + 67108864;
static_assert(WS_END <= 536870912, "workspace");
static_assert(WS_VT + 2097152 <= WS_END && (size_t)MTOK * DM * 2 <= 38u * 1048576u, "aliases");

struct P {
    const float *x_prompt, *x_sample, *mem_prompt, *cache_k, *cache_v, *state_conv, *state_re, *state_im, *norm_g, *mem_norm_g, *w_in, *conv_w, *w_conv_out,
        *lam_re, *lam_im, *log_dt, *b_re, *b_im, *c_re, *c_im, *ssm_d, *w_glu_a, *w_glu_b, *w_mem_k, *w_mem_v, *w_attn_out, *w_out, *final_g;
    float* out; unsigned char* ws;
};

__device__ __forceinline__ unsigned cvt_pk_bf16(float lo, float hi) { unsigned r; asm("v_cvt_pk_bf16_f32 %0, %1, %2" : "=v"(r) : "v"(lo), "v"(hi)); return r; }
__device__ __forceinline__ float bf_lo(unsigned w) { return __uint_as_float(w << 16); }
__device__ __forceinline__ float bf_hi(unsigned w) { return __uint_as_float(w & 0xffff0000u); }
__device__ __forceinline__ float rcp_(float x) { return __builtin_amdgcn_rcpf(x); }
__device__ __forceinline__ float sigmoidf_(float x) { return rcp_(1.0f + __expf(-x)); }
__device__ __forceinline__ float siluf_(float x) { return x * rcp_(1.0f + __expf(-x)); }
__device__ __forceinline__ float gelu_tanh(float x) { const float u = 1.5957691216057308f * (x + 0.044715f * x * x * x); return x * rcp_(1.0f + __expf(-u)); }
__device__ __forceinline__ bf16x8 pack8(const f32x4 a, const f32x4 b) {
    u32x4 w; w.x = cvt_pk_bf16(a[0], a[1]); w.y = cvt_pk_bf16(a[2], a[3]); w.z = cvt_pk_bf16(b[0], b[1]); w.w = cvt_pk_bf16(b[2], b[3]);
    return __builtin_bit_cast(bf16x8, w);
}
__device__ __forceinline__ u32x4 pack8u(const f32x4 a, const f32x4 b) {
    u32x4 w; w.x = cvt_pk_bf16(a[0], a[1]); w.y = cvt_pk_bf16(a[2], a[3]); w.z = cvt_pk_bf16(b[0], b[1]); w.w = cvt_pk_bf16(b[2], b[3]); return w;
}
__device__ __forceinline__ void unpack8(const u32x4 w, float (&f)[8]) {
    f[0] = bf_lo(w.x); f[1] = bf_hi(w.x); f[2] = bf_lo(w.y); f[3] = bf_hi(w.y); f[4] = bf_lo(w.z); f[5] = bf_hi(w.z); f[6] = bf_lo(w.w); f[7] = bf_hi(w.w);
}
__device__ __forceinline__ int otid() { int t = threadIdx.x; asm volatile("" : "+v"(t)); return t; }
#define NTL(p) __builtin_nontemporal_load(p)
#define NTS(v, p) __builtin_nontemporal_store((v), (p))
#define MFMA16(a, b, c) __builtin_amdgcn_mfma_f32_16x16x32_bf16((a), (b), (c), 0, 0, 0)

namespace pg8 {
constexpr int BM = 256, BK = 64, HALF = 128, HTB = HALF * BK * 2, STAGE_BYTES = 8 * HTB;
__device__ __forceinline__ int lds_byte(int r, int c) { const int st = (r >> 4) * 2 + (c >> 5), rr = r & 15, cc = c & 31, ob = rr * 64 + cc * 2; return st * 1024 + (ob ^ (((ob >> 9) & 1) << 5)); }
__device__ __forceinline__ void stage_rc(int b, int& R, int& C) { const int st = b / 1024, sb = b % 1024, swz = sb ^ (((sb >> 9) & 1) << 5); R = (st >> 1) * 16 + swz / 64; C = (st & 1) * 32 + (swz % 64) / 2; }
__device__ __forceinline__ int perm32(int rho) { const int n = rho >> 4, i = rho & 15; return 8 * (i >> 2) + 4 * n + (i & 3); }
struct Unit { const char* a; const char* b; int pm, pn, kind; };

template <class Sched, class Epi>
__device__ __forceinline__ void gemm_phase(LAS unsigned char* lds, const int K, const int ld, const Sched& S, const Epi& E) {
    const int tid = otid(), wid = __builtin_amdgcn_readfirstlane(tid >> 6), lane = tid & 63, wr = wid >> 2, wc = wid & 3, fr = lane & 15, fq = lane >> 4;
    const int nt = K / BK;
    unsigned voffA[2], voffB[2];
#pragma unroll
    for (int i = 0; i < 2; ++i) { int R, C; stage_rc(tid * 16 + i * 8192, R, C); const int Rb = (R & ~31) + perm32(R & 31);
        voffA[i] = (unsigned)(R * ld + C) * 2u; voffB[i] = (unsigned)(Rb * ld + C) * 2u; }
    const size_t kstep = (size_t)(BK * 2);
    const size_t hstep = (size_t)HALF * ld * 2;
    const unsigned ldsw = (unsigned)wid * 1024u;
    const int aoff = lds_byte(wr * 64 + fr, fq * 8), boff = lds_byte(wc * 32 + fr, fq * 8);
#define PG8_SA(b, h) (((b) * 2 + (h)) * HTB)
#define PG8_SB(b, h) ((4 + (b) * 2 + (h)) * HTB)
#define PG8_STAGE(bufoff, gbase, voff) do { _Pragma("unroll") for (int _i = 0; _i < 2; ++_i) \
        __builtin_amdgcn_global_load_lds((const unsigned*)((const char*)(gbase) + (voff)[_i]), (LAS unsigned*)(lds + (bufoff) + ldsw + _i * 8192), 16, 0, 0); } while (0)
#define PG8_LDA(dst, b, h) do { _Pragma("unroll") for (int m = 0; m < 4; ++m) _Pragma("unroll") for (int k = 0; k < 2; ++k) dst[m][k] = *(const LAS bf16x8*)(lds + PG8_SA(b, h) + aoff + m * 2048 + k * 1024); } while (0)
#define PG8_LDB(dst, b, h) do { _Pragma("unroll") for (int n = 0; n < 2; ++n) _Pragma("unroll") for (int k = 0; k < 2; ++k) dst[n][k] = *(const LAS bf16x8*)(lds + PG8_SB(b, h) + boff + n * 2048 + k * 1024); } while (0)
#define PG8_MMA(ai, bj, At, Bt) do { __builtin_amdgcn_s_setprio(1); _Pragma("unroll") for (int m = 0; m < 4; ++m) _Pragma("unroll") for (int n = 0; n < 2; ++n) _Pragma("unroll") for (int k = 0; k < 2; ++k) \
        acc[ai][bj][m][n] = __builtin_amdgcn_mfma_f32_16x16x32_bf16(Bt[n][k], At[m][k], acc[ai][bj][m][n], 0, 0, 0); __builtin_amdgcn_s_setprio(0); } while (0)
#define PG8_WAIT_V(n) asm volatile("s_waitcnt vmcnt(" #n ")" ::: "memory")
#define PG8_WAIT_L(n) asm volatile("s_waitcnt lgkmcnt(" #n ")" ::: "memory")
#define PG8_BAR __builtin_amdgcn_s_barrier()
#define PG8_SCHED __builtin_amdgcn_sched_barrier(0)
    Unit cur, nxt; int ui = 0;
    if (!S.next(0, cur)) return;
    f32x4 acc[2][2][4][2];
#pragma unroll
    for (int a = 0; a < 2; ++a)
#pragma unroll
        for (int b = 0; b < 2; ++b)
#pragma unroll
            for (int m = 0; m < 4; ++m)
#pragma unroll
                for (int n = 0; n < 2; ++n) acc[a][b][m][n] = (f32x4){0.f, 0.f, 0.f, 0.f};
    bf16x8 At[4][2], B0[2][2], B1[2][2];
    const char* cA = cur.a; const char* cB = cur.b;
    PG8_STAGE(PG8_SB(0, 0), cB, voffB); PG8_STAGE(PG8_SA(0, 0), cA, voffA); PG8_STAGE(PG8_SB(0, 1), cB + hstep, voffB); PG8_STAGE(PG8_SA(0, 1), cA + hstep, voffA);
    if (wr == 1) PG8_BAR;
    PG8_WAIT_V(4); PG8_BAR;
    PG8_STAGE(PG8_SB(1, 0), cB + kstep, voffB); PG8_STAGE(PG8_SA(1, 0), cA + kstep, voffA); PG8_STAGE(PG8_SB(1, 1), cB + hstep + kstep, voffB);
    PG8_WAIT_V(6); PG8_BAR;
    for (;;) {
        const bool has_next = S.next(ui + 1, nxt);
        const char* nA = has_next ? nxt.a : cA; const char* nB = has_next ? nxt.b : cB;
        for (int t = 0; t < nt; t += 2) {
            const bool last = (t == nt - 2);
            const char* a1 = cA + (size_t)(t + 1) * kstep;
            const char* a2 = last ? nA : cA + (size_t)(t + 2) * kstep; const char* b2 = last ? nB : cB + (size_t)(t + 2) * kstep;
            const char* a3 = a2 + kstep; const char* b3 = b2 + kstep;
            PG8_LDB(B0, 0, 0); PG8_SCHED; PG8_LDA(At, 0, 0); PG8_STAGE(PG8_SA(1, 1), a1 + hstep, voffA);
            PG8_WAIT_L(8); PG8_BAR; PG8_WAIT_L(0); PG8_MMA(0, 0, At, B0); PG8_BAR; PG8_SCHED;
            PG8_LDB(B1, 0, 1); PG8_STAGE(PG8_SB(0, 0), b2, voffB);
            PG8_BAR; PG8_WAIT_L(0); PG8_MMA(0, 1, At, B1); PG8_BAR;
            PG8_LDA(At, 0, 1); PG8_STAGE(PG8_SA(0, 0), a2, voffA);
            PG8_BAR; PG8_WAIT_L(0); PG8_MMA(1, 0, At, B0); PG8_BAR; PG8_SCHED;
            PG8_STAGE(PG8_SB(0, 1), b2 + hstep, voffB);
            PG8_WAIT_V(6); PG8_BAR; PG8_MMA(1, 1, At, B1); PG8_BAR;
            PG8_LDB(B0, 1, 0); PG8_SCHED; PG8_LDA(At, 1, 0); PG8_STAGE(PG8_SA(0, 1), a2 + hstep, voffA);
            PG8_WAIT_L(8); PG8_BAR; PG8_WAIT_L(0); PG8_MMA(0, 0, At, B0); PG8_BAR; PG8_SCHED;
            PG8_LDB(B1, 1, 1); PG8_STAGE(PG8_SB(1, 0), b3, voffB);
            PG8_BAR; PG8_WAIT_L(0); PG8_MMA(0, 1, At, B1); PG8_BAR;
            PG8_LDA(At, 1, 1); PG8_STAGE(PG8_SA(1, 0), a3, voffA);
            PG8_BAR; PG8_WAIT_L(0); PG8_MMA(1, 0, At, B0); PG8_BAR; PG8_SCHED;
            PG8_STAGE(PG8_SB(1, 1), b3 + hstep, voffB);
            PG8_WAIT_V(6); PG8_BAR; PG8_MMA(1, 1, At, B1); PG8_BAR;
        }
        const bool keep = E(acc, cur, wr, wc, fr, fq);
        if (!has_next) break;
        if (!keep) {
#pragma unroll
            for (int a = 0; a < 2; ++a)
#pragma unroll
                for (int b = 0; b < 2; ++b)
#pragma unroll
                    for (int m = 0; m < 4; ++m)
#pragma unroll
                        for (int n = 0; n < 2; ++n) acc[a][b][m][n] = (f32x4){0.f, 0.f, 0.f, 0.f};
        }
        cur = nxt; cA = nA; cB = nB; ++ui;
    }
    PG8_WAIT_V(0);
    if (wr == 0) PG8_BAR;
    PG8_BAR;
#undef PG8_SA
#undef PG8_SB
#undef PG8_STAGE
#undef PG8_LDA
#undef PG8_LDB
#undef PG8_MMA
#undef PG8_WAIT_V
#undef PG8_WAIT_L
#undef PG8_BAR
#undef PG8_SCHED
}
}
using pg8::Unit;

__device__ __forceinline__ void xcd_tile_order(int wgid, const int nM, const int nN, int& pm, int& pn) {
    const int nwg = nM * nN, NX = 8, WGM = 8;
    { const int q = nwg / NX, r = nwg % NX, xcd = wgid % NX, off = wgid / NX; wgid = (xcd < r ? xcd * (q + 1) : r * (q + 1) + (xcd - r) * q) + off; }
    const int nig = WGM * nN, gid = wgid / nig, fm = gid * WGM, gsz = (nM - fm) < WGM ? (nM - fm) : WGM;
    pm = fm + ((wgid % nig) % gsz); pn = (wgid % nig) / gsz;
}
struct Sched1 {
    const char *H, *WIN, *MEMN, *WK, *WV; int G, c;
    __device__ __forceinline__ bool next(int i, Unit& u) const {
        const int L = i * G + c; if (L >= 1792) return false;
        if (L < 1760) {
            int pm, pn;
            if (L < 1292) xcd_tile_order(L, 34, 38, pm, pn);
            else { xcd_tile_order(L - 1292, 26, 18, pm, pn); pn += 38; }
            u.pm = pm; u.pn = pn; u.kind = 0; u.a = H + (size_t)pm * 1048576; u.b = WIN + (size_t)pn * 1048576;
        } else if (L < 1776) { const int j = L - 1760; u.pm = j >> 2; u.pn = j & 3; u.kind = 1; u.a = MEMN + (size_t)u.pm * 1048576; u.b = WK + (size_t)u.pn * 1048576; }
        else { const int j = L - 1776; u.pm = j >> 2; u.pn = j & 3; u.kind = 2; u.a = WV + (size_t)u.pm * 1048576; u.b = MEMN + (size_t)u.pn * 1048576; }
        return true;
    }
};
struct Sched1g {
    const char *H, *WIN; int G, c;
    __device__ __forceinline__ bool next(int i, Unit& u) const {
        const int j = i * G + c; if (j >= 144) return false;
        u.pm = 26 + (j & 7); u.pn = 38 + (j >> 3); u.kind = 0;
        u.a = H + (size_t)u.pm * 1048576; u.b = WIN + (size_t)u.pn * 1048576; return true;
    }
};
struct Epi1 {
    bf16_t* PROJ; float* outK; bf16_t* KB; float* outV; bf16_t* VT; bf16_t* SUZ;
    __device__ __forceinline__ bool operator()(f32x4 (&acc)[2][2][4][2], const Unit& u, int wr, int wc, int fr, int fq) const {
        const int r0 = u.pm * 256 + wr * 64 + fr, c0 = u.pn * 256 + wc * 32 + 8 * fq;
        if (u.kind == 0) {
            const bool gate = u.pn >= 32;
            if (u.pn >= 16 && u.pn < 24) {
#pragma unroll
                for (int ai = 0; ai < 2; ++ai)
#pragma unroll
                    for (int m = 0; m < 4; ++m) { const size_t row = (size_t)(r0 + ai * 128 + m * 16);
#pragma unroll
                        for (int bj = 0; bj < 2; ++bj) { const int cc = c0 + bj * 128 - 4096;
                            *(u32x4*)(SUZ + ((size_t)(cc >> 4) * MTOK + row) * 16 + (cc & 8)) = pack8u(acc[ai][bj][m][0], acc[ai][bj][m][1]); } }
                return false;
            }
#pragma unroll
            for (int ai = 0; ai < 2; ++ai)
#pragma unroll
                for (int m = 0; m < 4; ++m) { bf16_t* rowp = PROJ + (size_t)(r0 + ai * 128 + m * 16) * NIN + c0;
#pragma unroll
                    for (int bj = 0; bj < 2; ++bj) { const u32x4 w = pack8u(acc[ai][bj][m][0], acc[ai][bj][m][1]);
                        if (gate) NTS(w, (u32x4*)(rowp + bj * 128)); else *(u32x4*)(rowp + bj * 128) = w; } }
        } else if (u.kind == 1) {
#pragma unroll
            for (int ai = 0; ai < 2; ++ai)
#pragma unroll
                for (int m = 0; m < 4; ++m) { const size_t off = (size_t)(r0 + ai * 128 + m * 16) * 1024 + c0;
#pragma unroll
                    for (int bj = 0; bj < 2; ++bj) { NTS(acc[ai][bj][m][0], (f32x4*)(outK + off + bj * 128)); NTS(acc[ai][bj][m][1], (f32x4*)(outK + off + bj * 128 + 4));
                        *(u32x4*)(KB + off + bj * 128) = pack8u(acc[ai][bj][m][0], acc[ai][bj][m][1]); } }
        } else {
            const int h = u.pm, b = u.pn;
#pragma unroll
            for (int ai = 0; ai < 2; ++ai)
#pragma unroll
                for (int m = 0; m < 4; ++m) { const int d = wr * 64 + fr + ai * 128 + m * 16;
#pragma unroll
                    for (int bj = 0; bj < 2; ++bj) { const int key0 = wc * 32 + 8 * fq + bj * 128;
                        *(u32x4*)(VT + ((size_t)((b * 4 + h) * 256 + d)) * 256 + key0) = pack8u(acc[ai][bj][m][0], acc[ai][bj][m][1]);
                        float* fp = outV + ((size_t)(b * 256 + key0)) * 1024 + h * 256 + d;
#pragma unroll
                        for (int e = 0; e < 4; ++e) { fp[(size_t)e * 1024] = acc[ai][bj][m][0][e]; fp[(size_t)(e + 4) * 1024] = acc[ai][bj][m][1][e]; } } }
        }
        return false;
    }
};

struct Sched2 {
    const char* ws; int G, c;
    __device__ __forceinline__ bool next(int i, Unit& u) const {
        int L;
        if (G == 256) { if (c < 144) { if (i >= 4) return false; L = c + 144 * i; } else { L = 576 + (c - 144) + 112 * i; } }
        else L = i * G + c;
        if (L >= 1088) return false;
        const int x = L & 7;
        if (L < 544) { const int j = L >> 3;
            if (j < 64) { u.pm = (j >> 4) * 8 + x; u.pn = j & 15; } else { const int r = (j - 64) * 8 + x; u.pm = 32 + (r >> 4); u.pn = r & 15; }
            u.kind = 0; u.a = ws + WS_YS + (size_t)u.pm * 524288; u.b = ws + WS_WG + (size_t)u.pn * 524288; }
        else { const int j = L - 544, k = j >= 272 ? 1 : 0, jj = (j - 272 * k) >> 3;
            if (jj < 32) { u.pm = (jj >> 3) * 8 + x; u.pn = jj & 7; } else { const int r = (jj - 32) * 8 + x; u.pm = 32 + (r >> 3); u.pn = r & 7; }
            u.kind = 1 + k;
            u.a = ws + WS_ACONV + (size_t)k * ((size_t)MTOK * 1024 * 2) + (size_t)u.pm * 524288; u.b = ws + WS_WC + (size_t)k * 4194304 + (size_t)u.pn * 524288; }
        return true;
    }
};
struct Epi2 {
    bf16_t* GLU; bf16_t* CONVO; bf16_t* ATTO;
    __device__ __forceinline__ bool operator()(f32x4 (&acc)[2][2][4][2], const Unit& u, int wr, int wc, int fr, int fq) const {
        const int r0 = u.pm * 256 + wr * 64 + fr;
        if (u.kind == 0) {
            const int c0 = u.pn * 128 + wc * 32 + 8 * fq;
#pragma unroll
            for (int ai = 0; ai < 2; ++ai)
#pragma unroll
                for (int m = 0; m < 4; ++m) {
                    f32x4 t0, t1;
#pragma unroll
                    for (int e = 0; e < 4; ++e) { t0[e] = acc[ai][0][m][0][e] * sigmoidf_(acc[ai][1][m][0][e]); t1[e] = acc[ai][0][m][1][e] * sigmoidf_(acc[ai][1][m][1][e]); }
                    *(u32x4*)(GLU + (size_t)(r0 + ai * 128 + m * 16) * 2048 + c0) = pack8u(t0, t1);
                }
        } else {
            bf16_t* O = u.kind == 1 ? CONVO : ATTO; const int c0 = u.pn * 256 + wc * 32 + 8 * fq;
#pragma unroll
            for (int ai = 0; ai < 2; ++ai)
#pragma unroll
                for (int m = 0; m < 4; ++m) { bf16_t* rowp = O + (size_t)(r0 + ai * 128 + m * 16) * 2048 + c0;
#pragma unroll
                    for (int bj = 0; bj < 2; ++bj) *(u32x4*)(rowp + bj * 128) = pack8u(acc[ai][bj][m][0], acc[ai][bj][m][1]); }
        }
        return false;
    }
};
__device__ __forceinline__ void merge_phase(const P& p) {
    const bf16_t* PROJ = (const bf16_t*)(p.ws + WS_PROJ); const bf16_t* GLU = (const bf16_t*)(p.ws + WS_GLU); const bf16_t* CONVO = (const bf16_t*)(p.ws + WS_CONVO);
    const bf16_t* ATTO = (const bf16_t*)(p.ws + WS_ATTO); bf16_t* MERGED = (bf16_t*)(p.ws + WS_MERGED);
    const int NT = MTOK * 256, stride = gridDim.x * 512;
    for (int t = blockIdx.x * 512 + otid(); t < NT; t += 2 * stride) {
        u32x4 L[2][6]; const int t1 = t + stride; const bool has1 = t1 < NT;
#pragma unroll
        for (int k = 0; k < 2; ++k) { const int tt = k == 0 ? t : (has1 ? t1 : t);
            const size_t row = (size_t)(tt >> 8); const int c0 = (tt & 255) * 8; const bf16_t* pr = PROJ + row * NIN + OFF_G + c0; const size_t o = row * 2048 + c0;
            L[k][0] = NTL((const u32x4*)pr); L[k][1] = NTL((const u32x4*)(pr + 2048)); L[k][2] = NTL((const u32x4*)(pr + 4096));
            L[k][3] = NTL((const u32x4*)(CONVO + o)); L[k][4] = NTL((const u32x4*)(GLU + o)); L[k][5] = NTL((const u32x4*)(ATTO + o)); }
#pragma unroll
        for (int k = 0; k < 2; ++k) { if (k == 1 && !has1) break; const int tt = k == 0 ? t : t1;
            const size_t row = (size_t)(tt >> 8); const int c0 = (tt & 255) * 8; const size_t o = row * 2048 + c0;
            float g0[8], g1[8], g2[8], cv[8], gl[8], at[8];
            unpack8(L[k][0], g0); unpack8(L[k][1], g1); unpack8(L[k][2], g2); unpack8(L[k][3], cv); unpack8(L[k][4], gl); unpack8(L[k][5], at);
            f32x4 m0, m1;
#pragma unroll
            for (int e = 0; e < 8; ++e) { const float v = sigmoidf_(g0[e]) * cv[e] + sigmoidf_(g1[e]) * gl[e] + sigmoidf_(g2[e]) * at[e]; if (e < 4) m0[e] = v; else m1[e - 4] = v; }
            *(u32x4*)(MERGED + o) = pack8u(m0, m1); }
    }
}

struct Sched3 {
    const char *MERGED, *WO; int G, c;
    __device__ __forceinline__ bool next(int i, Unit& u) const {
        const int L = i * G + c; if (L >= 256) return false;
        const int x = L & 7, j = L >> 3;
        u.pm = (j >> 3) * 8 + x; u.pn = j & 7; u.kind = 0; u.a = MERGED + (size_t)u.pm * 1048576; u.b = WO + (size_t)u.pn * 1048576; return true;
    }
};
struct Sched3b {
    const char *MERGED, *WO; int G, c;
    __device__ __forceinline__ bool next(int i, Unit& u) const {
        const int L = i * G + c; if (L >= 128) return false;
        const int tile = L >> 3, ks = L & 7; u.pm = 32 + (tile >> 3); u.pn = tile & 7; u.kind = ks;
        u.a = MERGED + (size_t)u.pm * 1048576 + (size_t)ks * 512; u.b = WO + (size_t)u.pn * 1048576 + (size_t)ks * 512; return true;
    }
};
struct Epi3 {
    bf16_t* delta; float* part;
    bool sample;
    __device__ __forceinline__ bool operator()(f32x4 (&acc)[2][2][4][2], const Unit& u, int wr, int wc, int fr, int fq) const {
        const int r0 = u.pm * 256 + wr * 64 + fr, c0 = u.pn * 256 + wc * 32 + 8 * fq;
        if (!sample) {
#pragma unroll
            for (int ai = 0; ai < 2; ++ai)
#pragma unroll
                for (int m = 0; m < 4; ++m) { bf16_t* o = delta + (size_t)(r0 + ai * 128 + m * 16) * DM + c0;
#pragma unroll
                    for (int bj = 0; bj < 2; ++bj) *(u32x4*)(o + bj * 128) = pack8u(acc[ai][bj][m][0], acc[ai][bj][m][1]); }
        } else {
            float* base = part + ((size_t)u.kind * 512 - NPROMPT) * DM;
#pragma unroll
            for (int ai = 0; ai < 2; ++ai)
#pragma unroll
                for (int m = 0; m < 4; ++m) {
                    float* o = base + (size_t)(r0 + ai * 128 + m * 16) * DM + c0;
#pragma unroll
                    for (int bj = 0; bj < 2; ++bj)
#pragma unroll
                        for (int n = 0; n < 2; ++n) *(f32x4*)(o + bj * 128 + 4 * n) = acc[ai][bj][m][n];
                }
        }
        return false;
    }
};

__device__ __forceinline__ void transpose_tile(const float* __restrict__ src, const int K, const int N, bf16_t* __restrict__ dst, const int mode, const int t, LAS float* tile) {
    const int tid = otid(); const int tn = N / 256;
    const int r = tid >> 3, c8 = (tid & 7) * 8;
    const int k0 = (t / tn) * 64, n0 = (t % tn) * 256;
    const float* s = src + (size_t)(k0 + r) * N + n0 + c8;
    f32x4 v[8];
#pragma unroll
    for (int j = 0; j < 4; ++j) { v[2 * j] = NTL((const f32x4*)(s + j * 64)); v[2 * j + 1] = NTL((const f32x4*)(s + j * 64 + 4)); }
#pragma unroll
    for (int j = 0; j < 4; ++j)
#pragma unroll
        for (int e = 0; e < 4; ++e) { tile[j * 4160 + r * 65 + c8 + e] = v[2 * j][e]; tile[j * 4160 + r * 65 + c8 + 4 + e] = v[2 * j + 1][e]; }
    __syncthreads();
#pragma unroll
    for (int j = 0; j < 4; ++j) {
        f32x4 a, b;
#pragma unroll
        for (int e = 0; e < 4; ++e) { a[e] = tile[j * 4160 + (c8 + e) * 65 + r]; b[e] = tile[j * 4160 + (c8 + 4 + e) * 65 + r]; }
        const int n = n0 + j * 64 + r;
        const int row = mode == 0 ? n : ((n >> 7) * 256 + (mode - 1) * 128 + (n & 127));
        *(u32x4*)(dst + (size_t)row * K + k0 + c8) = pack8u(a, b);
    }
    __syncthreads();
}
__device__ __forceinline__ void tload_win(const float* w_in, int t, int r, int c8, f32x4 (&v)[8]) {
    const int k0 = (t / 56) * 64, n0 = (t % 56) * 256;
    const float* s = w_in + (size_t)(k0 + r) * NIN + n0 + c8;
#pragma unroll
    for (int j = 0; j < 4; ++j) { v[2 * j] = NTL((const f32x4*)(s + j * 64)); v[2 * j + 1] = NTL((const f32x4*)(s + j * 64 + 4)); }
}
__device__ __forceinline__ void phase0(const P& p, LAS unsigned char* lds) {
    unsigned char* ws = p.ws; LAS float* tile = (LAS float*)lds;
    {
        const int tid = otid(); const int r = tid >> 3, c8 = (tid & 7) * 8;
        bf16_t* dst = (bf16_t*)(ws + WS_WIN);
        int j = blockIdx.x; f32x4 v[8];
        if (j < 1792) tload_win(p.w_in, j, r, c8, v);
        while (j < 1792) {
#pragma unroll
            for (int q = 0; q < 4; ++q)
#pragma unroll
                for (int e = 0; e < 4; ++e) { tile[q * 4160 + r * 65 + c8 + e] = v[2 * q][e]; tile[q * 4160 + r * 65 + c8 + 4 + e] = v[2 * q + 1][e]; }
            const int jn = j + gridDim.x;
            if (jn < 1792) tload_win(p.w_in, jn, r, c8, v);
            __syncthreads();
            const int k0 = (j / 56) * 64, n0 = (j % 56) * 256;
#pragma unroll
            for (int q = 0; q < 4; ++q) {
                f32x4 a, b;
#pragma unroll
                for (int e = 0; e < 4; ++e) { a[e] = tile[q * 4160 + (c8 + e) * 65 + r]; b[e] = tile[q * 4160 + (c8 + 4 + e) * 65 + r]; }
                *(u32x4*)(dst + (size_t)(n0 + q * 64 + r) * 2048 + k0 + c8) = pack8u(a, b);
            }
            __syncthreads();
            j = jn;
        }
    }
    for (int t = blockIdx.x; t < 256; t += gridDim.x) {
        if (t < 128) transpose_tile(p.w_mem_k, 2048, 1024, (bf16_t*)(ws + WS_WK), 0, t, tile);
        else transpose_tile(p.w_mem_v, 2048, 1024, (bf16_t*)(ws + WS_WV), 0, t - 128, tile);
    }
    const int t0 = otid(); const int lane = t0 & 63, gw = blockIdx.x * 8 + (t0 >> 6), nw = gridDim.x * 8;
    auto rowsrc = [&](int row) -> const float* { return row < NPROMPT ? p.x_prompt + (size_t)row * DM : (row < MTOK ? p.x_sample + (size_t)(row - NPROMPT) * DM : p.mem_prompt + (size_t)(row - MTOK) * DM); };
    f32x4 v[8], vn[8];
    if (gw < MTOK + 1024) { const float* src = rowsrc(gw);
#pragma unroll
        for (int i = 0; i < 8; ++i) v[i] = NTL((const f32x4*)(src + 4 * (lane + 64 * i))); }
    for (int row = gw; row < MTOK + 1024; row += nw) {
        const float* g = row < MTOK ? p.norm_g : p.mem_norm_g;
        bf16_t* dst = row < MTOK ? (bf16_t*)(ws + WS_H) + (size_t)row * DM : (bf16_t*)(ws + WS_MEMN) + (size_t)(row - MTOK) * DM;
        if (row + nw < MTOK + 1024) { const float* src = rowsrc(row + nw);
#pragma unroll
            for (int i = 0; i < 8; ++i) vn[i] = NTL((const f32x4*)(src + 4 * (lane + 64 * i))); }
        float s = 0.f;
#pragma unroll
        for (int i = 0; i < 8; ++i) s += (v[i][0] * v[i][0] + v[i][1] * v[i][1]) + (v[i][2] * v[i][2] + v[i][3] * v[i][3]);
#pragma unroll
        for (int o = 32; o >= 1; o >>= 1) s += __shfl_xor(s, o);
        const float rstd = 1.0f / sqrtf(s * (1.0f / 2048.0f) + 1e-6f);
#pragma unroll
        for (int i = 0; i < 8; ++i) { const f32x4 gv = *(const f32x4*)(g + 4 * (lane + 64 * i));
            u32x2 w; w.x = cvt_pk_bf16(v[i][0] * rstd * gv[0], v[i][1] * rstd * gv[1]); w.y = cvt_pk_bf16(v[i][2] * rstd * gv[2], v[i][3] * rstd * gv[3]);
            *(u32x2*)(dst + 4 * (lane + 64 * i)) = w; }
#pragma unroll
        for (int i = 0; i < 8; ++i) v[i] = vn[i];
    }
}

__device__ __forceinline__ void late_transposes(const P& p, LAS unsigned char* lds, const int first, const int stride, const int end) {
    unsigned char* ws = p.ws; LAS float* tile = (LAS float*)lds;
    for (int t = first; t < end; t += stride) {
        if (t < 128) transpose_tile(p.w_conv_out, 1024, 2048, (bf16_t*)(ws + WS_WC), 0, t, tile);
        else if (t < 256) transpose_tile(p.w_attn_out, 1024, 2048, (bf16_t*)(ws + WS_WA), 0, t - 128, tile);
        else if (t < 384) transpose_tile(p.w_glu_a, 1024, 2048, (bf16_t*)(ws + WS_WG), 1, t - 256, tile);
        else if (t < 512) transpose_tile(p.w_glu_b, 1024, 2048, (bf16_t*)(ws + WS_WG), 2, t - 384, tile);
        else transpose_tile(p.w_out, 2048, 2048, (bf16_t*)(ws + WS_WO), 0, t - 512, tile);
    }
}

template <int LEN, bool PROMPT>
__device__ __forceinline__ void conv_task(const P& p, const int r0, const int cgp, const int bs) {
    const bf16_t* PROJ = (const bf16_t*)(p.ws + WS_PROJ); bf16_t* ACONV = (bf16_t*)(p.ws + WS_ACONV);
    const int c0 = cgp * 8;
    const bf16_t* pr = PROJ + (size_t)r0 * NIN + c0;
    u32x4 lcb[LEN], lcz[LEN], lcc[LEN + 2], lch[LEN + 2];
    const bool has_halo = PROMPT && (r0 & 2047) != 0;
#pragma unroll
    for (int i = 0; i < LEN; ++i) { lcb[i] = NTL((const u32x4*)(pr + (size_t)i * NIN + OFF_CB)); lcz[i] = NTL((const u32x4*)(pr + (size_t)i * NIN + OFF_CZ));
        lcc[i + 2] = NTL((const u32x4*)(pr + (size_t)i * NIN + OFF_CC)); lch[i + 2] = NTL((const u32x4*)(pr + (size_t)i * NIN + OFF_CH)); }
#pragma unroll
    for (int i = 0; i < 2; ++i) { lcc[i] = (u32x4){0u, 0u, 0u, 0u}; lch[i] = lcc[i];
        if (has_halo) { lcc[i] = *(const u32x4*)(pr - (size_t)(2 - i) * NIN + OFF_CC); lch[i] = *(const u32x4*)(pr - (size_t)(2 - i) * NIN + OFF_CH); } }
    float w0[8], w1[8], w2[8], vm2[8], vm1[8];
    { const f32x4 a0 = *(const f32x4*)(p.conv_w + c0), a1 = *(const f32x4*)(p.conv_w + c0 + 4), b0 = *(const f32x4*)(p.conv_w + 1024 + c0), b1 = *(const f32x4*)(p.conv_w + 1024 + c0 + 4),
          d0 = *(const f32x4*)(p.conv_w + 2048 + c0), d1 = *(const f32x4*)(p.conv_w + 2048 + c0 + 4);
#pragma unroll
      for (int e = 0; e < 4; ++e) { w0[e] = a0[e]; w0[e + 4] = a1[e]; w1[e] = b0[e]; w1[e + 4] = b1[e]; w2[e] = d0[e]; w2[e + 4] = d1[e]; } }
    if (PROMPT) {
        float a[8], b[8];
        unpack8(lcc[0], a); unpack8(lch[0], b);
#pragma unroll
        for (int e = 0; e < 8; ++e) vm2[e] = a[e] * b[e];
        unpack8(lcc[1], a); unpack8(lch[1], b);
#pragma unroll
        for (int e = 0; e < 8; ++e) vm1[e] = a[e] * b[e];
    } else {
        const float* sc = p.state_conv + (size_t)bs * 2048 + c0;
        const f32x4 a0 = *(const f32x4*)sc, a1 = *(const f32x4*)(sc + 4), b0 = *(const f32x4*)(sc + 1024), b1 = *(const f32x4*)(sc + 1028);
#pragma unroll
        for (int e = 0; e < 4; ++e) { vm2[e] = a0[e]; vm2[e + 4] = a1[e]; vm1[e] = b0[e]; vm1[e + 4] = b1[e]; }
    }
#pragma unroll
    for (int i = 0; i < LEN; ++i) {
        const size_t row = (size_t)(r0 + i);
        float cb[8], cc[8], ch[8], cz[8], v[8];
        unpack8(lcb[i], cb); unpack8(lcc[i + 2], cc); unpack8(lch[i + 2], ch); unpack8(lcz[i], cz);
        f32x4 o0, o1;
#pragma unroll
        for (int e = 0; e < 8; ++e) { v[e] = cc[e] * ch[e]; const float cv = w0[e] * vm2[e] + w1[e] * vm1[e] + w2[e] * v[e]; const float r = cb[e] * cv * siluf_(cz[e]);
            if (e < 4) o0[e] = r; else o1[e - 4] = r; vm2[e] = vm1[e]; vm1[e] = v[e]; }
        *(u32x4*)(ACONV + row * 1024 + c0) = pack8u(o0, o1);
        float* dst = nullptr;
        if (PROMPT) { const int pos = (r0 + i) & 2047; if (pos >= 2046) dst = p.out + O_CP + ((size_t)((r0 + i) >> 11) * 2 + (pos - 2046)) * 1024 + c0; }
        else if (i >= 2) dst = p.out + O_CS + ((size_t)bs * 2 + (i - 2)) * 1024 + c0;
        if (dst) { *(f32x4*)dst = (f32x4){v[0], v[1], v[2], v[3]}; *(f32x4*)(dst + 4) = (f32x4){v[4], v[5], v[6], v[7]}; }
    }
}
__device__ __forceinline__ void conv_phase(const P& p) {
    const int t0 = blockIdx.x * 512 + otid(), nt = gridDim.x * 512;
    for (int task = t0; task < 262144; task += nt) conv_task<4, true>(p, (task >> 7) * 4, task & 127, 0);
    for (int task = t0; task < 16384; task += nt) conv_task<4, false>(p, NPROMPT + 4 * (task >> 7), task & 127, task >> 7);
}

struct S5In { bf16x8 U[4]; u32x2 u4[4], z4[4]; };
__device__ __forceinline__ void s5_load4(S5In& in, const bf16_t* SUZ, const size_t row0, const int g, const int g4) {
    const bf16_t* su = SUZ + ((size_t)g * MTOK + row0) * 16; const bf16_t* sz = SUZ + ((size_t)(64 + g) * MTOK + row0) * 16;
#pragma unroll
    for (int i = 0; i < 4; ++i) {
        in.U[i] = *(const bf16x8*)(su + i * 16 + 8 * (g4 & 1));
        in.u4[i] = *(const u32x2*)(su + i * 16 + 4 * g4); in.z4[i] = *(const u32x2*)(sz + i * 16 + 4 * g4);
    }
}
__device__ __forceinline__ void s5_steps4(const S5In& in, bf16_t* YS, const size_t row0, const int g, const int g4, const bool Y,
                                          const bf16x8 (&bre)[4], const bf16x8 (&bim)[4], const bf16x8 (&cf)[4], const float (&ar)[16], const float (&ai)[16], const f32x4 dsk,
                                          float (&sr)[16], float (&si)[16]) {
    const f32x4 zero4 = (f32x4){0.f, 0.f, 0.f, 0.f};
#pragma unroll
    for (int i = 0; i < 4; ++i) {
#pragma unroll
        for (int pb = 0; pb < 4; ++pb) {
            const f32x4 xr = MFMA16(bre[pb], in.U[i], zero4), xi = MFMA16(bim[pb], in.U[i], zero4);
#pragma unroll
            for (int j = 0; j < 4; ++j) { const int k = pb * 4 + j; const float nr = ar[k] * sr[k] - ai[k] * si[k] + xr[j]; const float ni = ar[k] * si[k] + ai[k] * sr[k] + xi[j]; sr[k] = nr; si[k] = ni; }
        }
        if (Y) {
            f32x4 y = zero4;
            y = MFMA16(cf[0], pack8((f32x4){sr[0], sr[1], sr[2], sr[3]}, (f32x4){sr[4], sr[5], sr[6], sr[7]}), y);
            y = MFMA16(cf[1], pack8((f32x4){sr[8], sr[9], sr[10], sr[11]}, (f32x4){sr[12], sr[13], sr[14], sr[15]}), y);
            y = MFMA16(cf[2], pack8((f32x4){si[0], si[1], si[2], si[3]}, (f32x4){si[4], si[5], si[6], si[7]}), y);
            y = MFMA16(cf[3], pack8((f32x4){si[8], si[9], si[10], si[11]}, (f32x4){si[12], si[13], si[14], si[15]}), y);
            const float uu[4] = {bf_lo(in.u4[i].x), bf_hi(in.u4[i].x), bf_lo(in.u4[i].y), bf_hi(in.u4[i].y)};
            const float zz[4] = {bf_lo(in.z4[i].x), bf_hi(in.z4[i].x), bf_lo(in.z4[i].y), bf_hi(in.z4[i].y)};
            float o[4];
#pragma unroll
            for (int j = 0; j < 4; ++j) { const float ysv = y[j] + dsk[j] * uu[j]; o[j] = gelu_tanh(ysv * siluf_(zz[j])); }
            u32x2 w; w.x = cvt_pk_bf16(o[0], o[1]); w.y = cvt_pk_bf16(o[2], o[3]);
            *(u32x2*)(YS + (row0 + i) * 1024 + g * 16 + 4 * g4) = w;
        }
    }
}
__device__ __forceinline__ void s5_coef(const P& p, int g, int pp, float dt, float& ar, float& ai, float& fr, float& fi) {
    const float lr = p.lam_re[g * 64 + pp], li = p.lam_im[g * 64 + pp];
    const float mag = expf(lr * dt), ang = li * dt; float sn, cs; sincosf(ang, &sn, &cs);
    ar = mag * cs; ai = mag * sn; const float den = lr * lr + li * li;
    fr = ((ar - 1.0f) * lr + ai * li) / den; fi = (ai * lr - (ar - 1.0f) * li) / den;
}
__device__ __forceinline__ void s5_unit(const P& p, const int unit, LAS unsigned char* lds) {
    const bf16_t* PROJ = (const bf16_t*)(p.ws + WS_SUZ); bf16_t* YS = (bf16_t*)(p.ws + WS_YS);
    const int tid = otid(), lane = tid & 63, w = tid >> 6, cl = lane & 15, g4 = lane >> 4;
    const bool prompt = unit < 256; const int g = prompt ? (unit & 63) : (unit - 256); const int b = unit >> 6;
    const float dt = expf(p.log_dt[g]);
    LAS float* E = (LAS float*)lds;
    LAS f32x4* CT = (LAS f32x4*)(lds + 65536);
    if (tid < 64) { float a_r, a_i, fr_, fi_; s5_coef(p, g, tid, dt, a_r, a_i, fr_, fi_); CT[tid] = (f32x4){a_r, a_i, fr_, fi_}; }
    __syncthreads();
    float ar[16], ai[16];
#pragma unroll
    for (int pb = 0; pb < 4; ++pb)
#pragma unroll
        for (int j = 0; j < 4; ++j) { const f32x4 t = CT[16 * pb + 4 * g4 + j]; ar[pb * 4 + j] = t[0]; ai[pb * 4 + j] = t[1]; }
    bf16x8 bre[4], bim[4], cf[4];
    const float bmask = g4 < 2 ? 1.0f : 0.0f;
#pragma unroll
    for (int pb = 0; pb < 4; ++pb) {
        const int pp = 16 * pb + cl; const f32x4 t = CT[pp]; const float fr_ = t[2] * bmask, fi_ = t[3] * bmask;
        const float* br = p.b_re + ((size_t)(g * 64 + pp)) * 16 + 8 * (g4 & 1); const float* bi = p.b_im + ((size_t)(g * 64 + pp)) * 16 + 8 * (g4 & 1);
        const f32x4 r0 = *(const f32x4*)br, r1 = *(const f32x4*)(br + 4), i0 = *(const f32x4*)bi, i1 = *(const f32x4*)(bi + 4);
        bre[pb] = pack8(fr_ * r0 - fi_ * i0, fr_ * r1 - fi_ * i1);
        bim[pb] = pack8(fr_ * i0 + fi_ * r0, fr_ * i1 + fi_ * r1);
    }
#pragma unroll
    for (int ks = 0; ks < 4; ++ks) {
        const float* cp = (ks < 2 ? p.c_re : p.c_im) + ((size_t)(g * 16 + cl)) * 64 + 32 * (ks & 1) + 4 * g4;
        f32x4 a = *(const f32x4*)cp, c = *(const f32x4*)(cp + 16);
        if (ks >= 2) { a = -a; c = -c; }
        cf[ks] = pack8(a, c);
    }
    const f32x4 dsk = *(const f32x4*)(p.ssm_d + g * 16 + 4 * g4);
    const int chain = 16 * w + cl;
    const size_t row0 = prompt ? (size_t)b * 2048 + (size_t)chain * 16 : (size_t)NPROMPT + 4 * chain;
    const size_t so = ((size_t)chain * 64 + g) * 64 + 4 * g4;
    const int nq = prompt ? 4 : 1;
    float sr[16], si[16];
#pragma unroll
    for (int k = 0; k < 16; ++k) { sr[k] = 0.f; si[k] = 0.f; }
    if (!prompt) {
#pragma unroll
        for (int pb = 0; pb < 4; ++pb) { const f32x4 a = *(const f32x4*)(p.state_re + so + 16 * pb), c = *(const f32x4*)(p.state_im + so + 16 * pb);
#pragma unroll
            for (int j = 0; j < 4; ++j) { sr[pb * 4 + j] = a[j]; si[pb * 4 + j] = c[j]; } }
    }
#pragma unroll 1
    for (int pass = prompt ? 0 : 1; pass < 2; ++pass) {
        if (pass == 1 && prompt) {
#pragma unroll
            for (int pb = 0; pb < 4; ++pb) {
                *(LAS f32x4*)(E + (chain * 2 + 0) * 64 + 16 * pb + 4 * g4) = (f32x4){sr[pb * 4], sr[pb * 4 + 1], sr[pb * 4 + 2], sr[pb * 4 + 3]};
                *(LAS f32x4*)(E + (chain * 2 + 1) * 64 + 16 * pb + 4 * g4) = (f32x4){si[pb * 4], si[pb * 4 + 1], si[pb * 4 + 2], si[pb * 4 + 3]};
            }
            __syncthreads();
            if (w == 0) {
                float a_r, a_i; { const f32x4 t = CT[lane]; a_r = t[0]; a_i = t[1]; }
#pragma unroll
                for (int q = 0; q < 4; ++q) { const float nr = a_r * a_r - a_i * a_i, ni = 2.0f * a_r * a_i; a_r = nr; a_i = ni; }
                float Fr = 0.f, Fi = 0.f;
#pragma unroll 8
                for (int k = 0; k < 128; ++k) {
                    const float er = E[(2 * k) * 64 + lane], ei = E[(2 * k + 1) * 64 + lane];
                    E[(2 * k) * 64 + lane] = Fr; E[(2 * k + 1) * 64 + lane] = Fi;
                    const float nr = a_r * Fr - a_i * Fi + er; Fi = a_r * Fi + a_i * Fr + ei; Fr = nr;
                }
                p.out[O_RP + (size_t)(b * 64 + g) * 64 + lane] = Fr; p.out[O_IP + (size_t)(b * 64 + g) * 64 + lane] = Fi;
            }
            __syncthreads();
#pragma unroll
            for (int pb = 0; pb < 4; ++pb) {
                const f32x4 a = *(LAS f32x4*)(E + (chain * 2 + 0) * 64 + 16 * pb + 4 * g4), c = *(LAS f32x4*)(E + (chain * 2 + 1) * 64 + 16 * pb + 4 * g4);
#pragma unroll
                for (int j = 0; j < 4; ++j) { sr[pb * 4 + j] = a[j]; si[pb * 4 + j] = c[j]; }
            }
        }
        S5In cur; s5_load4(cur, PROJ, row0, g, g4);
#pragma unroll 1
        for (int q = 0; q < nq; ++q) {
            S5In nxt = cur;
            if (q + 1 < nq) s5_load4(nxt, PROJ, row0 + 4 * (q + 1), g, g4);
            s5_steps4(cur, YS, row0 + 4 * q, g, g4, pass == 1, bre, bim, cf, ar, ai, dsk, sr, si);
            cur = nxt;
        }
    }
    if (!prompt) {
#pragma unroll
        for (int pb = 0; pb < 4; ++pb) {
            *(f32x4*)(p.out + O_RS + so + 16 * pb) = (f32x4){sr[pb * 4], sr[pb * 4 + 1], sr[pb * 4 + 2], sr[pb * 4 + 3]};
            *(f32x4*)(p.out + O_IS + so + 16 * pb) = (f32x4){si[pb * 4], si[pb * 4 + 1], si[pb * 4 + 2], si[pb * 4 + 3]};
        }
    }
    __syncthreads();
}

__device__ __forceinline__ void attn_prompt_unit(const P& p, const int unit, LAS unsigned char* lds) {
    const bf16_t* PROJ = (const bf16_t*)(p.ws + WS_PROJ); const bf16_t* KB = (const bf16_t*)(p.ws + WS_KB); const bf16_t* VT = (const bf16_t*)(p.ws + WS_VT);
    bf16_t* OATT = (bf16_t*)(p.ws + WS_OATT);
    const int tid = otid(), lane = tid & 63, w = tid >> 6, cl = lane & 15, g4 = lane >> 4;
    const int b = unit >> 6, h = (unit >> 4) & 3, qb = unit & 15;
    const bf16_t* kbase = KB + (size_t)(b * 256) * 1024 + h * 256;
#pragma unroll
    for (int i = 0; i < 16; ++i) { const int idx = tid + 512 * i, r = idx >> 5, m = idx & 31;
        const u32x4 v = *(const u32x4*)(kbase + (size_t)r * 1024 + m * 8); *(LAS u32x4*)(lds + r * 512 + ((m ^ (r & 15)) << 4)) = v; }
    const size_t qrow = (size_t)b * 2048 + qb * 128 + w * 16 + cl;
    const bf16_t* qp = PROJ + qrow * NIN + OFF_AQ + h * 256 + 8 * g4;
    bf16x8 qf[8];
#pragma unroll
    for (int ks = 0; ks < 8; ++ks) qf[ks] = NTL((const bf16x8*)(qp + 32 * ks));
    __syncthreads();
    f32x4 s[16];
#pragma unroll
    for (int kb = 0; kb < 16; ++kb) { s[kb] = (f32x4){0.f, 0.f, 0.f, 0.f};
#pragma unroll
        for (int ks = 0; ks < 8; ++ks) { const int key = 16 * kb + cl, m = 4 * ks + g4;
            const bf16x8 kf = *(const LAS bf16x8*)(lds + key * 512 + ((m ^ cl) << 4)); s[kb] = MFMA16(kf, qf[ks], s[kb]); }
        __builtin_amdgcn_sched_barrier(0); }
    __syncthreads();
    const bf16_t* vbase = VT + (size_t)((b * 4 + h) * 256) * 256;
    u32x4 vst[16];
#pragma unroll
    for (int i = 0; i < 16; ++i) { const int idx = tid + 512 * i, r = idx >> 5, m = idx & 31; vst[i] = *(const u32x4*)(vbase + (size_t)r * 256 + m * 8); }
    float mx = -3.0e38f;
#pragma unroll
    for (int kb = 0; kb < 16; ++kb)
#pragma unroll
        for (int j = 0; j < 4; ++j) mx = fmaxf(mx, s[kb][j]);
    mx = fmaxf(mx, __shfl_xor(mx, 16)); mx = fmaxf(mx, __shfl_xor(mx, 32));
    float sum = 0.f;
#pragma unroll
    for (int kb = 0; kb < 16; ++kb)
#pragma unroll
        for (int j = 0; j < 4; ++j) { const float e = __expf((s[kb][j] - mx) * 0.0625f); s[kb][j] = e; sum += e; }
    sum += __shfl_xor(sum, 16); sum += __shfl_xor(sum, 32);
    const float inv = rcp_(sum);
    bf16x8 pf[8];
#pragma unroll
    for (int kk = 0; kk < 8; ++kk) pf[kk] = pack8(s[2 * kk], s[2 * kk + 1]);
#pragma unroll
    for (int i = 0; i < 16; ++i) { const int idx = tid + 512 * i, r = idx >> 5, m = idx & 31; *(LAS u32x4*)(lds + r * 512 + ((m ^ (r & 15)) << 4)) = vst[i]; }
    __syncthreads();
    const bf16_t* azp = PROJ + qrow * NIN + OFF_AZ + h * 256 + 4 * g4;
    bf16_t* op = OATT + qrow * 1024 + h * 256 + 4 * g4;
    u32x2 azv[16];
#pragma unroll
    for (int db = 0; db < 16; ++db) azv[db] = NTL((const u32x2*)(azp + 16 * db));
#pragma unroll
    for (int db = 0; db < 16; ++db) {
        f32x4 o = (f32x4){0.f, 0.f, 0.f, 0.f}; const int d = 16 * db + cl;
#pragma unroll
        for (int kk = 0; kk < 8; ++kk) {
            const int ch0 = 8 * kk + g4, ch1 = ch0 + 4;
            const u32x2 lo = *(const LAS u32x2*)(lds + d * 512 + (((ch0 >> 1) ^ cl) << 4) + (ch0 & 1) * 8);
            const u32x2 hi = *(const LAS u32x2*)(lds + d * 512 + (((ch1 >> 1) ^ cl) << 4) + (ch1 & 1) * 8);
            const u32x4 vv = (u32x4){lo.x, lo.y, hi.x, hi.y};
            o = MFMA16(__builtin_bit_cast(bf16x8, vv), pf[kk], o);
        }
        const u32x2 az = azv[db];
        const float z[4] = {bf_lo(az.x), bf_hi(az.x), bf_lo(az.y), bf_hi(az.y)};
        u32x2 wv; wv.x = cvt_pk_bf16(o[0] * inv * siluf_(z[0]), o[1] * inv * siluf_(z[1])); wv.y = cvt_pk_bf16(o[2] * inv * siluf_(z[2]), o[3] * inv * siluf_(z[3]));
        *(u32x2*)(op + 16 * db) = wv;
        __builtin_amdgcn_sched_barrier(0);
    }
    __syncthreads();
}

__device__ __forceinline__ void attn_sample_pair(const P& p, const int u0, const int u1_, LAS unsigned char* lds) {
    const int u1 = u1_ < 512 ? u1_ : u0;
    const bf16_t* PROJ = (const bf16_t*)(p.ws + WS_PROJ); bf16_t* OATT = (bf16_t*)(p.ws + WS_OATT);
    const int tid = otid(), lane = tid & 63, w = tid >> 6, cl = lane & 15, g4 = lane >> 4;
    LAS float* Pw = (LAS float*)(lds + w * 512);
    LAS float* ST = (LAS float*)(lds + 4096);
    LAS float* OW = (LAS float*)(lds + 8192);
    f32x4 bA[16], bB[16], o[4], s0, s1;
    bf16x8 qf[8];
#define SA_LOADQ(unit) do { const bf16_t* qp_ = PROJ + ((size_t)NPROMPT + 4 * ((unit) >> 2) + (cl & 3)) * NIN + OFF_AQ + ((unit) & 3) * 256 + 8 * g4; \
        _Pragma("unroll") for (int ks = 0; ks < 8; ++ks) qf[ks] = *(const bf16x8*)(qp_ + 32 * ks); } while (0)
#define SA_LOADK(buf, unit, kblk) do { const float* kr_ = p.cache_k + ((size_t)((unit) >> 2) * 1024 + ((unit) & 3)) * 256 + (size_t)(32 * w + 16 * (kblk) + cl) * 1024 + 8 * g4; \
        _Pragma("unroll") for (int ks = 0; ks < 8; ++ks) { buf[2 * ks] = NTL((const f32x4*)(kr_ + 32 * ks)); buf[2 * ks + 1] = NTL((const f32x4*)(kr_ + 32 * ks + 4)); } } while (0)
#define SA_LOADV(buf, unit, half) do { const float* vr_ = p.cache_v + ((size_t)((unit) >> 2) * 1024 + ((unit) & 3)) * 256 + (size_t)(32 * w + 16 * (half)) * 1024 + 4 * lane; \
        _Pragma("unroll") for (int i = 0; i < 16; ++i) buf[i] = NTL((const f32x4*)(vr_ + (size_t)i * 1024)); } while (0)
#define SA_QK(buf, sv) do { sv = (f32x4){0.f, 0.f, 0.f, 0.f}; _Pragma("unroll") for (int ks = 0; ks < 8; ++ks) sv = MFMA16(pack8(buf[2 * ks], buf[2 * ks + 1]), qf[ks], sv); } while (0)
#define SA_PV(buf, half) do { _Pragma("unroll") for (int ii = 0; ii < 4; ++ii) _Pragma("unroll") for (int q = 0; q < 4; ++q) { const f32x4 pv_ = *(const LAS f32x4*)(Pw + q * 32 + 16 * (half) + 4 * ii); \
        o[q] += pv_[0] * buf[4 * ii] + pv_[1] * buf[4 * ii + 1] + pv_[2] * buf[4 * ii + 2] + pv_[3] * buf[4 * ii + 3]; } } while (0)
#define SA_SOFTMAX(slot) do { float m_ = fmaxf(fmaxf(fmaxf(s0[0], s0[1]), fmaxf(s0[2], s0[3])), fmaxf(fmaxf(s1[0], s1[1]), fmaxf(s1[2], s1[3]))); \
        m_ = fmaxf(m_, __shfl_xor(m_, 16)); m_ = fmaxf(m_, __shfl_xor(m_, 32)); float l_ = 0.f; \
        _Pragma("unroll") for (int j = 0; j < 4; ++j) { s0[j] = __expf((s0[j] - m_) * 0.0625f); s1[j] = __expf((s1[j] - m_) * 0.0625f); l_ += s0[j] + s1[j]; } \
        l_ += __shfl_xor(l_, 16); l_ += __shfl_xor(l_, 32); \
        if (cl < 4) { *(LAS f32x4*)(Pw + cl * 32 + 4 * g4) = s0; *(LAS f32x4*)(Pw + cl * 32 + 16 + 4 * g4) = s1; \
            if (g4 == 0) { ST[(((slot) * 8 + w) * 4 + cl) * 2] = m_; ST[(((slot) * 8 + w) * 4 + cl) * 2 + 1] = l_; } } } while (0)
#define SA_OZERO() do { _Pragma("unroll") for (int q = 0; q < 4; ++q) o[q] = (f32x4){0.f, 0.f, 0.f, 0.f}; } while (0)
#define SA_OWRITE(slot) do { _Pragma("unroll") for (int q = 0; q < 4; ++q) *(LAS f32x4*)(OW + (size_t)((((slot) * 8 + w) * 4 + q) * 256) + 4 * lane) = o[q]; } while (0)
#define SA_SB() __builtin_amdgcn_sched_barrier(0)
    SA_LOADQ(u0);
    SA_LOADK(bA, u0, 0); SA_LOADK(bB, u0, 1); SA_SB();
    SA_QK(bA, s0); SA_LOADV(bA, u0, 0); SA_SB();
    SA_QK(bB, s1); SA_LOADV(bB, u0, 1); SA_SB();
    SA_SOFTMAX(0);
    SA_LOADQ(u1);
    SA_OZERO(); SA_SB();
    SA_PV(bA, 0); SA_LOADK(bA, u1, 0); SA_SB();
    SA_PV(bB, 1); SA_LOADK(bB, u1, 1); SA_SB();
    SA_OWRITE(0);
    {
        SA_QK(bA, s0); SA_LOADV(bA, u1, 0); SA_SB();
        SA_QK(bB, s1); SA_LOADV(bB, u1, 1); SA_SB();
        SA_SOFTMAX(1);
        SA_OZERO(); SA_SB();
        SA_PV(bA, 0); SA_SB();
        SA_PV(bB, 1);
        SA_OWRITE(1);
    }
    __syncthreads();
    {
        const int slot = tid >> 8, q = (tid >> 6) & 3, d = (tid & 63) * 4;
        const int unit = slot == 0 ? u0 : u1;
        {
            float M = -3.0e38f;
#pragma unroll
            for (int ww = 0; ww < 8; ++ww) M = fmaxf(M, ST[((slot * 8 + ww) * 4 + q) * 2]);
            float L = 0.f; f32x4 a = (f32x4){0.f, 0.f, 0.f, 0.f};
#pragma unroll
            for (int ww = 0; ww < 8; ++ww) { const float f = __expf((ST[((slot * 8 + ww) * 4 + q) * 2] - M) * 0.0625f); L += f * ST[((slot * 8 + ww) * 4 + q) * 2 + 1];
                a += f * *(const LAS f32x4*)(OW + (size_t)(((slot * 8 + ww) * 4 + q) * 256) + d); }
            const float inv = rcp_(L);
            const size_t row = (size_t)NPROMPT + 4 * (unit >> 2) + q; const int h = unit & 3;
            const u32x2 az = *(const u32x2*)(PROJ + row * NIN + OFF_AZ + h * 256 + d);
            u32x2 wv; wv.x = cvt_pk_bf16(a[0] * inv * siluf_(bf_lo(az.x)), a[1] * inv * siluf_(bf_hi(az.x))); wv.y = cvt_pk_bf16(a[2] * inv * siluf_(bf_lo(az.y)), a[3] * inv * siluf_(bf_hi(az.y)));
            *(u32x2*)(OATT + row * 1024 + h * 256 + d) = wv;
        }
    }
    __syncthreads();
#undef SA_LOADQ
#undef SA_LOADK
#undef SA_LOADV
#undef SA_QK
#undef SA_PV
#undef SA_SOFTMAX
#undef SA_OZERO
#undef SA_OWRITE
#undef SA_SB
}

__device__ __forceinline__ void phase5(const P& p) {
    const float* part = (const float*)(p.ws + WS_PART);
    const int t0 = otid(); const int lane = t0 & 63, gw = blockIdx.x * 8 + (t0 >> 6), nw = gridDim.x * 8;
    for (int row = gw; row < MTOK; row += nw) {
        float* orow = p.out + (size_t)row * DM;
        f32x4 v[8]; float s = 0.f;
        if (row < NPROMPT) {
            const float* xr = p.x_prompt + (size_t)row * DM; const bf16_t* dr = (const bf16_t*)(p.ws + WS_DELTA) + (size_t)row * DM;
#pragma unroll
            for (int i = 0; i < 8; ++i) { const u32x2 d = NTL((const u32x2*)(dr + 4 * (lane + 64 * i)));
                v[i] = NTL((const f32x4*)(xr + 4 * (lane + 64 * i))) + (f32x4){bf_lo(d.x), bf_hi(d.x), bf_lo(d.y), bf_hi(d.y)}; }
        } else {
            const float* xr = p.x_sample + (size_t)(row - NPROMPT) * DM;
#pragma unroll
            for (int i = 0; i < 8; ++i) v[i] = NTL((const f32x4*)(xr + 4 * (lane + 64 * i)));
#pragma unroll 2
            for (int ks = 0; ks < 8; ++ks) { const float* pr = part + ((size_t)ks * 512 + (row - NPROMPT)) * DM;
#pragma unroll
                for (int i = 0; i < 8; ++i) v[i] += NTL((const f32x4*)(pr + 4 * (lane + 64 * i))); }
        }
#pragma unroll
        for (int i = 0; i < 8; ++i) s += (v[i][0] * v[i][0] + v[i][1] * v[i][1]) + (v[i][2] * v[i][2] + v[i][3] * v[i][3]);
#pragma unroll
        for (int o = 32; o >= 1; o >>= 1) s += __shfl_xor(s, o);
        const float rstd = 1.0f / sqrtf(s * (1.0f / 2048.0f) + 1e-6f);
#pragma unroll
        for (int i = 0; i < 8; ++i) { const f32x4 gv = *(const f32x4*)(p.final_g + 4 * (lane + 64 * i)); NTS(v[i] * rstd * gv, (f32x4*)(orow + 4 * (lane + 64 * i))); }
    }
}

#define XB_TMO      128
#define XB_XCNT(j)  (256  + 64 * (j))
#define XB_XSUB(j)  (1280 + 64 * (j))
#define XB_XGEN(j)  (2304 + 64 * (j))
#define XB_TOP      3328
#define XB_TOPGEN   3392
#define XB_SPIN_CAP (1u << 20)
__device__ __forceinline__ unsigned xb_ld(unsigned* p)              { return __hip_atomic_load(p, __ATOMIC_RELAXED, __HIP_MEMORY_SCOPE_AGENT); }
__device__ __forceinline__ unsigned xb_add(unsigned* p, unsigned v) { return __hip_atomic_fetch_add(p, v, __ATOMIC_RELAXED, __HIP_MEMORY_SCOPE_AGENT); }
__device__ __forceinline__ unsigned xb_xcc_id() { return (unsigned)__builtin_amdgcn_s_getreg((3 << 11) | 20) & 0xFu; }
#define XB_SPIN(cond, bar) do { unsigned _sp = 0; while (cond) { __builtin_amdgcn_s_sleep(1); \
    if ((++_sp & 255u) == 0u) { if (xb_ld(&(bar)[XB_TMO])) break; if (_sp > XB_SPIN_CAP) { atomicAdd(&(bar)[XB_TMO], 1u); break; } } } } while (0)
struct XcdBarrier { unsigned* bar; unsigned x; volatile LAS unsigned* st; };
__device__ __forceinline__ XcdBarrier xcd_barrier_post(unsigned* bar, volatile LAS unsigned* st) {
    XcdBarrier b; b.bar = bar; b.x = xb_xcc_id(); b.st = st;
    if (threadIdx.x == 0) (void)xb_add(&bar[XB_XCNT(b.x)], 1u);
    return b;
}
__device__ __forceinline__ void xcd_barrier_complete(unsigned* bar, unsigned x, unsigned& nloc, unsigned& nx) {
    const unsigned G = gridDim.x * gridDim.y * gridDim.z;
    unsigned sum, cnt, mine, sp = 0u;
    for (;;) {
        sum = 0u; cnt = 0u; mine = 0u;
#pragma unroll
        for (unsigned j = 0; j < 16; ++j) { const unsigned c = xb_ld(&bar[XB_XCNT(j)]); sum += c; cnt += (c > 0u) ? 1u : 0u; mine = (j == x) ? c : mine; }
        if (sum == G) break;
        __builtin_amdgcn_s_sleep(1);
        if ((++sp & 255u) == 0u) { if (xb_ld(&bar[XB_TMO])) break; if (sp > XB_SPIN_CAP) { atomicAdd(&bar[XB_TMO], 1u); break; } }
    }
    nloc = mine > 0u ? mine : 1u; nx = cnt > 0u ? cnt : 1u;
}
__device__ __forceinline__ void xcd_barrier(const XcdBarrier& b) {
    asm volatile("s_waitcnt vmcnt(0)" ::: "memory");
    __syncthreads();
    if (threadIdx.x == 0) {
        unsigned* bar = b.bar;
        __builtin_amdgcn_s_waitcnt(0);
        unsigned nloc = b.st[0], nx = b.st[1];
        if (nloc == 0u) { xcd_barrier_complete(bar, b.x, nloc, nx); b.st[0] = nloc; b.st[1] = nx; }
        const unsigned old = xb_add(&bar[XB_XSUB(b.x)], 1u);
        const unsigned gen = old / nloc;
        if (old + 1u == (gen + 1u) * nloc) {
            __builtin_amdgcn_fence(__ATOMIC_RELEASE, "agent");
            asm volatile("s_waitcnt vmcnt(0)" ::: "memory");
            const unsigned og = xb_add(&bar[XB_TOP], 1u);
            const unsigned tg = og / nx;
            if (og + 1u == (tg + 1u) * nx) xb_add(&bar[XB_TOPGEN], 1u);
            else XB_SPIN(xb_ld(&bar[XB_TOPGEN]) == tg, bar);
            __builtin_amdgcn_fence(__ATOMIC_ACQUIRE, "agent");
            xb_add(&bar[XB_XGEN(b.x)], 1u);
            asm volatile("s_waitcnt vmcnt(0)" ::: "memory");
        } else {
            XB_SPIN(xb_ld(&bar[XB_XGEN(b.x)]) == gen, bar);
            __builtin_amdgcn_fence(__ATOMIC_ACQUIRE, "agent");
            asm volatile("s_waitcnt vmcnt(0)" ::: "memory");
        }
    }
    __syncthreads();
}

__global__ void __launch_bounds__(512, 2) mega_fwd(P p) {
    extern __shared__ __attribute__((aligned(16))) unsigned char shm[];
    LAS unsigned char* lds = (LAS unsigned char*)shm;
    cg::grid_group grid = cg::this_grid();
    unsigned char* ws = p.ws;
    const int G = gridDim.x, c = blockIdx.x;
    volatile LAS unsigned* bst = (volatile LAS unsigned*)(lds + 131072);
    if (threadIdx.x == 0) { bst[0] = 0u; bst[1] = 0u; }
    __syncthreads();
    const XcdBarrier xbar = xcd_barrier_post((unsigned*)(ws + WS_BAR), bst);
    if (p.out == nullptr) grid.sync();
#define GSYNC() xcd_barrier(xbar)

#ifndef PHMASK
#define PHMASK 0xffff
#endif
#ifndef REPMASK
#define REPMASK 0
#endif
#define NREP(bit) ((REPMASK & (bit)) ? 2 : 1)
#ifndef TPHASE
#define TPHASE -1
#endif
#ifndef TMULT
#define TMULT 4
#endif
    unsigned long long ts[8]; int nts = 0;
#define STAMP() do { if (TPHASE >= 0 && TPHASE < 10) { ts[nts] = wall_clock64(); } ++nts; } while (0)
    STAMP();
    for (int rep = 0; rep < NREP(1); ++rep) if (PHMASK & 1) phase0(p, lds);
    GSYNC(); STAMP();

    for (int rep = 0; rep < NREP(2); ++rep) if (PHMASK & 2) {
        Sched1 S{(const char*)(ws + WS_H), (const char*)(ws + WS_WIN), (const char*)(ws + WS_MEMN), (const char*)(ws + WS_WK), (const char*)(ws + WS_WV), G, c};
        Epi1 E{(bf16_t*)(ws + WS_PROJ), p.out + O_MK, (bf16_t*)(ws + WS_KB), p.out + O_MV, (bf16_t*)(ws + WS_VT), (bf16_t*)(ws + WS_SUZ)};
        pg8::gemm_phase(lds, 2048, 2048, S, E);
    }
    GSYNC(); STAMP();

    for (int rep = 0; rep < NREP(4); ++rep) {
        unsigned long long m0 = 0, m1 = 0, m2 = 0, m3 = 0, m4 = 0;
        if (TPHASE >= 10) m0 = wall_clock64();
        const int sg = (c >> 3) & 3;
        if (sg == 0) for (int u = c; u < 512; u += 2 * G) attn_sample_pair(p, u, u + G, lds);
        if (TPHASE >= 10) m1 = wall_clock64();
        for (int u = c; u < 256; u += G) s5_unit(p, u, lds);
        for (int u = 256 + (G - 1 - c); u < 320; u += G) s5_unit(p, u, lds);
        if (TPHASE >= 10) m2 = wall_clock64();
        if (sg == 1) for (int u = c; u < 512; u += 2 * G) attn_sample_pair(p, u, u + G, lds);
        for (int u = c; u < 256; u += G) attn_prompt_unit(p, u, lds);
        if (TPHASE >= 10) m3 = wall_clock64();
        if (sg == 2) for (int u = c; u < 512; u += 2 * G) attn_sample_pair(p, u, u + G, lds);
        conv_phase(p);
        if (sg == 3) for (int u = c; u < 512; u += 2 * G) attn_sample_pair(p, u, u + G, lds);
        late_transposes(p, lds, c, G, G == 256 ? 512 : 768);
        if (TPHASE >= 10) { m4 = wall_clock64(); ts[0] = 0; ts[1] = TPHASE == 10 ? m1 - m0 : (TPHASE == 11 ? m2 - m1 : (TPHASE == 12 ? m3 - m2 : m4 - m3)); }
    }
    GSYNC(); STAMP();

    for (int rep = 0; rep < NREP(8); ++rep) if (PHMASK & 64) {
        { Sched1g Sg{(const char*)(ws + WS_H), (const char*)(ws + WS_WIN), G, c}; Epi1 Eg{(bf16_t*)(ws + WS_PROJ), p.out + O_MK, (bf16_t*)(ws + WS_KB), p.out + O_MV, (bf16_t*)(ws + WS_VT), (bf16_t*)(ws + WS_SUZ)}; pg8::gemm_phase(lds, 2048, 2048, Sg, Eg); }
        if (G == 256 && c >= 144) late_transposes(p, lds, 512 + (c - 144), 112, 768);
        Sched2 S{(const char*)ws, G, c};
        Epi2 E{(bf16_t*)(ws + WS_GLU), (bf16_t*)(ws + WS_CONVO), (bf16_t*)(ws + WS_ATTO)};
        pg8::gemm_phase(lds, 1024, 1024, S, E);
    }
    GSYNC(); STAMP();

    for (int rep = 0; rep < NREP(32); ++rep) merge_phase(p);
    GSYNC(); STAMP();

    for (int rep = 0; rep < NREP(16); ++rep) if (PHMASK & 128) {
        { Sched3 S{(const char*)(ws + WS_MERGED), (const char*)(ws + WS_WO), G, c}; Epi3 E{(bf16_t*)(ws + WS_DELTA), (float*)(ws + WS_PART), false}; pg8::gemm_phase(lds, 2048, 2048, S, E); }
        { Sched3b S{(const char*)(ws + WS_MERGED), (const char*)(ws + WS_WO), G, c}; Epi3 E{(bf16_t*)(ws + WS_DELTA), (float*)(ws + WS_PART), true}; pg8::gemm_phase(lds, 256, 2048, S, E); }
    }
    GSYNC(); STAMP();

    if (PHMASK & 256) phase5(p);
    STAMP();
    if (TPHASE >= 0 && blockIdx.x == 0 && threadIdx.x == 0) {
        const unsigned long long d = (TPHASE >= 10 ? ts[1] - ts[0] : ts[TPHASE + 1] - ts[TPHASE]) * TMULT, t0 = wall_clock64();
        while (wall_clock64() - t0 < d) __builtin_amdgcn_s_sleep(16);
    }
}

extern "C" void kernel_launch(void* const* d_in, const int* in_sizes, int n_in, void* d_out, int out_size, void* d_ws, size_t ws_size, hipStream_t stream) {
    static int grid = 0;
    if (grid == 0) {
        int dev = 0, cus = 0, per_cu = 0;
        hipGetDevice(&dev);
        hipDeviceGetAttribute(&cus, hipDeviceAttributeMultiprocessorCount, dev);
        if (hipFuncSetAttribute((const void*)mega_fwd, hipFuncAttributeMaxDynamicSharedMemorySize, LDS_BYTES) != hipSuccess) fprintf(stderr, "kernel_launch: hipFuncSetAttribute failed\n");
        if (hipOccupancyMaxActiveBlocksPerMultiprocessor(&per_cu, (const void*)mega_fwd, 512, LDS_BYTES) != hipSuccess || per_cu < 1) per_cu = 1;
        (void)hipGetLastError();
        grid = cus * per_cu;
        if (ws_size < WS_END) fprintf(stderr, "kernel_launch: workspace too small (%zu < %zu)\n", ws_size, (size_t)WS_END);
    }
    P p{};
    const float** pp = (const float**)&p;
    for (int i = 0; i < 28; ++i) pp[i] = (const float*)d_in[i];
    p.out = (float*)d_out; p.ws = (unsigned char*)d_ws;
    void* args[] = {&p};
    (void)hipMemsetAsync((unsigned char*)d_ws + WS_BAR, 0, 16384, stream);
    hipError_t e = hipLaunchCooperativeKernel((const void*)mega_fwd, dim3(grid), dim3(512), args, LDS_BYTES, stream);
    if (e != hipSuccess) fprintf(stderr, "cooperative launch failed: %s (grid %d)\n", hipGetErrorString(e), grid);
}
```
